# Optimizing an MI355X kernel written in HIP

```python
import math
import jax
import jax.numpy as jnp
from jax import lax
import numpy as np

D_MODEL = 2048
BATCH = 4
SEQ = 2048
DEPTH = 2

GRID_W = 64
CTX_LEN = 256
Q_BLOCK = 128
NORM_EPS = 1e-6
ROPE_BASE = 10000.0
FOURIER_W = D_MODEL // 2
FOURIER_GROUPS = 4
FOURIER_GROUP_W = FOURIER_W // FOURIER_GROUPS
DIFF_HEAD_DIM = 128
DIFF_HEADS = (D_MODEL - FOURIER_W) // (2 * DIFF_HEAD_DIM)
DIFF_QK_W = DIFF_HEADS * 2 * DIFF_HEAD_DIM
DIFF_V_W = DIFF_HEADS * 2 * DIFF_HEAD_DIM
EVEN_IN_W = FOURIER_W + 2 * DIFF_QK_W + DIFF_V_W
EVEN_OUT_W = FOURIER_W + DIFF_V_W
MLA_HEADS = D_MODEL // 128
MLA_Q_LORA = 512
MLA_KV_LORA = 512
MLA_NOPE = 128
MLA_ROPE = 64
MLA_V = 128
MLA_SCALE = (MLA_NOPE + MLA_ROPE) ** -0.5
FFN_DENSE = 5632
N_EXPERTS = 8
TOP_K = 2
FFN_EXPERT = 7168
ADA_INIT = 0.5
N_EVEN = (DEPTH + 1) // 2
N_ODD = DEPTH // 2

kernel_name = 'hybrid_fourier_diffattn_mla_moe_dit'


def rms_norm(x, g):
    xf = x.astype(jnp.float32)
    y = xf * lax.rsqrt(jnp.mean(xf * xf, axis=-1, keepdims=True) + NORM_EPS)
    return (y * g.astype(jnp.float32)).astype(x.dtype)


def modulate(x, shift, scale):
    return x * (1 + scale) + shift


def _rotate(u, pos):
    a = u.shape[-1]
    inv = ROPE_BASE ** (-jnp.arange(0, a, 2, dtype=jnp.float32) / a)
    ang = pos.astype(jnp.float32)[:, None] * inv[None, :]
    ang = ang.reshape((pos.shape[0],) + (1,) * (u.ndim - 3) + (a // 2,))
    cos, sin = jnp.cos(ang), jnp.sin(ang)
    u1, u2 = jnp.split(u, 2, axis=-1)
    return jnp.concatenate([u1 * cos - u2 * sin, u2 * cos + u1 * sin], axis=-1)


def axial_rope(x, row_pos, col_pos):
    xf = x.astype(jnp.float32)
    half = x.shape[-1] // 2
    out = jnp.concatenate([_rotate(xf[..., :half], row_pos), _rotate(xf[..., half:], col_pos)], axis=-1)
    return out.astype(x.dtype)


def map_query_blocks(fn, qs):
    n = qs[0].shape[1]
    nb = n // Q_BLOCK

    def split(a):
        return jnp.moveaxis(a.reshape((a.shape[0], nb, Q_BLOCK) + a.shape[2:]), 1, 0)

    out = lax.map(lambda blk: fn(*blk), tuple(split(a) for a in qs))
    out = jnp.moveaxis(out, 0, 1)
    return out.reshape((out.shape[0], n) + out.shape[3:])


def fourier_mix(f):
    b, n, _ = f.shape
    u = f.astype(jnp.float32).reshape(b, n, FOURIER_GROUPS, FOURIER_GROUP_W)
    y = jnp.fft.fft2(u, axes=(1, 3), norm='ortho').real
    return y.reshape(b, n, FOURIER_W).astype(f.dtype)


def diff_attn_block(q, k, v, lam):
    s = jnp.einsum('bqhcd,bkhcd->bhcqk', q, k, preferred_element_type=jnp.float32) * (DIFF_HEAD_DIM ** -0.5)
    p = jax.nn.softmax(s, axis=-1)
    a = p[:, :, 0] - lam * p[:, :, 1]
    return jnp.einsum('bhqk,bkhe->bqhe', a.astype(v.dtype), v)


def even_mixer(h, hc, w_in, w_out, lam_vec, subln_g, lam_init, row_pos, col_pos, ctx_out):
    def heads_qk(t):
        return t.reshape(t.shape[0], t.shape[1], DIFF_HEADS, 2, DIFF_HEAD_DIM)

    def heads_v(t):
        return t.reshape(t.shape[0], t.shape[1], DIFF_HEADS, 2 * DIFF_HEAD_DIM)

    lv = lam_vec.astype(jnp.float32)
    lam = jnp.exp(jnp.sum(lv[0] * lv[1])) - jnp.exp(jnp.sum(lv[2] * lv[3])) + lam_init

    def finish(f, o):
        o = rms_norm(o, subln_g) * (1.0 - lam_init)
        o = o.reshape(o.shape[0], o.shape[1], DIFF_V_W)
        return jnp.concatenate([fourier_mix(f), o], axis=-1) @ w_out

    f_l, q_l, k_l, v_l = jnp.split(h @ w_in, [FOURIER_W, FOURIER_W + DIFF_QK_W, FOURIER_W + 2 * DIFF_QK_W], axis=-1)
    k_c, v_c = jnp.split(hc @ w_in[:, FOURIER_W + DIFF_QK_W:], [DIFF_QK_W], axis=-1)
    q_l = axial_rope(heads_qk(q_l), row_pos, col_pos)
    k_l = axial_rope(heads_qk(k_l), row_pos, col_pos)
    k_c, v_c = heads_qk(k_c), heads_v(v_c)
    k_all = jnp.concatenate([k_c, k_l], axis=1)
    v_all = jnp.concatenate([v_c, heads_v(v_l)], axis=1)
    o_l = map_query_blocks(lambda qb: diff_attn_block(qb, k_all, v_all, lam), (q_l,))
    y_l = finish(f_l, o_l)
    y_c = None
    if ctx_out:
        f_c, q_c = jnp.split(hc @ w_in[:, :FOURIER_W + DIFF_QK_W], [FOURIER_W], axis=-1)
        o_c = map_query_blocks(lambda qb: diff_attn_block(qb, k_c, v_c, lam), (heads_qk(q_c),))
        y_c = finish(f_c, o_c)
    return y_l, y_c


def mla_block(qn, qr, kn, kr, v):
    s = (jnp.einsum('bqhd,bkhd->bhqk', qn, kn, preferred_element_type=jnp.float32)
         + jnp.einsum('bqhr,bkr->bhqk', qr, kr, preferred_element_type=jnp.float32)) * MLA_SCALE
    p = jax.nn.softmax(s, axis=-1)
    return jnp.einsum('bhqk,bkhd->bqhd', p.astype(v.dtype), v)


def mla_mixer(h, hc, w_dq, q_norm_g, w_uq, w_dkv, kv_norm_g, w_ukv, w_o, row_pos, col_pos, ctx_out):
    def queries(u):
        cq = rms_norm(u @ w_dq, q_norm_g)
        q = (cq @ w_uq).reshape(u.shape[0], u.shape[1], MLA_HEADS, MLA_NOPE + MLA_ROPE)
        return q[..., :MLA_NOPE], q[..., MLA_NOPE:]

    def keys_values(u):
        ckv = u @ w_dkv
        c_kv = rms_norm(ckv[..., :MLA_KV_LORA], kv_norm_g)
        kv = (c_kv @ w_ukv).reshape(u.shape[0], u.shape[1], MLA_HEADS, MLA_NOPE + MLA_V)
        return kv[..., :MLA_NOPE], ckv[..., MLA_KV_LORA:], kv[..., MLA_NOPE:]

    def out(o):
        return o.reshape(o.shape[0], o.shape[1], MLA_HEADS * MLA_V) @ w_o

    qn, qr = queries(h)
    qr = axial_rope(qr, row_pos, col_pos)
    kn_l, kr_l, v_l = keys_values(h)
    kr_l = axial_rope(kr_l, row_pos, col_pos)
    kn_c, kr_c, v_c = keys_values(hc)
    kn_all = jnp.concatenate([kn_c, kn_l], axis=1)
    kr_all = jnp.concatenate([kr_c, kr_l], axis=1)
    v_all = jnp.concatenate([v_c, v_l], axis=1)
    y_l = out(map_query_blocks(lambda a, b: mla_block(a, b, kn_all, kr_all, v_all), (qn, qr)))
    y_c = None
    if ctx_out:
        qn_c, qr_c = queries(hc)
        y_c = out(map_query_blocks(lambda a, b: mla_block(a, b, kn_c, kr_c, v_c), (qn_c, qr_c)))
    return y_l, y_c


def swiglu(u, wg, wu, wd):
    return (jax.nn.silu(u @ wg) * (u @ wu)) @ wd


def moe_ffn(u, router, wg, wu, wd):
    b, n, d = u.shape
    flat = u.reshape(b * n, d)
    logits = jnp.dot(flat, router, preferred_element_type=jnp.float32)
    top_vals, top_idx = lax.top_k(logits, TOP_K)
    top_w = jax.nn.softmax(top_vals, axis=-1)
    gate = jnp.sum(jax.nn.one_hot(top_idx, N_EXPERTS, dtype=jnp.float32) * top_w[..., None], axis=1).astype(u.dtype)
    out = jnp.zeros_like(flat)
    for e in range(N_EXPERTS):
        out = out + gate[:, e:e + 1] * swiglu(flat, wg[e], wu[e], wd[e])
    return out.reshape(b, n, d)


def setup_inputs(seed: int = 0) -> dict:
    key = jax.random.key(seed)
    ks = iter(jax.random.split(key, 40))
    D = D_MODEL

    def nrm(shape, scale):
        return jax.random.normal(next(ks), shape, jnp.float32) * scale

    def gain(shape):
        return 1.0 + nrm(shape, 0.01)

    return {
        'x': nrm((BATCH, SEQ, D), 1.0),
        'c': nrm((BATCH, D), 1.0),
        'ctx': nrm((BATCH, CTX_LEN, D), 1.0),
        'c_ctx': nrm((D,), 1.0),
        'ada_w': nrm((DEPTH, D, 6 * D), ADA_INIT * D ** -0.5),
        'ada_b': nrm((DEPTH, 6 * D), 0.02),
        'norm1_g': gain((DEPTH, D)),
        'norm2_g': gain((DEPTH, D)),
        'ev_w_in': nrm((N_EVEN, D, EVEN_IN_W), D ** -0.5),
        'ev_w_out': nrm((N_EVEN, EVEN_OUT_W, D), EVEN_OUT_W ** -0.5),
        'ev_lambda': nrm((N_EVEN, 4, DIFF_HEAD_DIM), 0.1),
        'ev_subln_g': gain((N_EVEN, 2 * DIFF_HEAD_DIM)),
        'od_w_dq': nrm((N_ODD, D, MLA_Q_LORA), D ** -0.5),
        'od_q_norm_g': gain((N_ODD, MLA_Q_LORA)),
        'od_w_uq': nrm((N_ODD, MLA_Q_LORA, MLA_HEADS * (MLA_NOPE + MLA_ROPE)), MLA_Q_LORA ** -0.5),
        'od_w_dkv': nrm((N_ODD, D, MLA_KV_LORA + MLA_ROPE), D ** -0.5),
        'od_kv_norm_g': gain((N_ODD, MLA_KV_LORA)),
        'od_w_ukv': nrm((N_ODD, MLA_KV_LORA, MLA_HEADS * (MLA_NOPE + MLA_V)), MLA_KV_LORA ** -0.5),
        'od_w_o': nrm((N_ODD, MLA_HEADS * MLA_V, D), (MLA_HEADS * MLA_V) ** -0.5),
        'ffn_w_gate': nrm((N_EVEN, D, FFN_DENSE), D ** -0.5),
        'ffn_w_up': nrm((N_EVEN, D, FFN_DENSE), D ** -0.5),
        'ffn_w_down': nrm((N_EVEN, FFN_DENSE, D), FFN_DENSE ** -0.5),
        'moe_router': nrm((N_ODD, D, N_EXPERTS), D ** -0.5),
        'moe_w_gate': nrm((N_ODD, N_EXPERTS, D, FFN_EXPERT), D ** -0.5),
        'moe_w_up': nrm((N_ODD, N_EXPERTS, D, FFN_EXPERT), D ** -0.5),
        'moe_w_down': nrm((N_ODD, N_EXPERTS, FFN_EXPERT, D), FFN_EXPERT ** -0.5),
        'final_norm_g': gain((D,)),
    }


def reference(x, c, ctx, c_ctx, ada_w, ada_b, norm1_g, norm2_g, ev_w_in, ev_w_out, ev_lambda, ev_subln_g,
              od_w_dq, od_q_norm_g, od_w_uq, od_w_dkv, od_kv_norm_g, od_w_ukv, od_w_o,
              ffn_w_gate, ffn_w_up, ffn_w_down, moe_router, moe_w_gate, moe_w_up, moe_w_down, final_norm_g):
    n_lat = x.shape[1]
    rows = n_lat // GRID_W
    row_pos = jnp.repeat(jnp.arange(rows, dtype=jnp.int32), GRID_W)
    col_pos = jnp.tile(jnp.arange(GRID_W, dtype=jnp.int32), rows)
    s_c = jax.nn.silu(c)
    s_cc = jax.nn.silu(c_ctx)

    def channel_mixer(i, j, u):
        if i % 2 == 0:
            return swiglu(u, ffn_w_gate[j], ffn_w_up[j], ffn_w_down[j])
        return moe_ffn(u, moe_router[j], moe_w_gate[j], moe_w_up[j], moe_w_down[j])

    x_l, x_c = x, ctx
    for i in range(DEPTH):
        last = i == DEPTH - 1
        j = i // 2
        mod_l = jnp.split((s_c @ ada_w[i] + ada_b[i])[:, None, :], 6, axis=-1)
        mod_c = jnp.split(s_cc @ ada_w[i] + ada_b[i], 6, axis=-1)
        h = modulate(rms_norm(x_l, norm1_g[i]), mod_l[0], mod_l[1])
        hc = modulate(rms_norm(x_c, norm1_g[i]), mod_c[0], mod_c[1])
        if i % 2 == 0:
            lam_init = 0.8 - 0.6 * math.exp(-0.3 * i)
            y, yc = even_mixer(h, hc, ev_w_in[j], ev_w_out[j], ev_lambda[j], ev_subln_g[j], lam_init,
                               row_pos, col_pos, not last)
        else:
            y, yc = mla_mixer(h, hc, od_w_dq[j], od_q_norm_g[j], od_w_uq[j], od_w_dkv[j], od_kv_norm_g[j],
                              od_w_ukv[j], od_w_o[j], row_pos, col_pos, not last)
        x_l = x_l + mod_l[2] * y
        h2 = modulate(rms_norm(x_l, norm2_g[i]), mod_l[3], mod_l[4])
        x_l = x_l + mod_l[5] * channel_mixer(i, j, h2)
        if not last:
            x_c = x_c + mod_c[2] * yc
            h2c = modulate(rms_norm(x_c, norm2_g[i]), mod_c[3], mod_c[4])
            x_c = x_c + mod_c[5] * channel_mixer(i, j, h2c)
    return rms_norm(x_l, final_norm_g)
```

```cpp
#ifndef ORACLE
#define ORACLE 0
#endif
#include <hip/hip_runtime.h>
#include <cstdio>
#include <cstdint>

constexpr int D = 2048, NB = 4, SEQ = 2048, CTX = 256, TPB = SEQ + CTX  , NTOK = NB * TPB  ;
constexpr int FW = 1024, QKW = 1024, VW = 1024, EIN = 4096, FFD = 5632, NEXP = 8, FFE = 7168;
constexpr int QLORA = 512, KVLORA = 512, MROPE = 64, MH = 16;
constexpr int NSLOT = 2 * NB * SEQ + NEXP * 256;
constexpr float EPS = 1e-6f;

typedef unsigned short bf16_t;
typedef float f32x4 __attribute__((ext_vector_type(4)));
typedef short bf16x8 __attribute__((ext_vector_type(8)));

__device__ __forceinline__ float bf2f(bf16_t v) { return __uint_as_float(((unsigned)v) << 16); }
__device__ __forceinline__ bf16_t f2bf(float f) { unsigned u = __float_as_uint(f); u += 0x7fffu + ((u >> 16) & 1u); return (bf16_t)(u >> 16); }
__device__ __forceinline__ float wave_sum(float v) {
#pragma unroll
    for (int o = 1; o < 64; o <<= 1) v += __shfl_xor(v, o);
    return v;
}
__device__ __forceinline__ float wave_max(float v) {
#pragma unroll
    for (int o = 1; o < 64; o <<= 1) v = fmaxf(v, __shfl_xor(v, o));
    return v;
}
__device__ __forceinline__ int lane_id() { int l; asm volatile("v_mbcnt_lo_u32_b32 %0, -1, 0\n\tv_mbcnt_hi_u32_b32 %0, -1, %0" : "=v"(l)); return l; }
__device__ __forceinline__ int tid_from(int wv) { asm volatile("" : "+s"(wv)); return wv * 64 + lane_id(); }
#define TID_FROM(wv) tid_from(wv)
constexpr float W8_GU = 32.f, W8_DN = 64.f, A8_ACT = 4.f;
__device__ __forceinline__ unsigned pack4_fp8(float a, float b, float c, float d) {
    a = fminf(fmaxf(a, -448.f), 448.f); b = fminf(fmaxf(b, -448.f), 448.f); c = fminf(fmaxf(c, -448.f), 448.f); d = fminf(fmaxf(d, -448.f), 448.f);
    int w = 0; w = __builtin_amdgcn_cvt_pk_fp8_f32(a, b, w, false); w = __builtin_amdgcn_cvt_pk_fp8_f32(c, d, w, true); return (unsigned)w;
}
__device__ __forceinline__ float silu_f(float x) { return x / (1.f + expf(-x)); }

constexpr size_t al(size_t x) { return (x + 4095) / 4096 * 4096; }
constexpr size_t WS_CTL = 0;
constexpr size_t WS_XS = 1u << 20;
constexpr size_t WS_MODS = WS_XS + al((size_t)NTOK * D * 4);
constexpr size_t WS_TABD = WS_MODS + al((size_t)2 * 5 * 6 * D * 4);
constexpr size_t WS_TABM = WS_TABD + al(64 * 32 * 8);
constexpr size_t WS_SCAL = WS_TABM + al(64 * 16 * 8);
constexpr size_t WS_H = WS_SCAL + 4096;
constexpr size_t WS_ROUTE = WS_H + al((size_t)NTOK * D * 2);
constexpr size_t RT_TE = 0, RT_TG = (size_t)NTOK * 8, RT_TSLOT = (size_t)NTOK * 16, RT_SLOTTOK = (size_t)NTOK * 24, RT_CNT = RT_SLOTTOK + (size_t)NSLOT * 4, RT_OFFS = RT_CNT + 64;
constexpr size_t WT_IN = WS_ROUTE + al(RT_OFFS + 64);
constexpr size_t WT_OUT = WT_IN + al((size_t)4096 * 2048 * 2);
constexpr size_t WT_GU = WT_OUT + al((size_t)2048 * 2048 * 2);
constexpr size_t WT_DN = WT_GU + al((size_t)2 * FFD * 2048 * 2);
constexpr size_t WT_DQKV = WT_DN + al((size_t)2048 * FFD * 2);
constexpr size_t WT_UQ = WT_DQKV + al((size_t)1280 * 2048 * 2);
constexpr size_t WT_UKV = WT_UQ + al((size_t)3072 * 512 * 2);
constexpr size_t WT_O = WT_UKV + al((size_t)4096 * 512 * 2);
constexpr size_t WT_MGU = WT_O + al((size_t)2048 * 2048 * 2);
constexpr size_t WT_MD = WT_MGU + al((size_t)8 * 2 * FFE * 2048);
constexpr size_t WS_WCS = WT_MD + al((size_t)8 * 2048 * FFE);
constexpr size_t WS_DFTN = WS_WCS + al(512 * 256 * 2);
constexpr size_t WS_DFTC = WS_DFTN + al((size_t)2048 * 4096 * 2);
constexpr size_t WS_ACTS = WS_DFTC + al(256 * 512 * 2);
constexpr size_t A0_F = WS_ACTS;
constexpr size_t A0_Q = A0_F + al((size_t)NTOK * 1024 * 2);
constexpr size_t A0_K = A0_Q + al((size_t)NTOK * 1024 * 2);
constexpr size_t A0_V = A0_K + al((size_t)NTOK * 1024 * 2);
constexpr size_t A0_VT = A0_V + al((size_t)NTOK * 1024 * 2);
constexpr size_t A0_VTC = A0_VT + al((size_t)16 * 256 * 4096 * 2);
constexpr size_t A0_OD = A0_VTC + al((size_t)16 * 256 * 512 * 2);
constexpr size_t A0_MIX = A0_OD + al((size_t)NTOK * 2048 * 4);
constexpr size_t A0_ACT = A0_MIX + al((size_t)NTOK * 2048 * 2);
constexpr size_t A0_END = A0_ACT + al((size_t)NTOK * FFD * 2);
constexpr size_t A1_CQ = WS_ACTS;
constexpr size_t A1_CKV = A1_CQ + al((size_t)NTOK * 512 * 4);
constexpr size_t A1_KR = A1_CKV + al((size_t)NTOK * 512 * 4);
constexpr size_t A1_CQN = A1_KR + al((size_t)NTOK * 64 * 2);
constexpr size_t A1_CKVN = A1_CQN + al((size_t)NTOK * 512 * 2);
constexpr size_t A1_QM = A1_CKVN + al((size_t)NTOK * 512 * 2);
constexpr size_t A1_KVM = A1_QM + al((size_t)NTOK * 3072 * 2);
constexpr size_t A1_OM = A1_KVM + al((size_t)NTOK * 4096 * 2);
constexpr size_t A1_AS = A1_OM + al((size_t)NTOK * 2048 * 2);
constexpr size_t A1_ACT2 = A1_AS + al((size_t)NSLOT * 2048);
constexpr size_t A1_Y = WS_ACTS;
constexpr size_t A1_END = A1_ACT2 + al((size_t)NSLOT * FFE);
static_assert(A1_Y + (size_t)NSLOT * 2048 * 4 <= A1_AS, "Y overlays only the dead MLA buffers");
constexpr size_t WS_ARENA_END = A0_END > A1_END ? A0_END : A1_END;
constexpr size_t WS_SLAB = WS_ARENA_END;
constexpr size_t SLAB_BYTES = (size_t)384 << 18;
constexpr size_t WS_END = WS_SLAB + SLAB_BYTES;
constexpr size_t WS_SCR = WS_SLAB;
constexpr size_t WS_SCR_XS = WS_END;

struct P {
    const float *x, *c, *ctx, *c_ctx, *ada_w, *ada_b, *norm1_g, *norm2_g, *ev_w_in, *ev_w_out, *ev_lambda, *ev_subln_g;
    const float *od_w_dq, *od_q_norm_g, *od_w_uq, *od_w_dkv, *od_kv_norm_g, *od_w_ukv, *od_w_o;
    const float *ffn_w_gate, *ffn_w_up, *ffn_w_down, *moe_router, *moe_w_gate, *moe_w_up, *moe_w_down, *final_norm_g;
    float* out; unsigned char* ws;
};
#define WSP(T, off) ((T*)(p.ws + (off)))

__device__ __forceinline__ int mod_row(int R) { const int b = R / TPB, j = R - b * TPB; return j < CTX ? 4 : b; }

__device__ __forceinline__ void ph_prologue(const P& p, int bid, int nb, float* lds_f, int wv) {
    int tid_ = TID_FROM(wv); asm volatile("" : "+v"(tid_)); const int tid = tid_, lane = tid & 63, wave = tid >> 6;
    float* XS = WSP(float, WS_XS);
    if (ORACLE) for (size_t i = (size_t)bid * 512 + tid; i < (size_t)NTOK * (D / 4); i += (size_t)nb * 512) {
        const int R = (int)(i / (D / 4)), c4 = (int)(i % (D / 4)); const int b = R / TPB, j = R - b * TPB;
        const float* src = j < CTX ? p.ctx + ((size_t)(b * CTX + j)) * D : p.x + ((size_t)(b * SEQ + (j - CTX))) * D;
        ((f32x4*)XS)[i] = ((const f32x4*)src)[c4];
    }
    if (bid == 0) {
        float2* TD = WSP(float2, WS_TABD); float2* TM = WSP(float2, WS_TABM);
        for (int i = tid; i < 64 * 32; i += 512) { const int pos = i / 32, fi = i % 32; const double inv = pow(10000.0, -(double)(2 * fi) / 64.0), a = (double)pos * inv; TD[i] = make_float2((float)cos(a), (float)sin(a)); }
        for (int i = tid; i < 64 * 16; i += 512) { const int pos = i / 16, fi = i % 16; const double inv = pow(10000.0, -(double)(2 * fi) / 32.0), a = (double)pos * inv; TM[i] = make_float2((float)cos(a), (float)sin(a)); }
        if (wave == 0) {
            float s01 = 0.f, s23 = 0.f;
            for (int i = lane; i < 128; i += 64) { s01 += p.ev_lambda[i] * p.ev_lambda[128 + i]; s23 += p.ev_lambda[256 + i] * p.ev_lambda[384 + i]; }
            s01 = wave_sum(s01); s23 = wave_sum(s23);
            if (lane == 0) WSP(float, WS_SCAL)[0] = expf(s01) - expf(s23) + 0.2f;
        }
    }
    float* S = lds_f;
    float* RED = lds_f + 5 * 2048;
    for (int i = tid; i < 5 * D; i += 512) { const int bb = i / D, k = i % D; const float v = bb < 4 ? p.c[bb * D + k] : p.c_ctx[k]; S[i] = silu_f(v); }
    __syncthreads();
    float* MODS = WSP(float, WS_MODS);
    for (int it = bid; it < 2 * 128; it += nb) {
        const int layer = it >> 7, cg = it & 127, ln = lane < 48 ? lane : 47, col = cg * 96 + ln * 2;
        const float* W = p.ada_w + (size_t)layer * D * 6 * D + col;
        float a0[5], a1[5];
#pragma unroll
        for (int bb = 0; bb < 5; ++bb) { a0[bb] = 0.f; a1[bb] = 0.f; }
        const int kb = wave * 256;
#pragma unroll 1
        for (int k0 = 0; k0 < 256; k0 += 16) {
            float2 w[16];
#pragma unroll
            for (int u = 0; u < 16; ++u) w[u] = *(const float2*)(W + (size_t)(kb + k0 + u) * 6 * D);
#pragma unroll
            for (int u = 0; u < 16; ++u) {
#pragma unroll
                for (int bb = 0; bb < 5; ++bb) { const float s = S[bb * D + kb + k0 + u]; a0[bb] += s * w[u].x; a1[bb] += s * w[u].y; } }
        }
        if (lane < 48) {
#pragma unroll
            for (int bb = 0; bb < 5; ++bb) { RED[(wave * 5 + bb) * 96 + lane * 2] = a0[bb]; RED[(wave * 5 + bb) * 96 + lane * 2 + 1] = a1[bb]; } }
        __syncthreads();
        for (int i = tid; i < 5 * 96; i += 512) { const int bb = i / 96, cc = i % 96; float s = 0.f;
#pragma unroll
            for (int w = 0; w < 8; ++w) s += RED[(w * 5 + bb) * 96 + cc];
            MODS[((size_t)layer * 5 + bb) * 6 * D + cg * 96 + cc] = s + p.ada_b[(size_t)layer * 6 * D + cg * 96 + cc]; }
        __syncthreads();
    }
}

__device__ __forceinline__ const float* in_row(const P& p, int R) { const int b = R / TPB, j = R - b * TPB; return j < CTX ? p.ctx + ((size_t)(b * CTX + j)) * D : p.x + ((size_t)(b * SEQ + (j - CTX))) * D; }
template <bool FROM_IN = false> __device__ __forceinline__ void ph_norm_mod(const P& p, const float* g, int layer, int csh, int csc, int bid, int nb, int wv) {
    int tid_ = TID_FROM(wv); asm volatile("" : "+v"(tid_)); const int tid = tid_, lane = tid & 63, wave = tid >> 6;
    const float* XS = WSP(float, WS_XS); const float* MODS = WSP(float, WS_MODS) + (size_t)layer * 5 * 6 * D; bf16_t* H = WSP(bf16_t, WS_H);
    for (int R = bid * 8 + wave; R < NTOK; R += nb * 8) {
        const f32x4* xr = (const f32x4*)(FROM_IN ? in_row(p, R) : XS + (size_t)R * D); f32x4 v[8]; float ss = 0.f;
#pragma unroll
        for (int j = 0; j < 8; ++j) { v[j] = xr[lane + 64 * j]; ss += v[j].x * v[j].x + v[j].y * v[j].y + v[j].z * v[j].z + v[j].w * v[j].w; }
        const float rstd = 1.0f / sqrtf(wave_sum(ss) * (1.f / D) + EPS);
        const float* mr = MODS + (size_t)mod_row(R) * 6 * D;
#pragma unroll
        for (int j = 0; j < 8; ++j) { const int c0 = (lane + 64 * j) * 4; const f32x4 gg = *(const f32x4*)(g + c0), sh = *(const f32x4*)(mr + csh * D + c0), sc = *(const f32x4*)(mr + csc * D + c0);
            const f32x4 o = (v[j] * rstd * gg) * (sc + 1.f) + sh;
            ushort4 w; w.x = f2bf(o.x); w.y = f2bf(o.y); w.z = f2bf(o.z); w.w = f2bf(o.w);
            *(ushort4*)(H + (size_t)R * D + c0) = w; }
    }
}

__device__ __forceinline__ void ph_subln(const P& p, int bid, int nb, int wv) {
    int tid_ = TID_FROM(wv); asm volatile("" : "+v"(tid_)); const int tid = tid_, lane = tid & 63, wave = tid >> 6;
    const float* OD = WSP(float, A0_OD); bf16_t* MIX = WSP(bf16_t, A0_MIX); const float lam = WSP(float, WS_SCAL)[0];
    const f32x4 gg = *(const f32x4*)(p.ev_subln_g + lane * 4);
    for (int it0 = bid * 8 + wave; it0 < NTOK * 4; it0 += nb * 8 * 4) {
        f32x4 o0[4], o1[4];
#pragma unroll
        for (int u = 0; u < 4; ++u) { const int it = it0 + u * nb * 8; if (it < NTOK * 4) { o0[u] = *(const f32x4*)(OD + ((size_t)it * 2 + 0) * 256 + lane * 4); o1[u] = *(const f32x4*)(OD + ((size_t)it * 2 + 1) * 256 + lane * 4); } else { o0[u] = o1[u] = (f32x4){0.f, 0.f, 0.f, 0.f}; } }
#pragma unroll
        for (int u = 0; u < 4; ++u) { const int it = it0 + u * nb * 8; const int R = it >> 2, h = it & 3;
            const f32x4 o = o0[u] - o1[u] * lam;
            const float rstd = 1.0f / sqrtf(wave_sum(o.x * o.x + o.y * o.y + o.z * o.z + o.w * o.w) * (1.f / 256.f) + EPS);
            const f32x4 r = o * rstd * gg * 0.8f;
            ushort4 w; w.x = f2bf(r.x); w.y = f2bf(r.y); w.z = f2bf(r.z); w.w = f2bf(r.w);
            if (it < NTOK * 4) *(ushort4*)(MIX + (size_t)R * 2048 + 1024 + h * 256 + lane * 4) = w; }
    }
}

__device__ __forceinline__ void ph_lora_norm(const P& p, int bid, int nb, int wv) {
    int tid_ = TID_FROM(wv); asm volatile("" : "+v"(tid_)); const int tid = tid_, lane = tid & 63, wave = tid >> 6;
    for (int it = bid * 8 + wave; it < NTOK * 2; it += nb * 8) {
        const int R = it >> 1, which = it & 1;
        const float* src = (which ? WSP(float, A1_CKV) : WSP(float, A1_CQ)) + (size_t)R * 512; const float* g = which ? p.od_kv_norm_g : p.od_q_norm_g;
        bf16_t* dst = (which ? WSP(bf16_t, A1_CKVN) : WSP(bf16_t, A1_CQN)) + (size_t)R * 512;
        f32x4 v[2]; float ss = 0.f;
#pragma unroll
        for (int j = 0; j < 2; ++j) { v[j] = *(const f32x4*)(src + (lane + 64 * j) * 4); ss += v[j].x * v[j].x + v[j].y * v[j].y + v[j].z * v[j].z + v[j].w * v[j].w; }
        const float rstd = 1.0f / sqrtf(wave_sum(ss) * (1.f / 512.f) + EPS);
#pragma unroll
        for (int j = 0; j < 2; ++j) { const int c0 = (lane + 64 * j) * 4; const f32x4 gg = *(const f32x4*)(g + c0); const f32x4 o = v[j] * rstd * gg;
            ushort4 w; w.x = f2bf(o.x); w.y = f2bf(o.y); w.z = f2bf(o.z); w.w = f2bf(o.w); *(ushort4*)(dst + c0) = w; }
    }
}

__device__ __forceinline__ void ph_route(const P& p, int bid, int nb, float* rt  , int wv) {
    int tid_ = TID_FROM(wv); asm volatile("" : "+v"(tid_)); const int tid = tid_, lane = tid & 63, wave = tid >> 6;
    const float* XS = WSP(float, WS_XS); const float* MODS = WSP(float, WS_MODS) + (size_t)1 * 5 * 6 * D; bf16_t* H = WSP(bf16_t, WS_H);
    const float* g = p.norm2_g + D; int* TE = (int*)(p.ws + WS_ROUTE + RT_TE); float* TG = (float*)(p.ws + WS_ROUTE + RT_TG);
    for (int i = tid; i < D * 2; i += 512) { const f32x4 v = ((const f32x4*)p.moe_router)[i]; const int k = i >> 1, e0 = (i & 1) * 4; rt[(e0 + 0) * D + k] = v.x; rt[(e0 + 1) * D + k] = v.y; rt[(e0 + 2) * D + k] = v.z; rt[(e0 + 3) * D + k] = v.w; }
    __syncthreads();
    for (int t0 = (bid * 8 + wave) * 4; t0 < NB * SEQ; t0 += nb * 8 * 4) {
        const int b = t0 / SEQ, R0 = b * TPB + CTX + (t0 - b * SEQ);
        const float* mr = MODS + (size_t)b * 6 * D;
        f32x4 am[8], bm[8];
#pragma unroll
        for (int j = 0; j < 8; ++j) { const int c0 = (lane + 64 * j) * 4; const f32x4 gg = *(const f32x4*)(g + c0), sc = *(const f32x4*)(mr + 4 * D + c0); am[j] = gg * (sc + 1.f); bm[j] = *(const f32x4*)(mr + 3 * D + c0); }
        f32x4 v[8], vn[8];
#pragma unroll
        for (int j = 0; j < 8; ++j) v[j] = ((const f32x4*)(XS + (size_t)R0 * D))[lane + 64 * j];
#pragma unroll
        for (int k = 0; k < 4; ++k) {
            const int R = R0 + k;
            if (k < 3) {
#pragma unroll
                for (int j = 0; j < 8; ++j) vn[j] = ((const f32x4*)(XS + (size_t)(R + 1) * D))[lane + 64 * j]; }
            float ss = 0.f;
#pragma unroll
            for (int j = 0; j < 8; ++j) ss += v[j].x * v[j].x + v[j].y * v[j].y + v[j].z * v[j].z + v[j].w * v[j].w;
            const float rstd = 1.0f / sqrtf(wave_sum(ss) * (1.f / D) + EPS);
            float lg[8];
#pragma unroll
            for (int e = 0; e < 8; ++e) lg[e] = 0.f;
#pragma unroll
            for (int j = 0; j < 8; ++j) { const int c0 = (lane + 64 * j) * 4;
                const f32x4 o = (v[j] * rstd) * am[j] + bm[j];
                *(unsigned*)((unsigned char*)H + (size_t)R * D + c0) = pack4_fp8(o.x, o.y, o.z, o.w);
#pragma unroll
                for (int e = 0; e < 8; ++e) { const f32x4 r4 = *(const f32x4*)(rt + e * D + c0); lg[e] += (o.x * r4.x + o.y * r4.y) + (o.z * r4.z + o.w * r4.w); }
                asm volatile("" ::: "memory"); }
#pragma unroll
            for (int e = 0; e < 8; ++e) lg[e] = wave_sum(lg[e]);
            if (lane == 0) {
                int e1 = 0; float v1 = lg[0];
#pragma unroll
                for (int e = 1; e < 8; ++e) if (lg[e] > v1) { v1 = lg[e]; e1 = e; }
                int e2 = -1; float v2 = -3.0e38f;
#pragma unroll
                for (int e = 0; e < 8; ++e) if (e != e1 && lg[e] > v2) { v2 = lg[e]; e2 = e; }
                const float ex = expf(v2 - v1), w1 = 1.f / (1.f + ex), w2 = ex / (1.f + ex);
                TE[R * 2] = e1; TE[R * 2 + 1] = e2; TG[R * 2] = w1; TG[R * 2 + 1] = w2;
            }
#pragma unroll
            for (int j = 0; j < 8; ++j) v[j] = vn[j];
        }
    }
}

__device__ __forceinline__ void ph_sort(const P& p, int bid, int* lds_i, int wv) {
    if (bid != 0) return;
    int tid_ = TID_FROM(wv); asm volatile("" : "+v"(tid_)); const int tid = tid_;
    const int* TE = (const int*)(p.ws + WS_ROUTE + RT_TE); int* TSLOT = (int*)(p.ws + WS_ROUTE + RT_TSLOT); int* SLOTTOK = (int*)(p.ws + WS_ROUTE + RT_SLOTTOK);
    int* CNT = (int*)(p.ws + WS_ROUTE + RT_CNT); int* OFFS = (int*)(p.ws + WS_ROUTE + RT_OFFS);
    int* cn = lds_i;
    int* offs = lds_i + 8 * 512;
    int* tot = offs + 16;
    int c0 = 0, c1 = 0, c2 = 0, c3 = 0, c4 = 0, c5 = 0, c6 = 0, c7 = 0;
    for (int i = 0; i < 16; ++i) { const int t = tid * 16 + i, b = t / SEQ, R = b * TPB + CTX + (t - b * SEQ);
        for (int k = 0; k < 2; ++k) { const int e = TE[R * 2 + k]; c0 += e == 0; c1 += e == 1; c2 += e == 2; c3 += e == 3; c4 += e == 4; c5 += e == 5; c6 += e == 6; c7 += e == 7; } }
    cn[0 * 512 + tid] = c0; cn[1 * 512 + tid] = c1; cn[2 * 512 + tid] = c2; cn[3 * 512 + tid] = c3; cn[4 * 512 + tid] = c4; cn[5 * 512 + tid] = c5; cn[6 * 512 + tid] = c6; cn[7 * 512 + tid] = c7;
    __syncthreads();
    {
        const int e = tid >> 6, ln = tid & 63; int v[8]; int run = 0;
#pragma unroll
        for (int j = 0; j < 8; ++j) { const int t = cn[e * 512 + ln * 8 + j]; v[j] = run; run += t; }
        int incl = run;
#pragma unroll
        for (int o = 1; o < 64; o <<= 1) { const int n = __shfl_up(incl, o); if (ln >= o) incl += n; }
        const int excl = incl - run;
#pragma unroll
        for (int j = 0; j < 8; ++j) cn[e * 512 + ln * 8 + j] = v[j] + excl;
        if (ln == 63) tot[e] = incl;
    }
    __syncthreads();
    if (tid == 0) { int o = 0; for (int e = 0; e < 8; ++e) { offs[e] = o; OFFS[e] = o; CNT[e] = tot[e]; o += (tot[e] + 255) / 256 * 256; } offs[8] = o; OFFS[8] = o; }
    __syncthreads();
    for (int i = tid; i < NSLOT; i += 512) SLOTTOK[i] = -1;
    __syncthreads();
    int r0 = cn[0 * 512 + tid] + offs[0], r1 = cn[1 * 512 + tid] + offs[1], r2 = cn[2 * 512 + tid] + offs[2], r3 = cn[3 * 512 + tid] + offs[3];
    int r4 = cn[4 * 512 + tid] + offs[4], r5 = cn[5 * 512 + tid] + offs[5], r6 = cn[6 * 512 + tid] + offs[6], r7 = cn[7 * 512 + tid] + offs[7];
    for (int i = 0; i < 16; ++i) { const int t = tid * 16 + i, b = t / SEQ, R = b * TPB + CTX + (t - b * SEQ);
        for (int k = 0; k < 2; ++k) { const int e = TE[R * 2 + k]; int s;
            s = e == 0 ? r0 : e == 1 ? r1 : e == 2 ? r2 : e == 3 ? r3 : e == 4 ? r4 : e == 5 ? r5 : e == 6 ? r6 : r7;
            r0 += e == 0; r1 += e == 1; r2 += e == 2; r3 += e == 3; r4 += e == 4; r5 += e == 5; r6 += e == 6; r7 += e == 7;
            TSLOT[R * 2 + k] = s; SLOTTOK[s] = R; } }
}

__device__ __forceinline__ void ph_gather(const P& p, int bid, int nb, int wv) {
    int tid_ = TID_FROM(wv); asm volatile("" : "+v"(tid_)); const int tid = tid_, lane = tid & 63, wave = tid >> 6;
    const int* SLOTTOK = (const int*)(p.ws + WS_ROUTE + RT_SLOTTOK); const int* OFFS = (const int*)(p.ws + WS_ROUTE + RT_OFFS);
    const unsigned char* H8 = WSP(unsigned char, WS_H); unsigned char* AS = WSP(unsigned char, A1_AS); const int total = OFFS[8];
    for (int s0 = bid * 8 + wave; s0 < total; s0 += nb * 8 * 4) {
        int Rr[4];
#pragma unroll
        for (int u = 0; u < 4; ++u) { const int s = s0 + u * nb * 8; Rr[u] = SLOTTOK[s < total ? s : total - 1]; }
        uint4 v[4][2];
#pragma unroll
        for (int u = 0; u < 4; ++u) { const uint4* src = (const uint4*)(H8 + (size_t)(Rr[u] > 0 ? Rr[u] : 0) * D);
#pragma unroll
            for (int j = 0; j < 2; ++j) v[u][j] = src[lane + 64 * j]; }
#pragma unroll
        for (int u = 0; u < 4; ++u) { const int s = s0 + u * nb * 8; const bool pad = Rr[u] < 0; uint4* dst = (uint4*)(AS + (size_t)(s < total ? s : total - 1) * D);
#pragma unroll
            for (int j = 0; j < 2; ++j) { uint4 w = v[u][j]; if (pad) w = make_uint4(0, 0, 0, 0); if (s < total) dst[lane + 64 * j] = w; } }
    }
}

__device__ __forceinline__ void ph_final(const P& p, int bid, int nb, int wv) {
    int tid_ = TID_FROM(wv); asm volatile("" : "+v"(tid_)); const int tid = tid_, lane = tid & 63, wave = tid >> 6;
    const float* XS = WSP(float, WS_XS); const float* MODS = WSP(float, WS_MODS) + (size_t)1 * 5 * 6 * D; const float* Y = WSP(float, A1_Y);
    const float* TG = (const float*)(p.ws + WS_ROUTE + RT_TG); const int* TSLOT = (const int*)(p.ws + WS_ROUTE + RT_TSLOT);
    for (int t = bid * 8 + wave; t < NB * SEQ; t += nb * 8) {
        const int b = t / SEQ, R = b * TPB + CTX + (t - b * SEQ);
        const float g1 = TG[R * 2], g2 = TG[R * 2 + 1]; const int s1 = TSLOT[R * 2], s2 = TSLOT[R * 2 + 1];
        const float* mr = MODS + (size_t)b * 6 * D + 5 * D;
        f32x4 v[8]; float ss = 0.f;
#pragma unroll
        for (int j = 0; j < 8; ++j) { const int c0 = (lane + 64 * j) * 4;
            const f32x4 xv = *(const f32x4*)(XS + (size_t)R * D + c0), y1 = *(const f32x4*)(Y + (size_t)s1 * D + c0), y2 = *(const f32x4*)(Y + (size_t)s2 * D + c0), m5 = *(const f32x4*)(mr + c0);
            v[j] = xv + m5 * (y1 * g1 + y2 * g2); ss += v[j].x * v[j].x + v[j].y * v[j].y + v[j].z * v[j].z + v[j].w * v[j].w; }
        const float rstd = 1.0f / sqrtf(wave_sum(ss) * (1.f / D) + EPS);
#pragma unroll
        for (int j = 0; j < 8; ++j) { const int c0 = (lane + 64 * j) * 4; const f32x4 gg = *(const f32x4*)(p.final_norm_g + c0); *(f32x4*)(p.out + (size_t)t * D + c0) = v[j] * rstd * gg; }
    }
}


#define LAS __attribute__((address_space(3)))
typedef unsigned u32x4 __attribute__((ext_vector_type(4)));
typedef unsigned u32x2 __attribute__((ext_vector_type(2)));
typedef int i32x4 __attribute__((ext_vector_type(4)));
__device__ __forceinline__ unsigned cvt_pk_bf16(float lo, float hi) { unsigned r; asm volatile("v_cvt_pk_bf16_f32 %0, %1, %2" : "=v"(r) : "v"(lo), "v"(hi)); return r; }
__device__ __forceinline__ void store4bf(bf16_t* dst, const f32x4& v) { u32x2 w; w.x = cvt_pk_bf16(v[0], v[1]); w.y = cvt_pk_bf16(v[2], v[3]); *(u32x2*)dst = w; }
typedef float f32x2 __attribute__((ext_vector_type(2)));
__device__ __forceinline__ f32x2 swiglu2(f32x2 g, f32x2 u, float c1, float kinv) {
    const f32x2 t = g * c1; f32x2 e; e.x = __builtin_amdgcn_exp2f(t.x); e.y = __builtin_amdgcn_exp2f(t.y);
    const f32x2 d = e * kinv + kinv; f32x2 r; r.x = __builtin_amdgcn_rcpf(d.x); r.y = __builtin_amdgcn_rcpf(d.y);
    return (g * u) * r;
}
__device__ __forceinline__ float fast_silu(float x) { return x * __builtin_amdgcn_rcpf(1.f + __builtin_amdgcn_exp2f(-1.4426950408889634f * x)); }

constexpr int NWAVES = 8, RING_BYTES = 131072, MISC_OFF = RING_BYTES + 320, LDS_BYTES = 147456;
constexpr int CW_QUEUE = 2048;
constexpr int CW_DONE = 132096;
constexpr int CW_FILL = 140288;
#ifndef FILL
#define FILL 1
#endif
constexpr int CW_BAR = 4096;
constexpr int CW_ERR = 131072;

#define XB_TMO      128
#define XB_XCNT(j)  (256  + 64 * (j))
#define XB_XSUB(j)  (1280 + 64 * (j))
#define XB_XGEN(j)  (2304 + 64 * (j))
#define XB_TOP      3328
#define XB_TOPGEN   3392
#define XCD_BAR_WORDS 3456
#define XB_SPIN_CAP (1u << 18)

__device__ __forceinline__ unsigned xb_ld(unsigned* p)              { return __hip_atomic_load(p, __ATOMIC_RELAXED, __HIP_MEMORY_SCOPE_AGENT); }
__device__ __forceinline__ unsigned xb_add(unsigned* p, unsigned v) { return __hip_atomic_fetch_add(p, v, __ATOMIC_RELAXED, __HIP_MEMORY_SCOPE_AGENT); }
__device__ __forceinline__ unsigned xb_xcc_id() { return (unsigned)__builtin_amdgcn_s_getreg((3 << 11) | 20) & 0xFu; }
#define XB_SPIN(cond, bar) do { unsigned _sp = 0; while (cond) { __builtin_amdgcn_s_sleep(1); \
    if ((++_sp & 255u) == 0u) { if (xb_ld(&(bar)[XB_TMO])) break; if (_sp > XB_SPIN_CAP) { atomicAdd(&(bar)[XB_TMO], 1u); break; } } } } while (0)

struct XcdBarrier {
    unsigned* bar; unsigned x;
    volatile LAS unsigned* st;
};
__device__ __forceinline__ XcdBarrier xcd_barrier_post(unsigned* bar, volatile LAS unsigned* st, int wv) {
    XcdBarrier b; b.bar = bar; b.x = xb_xcc_id(); b.st = st;
    if (wv == 0 && lane_id() == 0) (void)xb_add(&bar[XB_XCNT(b.x)], 1u);
    return b;
}
__device__ __forceinline__ void xcd_barrier_complete(unsigned* bar, unsigned x, unsigned& nloc, unsigned& nx) {
    const unsigned G = gridDim.x * gridDim.y * gridDim.z;
    unsigned sum, cnt, mine, sp = 0u;
    for (;;) {
        sum = 0u; cnt = 0u; mine = 0u;
#pragma unroll
        for (unsigned j = 0; j < 16; ++j) { const unsigned c = xb_ld(&bar[XB_XCNT(j)]); sum += c; cnt += (c > 0u) ? 1u : 0u; mine = (j == x) ? c : mine; }
        if (sum == G) break;
        __builtin_amdgcn_s_sleep(1);
        if ((++sp & 255u) == 0u) { if (xb_ld(&bar[XB_TMO])) break; if (sp > XB_SPIN_CAP) { atomicAdd(&bar[XB_TMO], 1u); break; } }
    }
    nloc = mine > 0u ? mine : 1u; nx = cnt > 0u ? cnt : 1u;
}
__device__ __forceinline__ void xcd_barrier(const XcdBarrier& b, int wv) {
    asm volatile("s_waitcnt vmcnt(0)" ::: "memory");
    __syncthreads();
    if (wv == 0 && lane_id() == 0) {
        unsigned* bar = b.bar;
        __builtin_amdgcn_s_waitcnt(0);
        unsigned nloc = b.st[0], nx = b.st[1];
        if (nloc == 0u) { xcd_barrier_complete(bar, b.x, nloc, nx); b.st[0] = nloc; b.st[1] = nx; }
        const unsigned old = xb_add(&bar[XB_XSUB(b.x)], 1u);
        const unsigned gen = old / nloc;
        if (old + 1u == (gen + 1u) * nloc) {
            __builtin_amdgcn_fence(__ATOMIC_RELEASE, "agent");
            asm volatile("s_waitcnt vmcnt(0)" ::: "memory");
            const unsigned og = xb_add(&bar[XB_TOP], 1u);
            const unsigned tg = og / nx;
            if (og + 1u == (tg + 1u) * nx) xb_add(&bar[XB_TOPGEN], 1u);
            else XB_SPIN(xb_ld(&bar[XB_TOPGEN]) == tg, bar);
            __builtin_amdgcn_fence(__ATOMIC_ACQUIRE, "agent");
            xb_add(&bar[XB_XGEN(b.x)], 1u);
            asm volatile("s_waitcnt vmcnt(0)" ::: "memory");
        } else {
            XB_SPIN(xb_ld(&bar[XB_XGEN(b.x)]) == gen, bar);
            __builtin_amdgcn_fence(__ATOMIC_ACQUIRE, "agent");
            asm volatile("s_waitcnt vmcnt(0)" ::: "memory");
        }
    }
    __syncthreads();
}

namespace pg8 {
#define PG8_LAS __attribute__((address_space(3)))
constexpr int BM = 256, BK = 64, HALF = 128, HTB = HALF * BK * 2  , STAGE_BYTES = 8 * HTB, NXCD = 8, WGM = 8;
__host__ __device__ __forceinline__ int lds_byte(int r, int c) { const int st = (r >> 4) * 2 + (c >> 5), rr = r & 15, cc = c & 31, ob = rr * 64 + cc * 2; return st * 1024 + (ob ^ (((ob >> 9) & 1) << 5)); }
__host__ __device__ __forceinline__ void stage_rc(int b, int& R, int& C) { const int st = b / 1024, sb = b % 1024, swz = sb ^ (((sb >> 9) & 1) << 5); R = (st >> 1) * 16 + swz / 64; C = (st & 1) * 32 + (swz % 64) / 2; }

struct Unit { const char* A; const char* B; int pm, pn, z, nt; int ti, ks, nks, pad; };
struct Dims { int lda, ldb; float* slabs; };

template <class F> struct Epi {
    F f;
    __device__ __forceinline__ void operator()(const f32x4 (&acc)[2][2][4][2], const Unit& u, int wr, int wc, int fr, int fq) const {
        asm volatile("" : "+v"(fr), "+v"(fq));
#pragma unroll
        for (int ai = 0; ai < 2; ++ai)
#pragma unroll
            for (int m = 0; m < 4; ++m) { const int rt = ai * HALF + wr * 64 + m * 16 + fr;
#pragma unroll
                for (int bj = 0; bj < 2; ++bj) f.put(u, rt, bj * HALF + wc * 32, fq, acc[ai][bj][m][0], acc[ai][bj][m][1]); }
    }
};

template <bool FP8 = false, class EpiT, class Sched>
__device__ __forceinline__ void gemm_phase(PG8_LAS unsigned char* lds, const Dims g, const Sched& S, const EpiT& E, int wv) {
    int tid_ = TID_FROM(wv); asm volatile("" : "+v"(tid_));
    const int tid = tid_, wid = __builtin_amdgcn_readfirstlane(tid >> 6), lane = tid & 63, wr = wid >> 2, wc = wid & 3, fr = lane & 15, fq = lane >> 4;
    unsigned voffA[2], voffB[2];
#pragma unroll
    for (int i = 0; i < 2; ++i) { int R, C; stage_rc(tid * 16 + i * 8192, R, C); voffA[i] = (unsigned)(R * g.lda + C) * 2u; voffB[i] = (unsigned)(R * g.ldb + C) * 2u; }
    const size_t kstep = (size_t)(BK * 2);
    const size_t hstepA = (size_t)HALF * g.lda * 2, hstepB = (size_t)HALF * g.ldb * 2;
    const unsigned ldsw = (unsigned)wid * 1024u;
    const int aoff = lds_byte(wr * 64 + fr, fq * 8), boff = lds_byte(wc * 32 + fr, fq * 8);
#define PG8_SA(b, h) (((b) * 2 + (h)) * HTB)
#define PG8_SB(b, h) ((4 + (b) * 2 + (h)) * HTB)
#define PG8_STAGE(bufoff, gbase, voff) do { const char* g_ = (const char*)(gbase); asm volatile("" : "+s"(g_));     \
        _Pragma("unroll") for (int _i = 0; _i < 2; ++_i) \
        __builtin_amdgcn_global_load_lds((const unsigned*)(g_ + (voff)[_i]), (PG8_LAS unsigned*)(lds + (bufoff) + ldsw + _i * 8192), 16, 0, 0); } while (0)
#define PG8_LDA(dst, b, h) do { _Pragma("unroll") for (int m = 0; m < 4; ++m) _Pragma("unroll") for (int k = 0; k < 2; ++k) dst[m][k] = *(const PG8_LAS bf16x8*)(lds + PG8_SA(b, h) + aoff + m * 2048 + k * 1024); } while (0)
#define PG8_LDB(dst, b, h) do { _Pragma("unroll") for (int n = 0; n < 2; ++n) _Pragma("unroll") for (int k = 0; k < 2; ++k) dst[n][k] = *(const PG8_LAS bf16x8*)(lds + PG8_SB(b, h) + boff + n * 2048 + k * 1024); } while (0)
#define PG8_CAT(lo, hi) __builtin_shufflevector(__builtin_bit_cast(i32x4, lo), __builtin_bit_cast(i32x4, hi), 0, 1, 2, 3, 4, 5, 6, 7)
#define PG8_MMA(ai, bj, At, Bt) do { __builtin_amdgcn_s_setprio(1); if constexpr (FP8) { _Pragma("unroll") for (int m = 0; m < 4; ++m) _Pragma("unroll") for (int n = 0; n < 2; ++n) \
        acc[ai][bj][m][n] = __builtin_amdgcn_mfma_scale_f32_16x16x128_f8f6f4(PG8_CAT(Bt[n][0], Bt[n][1]), PG8_CAT(At[m][0], At[m][1]), acc[ai][bj][m][n], 0, 0, 0, 0, 0, 0); }     \
        else { _Pragma("unroll") for (int m = 0; m < 4; ++m) _Pragma("unroll") for (int n = 0; n < 2; ++n) _Pragma("unroll") for (int k = 0; k < 2; ++k) \
        acc[ai][bj][m][n] = __builtin_amdgcn_mfma_f32_16x16x32_bf16(Bt[n][k], At[m][k], acc[ai][bj][m][n], 0, 0, 0); } __builtin_amdgcn_s_setprio(0); } while (0)
#define PG8_WAIT_V(n) asm volatile("s_waitcnt vmcnt(" #n ")" ::: "memory")
#define PG8_WAIT_L(n) asm volatile("s_waitcnt lgkmcnt(" #n ")" ::: "memory")
#define PG8_BAR __builtin_amdgcn_s_barrier()
#define PG8_SCHED __builtin_amdgcn_sched_barrier(0)
    Unit cur, nxt; int ui = 0;
    if (!S.next(0, cur)) return;
    f32x4 acc[2][2][4][2];
#pragma unroll
    for (int a = 0; a < 2; ++a)
#pragma unroll
        for (int b = 0; b < 2; ++b)
#pragma unroll
            for (int m = 0; m < 4; ++m)
#pragma unroll
                for (int n = 0; n < 2; ++n) acc[a][b][m][n] = (f32x4){0.f, 0.f, 0.f, 0.f};
    bf16x8 At[4][2], B0[2][2], B1[2][2];
    const char* cA = cur.A; const char* cB = cur.B;
    PG8_STAGE(PG8_SB(0, 0), cB, voffB); PG8_STAGE(PG8_SB(0, 1), cB + hstepB, voffB); PG8_STAGE(PG8_SA(0, 0), cA, voffA); PG8_STAGE(PG8_SA(0, 1), cA + hstepA, voffA);
    if (wr == 1) PG8_BAR;
    PG8_WAIT_V(2); PG8_BAR;
    PG8_STAGE(PG8_SB(1, 0), cB + kstep, voffB); PG8_STAGE(PG8_SA(1, 0), cA + kstep, voffA); PG8_STAGE(PG8_SB(1, 1), cB + hstepB + kstep, voffB);
    PG8_WAIT_V(6); PG8_BAR;
    for (;;) {
        const bool has_next = S.next(ui + 1, nxt);
        const char* nA = has_next ? nxt.A : cA; const char* nB = has_next ? nxt.B : cB;
        const int nt = cur.nt;
        for (int t = 0; t < nt; t += 2) {
            const bool last = (t == nt - 2);
            const char* a1 = cA + (size_t)(t + 1) * kstep;
            const char* a2 = last ? nA : cA + (size_t)(t + 2) * kstep; const char* b2 = last ? nB : cB + (size_t)(t + 2) * kstep;
            const char* a3 = a2 + kstep; const char* b3 = b2 + kstep;
            PG8_LDB(B0, 0, 0); PG8_LDB(B1, 0, 1); PG8_SCHED; PG8_LDA(At, 0, 0); PG8_STAGE(PG8_SA(1, 1), a1 + hstepA, voffA);
            PG8_WAIT_V(8); PG8_WAIT_L(0); PG8_BAR; PG8_MMA(0, 0, At, B0); PG8_MMA(0, 1, At, B1); PG8_BAR; PG8_SCHED;
            PG8_LDA(At, 0, 1); PG8_STAGE(PG8_SB(0, 0), b2, voffB); PG8_STAGE(PG8_SB(0, 1), b2 + hstepB, voffB); PG8_STAGE(PG8_SA(0, 0), a2, voffA);
            PG8_WAIT_V(8); PG8_WAIT_L(0); PG8_BAR; PG8_MMA(1, 0, At, B0); PG8_MMA(1, 1, At, B1); PG8_BAR; PG8_SCHED;
            PG8_LDB(B0, 1, 0); PG8_LDB(B1, 1, 1); PG8_SCHED; PG8_LDA(At, 1, 0); PG8_STAGE(PG8_SA(0, 1), a2 + hstepA, voffA);
            PG8_WAIT_V(8); PG8_WAIT_L(0); PG8_BAR; PG8_MMA(0, 0, At, B0); PG8_MMA(0, 1, At, B1); PG8_BAR; PG8_SCHED;
            PG8_LDA(At, 1, 1); PG8_STAGE(PG8_SB(1, 0), b3, voffB); PG8_STAGE(PG8_SB(1, 1), b3 + hstepB, voffB); PG8_STAGE(PG8_SA(1, 0), a3, voffA);
            PG8_WAIT_V(8); PG8_WAIT_L(0); PG8_BAR; PG8_MMA(1, 0, At, B0); PG8_MMA(1, 1, At, B1); PG8_BAR; PG8_SCHED;
        }
        if (wr == 0) PG8_BAR;
        if (cur.nks > 1) {
            int t2 = tid; asm volatile("" : "+v"(t2));
            float* sb = g.slabs + ((size_t)(cur.ti * cur.nks + cur.ks) << 16) + t2 * 4;
#pragma unroll
            for (int a = 0; a < 2; ++a)
#pragma unroll
                for (int m = 0; m < 4; ++m)
#pragma unroll
                    for (int b = 0; b < 2; ++b)
#pragma unroll
                        for (int n = 0; n < 2; ++n) *(f32x4*)(sb + ((((a * 4 + m) * 2 + b) * 2 + n) << 11)) = acc[a][b][m][n];
        } else E(acc, cur, wr, wc, fr, fq);
        if (!has_next) break;
#pragma unroll
        for (int a = 0; a < 2; ++a)
#pragma unroll
            for (int b = 0; b < 2; ++b)
#pragma unroll
                for (int m = 0; m < 4; ++m)
#pragma unroll
                    for (int n = 0; n < 2; ++n) acc[a][b][m][n] = (f32x4){0.f, 0.f, 0.f, 0.f};
        cur = nxt; cA = nA; cB = nB; ++ui;
        if (wr == 1) PG8_BAR;
    }
    PG8_WAIT_V(0);
    PG8_BAR;
#undef PG8_SA
#undef PG8_SB
#undef PG8_STAGE
#undef PG8_LDA
#undef PG8_LDB
#undef PG8_MMA
#undef PG8_CAT
#undef PG8_WAIT_V
#undef PG8_WAIT_L
#undef PG8_BAR
#undef PG8_SCHED
}

__device__ __forceinline__ int xcd_remap(int L, int total) { const int q = total / 8, r = total % 8, xcd = L % 8, off = L / 8; return (xcd < r ? xcd * (q + 1) : r * (q + 1) + (xcd - r) * q) + off; }
template <class Base> struct TailSched {
    Base b; int G, c, total, Fcut, r, s, nt_full, ksl;
    __device__ __forceinline__ void init(int total_, int K, int G_, int c_, int smax = 8) {
        total = total_; G = G_; c = c_; nt_full = K / BK; Fcut = (total / G) * G; r = total - Fcut; const int kp = nt_full / 2;
        s = 1;
        if (r > 0) { if (smax >= 8 && kp % 8 == 0 && kp / 8 >= 2 && r * 8 <= G) s = 8; else if (smax >= 4 && kp % 4 == 0 && kp / 4 >= 2 && r * 4 <= G) s = 4; else if (smax >= 2 && kp % 2 == 0 && kp / 2 >= 2 && r * 2 <= G) s = 2; }
        ksl = nt_full / s;
    }
    __device__ __forceinline__ bool next(int i, Unit& u) const {
        const int L = i * G + c;
#ifndef CHUNK_DEAL
#define CHUNK_DEAL 0
#endif
        if (L < Fcut) { b.decode(CHUNK_DEAL ? c * (Fcut / G) + i : xcd_remap(L, Fcut), u); u.nt = nt_full; u.ti = -1; u.ks = 0; u.nks = 1; u.pad = 0; return true; }
        const int q = L - Fcut; if (q >= r * s) return false;
        const int ti = q / s, ks = q - ti * s; b.decode(Fcut + ti, u);
        u.A += (size_t)ks * ksl * (BK * 2); u.B += (size_t)ks * ksl * (BK * 2); u.nt = ksl; u.ti = ti; u.ks = ks; u.nks = s; u.pad = 0; return true;
    }
};
template <class EpiT, class Base> __device__ __forceinline__ void tail_reduce(const TailSched<Base>& S, const EpiT& E, const float* slabs, int bid, int nb, int wv) {
    if (S.s <= 1) return;
    int tid_ = TID_FROM(wv); asm volatile("" : "+v"(tid_)); const int tid = tid_, wid = tid >> 6, lane = tid & 63, wr = wid >> 2, wc = wid & 3, fr = lane & 15, fq = lane >> 4;
    for (int it = bid; it < S.r * 16; it += nb) {
        const int ti = it >> 4, c16 = it & 15, ai = c16 >> 3, m = (c16 >> 1) & 3, bj = c16 & 1;
        Unit u; S.b.decode(S.Fcut + ti, u); u.nt = 0; u.ti = ti; u.ks = 0; u.nks = 1; u.pad = 0;
        f32x4 v0 = {0.f, 0.f, 0.f, 0.f}, v1 = {0.f, 0.f, 0.f, 0.f};
        for (int ks = 0; ks < S.s; ++ks) { const float* sb = slabs + ((size_t)(ti * S.s + ks) << 16) + tid * 4 + ((size_t)(c16 * 2) << 11); v0 += *(const f32x4*)sb; v1 += *(const f32x4*)(sb + 2048); }
        E.f.put(u, ai * HALF + wr * 64 + m * 16 + fr, bj * HALF + wc * 32, fq, v0, v1);
    }
}
template <bool LAT> struct GridBase {
    const char* A; const char* B; size_t atile, btile; int nM, nN;
    __device__ __forceinline__ void decode(int wgid, Unit& u) const {
        const int nig = WGM * nN, gid = wgid / nig, fm = gid * WGM, gsz = (nM - fm) < WGM ? (nM - fm) : WGM;
        int pm = fm + ((wgid % nig) % gsz); const int pn = (wgid % nig) / gsz;
        if (LAT) pm = pm + pm / 8 + 1;
        u.pm = pm; u.pn = pn; u.z = 0; u.A = A + (size_t)pm * atile; u.B = B + (size_t)pn * btile;
    }
};
template <bool LAT> struct GridSched : TailSched<GridBase<LAT>> {
    __device__ __forceinline__ void init(const void* A_, size_t atile_, const void* B_, size_t btile_, int nM_, int nN_, int K, int G_, int c_, int smax = 8) {
        this->b.A = (const char*)A_; this->b.B = (const char*)B_; this->b.atile = atile_; this->b.btile = btile_; this->b.nM = nM_; this->b.nN = nN_;
        TailSched<GridBase<LAT>>::init(nM_ * nN_, K, G_, c_, smax);
    }
};
}

struct EF_in {
    bf16_t *F, *Q, *Kd, *V; const float2* tab;
    __device__ __forceinline__ void put(const pg8::Unit& u, int rt, int c32, int fq, const f32x4& v0, const f32x4& v1) const {
        const int R = u.pm * 256 + rt, cg = u.pn * 256 + c32;
        if (cg < 1024) { store4bf(F + (size_t)R * 1024 + cg + 4 * fq, v0); store4bf(F + (size_t)R * 1024 + cg + 16 + 4 * fq, v1); return; }
        if (cg >= 3072) { store4bf(V + (size_t)R * 1024 + (cg - 3072) + 4 * fq, v0); store4bf(V + (size_t)R * 1024 + (cg - 3072) + 16 + 4 * fq, v1); return; }
        const int G = cg >> 6, w = (cg >> 5) & 1, a0 = 64 * G + 16 * w + 4 * fq;
        bf16_t* dst = cg < 2048 ? Q + (size_t)R * 1024 + (a0 - 1024) : Kd + (size_t)R * 1024 + (a0 - 2048);
        const int j = R % TPB; f32x4 o0 = v0, o1 = v1;
        if (j >= CTX) { const int nl = j - CTX, pos = (G & 1) ? (nl & 63) : (nl >> 6); const f32x4* t4 = (const f32x4*)(tab + pos * 32 + 16 * w + 4 * fq); const f32x4 ta = t4[0], tb = t4[1];
            const f32x4 cs = {ta[0], ta[2], tb[0], tb[2]}, sn = {ta[1], ta[3], tb[1], tb[3]};
            o0 = v0 * cs - v1 * sn; o1 = v1 * cs + v0 * sn; }
        store4bf(dst, o0); store4bf(dst + 32, o1);
    }
};
struct EF_res {
    float* XS; const float* mods; int chunk, pad;
    __device__ __forceinline__ void put(const pg8::Unit& u, int rt, int c32, int fq, const f32x4& v0, const f32x4& v1) const {
        const int R = u.pm * 256 + rt, col = u.pn * 256 + c32 + 4 * fq; const int bb = (u.pm % 9 == 0) ? 4 : u.pm / 9;
        const float* m = mods + (size_t)bb * 6 * D + chunk * D + col; float* x = XS + (size_t)R * D + col;
        *(f32x4*)x = *(const f32x4*)x + *(const f32x4*)m * v0; *(f32x4*)(x + 16) = *(const f32x4*)(x + 16) + *(const f32x4*)(m + 16) * v1;
    }
};
struct EF_res0 {
    float* XS; const float* mods; const float* x; const float* ctx; int chunk, pad;
    __device__ __forceinline__ void put(const pg8::Unit& u, int rt, int c32, int fq, const f32x4& v0, const f32x4& v1) const {
        const int R = u.pm * 256 + rt, col = u.pn * 256 + c32 + 4 * fq; const int b = u.pm / 9, t9 = u.pm - 9 * b; const int bb = t9 == 0 ? 4 : b;
        const float* s = (t9 == 0 ? ctx + ((size_t)(b * CTX + rt)) * D : x + ((size_t)(b * SEQ + (t9 - 1) * 256 + rt)) * D) + col;
        const float* m = mods + (size_t)bb * 6 * D + chunk * D + col; float* o = XS + (size_t)R * D + col;
        *(f32x4*)o = *(const f32x4*)s + *(const f32x4*)m * v0; *(f32x4*)(o + 16) = *(const f32x4*)(s + 16) + *(const f32x4*)(m + 16) * v1;
    }
};
struct EF_swiglu {
    bf16_t* ACT; int ld, pad;
    __device__ __forceinline__ void put(const pg8::Unit& u, int rt, int c32, int fq, const f32x4& v0, const f32x4& v1) const {
        const size_t R = (size_t)u.pm * 256 + rt; const int oc = ((u.pn * 256 + c32) >> 1) + 4 * fq;
        const f32x2 a = swiglu2(f32x2{v0[0], v0[1]}, f32x2{v1[0], v1[1]}, -1.4426950408889634f, 1.f), b = swiglu2(f32x2{v0[2], v0[3]}, f32x2{v1[2], v1[3]}, -1.4426950408889634f, 1.f);
        store4bf(ACT + R * ld + oc, f32x4{a.x, a.y, b.x, b.y});
    }
};
struct EF_dqkv {
    float *CQ, *CKV; bf16_t* KR; const float2* tab;
    __device__ __forceinline__ void put(const pg8::Unit& u, int rt, int c32, int fq, const f32x4& v0, const f32x4& v1) const {
        const int R = u.pm * 256 + rt, cg = u.pn * 256 + c32;
        if (cg < 512) { float* d = CQ + (size_t)R * 512 + cg + 4 * fq; *(f32x4*)d = v0; *(f32x4*)(d + 16) = v1; return; }
        if (cg < 1024) { float* d = CKV + (size_t)R * 512 + (cg - 512) + 4 * fq; *(f32x4*)d = v0; *(f32x4*)(d + 16) = v1; return; }
        if (cg >= 1088) return;
        const int half = (cg - 1024) >> 5, j = R % TPB; f32x4 o0 = v0, o1 = v1;
        if (j >= CTX) { const int nl = j - CTX, pos = half ? (nl & 63) : (nl >> 6); const f32x4* t4 = (const f32x4*)(tab + pos * 16 + 4 * fq); const f32x4 ta = t4[0], tb = t4[1];
            const f32x4 cs = {ta[0], ta[2], tb[0], tb[2]}, sn = {ta[1], ta[3], tb[1], tb[3]};
            o0 = v0 * cs - v1 * sn; o1 = v1 * cs + v0 * sn; }
        bf16_t* d = KR + (size_t)R * 64 + (cg - 1024) + 4 * fq; store4bf(d, o0); store4bf(d + 16, o1);
    }
};
struct EF_uq {
    bf16_t* QM; const float2* tab;
    __device__ __forceinline__ void put(const pg8::Unit& u, int rt, int c32, int fq, const f32x4& v0, const f32x4& v1) const {
        const int R = u.pm * 256 + rt, cg = u.pn * 256 + c32; const int q = (cg >> 5) % 6; f32x4 o0 = v0, o1 = v1;
        if (q >= 4) { const int nl = R % TPB - CTX, pos = (q == 5) ? (nl & 63) : (nl >> 6); const f32x4* t4 = (const f32x4*)(tab + pos * 16 + 4 * fq); const f32x4 ta = t4[0], tb = t4[1];
            const f32x4 cs = {ta[0], ta[2], tb[0], tb[2]}, sn = {ta[1], ta[3], tb[1], tb[3]};
            o0 = v0 * cs - v1 * sn; o1 = v1 * cs + v0 * sn; }
        bf16_t* d = QM + (size_t)R * 3072 + cg + 4 * fq; store4bf(d, o0); store4bf(d + 16, o1);
    }
};
struct EF_bf {
    bf16_t* O; int ld, pad;
    __device__ __forceinline__ void put(const pg8::Unit& u, int rt, int c32, int fq, const f32x4& v0, const f32x4& v1) const {
        bf16_t* d = O + ((size_t)u.pm * 256 + rt) * ld + u.pn * 256 + c32 + 4 * fq; store4bf(d, v0); store4bf(d + 16, v1);
    }
};
struct EF_swiglu8 {
    unsigned char* ACT; int ld, pad;
    __device__ __forceinline__ void put(const pg8::Unit& u, int rt, int c32, int fq, const f32x4& v0, const f32x4& v1) const {
        const size_t R = (size_t)u.pm * 256 + rt; const int oc = ((u.pn * 256 + c32) >> 1) + 4 * fq; const float is = 1.0f / W8_GU;
        const f32x2 a = swiglu2(f32x2{v0[0], v0[1]}, f32x2{v1[0], v1[1]}, -1.4426950408889634f * is, 1.f / (is * is * A8_ACT)), b = swiglu2(f32x2{v0[2], v0[3]}, f32x2{v1[2], v1[3]}, -1.4426950408889634f * is, 1.f / (is * is * A8_ACT));
        *(unsigned*)(ACT + R * ld + oc) = pack4_fp8(a.x, a.y, b.x, b.y);
    }
};
struct EF_y8 {
    float* O; int ld, pad;
    __device__ __forceinline__ void put(const pg8::Unit& u, int rt, int c32, int fq, const f32x4& v0, const f32x4& v1) const {
        float* d = O + ((size_t)u.pm * 256 + rt) * ld + u.pn * 256 + c32 + 4 * fq; const float is = 1.0f / (A8_ACT * W8_DN); *(f32x4*)d = v0 * is; *(f32x4*)(d + 16) = v1 * is;
    }
};
struct EF_probe {
    float* O; int ld, pad;
    __device__ __forceinline__ void put(const pg8::Unit& u, int rt, int c32, int fq, const f32x4& v0, const f32x4& v1) const {
        if (v0[0] + v0[1] + v0[2] + v0[3] + v1[0] + v1[1] + v1[2] + v1[3] == 1.2345678e30f) O[rt] = v0[0];
    }
};
struct EF_probe_math {
    unsigned char* ACT; int ld, pad;
    __device__ __forceinline__ void put(const pg8::Unit& u, int rt, int c32, int fq, const f32x4& v0, const f32x4& v1) const {
        const float is = 1.0f / W8_GU; float o[4];
#pragma unroll
        for (int e = 0; e < 4; ++e) o[e] = fast_silu(v0[e] * is) * (v1[e] * is) * A8_ACT;
        const unsigned w = pack4_fp8(o[0], o[1], o[2], o[3]);
        if (w == 0x12345678u) *(unsigned*)(ACT + rt) = w;
    }
};
struct EF_probe_store {
    unsigned char* ACT; int ld, pad;
    __device__ __forceinline__ void put(const pg8::Unit& u, int rt, int c32, int fq, const f32x4& v0, const f32x4& v1) const {
        const size_t R = ((size_t)u.pm * 256 + rt) & 8191; const int oc = ((u.pn * 256 + c32) >> 1) + 4 * fq;
        *(unsigned*)(ACT + R * ld + oc) = __builtin_bit_cast(unsigned, v0[0]) ^ __builtin_bit_cast(unsigned, v1[1]);
    }
};
struct EF_f32 {
    float* O; int ld, pad;
    __device__ __forceinline__ void put(const pg8::Unit& u, int rt, int c32, int fq, const f32x4& v0, const f32x4& v1) const {
        float* d = O + ((size_t)u.pm * 256 + rt) * ld + u.pn * 256 + c32 + 4 * fq; *(f32x4*)d = v0; *(f32x4*)(d + 16) = v1;
    }
};
struct EF_dftA {
    bf16_t *VT, *VTC;
    __device__ __forceinline__ void put(const pg8::Unit& u, int rt, int c32, int fq, const f32x4& v0, const f32x4& v1) const {
        const int bg = u.z & 15; bf16_t* d;
        if (u.z < 16) d = VT + ((size_t)bg * 256 + rt) * 4096 + u.pm * 2048 + u.pn * 256 + c32 + 4 * fq;
        else d = VTC + ((size_t)bg * 256 + rt) * 512 + u.pm * 256 + c32 + 4 * fq;
        store4bf(d, v0); store4bf(d + 16, v1);
    }
};
struct EF_dftB {
    bf16_t* MIX; float scale; int joff;
    __device__ __forceinline__ void put(const pg8::Unit& u, int rt, int c32, int fq, const f32x4& v0, const f32x4& v1) const {
        const int b = u.z >> 2, g = u.z & 3; const size_t R = (size_t)b * TPB + joff + u.pm * 256 + rt;
        bf16_t* d = MIX + R * 2048 + g * 256 + c32 + 4 * fq; store4bf(d, v0 * scale); store4bf(d + 16, v1 * scale);
    }
};

struct DftABase {
    const char* WCS; const char* F;
    __device__ __forceinline__ void decode(int L, pg8::Unit& u) const {
        int bg, part, pn, ctx;
        if (L < 256) { bg = L >> 4; part = (L >> 3) & 1; pn = L & 7; ctx = 0; } else { const int l = L - 256; bg = l >> 1; part = l & 1; pn = 0; ctx = 1; }
        const int b = bg >> 2, g = bg & 3;
        u.A = WCS + (size_t)part * 256 * 256 * 2; u.B = F + ((size_t)(b * TPB + (ctx ? 0 : CTX + pn * 256)) * 1024 + g * 256) * 2;
        u.pm = part; u.pn = pn; u.z = bg + 16 * ctx;
    }
};
struct DftBBase {
    const char* A; const char* B; size_t atile, bstride; int nk1, pad;
    __device__ __forceinline__ void decode(int L, pg8::Unit& u) const {
        const int bg = L / nk1, pm = L % nk1;
        u.A = A + (size_t)pm * atile; u.B = B + (size_t)bg * bstride; u.pm = pm; u.pn = 0; u.z = bg;
    }
};
struct MoeBase {
    const char* A; const char* B; size_t arow  , bexp  , btile; int nN, pad; int t0, t1, t2, t3, t4, t5, t6, t7; int o0, o1, o2, o3, o4, o5, o6, o7;
    __device__ __forceinline__ int init(const void* A_, size_t arow_, const void* B_, size_t bexp_, size_t btile_, int nN_, const int* CNT, const int* OFFS) {
        A = (const char*)A_; B = (const char*)B_; arow = arow_; bexp = bexp_; btile = btile_; nN = nN_; pad = 0;
        t0 = (CNT[0] + 255) >> 8; t1 = (CNT[1] + 255) >> 8; t2 = (CNT[2] + 255) >> 8; t3 = (CNT[3] + 255) >> 8; t4 = (CNT[4] + 255) >> 8; t5 = (CNT[5] + 255) >> 8; t6 = (CNT[6] + 255) >> 8; t7 = (CNT[7] + 255) >> 8;
        o0 = OFFS[0]; o1 = OFFS[1]; o2 = OFFS[2]; o3 = OFFS[3]; o4 = OFFS[4]; o5 = OFFS[5]; o6 = OFFS[6]; o7 = OFFS[7];
        return (t0 + t1 + t2 + t3 + t4 + t5 + t6 + t7) * nN;
    }
    __device__ __forceinline__ void decode(int l, pg8::Unit& u) const {
        int e = -1, te = 1, oe = 0;
#define MOE_STEP(k, tk, ok) if (e < 0) { const int n = tk * nN; if (l < n) { e = k; te = tk; oe = ok; } else l -= n; }
        MOE_STEP(0, t0, o0) MOE_STEP(1, t1, o1) MOE_STEP(2, t2, o2) MOE_STEP(3, t3, o3) MOE_STEP(4, t4, o4) MOE_STEP(5, t5, o5) MOE_STEP(6, t6, o6) MOE_STEP(7, t7, o7)
#undef MOE_STEP
        if (e < 0) { e = 0; l = 0; }
        const int mt = l % te, pn = l / te; const int row0 = oe + mt * 256;
        u.A = A + (size_t)row0 * arow; u.B = B + (size_t)e * bexp + (size_t)pn * btile; u.pm = row0 >> 8; u.pn = pn; u.z = e;
    }
};

template <int RM> __device__ __forceinline__ int rowmap(int c) {
    if (RM == 1) { if (c < 1024 || c >= 3072) return c; const int u = c & 63; return (c & ~63) + 32 * ((u & 31) >> 4) + 16 * (u >> 5) + (u & 15); }
    if (RM == 2) return 32 * (c >> 4) + (c & 15);
    if (RM == 3) return 32 * (c >> 4) + 16 + (c & 15);
    return c;
}
template <int RM> __device__ __forceinline__ void cvt_item(const float* W, int K, int N, bf16_t* WT, int row_off, LAS float* scr, int item, int lane) {
    const int nblk = N / 32, kb = item / nblk, nb = item % nblk, k0 = 64 * kb, n0 = 32 * nb;
    f32x4 v[8];
#pragma unroll
    for (int i = 0; i < 8; ++i) v[i] = *(const f32x4*)(W + (size_t)(k0 + (lane >> 3) + 8 * i) * N + n0 + 4 * (lane & 7));
#pragma unroll
    for (int i = 0; i < 8; ++i) { LAS float* d = scr + ((lane >> 3) + 8 * i) * 33 + 4 * (lane & 7); d[0] = v[i][0]; d[1] = v[i][1]; d[2] = v[i][2]; d[3] = v[i][3]; }
    asm volatile("s_waitcnt lgkmcnt(0)" ::: "memory");
    const int c = lane & 7;
#pragma unroll
    for (int j = 0; j < 4; ++j) { const int n = (lane >> 3) + 8 * j; const LAS float* s = scr + (8 * c) * 33 + n;
        u32x4 o; o.x = cvt_pk_bf16(s[0 * 33], s[1 * 33]); o.y = cvt_pk_bf16(s[2 * 33], s[3 * 33]); o.z = cvt_pk_bf16(s[4 * 33], s[5 * 33]); o.w = cvt_pk_bf16(s[6 * 33], s[7 * 33]);
        *(u32x4*)(WT + (size_t)(row_off + rowmap<RM>(n0 + n)) * K + k0 + 8 * c) = o; }
    asm volatile("s_waitcnt lgkmcnt(0)" ::: "memory");
}
template <int RM> __device__ __forceinline__ void cvt_item8(const float* W, int K, int N, unsigned char* WT, float scale, LAS float* scr, int item, int lane) {
    const int nblk = N / 32, kb = item / nblk, nb = item % nblk, k0 = 64 * kb, n0 = 32 * nb;
    f32x4 v[8];
#pragma unroll
    for (int i = 0; i < 8; ++i) v[i] = *(const f32x4*)(W + (size_t)(k0 + (lane >> 3) + 8 * i) * N + n0 + 4 * (lane & 7));
#pragma unroll
    for (int i = 0; i < 8; ++i) { LAS float* d = scr + ((lane >> 3) + 8 * i) * 33 + 4 * (lane & 7); d[0] = v[i][0]; d[1] = v[i][1]; d[2] = v[i][2]; d[3] = v[i][3]; }
    asm volatile("s_waitcnt lgkmcnt(0)" ::: "memory");
    const int c = lane & 7;
#pragma unroll
    for (int j = 0; j < 4; ++j) { const int n = (lane >> 3) + 8 * j; const LAS float* s = scr + (8 * c) * 33 + n;
        u32x2 o; o.x = pack4_fp8(s[0 * 33] * scale, s[1 * 33] * scale, s[2 * 33] * scale, s[3 * 33] * scale); o.y = pack4_fp8(s[4 * 33] * scale, s[5 * 33] * scale, s[6 * 33] * scale, s[7 * 33] * scale);
        *(u32x2*)(WT + (size_t)rowmap<RM>(n0 + n) * K + k0 + 8 * c) = o; }
    asm volatile("s_waitcnt lgkmcnt(0)" ::: "memory");
}
constexpr int MOE_I_MG = (2048 / 64) * (FFE / 32), MOE_I_MD = (FFE / 64) * (2048 / 32), MOE_ITEMS = 16 * MOE_I_MG + 8 * MOE_I_MD, MOE_BATCHES = MOE_ITEMS / 8;
__device__ __forceinline__ void moe_cvt_item(const P& p, int r, LAS float* scr, int lane) {
    if (r < 8 * MOE_I_MG) { const int e = r / MOE_I_MG; cvt_item8<2>(p.moe_w_gate + (size_t)e * 2048 * FFE, 2048, FFE, WSP(unsigned char, WT_MGU) + (size_t)e * 2 * FFE * 2048, W8_GU, scr, r % MOE_I_MG, lane); return; } r -= 8 * MOE_I_MG;
    if (r < 8 * MOE_I_MG) { const int e = r / MOE_I_MG; cvt_item8<3>(p.moe_w_up + (size_t)e * 2048 * FFE, 2048, FFE, WSP(unsigned char, WT_MGU) + (size_t)e * 2 * FFE * 2048, W8_GU, scr, r % MOE_I_MG, lane); return; } r -= 8 * MOE_I_MG;
    { const int e = r / MOE_I_MD; cvt_item8<0>(p.moe_w_down + (size_t)e * FFE * 2048, FFE, 2048, WSP(unsigned char, WT_MD) + (size_t)e * 2048 * FFE, W8_DN, scr, r % MOE_I_MD, lane); }
}
__device__ __forceinline__ bool moe_fill_list(const P& p, unsigned* ctl, int phase, int nb, int owner, LAS float* scr, int lane) {
    unsigned* ctr = ctl + CW_FILL + 64 * owner; const int nown = (MOE_ITEMS - owner + nb - 1) / nb;
    const int ch = phase >= 0 ? 1 : 4;
    for (;;) {
        if (phase >= 0 && (int)__builtin_amdgcn_readfirstlane(xb_ld(ctl + CW_DONE + 64 * phase)) >= nb) return false;
        unsigned idx = 0; if (lane == 0) idx = xb_add(ctr, (unsigned)ch);
        idx = __builtin_amdgcn_readfirstlane(idx);
        if ((int)idx >= nown) return true;
        for (int j = 0; j < ch && (int)idx + j < nown; ++j) moe_cvt_item(p, ((int)idx + j) * nb + owner, scr, lane);
    }
}
__device__ __forceinline__ void moe_fill(const P& p, unsigned* ctl, int phase, int nb, int bid, LAS unsigned char* lds, volatile LAS unsigned* MISC, int wv) {
    const int lane = lane_id();
    LAS float* scr = (LAS float*)(lds + wv * 16384);
    if (MISC[24] == 0u) { if (!moe_fill_list(p, ctl, phase, nb, bid, scr, lane)) return; MISC[24] = 1u; }
    if (phase >= 0) return;
#pragma unroll 1
    for (int k = 1; k <= 6; ++k) { if (!moe_fill_list(p, ctl, phase, nb, (bid + 41 * k) % nb, scr, lane)) return; }
}
__device__ __forceinline__ void ph_convert(const P& p, int bid, int nb, LAS unsigned char* lds, int wv) {
    int tid_ = TID_FROM(wv); asm volatile("" : "+v"(tid_)); const int tid = tid_, lane = tid & 63, wave = tid >> 6;
    LAS float* scr = (LAS float*)(lds + wave * 16384);
    const int gw = bid * NWAVES + wave, NGW = nb * NWAVES;
    constexpr int I_IN = (2048 / 64) * (4096 / 32), I_OUT = (2048 / 64) * (2048 / 32), I_G = (2048 / 64) * (FFD / 32), I_DN = (FFD / 64) * (2048 / 32);
    constexpr int I_DQ = (2048 / 64) * (512 / 32), I_DKV = (2048 / 64) * (576 / 32), I_UQ = (512 / 64) * (3072 / 32), I_UKV = (512 / 64) * (4096 / 32), I_O = I_OUT;
    constexpr int I_MG = (2048 / 64) * (FFE / 32), I_MD = (FFE / 64) * (2048 / 32);
    constexpr int NITEMS = I_IN + I_OUT + 2 * I_G + I_DN + I_DQ + I_DKV + I_UQ + I_UKV + I_O + (FILL ? 0 : 16 * I_MG + 8 * I_MD);
    for (int it = gw; it < NITEMS; it += NGW) {
        int r = it;
        if (r < I_IN) { cvt_item<1>(p.ev_w_in, 2048, 4096, WSP(bf16_t, WT_IN), 0, scr, r, lane); continue; } r -= I_IN;
        if (r < I_OUT) { cvt_item<0>(p.ev_w_out, 2048, 2048, WSP(bf16_t, WT_OUT), 0, scr, r, lane); continue; } r -= I_OUT;
        if (r < I_G) { cvt_item<2>(p.ffn_w_gate, 2048, FFD, WSP(bf16_t, WT_GU), 0, scr, r, lane); continue; } r -= I_G;
        if (r < I_G) { cvt_item<3>(p.ffn_w_up, 2048, FFD, WSP(bf16_t, WT_GU), 0, scr, r, lane); continue; } r -= I_G;
        if (r < I_DN) { cvt_item<0>(p.ffn_w_down, FFD, 2048, WSP(bf16_t, WT_DN), 0, scr, r, lane); continue; } r -= I_DN;
        if (r < I_DQ) { cvt_item<0>(p.od_w_dq, 2048, 512, WSP(bf16_t, WT_DQKV), 0, scr, r, lane); continue; } r -= I_DQ;
        if (r < I_DKV) { cvt_item<0>(p.od_w_dkv, 2048, 576, WSP(bf16_t, WT_DQKV), 512, scr, r, lane); continue; } r -= I_DKV;
        if (r < I_UQ) { cvt_item<0>(p.od_w_uq, 512, 3072, WSP(bf16_t, WT_UQ), 0, scr, r, lane); continue; } r -= I_UQ;
        if (r < I_UKV) { cvt_item<0>(p.od_w_ukv, 512, 4096, WSP(bf16_t, WT_UKV), 0, scr, r, lane); continue; } r -= I_UKV;
        if (r < I_O) { cvt_item<0>(p.od_w_o, 2048, 2048, WSP(bf16_t, WT_O), 0, scr, r, lane); continue; } r -= I_O;
        moe_cvt_item(p, r, scr, lane);
    }
    { bf16_t* z = WSP(bf16_t, WT_DQKV) + (size_t)1088 * 2048; for (size_t i = (size_t)bid * 512 + tid; i < (size_t)192 * 2048 / 8; i += (size_t)nb * 512) ((uint4*)z)[i] = make_uint4(0, 0, 0, 0); }
}
__device__ __forceinline__ void ph_dft_tables(const P& p, int bid, int nb, float* tab  , int wv) {
    int tid_ = TID_FROM(wv); asm volatile("" : "+v"(tid_)); const int tid = tid_;
    for (int i = tid; i < 2048; i += 512) tab[i] = cospif((float)i * (2.0f / 2048.0f));
    __syncthreads();
    bf16_t* DN = WSP(bf16_t, WS_DFTN); bf16_t* DC = WSP(bf16_t, WS_DFTC); bf16_t* WC = WSP(bf16_t, WS_WCS);
    for (size_t i = (size_t)bid * 512 + tid; i < (size_t)2048 * 4096 / 2; i += (size_t)nb * 512) {
        const int k1 = (int)(i / 2048), n2 = (int)(i % 2048) * 2; unsigned w = 0;
#pragma unroll
        for (int q = 0; q < 2; ++q) { const int nn = n2 + q, n = nn & 2047, part = nn >> 11; const int idx = (k1 * n) & 2047; const float v = part == 0 ? tab[idx] : -tab[(idx + 1536) & 2047]; w |= (unsigned)f2bf(v) << (16 * q); }
        ((unsigned*)DN)[i] = w;
    }
    for (int i = bid * 512 + tid; i < 256 * 512; i += nb * 512) { const int k1 = i / 512, nn = i % 512, n = nn & 255, part = nn >> 8; const int idx = ((k1 * n) & 255) * 8; DC[i] = f2bf(part == 0 ? tab[idx] : -tab[(idx + 1536) & 2047]); }
    for (int i = bid * 512 + tid; i < 512 * 256; i += nb * 512) { const int m = i / 256, cc = i % 256, k3 = m & 255; const int idx = ((k3 * cc) & 255) * 8; WC[i] = f2bf(m < 256 ? tab[idx] : tab[(idx + 1536) & 2047]); }
    __syncthreads();
}

#ifndef ATT_ROPE_SD1
#define ATT_ROPE_SD1 1
#endif
namespace att {
using s16x4  = __attribute__((ext_vector_type(4))) short;
using f32x16 = __attribute__((ext_vector_type(16))) float;
constexpr int QBLK = 32, KVBLK = 64, NW = 8;
constexpr size_t SHM_V = KVBLK * 128 * 2, SHM_K = KVBLK * 128 * 2, SHM_KR = KVBLK * 64 * 2;
constexpr size_t OFF_K = 2 * SHM_V, OFF_KR = OFF_K + 2 * SHM_K, OFF_WS = OFF_KR + 2 * SHM_KR, OFF_QR = OFF_WS + NW * 64 * 4, SHM_ATTN = OFF_QR + 256 * 128;
#define KSWZ(row, colB) ((row) * 256 + ((colB) ^ (((row) & 7) << 4)))
#define KRSWZ(row, colB) ((row) * 128 + ((colB) ^ (((row) & 7) << 4)))
#define SBAR() __builtin_amdgcn_sched_barrier(0)
__device__ __forceinline__ int crow(int r, int hi) { return (r & 3) + 8 * (r >> 2) + 4 * hi; }
__device__ __forceinline__ unsigned cvtpk(float lo, float hi) { unsigned r; asm volatile("v_cvt_pk_bf16_f32 %0, %1, %2" : "=v"(r) : "v"(lo), "v"(hi)); return r; }
__device__ __forceinline__ bf16x8 ld8(const bf16_t* p) { return *reinterpret_cast<const bf16x8*>(p); }

__device__ __forceinline__ void partialSM(f32x16& p0, f32x16& p1, float& m_reg, float& mn, float& alpha, const float C, const float thr) {
  float pmax = p0[0]; for (int r = 1; r < 16; ++r) pmax = fmaxf(pmax, p0[r]); for (int r = 0; r < 16; ++r) pmax = fmaxf(pmax, p1[r]);
  { auto rr = __builtin_amdgcn_permlane32_swap(__float_as_uint(pmax), __float_as_uint(pmax), false, false);
    pmax = fmaxf(__uint_as_float(rr[0]), __uint_as_float(rr[1])); }
  if (__builtin_expect(__all(pmax - m_reg <= thr), 1)) { mn = m_reg; alpha = 1.f; }
  else { mn = fmaxf(m_reg, pmax); alpha = __builtin_amdgcn_exp2f((m_reg - mn) * C); m_reg = mn; }
  float mnC = -mn * C;
  for (int r = 0; r < 16; ++r) p0[r] = fmaf(p0[r], C, mnC); for (int r = 0; r < 16; ++r) p1[r] = fmaf(p1[r], C, mnC);
  for (int r = 0; r < 16; ++r) p0[r] = __builtin_amdgcn_exp2f(p0[r]);
}
__device__ __forceinline__ void finishSM(f32x16& p0, f32x16& p1, float alpha, float& l_reg, bf16x8& pa0, bf16x8& pa1, bf16x8& pa2, bf16x8& pa3) {
  for (int r = 0; r < 16; ++r) p1[r] = __builtin_amdgcn_exp2f(p1[r]);
  float ps = 0; for (int r = 0; r < 16; ++r) ps += p0[r]; for (int r = 0; r < 16; ++r) ps += p1[r];
  { auto rr = __builtin_amdgcn_permlane32_swap(__float_as_uint(ps), __float_as_uint(ps), false, false);
    ps = __uint_as_float(rr[0]) + __uint_as_float(rr[1]); }
  l_reg = l_reg * alpha + ps;
#define PK4(P, BASE, OUT) do { unsigned a0 = cvtpk(P[BASE + 0], P[BASE + 1]), a1 = cvtpk(P[BASE + 2], P[BASE + 3]);   \
    unsigned b0 = cvtpk(P[BASE + 4], P[BASE + 5]), b1 = cvtpk(P[BASE + 6], P[BASE + 7]);                              \
    auto r0 = __builtin_amdgcn_permlane32_swap(a0, b0, false, false); auto r1 = __builtin_amdgcn_permlane32_swap(a1, b1, false, false); \
    u32x4 w = {r0[0], r1[0], r0[1], r1[1]}; OUT = *reinterpret_cast<bf16x8*>(&w); } while (0)
  PK4(p0, 0, pa0); PK4(p0, 8, pa1); PK4(p1, 0, pa2); PK4(p1, 8, pa3);
#undef PK4
}
template <bool ROPE> __device__ __forceinline__ void qkt(f32x16& p0, f32x16& p1, const char* Ks, const char* KRs, const char* QRs, const bf16x8* qr, int r32, int hi) {
  p0 = f32x16{}; p1 = f32x16{};
#pragma unroll
  for (int d0 = 0; d0 < 8; ++d0) { int cb = (d0 * 16 + hi * 8) * 2;
    bf16x8 b0 = *reinterpret_cast<const bf16x8*>(Ks + KSWZ(r32, cb));
    bf16x8 b1 = *reinterpret_cast<const bf16x8*>(Ks + KSWZ(32 + r32, cb));
    p0 = __builtin_amdgcn_mfma_f32_32x32x16_bf16(b0, qr[d0], p0, 0, 0, 0);
    p1 = __builtin_amdgcn_mfma_f32_32x32x16_bf16(b1, qr[d0], p1, 0, 0, 0); }
  if constexpr (ROPE) {
#pragma unroll
    for (int d1 = 0; d1 < 4; ++d1) { int cb = (d1 * 16 + hi * 8) * 2;
      bf16x8 b0 = *reinterpret_cast<const bf16x8*>(KRs + KRSWZ(r32, cb));
      bf16x8 b1 = *reinterpret_cast<const bf16x8*>(KRs + KRSWZ(32 + r32, cb));
      bf16x8 qf = *reinterpret_cast<const bf16x8*>(QRs + KRSWZ(r32, cb));
      p0 = __builtin_amdgcn_mfma_f32_32x32x16_bf16(b0, qf, p0, 0, 0, 0);
      p1 = __builtin_amdgcn_mfma_f32_32x32x16_bf16(b1, qf, p1, 0, 0, 0); }
  }
}
__device__ __forceinline__ int v_st(int k, int c) { const int kk = (k & ~0xC) | ((k & 4) << 1) | ((k & 8) >> 1); return ((kk >> 3) * 4 + (c >> 5)) * 512 + ((kk & 7) * 32 + (c & 31)) * 2; }
__device__ __forceinline__ int v_rd_base(int lane) { return ((lane & 3) << 3) | (((lane >> 2) & 3) << 6) | (((lane >> 4) & 1) << 5) | (((lane >> 5) & 1) << 8); }
constexpr int v_rd_off(int d0, int ks, int half) { return d0 * 512 + ks * 4096 + half * 2048; }
template <int OFF> __device__ __forceinline__ s16x4 tr_read(int vb) {
  s16x4 r; asm volatile("ds_read_b64_tr_b16 %0, %1 offset:%2" : "=&v"(r) : "v"(vb), "i"(OFF) : "memory"); return r;
}
template <int D0> __device__ __forceinline__ void pv_one(f32x16& od, int vb, bf16x8 pa0, bf16x8 pa1, bf16x8 pa2, bf16x8 pa3) {
  const s16x4 l0 = tr_read<v_rd_off(D0, 0, 0)>(vb), h0 = tr_read<v_rd_off(D0, 0, 1)>(vb), l1 = tr_read<v_rd_off(D0, 1, 0)>(vb), h1 = tr_read<v_rd_off(D0, 1, 1)>(vb);
  const s16x4 l2 = tr_read<v_rd_off(D0, 2, 0)>(vb), h2 = tr_read<v_rd_off(D0, 2, 1)>(vb), l3 = tr_read<v_rd_off(D0, 3, 0)>(vb), h3 = tr_read<v_rd_off(D0, 3, 1)>(vb);
  asm volatile("s_waitcnt lgkmcnt(0)" ::: "memory"); SBAR();
#define PK(L, H) (bf16x8){L[0], L[1], L[2], L[3], H[0], H[1], H[2], H[3]}
  od = __builtin_amdgcn_mfma_f32_32x32x16_bf16(pa0, PK(l0, h0), od, 0, 0, 0);
  od = __builtin_amdgcn_mfma_f32_32x32x16_bf16(pa1, PK(l1, h1), od, 0, 0, 0);
  od = __builtin_amdgcn_mfma_f32_32x32x16_bf16(pa2, PK(l2, h2), od, 0, 0, 0);
  od = __builtin_amdgcn_mfma_f32_32x32x16_bf16(pa3, PK(l3, h3), od, 0, 0, 0);
#undef PK
}
__device__ __forceinline__ void pv_d0(f32x16* o, int vb, bf16x8 pa0, bf16x8 pa1, bf16x8 pa2, bf16x8 pa3) {
  pv_one<0>(o[0], vb, pa0, pa1, pa2, pa3); pv_one<1>(o[1], vb, pa0, pa1, pa2, pa3); pv_one<2>(o[2], vb, pa0, pa1, pa2, pa3); pv_one<3>(o[3], vb, pa0, pa1, pa2, pa3);
}
template <int LDQ, int LDK, int LDV, int LDO, bool ROPE, bool OBF>
__device__ __forceinline__ void attn_body(const bf16_t* __restrict__ Qb, const bf16_t* __restrict__ Kh, const bf16_t* __restrict__ Vh, const bf16_t* __restrict__ KRh,
                                          void* __restrict__ Ob, int seq, const float C, const float thr, char* lds, int wv) {
  int tid_ = TID_FROM(wv); asm volatile("" : "+v"(tid_));
  const int tid = tid_, wid = tid >> 6, lane = tid & 63, r32 = lane & 31, hi = lane >> 5;
  char* V_lds = lds; char* K_lds = lds + OFF_K; char* KR_lds = lds + OFF_KR;
  float* ws = (float*)(lds + OFF_WS) + wid * 64; float* li_l = ws; float* al_l = ws + 32;
  float m_reg = -1e30f, l_reg = 0; f32x16 o[4] = {}; bf16x8 qr[8];
  const bf16_t* Qw = Qb + (long)(wid * QBLK + r32) * LDQ + hi * 8;
#pragma unroll
  for (int d0 = 0; d0 < 8; ++d0) qr[d0] = ld8(Qw + d0 * 16);
  const char* QR_lds = lds + OFF_QR + wid * 4096;
  if constexpr (ROPE) {
#pragma unroll
    for (int d1 = 0; d1 < 4; ++d1) *(bf16x8*)(lds + OFF_QR + wid * 4096 + KRSWZ(r32, (d1 * 16 + hi * 8) * 2)) = ld8(Qw + 128 + d1 * 16);
  }
  const int sr = tid >> 4, sc = (tid & 15) * 8, vst0 = v_st(sr, sc), vst1 = v_st(32 + sr, sc);
  const int krr = tid >> 3, krc = (tid & 7) * 8;
  const int vb0 = (int)(uintptr_t)V_lds + v_rd_base(lane);
  constexpr int SD = (ROPE && ATT_ROPE_SD1) ? 1 : 2;
  struct { bf16x8 vs0, vs1, ks0, ks1, kr; } sr_[SD];
#define SLOAD(i, k0) do { sr_[i].vs0 = ld8(&Vh[(long)((k0) + sr) * LDV + sc]); sr_[i].vs1 = ld8(&Vh[(long)((k0) + 32 + sr) * LDV + sc]); \
    sr_[i].ks0 = ld8(&Kh[(long)((k0) + sr) * LDK + sc]); sr_[i].ks1 = ld8(&Kh[(long)((k0) + 32 + sr) * LDK + sc]); \
    if constexpr (ROPE) sr_[i].kr = ld8(&KRh[(long)((k0) + krr) * 64 + krc]); } while (0)
#define SWRITE(b, i) do { *(bf16x8*)(V_lds + (b) * SHM_V + vst0) = sr_[i].vs0;          \
    *(bf16x8*)(V_lds + (b) * SHM_V + vst1) = sr_[i].vs1; int kc = sc * 2;               \
    *(bf16x8*)(K_lds + (b) * SHM_K + KSWZ(sr, kc)) = sr_[i].ks0;                       \
    *(bf16x8*)(K_lds + (b) * SHM_K + KSWZ(32 + sr, kc)) = sr_[i].ks1;                  \
    if constexpr (ROPE) *(bf16x8*)(KR_lds + (b) * SHM_KR + KRSWZ(krr, krc * 2)) = sr_[i].kr; } while (0)
#define SWAIT() do { if constexpr (SD == 1) asm volatile("s_waitcnt vmcnt(0)" ::: "memory"); else if constexpr (ROPE) asm volatile("s_waitcnt vmcnt(5)" ::: "memory"); else asm volatile("s_waitcnt vmcnt(4)" ::: "memory"); } while (0)
#define RESC(a) do { if (__any((a) < 1.f)) { if (hi == 0) al_l[r32] = (a); asm volatile("s_waitcnt lgkmcnt(0)" ::: "memory"); \
    for (int d = 0; d < 4; ++d) for (int r = 0; r < 16; ++r) o[d][r] *= al_l[crow(r, hi)]; } } while (0)
  f32x16 pA0, pA1, pB0, pB1; float mnA, mnB, alA, alB; bf16x8 pa0, pa1, pa2, pa3; const int NT = seq / KVBLK;
  constexpr int SE = 0, SO = SD - 1;
  SLOAD(SE, 0); asm volatile("s_waitcnt vmcnt(0)" ::: "memory"); SWRITE(0, SE); __syncthreads();
  qkt<ROPE>(pA0, pA1, K_lds, KR_lds, QR_lds, qr, r32, hi); partialSM(pA0, pA1, m_reg, mnA, alA, C, thr);
  SLOAD(SO, KVBLK); if constexpr (SD == 2) { if (2 < NT) SLOAD(SE, 2 * KVBLK); }
  SWAIT(); SWRITE(1, SO); __syncthreads();
  for (int j = 1; j + 1 < NT; j += 2) {
    SBAR(); qkt<ROPE>(pB0, pB1, K_lds + SHM_K, KR_lds + SHM_KR, QR_lds, qr, r32, hi);
    finishSM(pA0, pA1, alA, l_reg, pa0, pa1, pa2, pa3); SBAR();
    SLOAD(SO, (j + SD) * KVBLK); SBAR();
    pv_d0(o, vb0, pa0, pa1, pa2, pa3); partialSM(pB0, pB1, m_reg, mnB, alB, C, thr);
    __syncthreads(); SWAIT(); SWRITE(0, SE);
    RESC(alB); __syncthreads();
    SBAR(); qkt<ROPE>(pA0, pA1, K_lds, KR_lds, QR_lds, qr, r32, hi);
    finishSM(pB0, pB1, alB, l_reg, pa0, pa1, pa2, pa3); SBAR();
    if (SD == 1 || j + 3 < NT) SLOAD(SE, (j + 1 + SD) * KVBLK); SBAR();
    pv_d0(o, vb0 + (int)SHM_V, pa0, pa1, pa2, pa3); partialSM(pA0, pA1, m_reg, mnA, alA, C, thr);
    __syncthreads(); SWAIT(); SWRITE(1, SO);
    RESC(alA); __syncthreads();
  }
  SBAR(); qkt<ROPE>(pB0, pB1, K_lds + SHM_K, KR_lds + SHM_KR, QR_lds, qr, r32, hi);
  finishSM(pA0, pA1, alA, l_reg, pa0, pa1, pa2, pa3); SBAR();
  pv_d0(o, vb0, pa0, pa1, pa2, pa3); partialSM(pB0, pB1, m_reg, mnB, alB, C, thr);
  __syncthreads(); RESC(alB);
  finishSM(pB0, pB1, alB, l_reg, pa0, pa1, pa2, pa3); SBAR();
  pv_d0(o, vb0 + (int)SHM_V, pa0, pa1, pa2, pa3);
  if (hi == 0) li_l[r32] = l_reg; asm volatile("s_waitcnt lgkmcnt(0)" ::: "memory");
  float rli[16];
#pragma unroll
  for (int r = 0; r < 16; ++r) rli[r] = __builtin_amdgcn_rcpf(li_l[crow(r, hi)]);
#pragma unroll
  for (int r = 0; r < 16; ++r) { const int orow = wid * QBLK + crow(r, hi);
#pragma unroll
    for (int d0 = 0; d0 < 4; ++d0) { const float val = o[d0][r] * rli[r];
      if constexpr (OBF) ((bf16_t*)Ob)[(long)orow * LDO + d0 * 32 + r32] = f2bf(val); else ((float*)Ob)[(long)orow * LDO + d0 * 32 + r32] = val; } }
  __syncthreads();
#undef SLOAD
#undef SWRITE
#undef SWAIT
#undef RESC
}
#undef KSWZ
#undef KRSWZ
#undef SBAR
}

constexpr int NPH = 22;
typedef const __attribute__((address_space(4))) P* KP4;
__global__ void __launch_bounds__(512, 2) mega(P p_arg, int ph_lo, int ph_hi, int bar_idx) {
    const KP4 kp0 = (KP4)__builtin_amdgcn_kernarg_segment_ptr();
#define LOCAL_P KP4 kp_ = kp0; asm volatile("" : "+s"(kp_)); const P& p = *(const P*)kp_;
    LOCAL_P
    extern __shared__ __attribute__((aligned(16))) unsigned char lds_raw[];
    LAS unsigned char* lds = (LAS unsigned char*)lds_raw;
    const int wv = __builtin_amdgcn_readfirstlane((int)threadIdx.x >> 6);
    const int tid = TID_FROM(wv), bid = blockIdx.x, nb = gridDim.x;
    volatile LAS unsigned* MISC = (volatile LAS unsigned*)(lds + MISC_OFF);
    for (int u = tid; u < (LDS_BYTES - RING_BYTES) / 4; u += 512) ((LAS unsigned*)(lds + RING_BYTES))[u] = 0u;
    __syncthreads();
    unsigned* ctl = (unsigned*)(p.ws + WS_CTL);
    XcdBarrier bar = xcd_barrier_post(ctl + CW_BAR + bar_idx * XCD_BAR_WORDS, MISC + 8, wv);
    float* SLABS = WSP(float, WS_SLAB);
#ifndef NHELP
#define NHELP 0
#endif
    const int nbw = nb - NHELP; const bool helper = NHELP > 0 && bid >= nbw;
#ifndef FILL_TAILS
#define FILL_TAILS 1
#endif
#define FILL_TAIL(k) do { if (FILL && FILL_TAILS) { __syncthreads(); if (wv == 0 && lane_id() == 0) (void)xb_add(ctl + CW_DONE + 64 * (k), 1u); moe_fill(p, ctl, (k), nb, bid, lds, MISC, wv); } } while (0)
#define GEMM_TAIL(S, E, off) do { if ((S).s > 1) { xcd_barrier(bar, wv); pg8::tail_reduce(S, E, SLABS + ((size_t)(off) << 16), bid, nb, wv); } } while (0)
#ifndef PH_MASK
#define PH_MASK 0xFFFFFFFFu
#endif
#define RUN(k) (((PH_MASK >> (k)) & 1u) && ph_lo <= (k) && (k) < ph_hi)
#define SEAM(k) do { if (RUN(k) && RUN((k) + 1)) xcd_barrier(bar, wv); } while (0)
#ifndef REPEAT_PH
#define REPEAT_PH (-1)
#endif
#ifndef REPEAT_N
#define REPEAT_N 2
#endif
#define NREP(k) ((k) == REPEAT_PH ? REPEAT_N : 1)
#define PH_BEGIN(k) if (RUN(k)) { _Pragma("unroll") for (int rep = 0; rep < NREP(k); ++rep) { LOCAL_P
#define PH_END(k) if (rep + 1 < NREP(k)) xcd_barrier(bar, wv); } } SEAM(k);
    const size_t T2048 = (size_t)256 * 2048 * 2, T512 = (size_t)256 * 512 * 2;
#ifndef SPLIT_G1
#define SPLIT_G1 1
#endif
#ifndef SPLIT_G2
#define SPLIT_G2 4
#endif
#ifndef SPLIT_G3
#define SPLIT_G3 4
#endif
#ifndef SPLIT_G4
#define SPLIT_G4 4
#endif
#ifndef SPLIT_P13
#define SPLIT_P13 1
#endif
#ifndef SPLIT_G9
#define SPLIT_G9 1
#endif
#ifndef SPLIT_G10
#define SPLIT_G10 8
#endif

    PH_BEGIN(0) { ph_prologue(p, bid, nb, (float*)lds_raw, wv); __syncthreads(); ph_dft_tables(p, bid, nb, (float*)lds_raw, wv); ph_convert(p, bid, nb, lds, wv);
#ifdef CONVERT_TWICE
        __syncthreads(); ph_convert(p, bid, nb, lds, wv);
#endif
    }
    PH_END(0)
    PH_BEGIN(1) ph_norm_mod<!ORACLE>(p, p.norm1_g, 0, 0, 1, bid, nb, wv);
    PH_END(1)
#ifdef EXTRA_BARS
    for (int e_ = 0; e_ < EXTRA_BARS; ++e_) xcd_barrier(bar, wv);
#endif
    PH_BEGIN(2) { pg8::GridSched<false> S; S.init(WSP(bf16_t, WS_H), T2048, WSP(bf16_t, WT_IN), T2048, 36, 16, 2048, nbw, bid, SPLIT_G1);
        pg8::Epi<EF_in> E{{WSP(bf16_t, A0_F), WSP(bf16_t, A0_Q), WSP(bf16_t, A0_K), WSP(bf16_t, A0_V), WSP(float2, WS_TABD)}};
        if (!helper) { pg8::gemm_phase(lds, pg8::Dims{2048, 2048, SLABS}, S, E, wv); } FILL_TAIL(2);
        GEMM_TAIL(S, E, 0); }
    PH_END(2)
    PH_BEGIN(3) { pg8::TailSched<DftABase> S; S.b.WCS = (const char*)WSP(bf16_t, WS_WCS); S.b.F = (const char*)WSP(bf16_t, A0_F); S.init(288, 256, nb, bid);
        pg8::Epi<EF_dftA> E{{WSP(bf16_t, A0_VT), WSP(bf16_t, A0_VTC)}};
        pg8::gemm_phase(lds, pg8::Dims{256, 1024, SLABS}, S, E, wv); GEMM_TAIL(S, E, 0); }
    PH_END(3)
    PH_BEGIN(4) {
        pg8::TailSched<DftBBase> S1; S1.b = DftBBase{(const char*)WSP(bf16_t, WS_DFTN), (const char*)WSP(bf16_t, A0_VT), (size_t)256 * 4096 * 2, (size_t)256 * 4096 * 2, 8, 0}; S1.init(128, 4096, nb, bid, 1);
        pg8::Epi<EF_dftB> E1{{WSP(bf16_t, A0_MIX), 1.0f / sqrtf(2048.f * 256.f), CTX}};
        pg8::gemm_phase(lds, pg8::Dims{4096, 4096, SLABS}, S1, E1, wv);
        pg8::TailSched<DftBBase> S2; S2.b = DftBBase{(const char*)WSP(bf16_t, WS_DFTC), (const char*)WSP(bf16_t, A0_VTC), 0, (size_t)256 * 512 * 2, 1, 0}; S2.init(16, 512, nb, (bid + 128) % nb, 1);
        pg8::Epi<EF_dftB> E2{{WSP(bf16_t, A0_MIX), 1.0f / sqrtf(256.f * 256.f), 0}};
        pg8::gemm_phase(lds, pg8::Dims{512, 512, SLABS + ((size_t)256 << 16)}, S2, E2, wv);
        __syncthreads();
        volatile LAS int* qslot = (volatile LAS int*)(MISC + 16);
        const bf16_t* Qd = WSP(bf16_t, A0_Q); const bf16_t* Kd = WSP(bf16_t, A0_K); const bf16_t* Vd = WSP(bf16_t, A0_V); float* OD = WSP(float, A0_OD);
        for (;;) {
            if (tid == 0) *qslot = (int)xb_add(ctl + CW_QUEUE + 64 * rep, 1u);
            __syncthreads();
            const int it = *qslot;
            __syncthreads();
            if (it >= 576) break;
            int inst, row0, seq;
            if (it < 512) { inst = it >> 3; row0 = CTX + (it & 7) * 256; seq = TPB; } else { inst = it - 512; row0 = 0; seq = CTX; }
            const int b = inst >> 4, h = (inst >> 2) & 3, c = (inst >> 1) & 1, vh = inst & 1;
            const size_t R0 = (size_t)b * TPB + row0, K0 = (size_t)b * TPB;
            att::attn_body<1024, 1024, 1024, 2048, false, false>(Qd + R0 * 1024 + h * 256 + c * 128, Kd + K0 * 1024 + h * 256 + c * 128, Vd + K0 * 1024 + h * 256 + vh * 128, nullptr,
                OD + (R0 * 4 + h) * 512 + c * 256 + vh * 128, seq, 0.08838834764831845f * 1.4426950408889634f, 8.f / 0.08838834764831845f, (char*)lds_raw, wv);
        }
        FILL_TAIL(4);
        if (S1.s > 1 || S2.s > 1) { xcd_barrier(bar, wv); pg8::tail_reduce(S1, E1, SLABS, bid, nb, wv); pg8::tail_reduce(S2, E2, SLABS + ((size_t)256 << 16), bid, nb, wv); }
    }
    PH_END(4)
    PH_BEGIN(5) ph_subln(p, bid, nb, wv);
    PH_END(5)
    PH_BEGIN(6) { pg8::GridSched<false> S; S.init(WSP(bf16_t, A0_MIX), T2048, WSP(bf16_t, WT_OUT), T2048, 36, 8, 2048, nbw, bid, SPLIT_G2);
#if ORACLE
        pg8::Epi<EF_res> E{{WSP(float, WS_XS), WSP(float, WS_MODS), 2, 0}};
#else
        pg8::Epi<EF_res0> E{{WSP(float, WS_XS), WSP(float, WS_MODS), p.x, p.ctx, 2, 0}};
#endif
        if (!helper) { pg8::gemm_phase(lds, pg8::Dims{2048, 2048, SLABS}, S, E, wv); } FILL_TAIL(6);
        GEMM_TAIL(S, E, 0); }
    PH_END(6)
    PH_BEGIN(7) ph_norm_mod(p, p.norm2_g, 0, 3, 4, bid, nb, wv);
    PH_END(7)
    PH_BEGIN(8) { pg8::GridSched<false> S; S.init(WSP(bf16_t, WS_H), T2048, WSP(bf16_t, WT_GU), T2048, 36, 44, 2048, nbw, bid, SPLIT_G3);
        pg8::Epi<EF_swiglu> E{{WSP(bf16_t, A0_ACT), FFD, 0}};
        if (!helper) { pg8::gemm_phase(lds, pg8::Dims{2048, 2048, SLABS}, S, E, wv); } FILL_TAIL(8);
        GEMM_TAIL(S, E, 0); }
    PH_END(8)
    PH_BEGIN(9) { pg8::GridSched<false> S; S.init(WSP(bf16_t, A0_ACT), (size_t)256 * FFD * 2, WSP(bf16_t, WT_DN), (size_t)256 * FFD * 2, 36, 8, FFD, nbw, bid, SPLIT_G4);
        pg8::Epi<EF_res> E{{WSP(float, WS_XS), WSP(float, WS_MODS), 5, 0}};
        if (!helper) { pg8::gemm_phase(lds, pg8::Dims{FFD, FFD, SLABS}, S, E, wv); } FILL_TAIL(9);
        GEMM_TAIL(S, E, 0); }
    PH_END(9)
    PH_BEGIN(10) ph_norm_mod(p, p.norm1_g + D, 1, 0, 1, bid, nb, wv);
    PH_END(10)
    PH_BEGIN(11) { pg8::GridSched<false> S; S.init(WSP(bf16_t, WS_H), T2048, WSP(bf16_t, WT_DQKV), T2048, 36, 5, 2048, nbw, bid);
        pg8::Epi<EF_dqkv> E{{WSP(float, A1_CQ), WSP(float, A1_CKV), WSP(bf16_t, A1_KR), WSP(float2, WS_TABM)}};
        if (!helper) { pg8::gemm_phase(lds, pg8::Dims{2048, 2048, SLABS}, S, E, wv); } FILL_TAIL(11);
        GEMM_TAIL(S, E, 0); }
    PH_END(11)
    PH_BEGIN(12) ph_lora_norm(p, bid, nb, wv);
    PH_END(12)
    PH_BEGIN(13) {
        pg8::GridSched<true> S1; S1.init(WSP(bf16_t, A1_CQN), T512, WSP(bf16_t, WT_UQ), T512, 32, 12, 512, nbw, bid, SPLIT_P13);
        pg8::Epi<EF_uq> E1{{WSP(bf16_t, A1_QM), WSP(float2, WS_TABM)}};
        if (!helper) pg8::gemm_phase(lds, pg8::Dims{512, 512, SLABS}, S1, E1, wv);
        pg8::GridSched<false> S2; S2.init(WSP(bf16_t, A1_CKVN), T512, WSP(bf16_t, WT_UKV), T512, 36, 16, 512, nbw, nbw - 1 - bid, SPLIT_P13);
        pg8::Epi<EF_bf> E2{{WSP(bf16_t, A1_KVM), 4096, 0}};
        if (!helper) pg8::gemm_phase(lds, pg8::Dims{512, 512, SLABS + ((size_t)256 << 16)}, S2, E2, wv);
#ifdef PROBE_P13
        for (int q_ = 0; q_ < PROBE_P13; ++q_) { __syncthreads(); pg8::Epi<EF_probe> E3{{SLABS, 0, 0}}; if (!helper) pg8::gemm_phase(lds, pg8::Dims{512, 512, SLABS}, S2, E3, wv); }
#endif
        FILL_TAIL(13);
        if (S1.s > 1 || S2.s > 1) { xcd_barrier(bar, wv); pg8::tail_reduce(S1, E1, SLABS, bid, nb, wv); pg8::tail_reduce(S2, E2, SLABS + ((size_t)256 << 16), bid, nb, wv); }
    }
    PH_END(13)
    PH_BEGIN(14) {
        __syncthreads();
        const bf16_t* QM = WSP(bf16_t, A1_QM); const bf16_t* KVM = WSP(bf16_t, A1_KVM); const bf16_t* KR = WSP(bf16_t, A1_KR); bf16_t* OM = WSP(bf16_t, A1_OM);
        for (int r = 0; r * nb + bid < 512; ++r) {
            int it = r * nb + bid;
            if (nb == 256) { const int x = bid & 7, y = bid >> 3; it = (r * 32 + (y >> 3) * 8 + x) * 8 + (y & 7); }
            const int inst = it >> 3, qb = it & 7, b = inst >> 4, h = inst & 15;
            const size_t R0 = (size_t)b * TPB + CTX + qb * 256, K0 = (size_t)b * TPB;
            att::attn_body<3072, 4096, 4096, 2048, true, true>(QM + R0 * 3072 + h * 192, KVM + K0 * 4096 + h * 256, KVM + K0 * 4096 + h * 256 + 128, KR + K0 * 64,
                OM + R0 * 2048 + h * 128, TPB, 0.07216878364870323f * 1.4426950408889634f, 8.f / 0.07216878364870323f, (char*)lds_raw, wv);
        }
    }
    PH_END(14)
    PH_BEGIN(15) { pg8::GridSched<true> S; S.init(WSP(bf16_t, A1_OM), T2048, WSP(bf16_t, WT_O), T2048, 32, 8, 2048, nbw, bid);
        pg8::Epi<EF_res> E{{WSP(float, WS_XS), WSP(float, WS_MODS) + 5 * 6 * D, 2, 0}};
        if (!helper) { pg8::gemm_phase(lds, pg8::Dims{2048, 2048, SLABS}, S, E, wv); } FILL_TAIL(15);
        GEMM_TAIL(S, E, 0); }
    PH_END(15)
    PH_BEGIN(16) { __syncthreads(); ph_route(p, bid, nb, (float*)lds_raw, wv); }
    PH_END(16)
    PH_BEGIN(17) { __syncthreads(); ph_sort(p, bid, (int*)lds_raw, wv);
        if (FILL) { __syncthreads(); moe_fill(p, ctl, -1, nb, bid, lds, MISC, wv); } }
    PH_END(17)
    PH_BEGIN(18) ph_gather(p, bid, nb, wv);
    PH_END(18)
    PH_BEGIN(19) { pg8::TailSched<MoeBase> S; const int tot = S.b.init(WSP(unsigned char, A1_AS), (size_t)2048, WSP(unsigned char, WT_MGU), (size_t)2 * FFE * 2048, (size_t)256 * 2048, 56, (const int*)(p.ws + WS_ROUTE + RT_CNT), (const int*)(p.ws + WS_ROUTE + RT_OFFS)); S.init(tot, 1024, nb, bid, SPLIT_G9);
        pg8::Epi<EF_swiglu8> E{{WSP(unsigned char, A1_ACT2), FFE, 0}};
        pg8::gemm_phase<true>(lds, pg8::Dims{1024, 1024, SLABS}, S, E, wv); GEMM_TAIL(S, E, 0);
#ifdef PROBE_G9
#if PROBE_G9 == 1
        { xcd_barrier(bar, wv); pg8::Epi<EF_probe> E2{{SLABS, 0, 0}}; pg8::gemm_phase<true>(lds, pg8::Dims{1024, 1024, SLABS}, S, E2, wv); }
#elif PROBE_G9 == 2
        { xcd_barrier(bar, wv); pg8::Epi<EF_probe_math> E2{{(unsigned char*)SLABS, FFE, 0}}; pg8::gemm_phase<true>(lds, pg8::Dims{1024, 1024, SLABS}, S, E2, wv); }
#else
        { xcd_barrier(bar, wv); pg8::Epi<EF_probe_store> E2{{(unsigned char*)SLABS, FFE, 0}}; pg8::gemm_phase<true>(lds, pg8::Dims{1024, 1024, SLABS}, S, E2, wv); }
#endif
#endif
    }
    PH_END(19)
    PH_BEGIN(20) { pg8::TailSched<MoeBase> S; const int tot = S.b.init(WSP(unsigned char, A1_ACT2), (size_t)FFE, WSP(unsigned char, WT_MD), (size_t)2048 * FFE, (size_t)256 * FFE, 8, (const int*)(p.ws + WS_ROUTE + RT_CNT), (const int*)(p.ws + WS_ROUTE + RT_OFFS)); S.init(tot, FFE / 2, nb, bid, SPLIT_G10);
        pg8::Epi<EF_y8> E{{WSP(float, A1_Y), 2048, 0}};
        pg8::gemm_phase<true>(lds, pg8::Dims{FFE / 2, FFE / 2, SLABS}, S, E, wv); GEMM_TAIL(S, E, 0); }
    PH_END(20)
    PH_BEGIN(21) ph_final(p, bid, nb, wv);
    PH_END(21)
#undef GEMM_TAIL
#undef FILL_TAIL
#undef RUN
#undef SEAM
#undef PH_BEGIN
#undef PH_END
}
#if ORACLE
template <class G> __global__ __launch_bounds__(256) void ngemm(G g) {
    __shared__ float As[16][132]; __shared__ float Ws[16][132]; __shared__ float W2s[G::DUAL ? 16 : 1][132];
    const int z = blockIdx.z, M = g.rows(z), N = g.N, K = g.K, m0 = blockIdx.y * 128, n0 = blockIdx.x * 128;
    if (m0 >= M) return;
    const int tid = threadIdx.x, tx = tid & 15, ty = tid >> 4;
    float acc[8][8], acc2[G::DUAL ? 8 : 1][8];
#pragma unroll
    for (int i = 0; i < 8; ++i)
#pragma unroll
        for (int j = 0; j < 8; ++j) { acc[i][j] = 0.f; if constexpr (G::DUAL) acc2[i][j] = 0.f; }
    for (int k0 = 0; k0 < K; k0 += 16) {
#pragma unroll
        for (int i = 0; i < 8; ++i) { const int idx = tid + i * 256; const int k = idx & 15, m = idx >> 4; As[k][m] = (m0 + m < M) ? g.a(z, m0 + m, k0 + k) : 0.f; }
#pragma unroll
        for (int i = 0; i < 8; ++i) { const int idx = tid + i * 256; const int n = idx & 127, k = idx >> 7; const bool ok = n0 + n < N; Ws[k][n] = ok ? g.w(z, k0 + k, n0 + n) : 0.f; if constexpr (G::DUAL) W2s[k][n] = ok ? g.w2(z, k0 + k, n0 + n) : 0.f; }
        __syncthreads();
#pragma unroll
        for (int k = 0; k < 16; ++k) {
            float av[8], bv[8], b2[8];
#pragma unroll
            for (int i = 0; i < 8; ++i) { av[i] = As[k][ty * 8 + i]; bv[i] = Ws[k][tx * 8 + i]; if constexpr (G::DUAL) b2[i] = W2s[k][tx * 8 + i]; }
#pragma unroll
            for (int i = 0; i < 8; ++i)
#pragma unroll
                for (int j = 0; j < 8; ++j) { acc[i][j] += av[i] * bv[j]; if constexpr (G::DUAL) acc2[i][j] += av[i] * b2[j]; }
        }
        __syncthreads();
    }
#pragma unroll
    for (int i = 0; i < 8; ++i)
#pragma unroll
        for (int j = 0; j < 8; ++j) { const int m = m0 + ty * 8 + i, n = n0 + tx * 8 + j; if (m < M && n < N) g.epi(z, m, n, acc[i][j], G::DUAL ? acc2[i][j] : 0.f); }
}

template <int HALF> __device__ __forceinline__ int rope_partner(int d) { const int i = d % HALF; return i < HALF / 2 ? d + HALF / 2 : d - HALF / 2; }
template <int HALF> __device__ __forceinline__ float rope_apply(const float2* tab, int nl, int d, float v, float vp) {
    const int half = d / HALF, i = d % HALF, pos = half == 0 ? nl / 64 : nl % 64, fi = i % (HALF / 2); const float2 cs = tab[pos * (HALF / 2) + fi];
    return i < HALF / 2 ? v * cs.x - vp * cs.y : v * cs.x + vp * cs.y;
}

struct G_in {
    static constexpr bool DUAL = true; const bf16_t* H; const float* W; bf16_t *F, *Q, *Kd, *V; const float2* tab; int N, K;
    __device__ int rows(int) const { return NTOK; }
    __device__ float a(int, int m, int k) const { return bf2f(H[(size_t)m * D + k]); }
    __device__ float w(int, int k, int n) const { return W[(size_t)k * EIN + n]; }
    __device__ float w2(int, int k, int n) const { if (n < 1024 || n >= 3072) return 0.f; const int d = n & 127; return W[(size_t)k * EIN + (n - d) + rope_partner<64>(d)]; }
    __device__ void epi(int, int m, int n, float v, float vp) const {
        const int j = m % TPB;
        if (n < 1024) { F[(size_t)m * 1024 + n] = f2bf(v); return; }
        if (n >= 3072) { V[(size_t)m * 1024 + n - 3072] = f2bf(v); return; }
        float o = v; if (j >= CTX) o = rope_apply<64>(tab, j - CTX, n & 127, v, vp);
        if (n < 2048) Q[(size_t)m * 1024 + n - 1024] = f2bf(o); else Kd[(size_t)m * 1024 + n - 2048] = f2bf(o);
    }
};
struct G_dftA {
    static constexpr bool DUAL = false; const bf16_t* F; float* T; int N, K;
    __device__ int rows(int) const { return NTOK * 4; }
    __device__ float a(int, int m, int k) const { return bf2f(F[(size_t)m * 256 + k]); }
    __device__ float w(int, int k, int n) const { const int k3 = n & 255, idx = (k * k3) & 255; const float ang = (float)idx * (2.0f / 256.0f); return n < 256 ? cospif(ang) : sinpif(ang); }
    __device__ float w2(int, int, int) const { return 0.f; }
    __device__ void epi(int, int m, int n, float v, float) const { T[(size_t)m * 512 + n] = v; }
};
struct G_dftB {
    static constexpr bool DUAL = false; const float* T; bf16_t* MIX; int N, K, NS, joff; float scale; int pad;
    __device__ int rows(int) const { return NS; }
    __device__ float a(int, int m, int k) const { const int n = k % NS, part = k / NS; const int idx = (int)(((long)m * n) % NS); const float ang = (float)idx * (2.0f / (float)NS); return part == 0 ? cospif(ang) : -sinpif(ang); }
    __device__ float w(int z, int k, int n) const { const int b = z >> 2, g = z & 3, nn = k % NS, part = k / NS; const int R = b * TPB + joff + nn; return T[((size_t)R * 4 + g) * 512 + part * 256 + n]; }
    __device__ float w2(int, int, int) const { return 0.f; }
    __device__ void epi(int z, int m, int n, float v, float) const { const int b = z >> 2, g = z & 3; const int R = b * TPB + joff + m; MIX[(size_t)R * 2048 + g * 256 + n] = f2bf(v * scale); }
};
struct G_res {
    static constexpr bool DUAL = false; const bf16_t* A; const float* W; float* XS; const float* mods; int N, K, lda, chunk;
    __device__ int rows(int) const { return NTOK; }
    __device__ float a(int, int m, int k) const { return bf2f(A[(size_t)m * lda + k]); }
    __device__ float w(int, int k, int n) const { return W[(size_t)k * N + n]; }
    __device__ float w2(int, int, int) const { return 0.f; }
    __device__ void epi(int, int m, int n, float v, float) const { XS[(size_t)m * D + n] += mods[(size_t)mod_row(m) * 6 * D + chunk * D + n] * v; }
};
struct G_swiglu {
    static constexpr bool DUAL = true; const bf16_t* A; const float *Wg, *Wu; bf16_t* ACT; int N, K;
    __device__ int rows(int) const { return NTOK; }
    __device__ float a(int, int m, int k) const { return bf2f(A[(size_t)m * D + k]); }
    __device__ float w(int, int k, int n) const { return Wg[(size_t)k * N + n]; }
    __device__ float w2(int, int k, int n) const { return Wu[(size_t)k * N + n]; }
    __device__ void epi(int, int m, int n, float v, float v2) const { ACT[(size_t)m * N + n] = f2bf(silu_f(v) * v2); }
};
struct G_dq {
    static constexpr bool DUAL = false; const bf16_t* H; const float* W; float* CQ; int N, K;
    __device__ int rows(int) const { return NTOK; }
    __device__ float a(int, int m, int k) const { return bf2f(H[(size_t)m * D + k]); }
    __device__ float w(int, int k, int n) const { return W[(size_t)k * QLORA + n]; }
    __device__ float w2(int, int, int) const { return 0.f; }
    __device__ void epi(int, int m, int n, float v, float) const { CQ[(size_t)m * 512 + n] = v; }
};
struct G_dkv {
    static constexpr bool DUAL = true; const bf16_t* H; const float* W; float* CKV; bf16_t* KR; const float2* tab; int N, K;
    __device__ int rows(int) const { return NTOK; }
    __device__ float a(int, int m, int k) const { return bf2f(H[(size_t)m * D + k]); }
    __device__ float w(int, int k, int n) const { return W[(size_t)k * 576 + n]; }
    __device__ float w2(int, int k, int n) const { if (n < 512) return 0.f; return W[(size_t)k * 576 + 512 + rope_partner<32>(n - 512)]; }
    __device__ void epi(int, int m, int n, float v, float vp) const {
        if (n < 512) { CKV[(size_t)m * 512 + n] = v; return; }
        const int j = m % TPB; float o = v; if (j >= CTX) o = rope_apply<32>(tab, j - CTX, n - 512, v, vp);
        KR[(size_t)m * 64 + n - 512] = f2bf(o);
    }
};
struct G_uq {
    static constexpr bool DUAL = true; const bf16_t* A; const float* W; bf16_t* QM; const float2* tab; int N, K;
    __device__ int rows(int) const { return NTOK; }
    __device__ float a(int, int m, int k) const { return bf2f(A[(size_t)m * 512 + k]); }
    __device__ float w(int, int k, int n) const { return W[(size_t)k * 3072 + n]; }
    __device__ float w2(int, int k, int n) const { const int d = n % 192; if (d < 128) return 0.f; return W[(size_t)k * 3072 + (n - d) + 128 + rope_partner<32>(d - 128)]; }
    __device__ void epi(int, int m, int n, float v, float vp) const {
        const int d = n % 192, j = m % TPB; float o = v; if (d >= 128 && j >= CTX) o = rope_apply<32>(tab, j - CTX, d - 128, v, vp);
        QM[(size_t)m * 3072 + n] = f2bf(o);
    }
};
struct G_ukv {
    static constexpr bool DUAL = false; const bf16_t* A; const float* W; bf16_t* KVM; int N, K;
    __device__ int rows(int) const { return NTOK; }
    __device__ float a(int, int m, int k) const { return bf2f(A[(size_t)m * 512 + k]); }
    __device__ float w(int, int k, int n) const { return W[(size_t)k * 4096 + n]; }
    __device__ float w2(int, int, int) const { return 0.f; }
    __device__ void epi(int, int m, int n, float v, float) const { KVM[(size_t)m * 4096 + n] = f2bf(v); }
};
struct G_moe1 {
    static constexpr bool DUAL = true; const unsigned char* AS; const float *Wg, *Wu; bf16_t* ACT2; const int *CNT, *OFFS; int N, K;
    __device__ int rows(int z) const { return CNT[z]; }
    __device__ float a(int z, int m, int k) const { return __builtin_amdgcn_cvt_f32_fp8((int)AS[(size_t)(OFFS[z] + m) * D + k], 0); }
    __device__ float w(int z, int k, int n) const { return Wg[((size_t)z * D + k) * FFE + n]; }
    __device__ float w2(int z, int k, int n) const { return Wu[((size_t)z * D + k) * FFE + n]; }
    __device__ void epi(int z, int m, int n, float v, float v2) const { ACT2[(size_t)(OFFS[z] + m) * FFE + n] = f2bf(silu_f(v) * v2); }
};
struct G_moe2 {
    static constexpr bool DUAL = false; const unsigned char* ACT2; const float* Wd; float* Y; const int *CNT, *OFFS; int N, K;
    __device__ int rows(int z) const { return CNT[z]; }
    __device__ float a(int z, int m, int k) const { return __builtin_amdgcn_cvt_f32_fp8((int)ACT2[(size_t)(OFFS[z] + m) * FFE + k], 0) * (1.0f / A8_ACT); }
    __device__ float w(int z, int k, int n) const { return Wd[((size_t)z * FFE + k) * D + n]; }
    __device__ float w2(int, int, int) const { return 0.f; }
    __device__ void epi(int z, int m, int n, float v, float) const { Y[(size_t)(OFFS[z] + m) * D + n] = v; }
};

template <int DQK, int DV, class F> __global__ __launch_bounds__(256) void nattn(F f, int nkeys, float scale) {
    extern __shared__ float sm[];
    float* qs = sm;
    float* Pm = sm + 4 * DQK;
    __shared__ float rsum[4];
    const int z = blockIdx.y, q0 = blockIdx.x * 4, tid = threadIdx.x, lane = tid & 63, wave = tid >> 6;
    for (int i = tid; i < 4 * DQK; i += 256) { const int r = i / DQK, d = i % DQK; qs[i] = bf2f(f.qptr(z, q0 + r)[d]); }
    __syncthreads();
    for (int kk = tid; kk < nkeys; kk += 256) {
        float s0 = 0.f, s1 = 0.f, s2 = 0.f, s3 = 0.f;
        const bf16_t* kp = f.kptr(z, kk);
        for (int d = 0; d < 128; ++d) { const float kv = bf2f(kp[d]); s0 += qs[d] * kv; s1 += qs[DQK + d] * kv; s2 += qs[2 * DQK + d] * kv; s3 += qs[3 * DQK + d] * kv; }
        if (DQK > 128) { const bf16_t* k2 = f.k2ptr(z, kk);
            for (int d = 128; d < DQK; ++d) { const float kv = bf2f(k2[d - 128]); s0 += qs[d] * kv; s1 += qs[DQK + d] * kv; s2 += qs[2 * DQK + d] * kv; s3 += qs[3 * DQK + d] * kv; } }
        Pm[kk] = s0 * scale; Pm[nkeys + kk] = s1 * scale; Pm[2 * nkeys + kk] = s2 * scale; Pm[3 * nkeys + kk] = s3 * scale;
    }
    __syncthreads();
    {
        float* pr = Pm + wave * nkeys; float mx = -3.0e38f;
        for (int kk = lane; kk < nkeys; kk += 64) mx = fmaxf(mx, pr[kk]);
        mx = wave_max(mx); float s = 0.f;
        for (int kk = lane; kk < nkeys; kk += 64) { const float e = expf(pr[kk] - mx); pr[kk] = e; s += e; }
        s = wave_sum(s); if (lane == 0) rsum[wave] = s;
    }
    __syncthreads();
    for (int idx = tid; idx < 4 * DV; idx += 256) {
        const int r = idx / DV, e = idx % DV; const float* pr = Pm + r * nkeys; float acc = 0.f;
        for (int kk = 0; kk < nkeys; ++kk) acc += pr[kk] * bf2f(f.vptr(z, kk)[e]);
        f.store(z, q0 + r, e, acc / rsum[r]);
    }
}
struct A_diff {
    const bf16_t *Q, *K, *V; float* OD; int joff, pad;
    __device__ const bf16_t* qptr(int z, int qi) const { const int b = z >> 3, h = (z >> 1) & 3, c = z & 1; return Q + (size_t)(b * TPB + joff + qi) * 1024 + h * 256 + c * 128; }
    __device__ const bf16_t* kptr(int z, int kk) const { const int b = z >> 3, h = (z >> 1) & 3, c = z & 1; return K + (size_t)(b * TPB + kk) * 1024 + h * 256 + c * 128; }
    __device__ const bf16_t* k2ptr(int, int) const { return nullptr; }
    __device__ const bf16_t* vptr(int z, int kk) const { const int b = z >> 3, h = (z >> 1) & 3; return V + (size_t)(b * TPB + kk) * 1024 + h * 256; }
    __device__ void store(int z, int qi, int e, float v) const { const int b = z >> 3, h = (z >> 1) & 3, c = z & 1; OD[(((size_t)(b * TPB + joff + qi) * 4 + h) * 2 + c) * 256 + e] = v; }
};
struct A_mla {
    const bf16_t *QM, *KVM, *KR; bf16_t* OM;
    __device__ const bf16_t* qptr(int z, int qi) const { const int b = z >> 4, h = z & 15; return QM + (size_t)(b * TPB + CTX + qi) * 3072 + h * 192; }
    __device__ const bf16_t* kptr(int z, int kk) const { const int b = z >> 4, h = z & 15; return KVM + (size_t)(b * TPB + kk) * 4096 + h * 256; }
    __device__ const bf16_t* k2ptr(int z, int kk) const { const int b = z >> 4; return KR + (size_t)(b * TPB + kk) * 64; }
    __device__ const bf16_t* vptr(int z, int kk) const { const int b = z >> 4, h = z & 15; return KVM + (size_t)(b * TPB + kk) * 4096 + h * 256 + 128; }
    __device__ void store(int z, int qi, int e, float v) const { const int b = z >> 4, h = z & 15; OM[(size_t)(b * TPB + CTX + qi) * 2048 + h * 128 + e] = f2bf(v); }
};

#endif

#if ORACLE
__global__ __launch_bounds__(256) void k_cmp(const void* a, int a_bf  , const void* b, int b_bf, int rows, int cols, int lda, int ldb, int mask, const int* slottok, double* err) {
    double num = 0.0, den = 0.0;
    for (size_t i = (size_t)blockIdx.x * 256 + threadIdx.x; i < (size_t)rows * cols; i += (size_t)gridDim.x * 256) {
        const int r = (int)(i / cols), c = (int)(i % cols);
        if (mask == 1 && (r % TPB) < CTX) continue;
        if (mask == 2 && slottok[r] < 0) continue;
        const float va = a_bf == 2 ? __builtin_amdgcn_cvt_f32_fp8((int)((const unsigned char*)a)[(size_t)r * lda + c], 0) * (1.0f / A8_ACT) : a_bf ? bf2f(((const bf16_t*)a)[(size_t)r * lda + c]) : ((const float*)a)[(size_t)r * lda + c];
        const float vb = b_bf ? bf2f(((const bf16_t*)b)[(size_t)r * ldb + c]) : ((const float*)b)[(size_t)r * ldb + c];
        const double d = (double)va - (double)vb; num += d * d; den += (double)vb * (double)vb;
    }
    for (int o = 32; o >= 1; o >>= 1) { num += __shfl_xor(num, o); den += __shfl_xor(den, o); }
    if ((threadIdx.x & 63) == 0) { atomicAdd(err, num); atomicAdd(err + 1, den); }
}
__global__ __launch_bounds__(256) void k_verdict(float* out, size_t n, const double* err, int nslots, double tol) {
    int bad = -1;
    for (int s = 0; s < nslots; ++s) { const double num = err[2 * s], den = err[2 * s + 1]; const double t = s >= 16 ? 0.02 : tol; if (!(num <= t * den) || !(den > 0.0)) { bad = s; break; } }
    if (bad < 0) return;
    const float f = 1.0f + exp2f((float)(bad + 1));
    for (size_t i = (size_t)blockIdx.x * 256 + threadIdx.x; i < n; i += (size_t)gridDim.x * 256) out[i] *= f;
}
static_assert(sizeof(G_in) == 64 && sizeof(G_dftA) == 24 && sizeof(G_dftB) == 40 && sizeof(G_res) == 48 && sizeof(G_swiglu) == 40 && sizeof(G_dq) == 32 && sizeof(G_dkv) == 48 && sizeof(G_uq) == 40 && sizeof(G_ukv) == 32 && sizeof(G_moe1) == 56 && sizeof(G_moe2) == 48 && sizeof(A_diff) == 40 && sizeof(A_mla) == 32, "no padding bytes in by-value kernel arguments");
template <class G> static void run_gemm(const G& g, int Mmax, int Z, hipStream_t s) { hipLaunchKernelGGL(ngemm<G>, dim3((g.N + 127) / 128, (Mmax + 127) / 128, Z), dim3(256), 0, s, g); }
#endif
static_assert(sizeof(P) == 29 * 8, "P has no padding");

extern "C" void kernel_launch(void* const* d_in, const int* in_sizes, int n_in, void* d_out, int out_size, void* d_ws, size_t ws_size, hipStream_t stream) {
    static int grid = 0;
    if (grid == 0) {
        const size_t need = ORACLE ? (WS_SCR + (size_t)NSLOT * FFE * 2 > WS_SCR_XS + (size_t)NTOK * D * 4 ? WS_SCR + (size_t)NSLOT * FFE * 2 : WS_SCR_XS + (size_t)NTOK * D * 4) + 4096 : WS_END;
        if (n_in != 27 || ws_size < need) { fprintf(stderr, "kernel_launch: n_in %d ws %zu need %zu\n", n_in, ws_size, need); grid = -1; return; }
        int dev = 0, cus = 0, per_cu = 0;
        if (hipGetDevice(&dev) != hipSuccess || hipDeviceGetAttribute(&cus, hipDeviceAttributeMultiprocessorCount, dev) != hipSuccess) { grid = -1; return; }
        if (hipFuncSetAttribute((const void*)mega, hipFuncAttributeMaxDynamicSharedMemorySize, LDS_BYTES) != hipSuccess) { fprintf(stderr, "kernel_launch: hipFuncSetAttribute failed\n"); grid = -1; return; }
        if (hipOccupancyMaxActiveBlocksPerMultiprocessor(&per_cu, (const void*)mega, 512, LDS_BYTES) != hipSuccess || per_cu < 1) { fprintf(stderr, "kernel_launch: occupancy query says %d\n", per_cu); }
        (void)hipGetLastError();
        grid = cus;
    }
    if (grid < 0) return;
    (void)hipMemsetAsync((char*)d_ws + WS_CTL, 0, 1u << 20, stream);
    P p{};
    const float** pi = (const float**)&p;
    for (int i = 0; i < 27; ++i) pi[i] = (const float*)d_in[i];
    p.out = (float*)d_out; p.ws = (unsigned char*)d_ws;
#if !ORACLE
    hipLaunchKernelGGL(mega, dim3(grid), dim3(512), LDS_BYTES, stream, p, 0, NPH, 0);
#else
    double* ERR = (double*)(p.ws + WS_CTL + (size_t)CW_ERR * 4);
    unsigned char* SCR = p.ws + WS_SCR;
    const int* SLOTTOK = (const int*)(p.ws + WS_ROUTE + RT_SLOTTOK);
    auto PH = [&](int k) { hipLaunchKernelGGL(mega, dim3(grid), dim3(512), LDS_BYTES, stream, p, k, k + 1, k); };
    auto CMP = [&](int slot, const void* a, int abf, const void* b, int bbf, int rows, int cols, int lda, int ldb, int mask) {
        hipLaunchKernelGGL(k_cmp, dim3(2048), dim3(256), 0, stream, a, abf, b, bbf, rows, cols, lda, ldb, mask, SLOTTOK, ERR + 2 * slot); };
    const size_t SZ1K = (size_t)NTOK * 1024 * 2, SZXS = (size_t)NTOK * D * 4;
    PH(0); PH(1);
    PH(2);
    { bf16_t *Fo = (bf16_t*)SCR, *Qo = (bf16_t*)(SCR + SZ1K), *Ko = (bf16_t*)(SCR + 2 * SZ1K), *Vo = (bf16_t*)(SCR + 3 * SZ1K);
      G_in g{WSP(bf16_t, WS_H), p.ev_w_in, Fo, Qo, Ko, Vo, WSP(float2, WS_TABD), EIN, D}; run_gemm(g, NTOK, 1, stream);
      CMP(0, WSP(bf16_t, A0_F), 1, Fo, 1, NTOK, 1024, 1024, 1024, 0); CMP(1, WSP(bf16_t, A0_Q), 1, Qo, 1, NTOK, 1024, 1024, 1024, 0);
      CMP(2, WSP(bf16_t, A0_K), 1, Ko, 1, NTOK, 1024, 1024, 1024, 0); CMP(3, WSP(bf16_t, A0_V), 1, Vo, 1, NTOK, 1024, 1024, 1024, 0); }
    PH(3); PH(4);
    { float* T32 = (float*)SCR; bf16_t* MIXo = (bf16_t*)(SCR + (size_t)NTOK * 4 * 512 * 4);
      G_dftA g{WSP(bf16_t, A0_F), T32, 512, 256}; run_gemm(g, NTOK * 4, 1, stream);
      G_dftB g1{T32, MIXo, 256, 2 * SEQ, SEQ, CTX, 1.0f / sqrtf((float)SEQ * 256.f), 0}; run_gemm(g1, SEQ, 16, stream);
      G_dftB g2{T32, MIXo, 256, 2 * CTX, CTX, 0, 1.0f / sqrtf((float)CTX * 256.f), 0}; run_gemm(g2, CTX, 16, stream);
      CMP(4, WSP(bf16_t, A0_MIX), 1, MIXo, 1, NTOK, 1024, 2048, 2048, 0);
      float* ODo = (float*)SCR;
      A_diff f{WSP(bf16_t, A0_Q), WSP(bf16_t, A0_K), WSP(bf16_t, A0_V), ODo, CTX, 0};
      hipLaunchKernelGGL((nattn<128, 256, A_diff>), dim3(SEQ / 4, 32), dim3(256), (4 * 128 + 4 * TPB) * 4, stream, f, TPB, 0.08838834764831845f);
      A_diff f2{WSP(bf16_t, A0_Q), WSP(bf16_t, A0_K), WSP(bf16_t, A0_V), ODo, 0, 0};
      hipLaunchKernelGGL((nattn<128, 256, A_diff>), dim3(CTX / 4, 32), dim3(256), (4 * 128 + 4 * CTX) * 4, stream, f2, CTX, 0.08838834764831845f);
      CMP(5, WSP(float, A0_OD), 0, ODo, 0, NTOK, 2048, 2048, 2048, 0); }
    PH(5);
    { float* XSo = (float*)(p.ws + WS_SCR_XS); (void)hipMemcpyAsync(XSo, WSP(float, WS_XS), SZXS, hipMemcpyDeviceToDevice, stream);
      G_res g{WSP(bf16_t, A0_MIX), p.ev_w_out, XSo, WSP(float, WS_MODS), D, 2048, 2048, 2}; run_gemm(g, NTOK, 1, stream);
      PH(6); CMP(6, WSP(float, WS_XS), 0, XSo, 0, NTOK, D, D, D, 0); }
    PH(7);
    PH(8);
    { bf16_t* ACTo = (bf16_t*)SCR; G_swiglu g{WSP(bf16_t, WS_H), p.ffn_w_gate, p.ffn_w_up, ACTo, FFD, D}; run_gemm(g, NTOK, 1, stream);
      CMP(7, WSP(bf16_t, A0_ACT), 1, ACTo, 1, NTOK, FFD, FFD, FFD, 0); }
    { float* XSo = (float*)(p.ws + WS_SCR_XS); (void)hipMemcpyAsync(XSo, WSP(float, WS_XS), SZXS, hipMemcpyDeviceToDevice, stream);
      G_res g{WSP(bf16_t, A0_ACT), p.ffn_w_down, XSo, WSP(float, WS_MODS), D, FFD, FFD, 5}; run_gemm(g, NTOK, 1, stream);
      PH(9); CMP(8, WSP(float, WS_XS), 0, XSo, 0, NTOK, D, D, D, 0); }
    PH(10);
    PH(11);
    { float* CQo = (float*)SCR; float* CKVo = (float*)(SCR + (size_t)NTOK * 512 * 4); bf16_t* KRo = (bf16_t*)(SCR + (size_t)NTOK * 512 * 8);
      G_dq g{WSP(bf16_t, WS_H), p.od_w_dq, CQo, QLORA, D}; run_gemm(g, NTOK, 1, stream);
      G_dkv g2{WSP(bf16_t, WS_H), p.od_w_dkv, CKVo, KRo, WSP(float2, WS_TABM), 576, D}; run_gemm(g2, NTOK, 1, stream);
      CMP(9, WSP(float, A1_CQ), 0, CQo, 0, NTOK, 512, 512, 512, 0); CMP(10, WSP(float, A1_CKV), 0, CKVo, 0, NTOK, 512, 512, 512, 0); CMP(11, WSP(bf16_t, A1_KR), 1, KRo, 1, NTOK, 64, 64, 64, 0); }
    PH(12);
    PH(13);
    { bf16_t* QMo = (bf16_t*)SCR; bf16_t* KVMo = (bf16_t*)(SCR + (size_t)NTOK * 3072 * 2);
      G_uq g{WSP(bf16_t, A1_CQN), p.od_w_uq, QMo, WSP(float2, WS_TABM), 3072, 512}; run_gemm(g, NTOK, 1, stream);
      G_ukv g2{WSP(bf16_t, A1_CKVN), p.od_w_ukv, KVMo, 4096, 512}; run_gemm(g2, NTOK, 1, stream);
      CMP(12, WSP(bf16_t, A1_QM), 1, QMo, 1, NTOK, 3072, 3072, 3072, 1); CMP(13, WSP(bf16_t, A1_KVM), 1, KVMo, 1, NTOK, 4096, 4096, 4096, 0); }
    PH(14);
    { bf16_t* OMo = (bf16_t*)SCR; A_mla f{WSP(bf16_t, A1_QM), WSP(bf16_t, A1_KVM), WSP(bf16_t, A1_KR), OMo};
      hipLaunchKernelGGL((nattn<192, 128, A_mla>), dim3(SEQ / 4, 64), dim3(256), (4 * 192 + 4 * TPB) * 4, stream, f, TPB, 0.07216878364870323f);
      CMP(14, WSP(bf16_t, A1_OM), 1, OMo, 1, NTOK, 2048, 2048, 2048, 1); }
    { float* XSo = (float*)(p.ws + WS_SCR_XS); (void)hipMemcpyAsync(XSo, WSP(float, WS_XS), SZXS, hipMemcpyDeviceToDevice, stream);
      G_res g{WSP(bf16_t, A1_OM), p.od_w_o, XSo, WSP(float, WS_MODS) + 5 * 6 * D, D, 2048, 2048, 2}; run_gemm(g, NTOK, 1, stream);
      PH(15); CMP(15, WSP(float, WS_XS), 0, XSo, 0, NTOK, D, D, D, 1); }
    PH(16); PH(17); PH(18);
    PH(19);
    { bf16_t* ACT2o = (bf16_t*)SCR; G_moe1 g{WSP(unsigned char, A1_AS), p.moe_w_gate, p.moe_w_up, ACT2o, (const int*)(p.ws + WS_ROUTE + RT_CNT), (const int*)(p.ws + WS_ROUTE + RT_OFFS), FFE, D}; run_gemm(g, NB * SEQ, 8, stream);
      CMP(16, WSP(unsigned char, A1_ACT2), 2, ACT2o, 1, NSLOT, FFE, FFE, FFE, 2); }
    PH(20);
    { float* Yo = (float*)SCR; G_moe2 g{WSP(unsigned char, A1_ACT2), p.moe_w_down, Yo, (const int*)(p.ws + WS_ROUTE + RT_CNT), (const int*)(p.ws + WS_ROUTE + RT_OFFS), D, FFE}; run_gemm(g, NB * SEQ, 8, stream);
      CMP(17, WSP(float, A1_Y), 0, Yo, 0, NSLOT, D, D, D, 2); }
    PH(21);
    hipLaunchKernelGGL(k_verdict, dim3(2048), dim3(256), 0, stream, p.out, (size_t)NB * SEQ * D, (const double*)ERR, 18, 2.0e-4);
#endif
}
```

```cpp
#ifndef ORACLE
#define ORACLE 0
#endif
#include <hip/hip_runtime.h>
#include <cstdio>
#include <cstdint>

constexpr int D = 2048, NB = 4, SEQ = 2048, CTX = 256, TPB = SEQ + CTX  , NTOK = NB * TPB  ;
constexpr int FW = 1024, QKW = 1024, VW = 1024, EIN = 4096, FFD = 5632, NEXP = 8, FFE = 7168;
constexpr int QLORA = 512, KVLORA = 512, MROPE = 64, MH = 16;
constexpr int NSLOT = 2 * NB * SEQ + NEXP * 256;
constexpr float EPS = 1e-6f;

typedef unsigned short bf16_t;
typedef float f32x4 __attribute__((ext_vector_type(4)));
typedef short bf16x8 __attribute__((ext_vector_type(8)));

__device__ __forceinline__ float bf2f(bf16_t v) { return __uint_as_float(((unsigned)v) << 16); }
__device__ __forceinline__ bf16_t f2bf(float f) { unsigned u = __float_as_uint(f); u += 0x7fffu + ((u >> 16) & 1u); return (bf16_t)(u >> 16); }
__device__ __forceinline__ float wave_sum(float v) {
#pragma unroll
    for (int o = 1; o < 64; o <<= 1) v += __shfl_xor(v, o);
    return v;
}
__device__ __forceinline__ float wave_max(float v) {
#pragma unroll
    for (int o = 1; o < 64; o <<= 1) v = fmaxf(v, __shfl_xor(v, o));
    return v;
}
__device__ __forceinline__ int lane_id() { int l; asm volatile("v_mbcnt_lo_u32_b32 %0, -1, 0\n\tv_mbcnt_hi_u32_b32 %0, -1, %0" : "=v"(l)); return l; }
__device__ __forceinline__ int tid_from(int wv) { asm volatile("" : "+s"(wv)); return wv * 64 + lane_id(); }
#define TID_FROM(wv) tid_from(wv)
constexpr float W8_GU = 32.f, W8_DN = 64.f, A8_ACT = 4.f;
__device__ __forceinline__ unsigned pack4_fp8(float a, float b, float c, float d) {
    a = fminf(fmaxf(a, -448.f), 448.f); b = fminf(fmaxf(b, -448.f), 448.f); c = fminf(fmaxf(c, -448.f), 448.f); d = fminf(fmaxf(d, -448.f), 448.f);
    int w = 0; w = __builtin_amdgcn_cvt_pk_fp8_f32(a, b, w, false); w = __builtin_amdgcn_cvt_pk_fp8_f32(c, d, w, true); return (unsigned)w;
}
__device__ __forceinline__ float silu_f(float x) { return x / (1.f + expf(-x)); }

constexpr size_t al(size_t x) { return (x + 4095) / 4096 * 4096; }
constexpr size_t WS_CTL = 0;
constexpr size_t WS_XS = 1u << 20;
constexpr size_t WS_MODS = WS_XS + al((size_t)NTOK * D * 4);
constexpr size_t WS_TABD = WS_MODS + al((size_t)2 * 5 * 6 * D * 4);
constexpr size_t WS_TABM = WS_TABD + al(64 * 32 * 8);
constexpr size_t WS_SCAL = WS_TABM + al(64 * 16 * 8);
constexpr size_t WS_H = WS_SCAL + 4096;
constexpr size_t WS_ROUTE = WS_H + al((size_t)NTOK * D * 2);
constexpr size_t RT_TE = 0, RT_TG = (size_t)NTOK * 8, RT_TSLOT = (size_t)NTOK * 16, RT_SLOTTOK = (size_t)NTOK * 24, RT_CNT = RT_SLOTTOK + (size_t)NSLOT * 4, RT_OFFS = RT_CNT + 64;
constexpr size_t WT_IN = WS_ROUTE + al(RT_OFFS + 64);
constexpr size_t WT_OUT = WT_IN + al((size_t)4096 * 2048 * 2);
constexpr size_t WT_GU = WT_OUT + al((size_t)2048 * 2048 * 2);
constexpr size_t WT_DN = WT_GU + al((size_t)2 * FFD * 2048 * 2);
constexpr size_t WT_DQKV = WT_DN + al((size_t)2048 * FFD * 2);
constexpr size_t WT_UQ = WT_DQKV + al((size_t)1280 * 2048 * 2);
constexpr size_t WT_UKV = WT_UQ + al((size_t)3072 * 512 * 2);
constexpr size_t WT_O = WT_UKV + al((size_t)4096 * 512 * 2);
constexpr size_t WT_MGU = WT_O + al((size_t)2048 * 2048 * 2);
constexpr size_t WT_MD = WT_MGU + al((size_t)8 * 2 * FFE * 2048);
constexpr size_t WS_WCS = WT_MD + al((size_t)8 * 2048 * FFE);
constexpr size_t WS_DFTN = WS_WCS + al(512 * 256 * 2);
constexpr size_t WS_DFTC = WS_DFTN + al((size_t)2048 * 4096 * 2);
constexpr size_t WS_ACTS = WS_DFTC + al(256 * 512 * 2);
constexpr size_t A0_F = WS_ACTS;
constexpr size_t A0_Q = A0_F + al((size_t)NTOK * 1024 * 2);
constexpr size_t A0_K = A0_Q + al((size_t)NTOK * 1024 * 2);
constexpr size_t A0_V = A0_K + al((size_t)NTOK * 1024 * 2);
constexpr size_t A0_VT = A0_V + al((size_t)NTOK * 1024 * 2);
constexpr size_t A0_VTC = A0_VT + al((size_t)16 * 256 * 4096 * 2);
constexpr size_t A0_OD = A0_VTC + al((size_t)16 * 256 * 512 * 2);
constexpr size_t A0_MIX = A0_OD + al((size_t)NTOK * 2048 * 4);
constexpr size_t A0_ACT = A0_MIX + al((size_t)NTOK * 2048 * 2);
constexpr size_t A0_END = A0_ACT + al((size_t)NTOK * FFD * 2);
constexpr size_t A1_CQ = WS_ACTS;
constexpr size_t A1_CKV = A1_CQ + al((size_t)NTOK * 512 * 4);
constexpr size_t A1_KR = A1_CKV + al((size_t)NTOK * 512 * 4);
constexpr size_t A1_CQN = A1_KR + al((size_t)NTOK * 64 * 2);
constexpr size_t A1_CKVN = A1_CQN + al((size_t)NTOK * 512 * 2);
constexpr size_t A1_QM = A1_CKVN + al((size_t)NTOK * 512 * 2);
constexpr size_t A1_KVM = A1_QM + al((size_t)NTOK * 3072 * 2);
constexpr size_t A1_OM = A1_KVM + al((size_t)NTOK * 4096 * 2);
constexpr size_t A1_AS = A1_OM + al((size_t)NTOK * 2048 * 2);
constexpr size_t A1_ACT2 = A1_AS + al((size_t)NSLOT * 2048);
constexpr size_t A1_Y = WS_ACTS;
constexpr size_t A1_END = A1_ACT2 + al((size_t)NSLOT * FFE);
static_assert(A1_Y + (size_t)NSLOT * 2048 * 4 <= A1_AS, "Y overlays only the dead MLA buffers");
constexpr size_t WS_ARENA_END = A0_END > A1_END ? A0_END : A1_END;
constexpr size_t WS_SLAB = WS_ARENA_END;
constexpr size_t SLAB_BYTES = (size_t)384 << 18;
constexpr size_t WS_END = WS_SLAB + SLAB_BYTES;
constexpr size_t WS_SCR = WS_SLAB;
constexpr size_t WS_SCR_XS = WS_END;

struct P {
    const float *x, *c, *ctx, *c_ctx, *ada_w, *ada_b, *norm1_g, *norm2_g, *ev_w_in, *ev_w_out, *ev_lambda, *ev_subln_g;
    const float *od_w_dq, *od_q_norm_g, *od_w_uq, *od_w_dkv, *od_kv_norm_g, *od_w_ukv, *od_w_o;
    const float *ffn_w_gate, *ffn_w_up, *ffn_w_down, *moe_router, *moe_w_gate, *moe_w_up, *moe_w_down, *final_norm_g;
    float* out; unsigned char* ws;
};
#define WSP(T, off) ((T*)(p.ws + (off)))

__device__ __forceinline__ int mod_row(int R) { const int b = R / TPB, j = R - b * TPB; return j < CTX ? 4 : b; }

__device__ __forceinline__ void ph_prologue(const P& p, int bid, int nb, float* lds_f, int wv) {
    int tid_ = TID_FROM(wv); asm volatile("" : "+v"(tid_)); const int tid = tid_, lane = tid & 63, wave = tid >> 6;
    float* XS = WSP(float, WS_XS);
    if (ORACLE) for (size_t i = (size_t)bid * 512 + tid; i < (size_t)NTOK * (D / 4); i += (size_t)nb * 512) {
        const int R = (int)(i / (D / 4)), c4 = (int)(i % (D / 4)); const int b = R / TPB, j = R - b * TPB;
        const float* src = j < CTX ? p.ctx + ((size_t)(b * CTX + j)) * D : p.x + ((size_t)(b * SEQ + (j - CTX))) * D;
        ((f32x4*)XS)[i] = ((const f32x4*)src)[c4];
    }
    if (bid == 0) {
        float2* TD = WSP(float2, WS_TABD); float2* TM = WSP(float2, WS_TABM);
        for (int i = tid; i < 64 * 32; i += 512) { const int pos = i / 32, fi = i % 32; const double inv = pow(10000.0, -(double)(2 * fi) / 64.0), a = (double)pos * inv; TD[i] = make_float2((float)cos(a), (float)sin(a)); }
        for (int i = tid; i < 64 * 16; i += 512) { const int pos = i / 16, fi = i % 16; const double inv = pow(10000.0, -(double)(2 * fi) / 32.0), a = (double)pos * inv; TM[i] = make_float2((float)cos(a), (float)sin(a)); }
        if (wave == 0) {
            float s01 = 0.f, s23 = 0.f;
            for (int i = lane; i < 128; i += 64) { s01 += p.ev_lambda[i] * p.ev_lambda[128 + i]; s23 += p.ev_lambda[256 + i] * p.ev_lambda[384 + i]; }
            s01 = wave_sum(s01); s23 = wave_sum(s23);
            if (lane == 0) WSP(float, WS_SCAL)[0] = expf(s01) - expf(s23) + 0.2f;
        }
    }
    float* S = lds_f;
    float* RED = lds_f + 5 * 2048;
    for (int i = tid; i < 5 * D; i += 512) { const int bb = i / D, k = i % D; const float v = bb < 4 ? p.c[bb * D + k] : p.c_ctx[k]; S[i] = silu_f(v); }
    __syncthreads();
    float* MODS = WSP(float, WS_MODS);
    for (int it = bid; it < 2 * 128; it += nb) {
        const int layer = it >> 7, cg = it & 127, ln = lane < 48 ? lane : 47, col = cg * 96 + ln * 2;
        const float* W = p.ada_w + (size_t)layer * D * 6 * D + col;
        float a0[5], a1[5];
#pragma unroll
        for (int bb = 0; bb < 5; ++bb) { a0[bb] = 0.f; a1[bb] = 0.f; }
        const int kb = wave * 256;
#pragma unroll 1
        for (int k0 = 0; k0 < 256; k0 += 16) {
            float2 w[16];
#pragma unroll
            for (int u = 0; u < 16; ++u) w[u] = *(const float2*)(W + (size_t)(kb + k0 + u) * 6 * D);
#pragma unroll
            for (int u = 0; u < 16; ++u) {
#pragma unroll
                for (int bb = 0; bb < 5; ++bb) { const float s = S[bb * D + kb + k0 + u]; a0[bb] += s * w[u].x; a1[bb] += s * w[u].y; } }
        }
        if (lane < 48) {
#pragma unroll
            for (int bb = 0; bb < 5; ++bb) { RED[(wave * 5 + bb) * 96 + lane * 2] = a0[bb]; RED[(wave * 5 + bb) * 96 + lane * 2 + 1] = a1[bb]; } }
        __syncthreads();
        for (int i = tid; i < 5 * 96; i += 512) { const int bb = i / 96, cc = i % 96; float s = 0.f;
#pragma unroll
            for (int w = 0; w < 8; ++w) s += RED[(w * 5 + bb) * 96 + cc];
            MODS[((size_t)layer * 5 + bb) * 6 * D + cg * 96 + cc] = s + p.ada_b[(size_t)layer * 6 * D + cg * 96 + cc]; }
        __syncthreads();
    }
}

__device__ __forceinline__ const float* in_row(const P& p, int R) { const int b = R / TPB, j = R - b * TPB; return j < CTX ? p.ctx + ((size_t)(b * CTX + j)) * D : p.x + ((size_t)(b * SEQ + (j - CTX))) * D; }
template <bool FROM_IN = false> __device__ __forceinline__ void ph_norm_mod(const P& p, const float* g, int layer, int csh, int csc, int bid, int nb, int wv) {
    int tid_ = TID_FROM(wv); asm volatile("" : "+v"(tid_)); const int tid = tid_, lane = tid & 63, wave = tid >> 6;
    const float* XS = WSP(float, WS_XS); const float* MODS = WSP(float, WS_MODS) + (size_t)layer * 5 * 6 * D; bf16_t* H = WSP(bf16_t, WS_H);
    for (int R = bid * 8 + wave; R < NTOK; R += nb * 8) {
        const f32x4* xr = (const f32x4*)(FROM_IN ? in_row(p, R) : XS + (size_t)R * D); f32x4 v[8]; float ss = 0.f;
#pragma unroll
        for (int j = 0; j < 8; ++j) { v[j] = xr[lane + 64 * j]; ss += v[j].x * v[j].x + v[j].y * v[j].y + v[j].z * v[j].z + v[j].w * v[j].w; }
        const float rstd = 1.0f / sqrtf(wave_sum(ss) * (1.f / D) + EPS);
        const float* mr = MODS + (size_t)mod_row(R) * 6 * D;
#pragma unroll
        for (int j = 0; j < 8; ++j) { const int c0 = (lane + 64 * j) * 4; const f32x4 gg = *(const f32x4*)(g + c0), sh = *(const f32x4*)(mr + csh * D + c0), sc = *(const f32x4*)(mr + csc * D + c0);
            const f32x4 o = (v[j] * rstd * gg) * (sc + 1.f) + sh;
            ushort4 w; w.x = f2bf(o.x); w.y = f2bf(o.y); w.z = f2bf(o.z); w.w = f2bf(o.w);
            *(ushort4*)(H + (size_t)R * D + c0) = w; }
    }
}

__device__ __forceinline__ void ph_subln(const P& p, int bid, int nb, int wv) {
    int tid_ = TID_FROM(wv); asm volatile("" : "+v"(tid_)); const int tid = tid_, lane = tid & 63, wave = tid >> 6;
    const float* OD = WSP(float, A0_OD); bf16_t* MIX = WSP(bf16_t, A0_MIX); const float lam = WSP(float, WS_SCAL)[0];
    const f32x4 gg = *(const f32x4*)(p.ev_subln_g + lane * 4);
    for (int it0 = bid * 8 + wave; it0 < NTOK * 4; it0 += nb * 8 * 4) {
        f32x4 o0[4], o1[4];
#pragma unroll
        for (int u = 0; u < 4; ++u) { const int it = it0 + u * nb * 8; if (it < NTOK * 4) { o0[u] = *(const f32x4*)(OD + ((size_t)it * 2 + 0) * 256 + lane * 4); o1[u] = *(const f32x4*)(OD + ((size_t)it * 2 + 1) * 256 + lane * 4); } else { o0[u] = o1[u] = (f32x4){0.f, 0.f, 0.f, 0.f}; } }
#pragma unroll
        for (int u = 0; u < 4; ++u) { const int it = it0 + u * nb * 8; const int R = it >> 2, h = it & 3;
            const f32x4 o = o0[u] - o1[u] * lam;
            const float rstd = 1.0f / sqrtf(wave_sum(o.x * o.x + o.y * o.y + o.z * o.z + o.w * o.w) * (1.f / 256.f) + EPS);
            const f32x4 r = o * rstd * gg * 0.8f;
            ushort4 w; w.x = f2bf(r.x); w.y = f2bf(r.y); w.z = f2bf(r.z); w.w = f2bf(r.w);
            if (it < NTOK * 4) *(ushort4*)(MIX + (size_t)R * 2048 + 1024 + h * 256 + lane * 4) = w; }
    }
}

__device__ __forceinline__ void ph_lora_norm(const P& p, int bid, int nb, int wv) {
    int tid_ = TID_FROM(wv); asm volatile("" : "+v"(tid_)); const int tid = tid_, lane = tid & 63, wave = tid >> 6;
    for (int it = bid * 8 + wave; it < NTOK * 2; it += nb * 8) {
        const int R = it >> 1, which = it & 1;
        const float* src = (which ? WSP(float, A1_CKV) : WSP(float, A1_CQ)) + (size_t)R * 512; const float* g = which ? p.od_kv_norm_g : p.od_q_norm_g;
        bf16_t* dst = (which ? WSP(bf16_t, A1_CKVN) : WSP(bf16_t, A1_CQN)) + (size_t)R * 512;
        f32x4 v[2]; float ss = 0.f;
#pragma unroll
        for (int j = 0; j < 2; ++j) { v[j] = *(const f32x4*)(src + (lane + 64 * j) * 4); ss += v[j].x * v[j].x + v[j].y * v[j].y + v[j].z * v[j].z + v[j].w * v[j].w; }
        const float rstd = 1.0f / sqrtf(wave_sum(ss) * (1.f / 512.f) + EPS);
#pragma unroll
        for (int j = 0; j < 2; ++j) { const int c0 = (lane + 64 * j) * 4; const f32x4 gg = *(const f32x4*)(g + c0); const f32x4 o = v[j] * rstd * gg;
            ushort4 w; w.x = f2bf(o.x); w.y = f2bf(o.y); w.z = f2bf(o.z); w.w = f2bf(o.w); *(ushort4*)(dst + c0) = w; }
    }
}

__device__ __forceinline__ void ph_route(const P& p, int bid, int nb, float* rt  , int wv) {
    int tid_ = TID_FROM(wv); asm volatile("" : "+v"(tid_)); const int tid = tid_, lane = tid & 63, wave = tid >> 6;
    const float* XS = WSP(float, WS_XS); const float* MODS = WSP(float, WS_MODS) + (size_t)1 * 5 * 6 * D; bf16_t* H = WSP(bf16_t, WS_H);
    const float* g = p.norm2_g + D; int* TE = (int*)(p.ws + WS_ROUTE + RT_TE); float* TG = (float*)(p.ws + WS_ROUTE + RT_TG);
    for (int i = tid; i < D * 2; i += 512) { const f32x4 v = ((const f32x4*)p.moe_router)[i]; const int k = i >> 1, e0 = (i & 1) * 4; rt[(e0 + 0) * D + k] = v.x; rt[(e0 + 1) * D + k] = v.y; rt[(e0 + 2) * D + k] = v.z; rt[(e0 + 3) * D + k] = v.w; }
    __syncthreads();
    for (int t0 = (bid * 8 + wave) * 4; t0 < NB * SEQ; t0 += nb * 8 * 4) {
        const int b = t0 / SEQ, R0 = b * TPB + CTX + (t0 - b * SEQ);
        const float* mr = MODS + (size_t)b * 6 * D;
        f32x4 am[8], bm[8];
#pragma unroll
        for (int j = 0; j < 8; ++j) { const int c0 = (lane + 64 * j) * 4; const f32x4 gg = *(const f32x4*)(g + c0), sc = *(const f32x4*)(mr + 4 * D + c0); am[j] = gg * (sc + 1.f); bm[j] = *(const f32x4*)(mr + 3 * D + c0); }
        f32x4 v[8], vn[8];
#pragma unroll
        for (int j = 0; j < 8; ++j) v[j] = ((const f32x4*)(XS + (size_t)R0 * D))[lane + 64 * j];
#pragma unroll
        for (int k = 0; k < 4; ++k) {
            const int R = R0 + k;
            if (k < 3) {
#pragma unroll
                for (int j = 0; j < 8; ++j) vn[j] = ((const f32x4*)(XS + (size_t)(R + 1) * D))[lane + 64 * j]; }
            float ss = 0.f;
#pragma unroll
            for (int j = 0; j < 8; ++j) ss += v[j].x * v[j].x + v[j].y * v[j].y + v[j].z * v[j].z + v[j].w * v[j].w;
            const float rstd = 1.0f / sqrtf(wave_sum(ss) * (1.f / D) + EPS);
            float lg[8];
#pragma unroll
            for (int e = 0; e < 8; ++e) lg[e] = 0.f;
#pragma unroll
            for (int j = 0; j < 8; ++j) { const int c0 = (lane + 64 * j) * 4;
                const f32x4 o = (v[j] * rstd) * am[j] + bm[j];
                *(unsigned*)((unsigned char*)H + (size_t)R * D + c0) = pack4_fp8(o.x, o.y, o.z, o.w);
#pragma unroll
                for (int e = 0; e < 8; ++e) { const f32x4 r4 = *(const f32x4*)(rt + e * D + c0); lg[e] += (o.x * r4.x + o.y * r4.y) + (o.z * r4.z + o.w * r4.w); }
                asm volatile("" ::: "memory"); }
#pragma unroll
            for (int e = 0; e < 8; ++e) lg[e] = wave_sum(lg[e]);
            if (lane == 0) {
                int e1 = 0; float v1 = lg[0];
#pragma unroll
                for (int e = 1; e < 8; ++e) if (lg[e] > v1) { v1 = lg[e]; e1 = e; }
                int e2 = -1; float v2 = -3.0e38f;
#pragma unroll
                for (int e = 0; e < 8; ++e) if (e != e1 && lg[e] > v2) { v2 = lg[e]; e2 = e; }
                const float ex = expf(v2 - v1), w1 = 1.f / (1.f + ex), w2 = ex / (1.f + ex);
                TE[R * 2] = e1; TE[R * 2 + 1] = e2; TG[R * 2] = w1; TG[R * 2 + 1] = w2;
            }
#pragma unroll
            for (int j = 0; j < 8; ++j) v[j] = vn[j];
        }
    }
}

__device__ __forceinline__ void ph_sort(const P& p, int bid, int* lds_i, int wv) {
    if (bid != 0) return;
    int tid_ = TID_FROM(wv); asm volatile("" : "+v"(tid_)); const int tid = tid_;
    const int* TE = (const int*)(p.ws + WS_ROUTE + RT_TE); int* TSLOT = (int*)(p.ws + WS_ROUTE + RT_TSLOT); int* SLOTTOK = (int*)(p.ws + WS_ROUTE + RT_SLOTTOK);
    int* CNT = (int*)(p.ws + WS_ROUTE + RT_CNT); int* OFFS = (int*)(p.ws + WS_ROUTE + RT_OFFS);
    int* cn = lds_i;
    int* offs = lds_i + 8 * 512;
    int* tot = offs + 16;
    int c0 = 0, c1 = 0, c2 = 0, c3 = 0, c4 = 0, c5 = 0, c6 = 0, c7 = 0;
    for (int i = 0; i < 16; ++i) { const int t = tid * 16 + i, b = t / SEQ, R = b * TPB + CTX + (t - b * SEQ);
        for (int k = 0; k < 2; ++k) { const int e = TE[R * 2 + k]; c0 += e == 0; c1 += e == 1; c2 += e == 2; c3 += e == 3; c4 += e == 4; c5 += e == 5; c6 += e == 6; c7 += e == 7; } }
    cn[0 * 512 + tid] = c0; cn[1 * 512 + tid] = c1; cn[2 * 512 + tid] = c2; cn[3 * 512 + tid] = c3; cn[4 * 512 + tid] = c4; cn[5 * 512 + tid] = c5; cn[6 * 512 + tid] = c6; cn[7 * 512 + tid] = c7;
    __syncthreads();
    {
        const int e = tid >> 6, ln = tid & 63; int v[8]; int run = 0;
#pragma unroll
        for (int j = 0; j < 8; ++j) { const int t = cn[e * 512 + ln * 8 + j]; v[j] = run; run += t; }
        int incl = run;
#pragma unroll
        for (int o = 1; o < 64; o <<= 1) { const int n = __shfl_up(incl, o); if (ln >= o) incl += n; }
        const int excl = incl - run;
#pragma unroll
        for (int j = 0; j < 8; ++j) cn[e * 512 + ln * 8 + j] = v[j] + excl;
        if (ln == 63) tot[e] = incl;
    }
    __syncthreads();
    if (tid == 0) { int o = 0; for (int e = 0; e < 8; ++e) { offs[e] = o; OFFS[e] = o; CNT[e] = tot[e]; o += (tot[e] + 255) / 256 * 256; } offs[8] = o; OFFS[8] = o; }
    __syncthreads();
    for (int i = tid; i < NSLOT; i += 512) SLOTTOK[i] = -1;
    __syncthreads();
    int r0 = cn[0 * 512 + tid] + offs[0], r1 = cn[1 * 512 + tid] + offs[1], r2 = cn[2 * 512 + tid] + offs[2], r3 = cn[3 * 512 + tid] + offs[3];
    int r4 = cn[4 * 512 + tid] + offs[4], r5 = cn[5 * 512 + tid] + offs[5], r6 = cn[6 * 512 + tid] + offs[6], r7 = cn[7 * 512 + tid] + offs[7];
    for (int i = 0; i < 16; ++i) { const int t = tid * 16 + i, b = t / SEQ, R = b * TPB + CTX + (t - b * SEQ);
        for (int k = 0; k < 2; ++k) { const int e = TE[R * 2 + k]; int s;
            s = e == 0 ? r0 : e == 1 ? r1 : e == 2 ? r2 : e == 3 ? r3 : e == 4 ? r4 : e == 5 ? r5 : e == 6 ? r6 : r7;
            r0 += e == 0; r1 += e == 1; r2 += e == 2; r3 += e == 3; r4 += e == 4; r5 += e == 5; r6 += e == 6; r7 += e == 7;
            TSLOT[R * 2 + k] = s; SLOTTOK[s] = R; } }
}

__device__ __forceinline__ void ph_gather(const P& p, int bid, int nb, int wv) {
    int tid_ = TID_FROM(wv); asm volatile("" : "+v"(tid_)); const int tid = tid_, lane = tid & 63, wave = tid >> 6;
    const int* SLOTTOK = (const int*)(p.ws + WS_ROUTE + RT_SLOTTOK); const int* OFFS = (const int*)(p.ws + WS_ROUTE + RT_OFFS);
    const unsigned char* H8 = WSP(unsigned char, WS_H); unsigned char* AS = WSP(unsigned char, A1_AS); const int total = OFFS[8];
    for (int s0 = bid * 8 + wave; s0 < total; s0 += nb * 8 * 4) {
        int Rr[4];
#pragma unroll
        for (int u = 0; u < 4; ++u) { const int s = s0 + u * nb * 8; Rr[u] = SLOTTOK[s < total ? s : total - 1]; }
        uint4 v[4][2];
#pragma unroll
        for (int u = 0; u < 4; ++u) { const uint4* src = (const uint4*)(H8 + (size_t)(Rr[u] > 0 ? Rr[u] : 0) * D);
#pragma unroll
            for (int j = 0; j < 2; ++j) v[u][j] = src[lane + 64 * j]; }
#pragma unroll
        for (int u = 0; u < 4; ++u) { const int s = s0 + u * nb * 8; const bool pad = Rr[u] < 0; uint4* dst = (uint4*)(AS + (size_t)(s < total ? s : total - 1) * D);
#pragma unroll
            for (int j = 0; j < 2; ++j) { uint4 w = v[u][j]; if (pad) w = make_uint4(0, 0, 0, 0); if (s < total) dst[lane + 64 * j] = w; } }
    }
}

__device__ __forceinline__ void ph_final(const P& p, int bid, int nb, int wv) {
    int tid_ = TID_FROM(wv); asm volatile("" : "+v"(tid_)); const int tid = tid_, lane = tid & 63, wave = tid >> 6;
    const float* XS = WSP(float, WS_XS); const float* MODS = WSP(float, WS_MODS) + (size_t)1 * 5 * 6 * D; const float* Y = WSP(float, A1_Y);
    const float* TG = (const float*)(p.ws + WS_ROUTE + RT_TG); const int* TSLOT = (const int*)(p.ws + WS_ROUTE + RT_TSLOT);
    for (int t = bid * 8 + wave; t < NB * SEQ; t += nb * 8) {
        const int b = t / SEQ, R = b * TPB + CTX + (t - b * SEQ);
        const float g1 = TG[R * 2], g2 = TG[R * 2 + 1]; const int s1 = TSLOT[R * 2], s2 = TSLOT[R * 2 + 1];
        const float* mr = MODS + (size_t)b * 6 * D + 5 * D;
        f32x4 v[8]; float ss = 0.f;
#pragma unroll
        for (int j = 0; j < 8; ++j) { const int c0 = (lane + 64 * j) * 4;
            const f32x4 xv = *(const f32x4*)(XS + (size_t)R * D + c0), y1 = *(const f32x4*)(Y + (size_t)s1 * D + c0), y2 = *(const f32x4*)(Y + (size_t)s2 * D + c0), m5 = *(const f32x4*)(mr + c0);
            v[j] = xv + m5 * (y1 * g1 + y2 * g2); ss += v[j].x * v[j].x + v[j].y * v[j].y + v[j].z * v[j].z + v[j].w * v[j].w; }
        const float rstd = 1.0f / sqrtf(wave_sum(ss) * (1.f / D) + EPS);
#pragma unroll
        for (int j = 0; j < 8; ++j) { const int c0 = (lane + 64 * j) * 4; const f32x4 gg = *(const f32x4*)(p.final_norm_g + c0); *(f32x4*)(p.out + (size_t)t * D + c0) = v[j] * rstd * gg; }
    }
}


#define LAS __attribute__((address_space(3)))
typedef unsigned u32x4 __attribute__((ext_vector_type(4)));
typedef unsigned u32x2 __attribute__((ext_vector_type(2)));
typedef int i32x4 __attribute__((ext_vector_type(4)));
__device__ __forceinline__ unsigned cvt_pk_bf16(float lo, float hi) { unsigned r; asm volatile("v_cvt_pk_bf16_f32 %0, %1, %2" : "=v"(r) : "v"(lo), "v"(hi)); return r; }
__device__ __forceinline__ void store4bf(bf16_t* dst, const f32x4& v) { u32x2 w; w.x = cvt_pk_bf16(v[0], v[1]); w.y = cvt_pk_bf16(v[2], v[3]); *(u32x2*)dst = w; }
typedef float f32x2 __attribute__((ext_vector_type(2)));
__device__ __forceinline__ f32x2 swiglu2(f32x2 g, f32x2 u, float c1, float kinv) {
    const f32x2 t = g * c1; f32x2 e; e.x = __builtin_amdgcn_exp2f(t.x); e.y = __builtin_amdgcn_exp2f(t.y);
    const f32x2 d = e * kinv + kinv; f32x2 r; r.x = __builtin_amdgcn_rcpf(d.x); r.y = __builtin_amdgcn_rcpf(d.y);
    return (g * u) * r;
}
__device__ __forceinline__ float fast_silu(float x) { return x * __builtin_amdgcn_rcpf(1.f + __builtin_amdgcn_exp2f(-1.4426950408889634f * x)); }

constexpr int NWAVES = 8, RING_BYTES = 131072, MISC_OFF = RING_BYTES + 320, LDS_BYTES = 147456;
constexpr int CW_QUEUE = 2048;
constexpr int CW_DONE = 132096;
constexpr int CW_FILL = 140288;
#ifndef FILL
#define FILL 1
#endif
constexpr int CW_BAR = 4096;
constexpr int CW_ERR = 131072;

#define XB_TMO      128
#define XB_XCNT(j)  (256  + 64 * (j))
#define XB_XSUB(j)  (1280 + 64 * (j))
#define XB_XGEN(j)  (2304 + 64 * (j))
#define XB_TOP      3328
#define XB_TOPGEN   3392
#define XCD_BAR_WORDS 3456
#define XB_SPIN_CAP (1u << 18)

__device__ __forceinline__ unsigned xb_ld(unsigned* p)              { return __hip_atomic_load(p, __ATOMIC_RELAXED, __HIP_MEMORY_SCOPE_AGENT); }
__device__ __forceinline__ unsigned xb_add(unsigned* p, unsigned v) { return __hip_atomic_fetch_add(p, v, __ATOMIC_RELAXED, __HIP_MEMORY_SCOPE_AGENT); }
__device__ __forceinline__ unsigned xb_xcc_id() { return (unsigned)__builtin_amdgcn_s_getreg((3 << 11) | 20) & 0xFu; }
#define XB_SPIN(cond, bar) do { unsigned _sp = 0; while (cond) { __builtin_amdgcn_s_sleep(1); \
    if ((++_sp & 255u) == 0u) { if (xb_ld(&(bar)[XB_TMO])) break; if (_sp > XB_SPIN_CAP) { atomicAdd(&(bar)[XB_TMO], 1u); break; } } } } while (0)

struct XcdBarrier {
    unsigned* bar; unsigned x;
    volatile LAS unsigned* st;
};
__device__ __forceinline__ XcdBarrier xcd_barrier_post(unsigned* bar, volatile LAS unsigned* st, int wv) {
    XcdBarrier b; b.bar = bar; b.x = xb_xcc_id(); b.st = st;
    if (wv == 0 && lane_id() == 0) (void)xb_add(&bar[XB_XCNT(b.x)], 1u);
    return b;
}
__device__ __forceinline__ void xcd_barrier_complete(unsigned* bar, unsigned x, unsigned& nloc, unsigned& nx) {
    const unsigned G = gridDim.x * gridDim.y * gridDim.z;
    unsigned sum, cnt, mine, sp = 0u;
    for (;;) {
        sum = 0u; cnt = 0u; mine = 0u;
#pragma unroll
        for (unsigned j = 0; j < 16; ++j) { const unsigned c = xb_ld(&bar[XB_XCNT(j)]); sum += c; cnt += (c > 0u) ? 1u : 0u; mine = (j == x) ? c : mine; }
        if (sum == G) break;
        __builtin_amdgcn_s_sleep(1);
        if ((++sp & 255u) == 0u) { if (xb_ld(&bar[XB_TMO])) break; if (sp > XB_SPIN_CAP) { atomicAdd(&bar[XB_TMO], 1u); break; } }
    }
    nloc = mine > 0u ? mine : 1u; nx = cnt > 0u ? cnt : 1u;
}
__device__ __forceinline__ void xcd_barrier(const XcdBarrier& b, int wv) {
    asm volatile("s_waitcnt vmcnt(0)" ::: "memory");
    __syncthreads();
    if (wv == 0 && lane_id() == 0) {
        unsigned* bar = b.bar;
        __builtin_amdgcn_s_waitcnt(0);
        unsigned nloc = b.st[0], nx = b.st[1];
        if (nloc == 0u) { xcd_barrier_complete(bar, b.x, nloc, nx); b.st[0] = nloc; b.st[1] = nx; }
        const unsigned old = xb_add(&bar[XB_XSUB(b.x)], 1u);
        const unsigned gen = old / nloc;
        if (old + 1u == (gen + 1u) * nloc) {
            __builtin_amdgcn_fence(__ATOMIC_RELEASE, "agent");
            asm volatile("s_waitcnt vmcnt(0)" ::: "memory");
            const unsigned og = xb_add(&bar[XB_TOP], 1u);
            const unsigned tg = og / nx;
            if (og + 1u == (tg + 1u) * nx) xb_add(&bar[XB_TOPGEN], 1u);
            else XB_SPIN(xb_ld(&bar[XB_TOPGEN]) == tg, bar);
            __builtin_amdgcn_fence(__ATOMIC_ACQUIRE, "agent");
            xb_add(&bar[XB_XGEN(b.x)], 1u);
            asm volatile("s_waitcnt vmcnt(0)" ::: "memory");
        } else {
            XB_SPIN(xb_ld(&bar[XB_XGEN(b.x)]) == gen, bar);
            __builtin_amdgcn_fence(__ATOMIC_ACQUIRE, "agent");
            asm volatile("s_waitcnt vmcnt(0)" ::: "memory");
        }
    }
    __syncthreads();
}

namespace pg8 {
#define PG8_LAS __attribute__((address_space(3)))
constexpr int BM = 256, BK = 64, HALF = 128, HTB = HALF * BK * 2  , STAGE_BYTES = 8 * HTB, NXCD = 8, WGM = 8;
__host__ __device__ __forceinline__ int lds_byte(int r, int c) { const int st = (r >> 4) * 2 + (c >> 5), rr = r & 15, cc = c & 31, ob = rr * 64 + cc * 2; return st * 1024 + (ob ^ (((ob >> 9) & 1) << 5)); }
__host__ __device__ __forceinline__ void stage_rc(int b, int& R, int& C) { const int st = b / 1024, sb = b % 1024, swz = sb ^ (((sb >> 9) & 1) << 5); R = (st >> 1) * 16 + swz / 64; C = (st & 1) * 32 + (swz % 64) / 2; }

struct Unit { const char* A; const char* B; int pm, pn, z, nt; int ti, ks, nks, pad; };
struct Dims { int lda, ldb; float* slabs; };

template <class F> struct Epi {
    F f;
    __device__ __forceinline__ void operator()(const f32x4 (&acc)[2][2][4][2], const Unit& u, int wr, int wc, int fr, int fq) const {
        asm volatile("" : "+v"(fr), "+v"(fq));
#pragma unroll
        for (int ai = 0; ai < 2; ++ai)
#pragma unroll
            for (int m = 0; m < 4; ++m) { const int rt = ai * HALF + wr * 64 + m * 16 + fr;
#pragma unroll
                for (int bj = 0; bj < 2; ++bj) f.put(u, rt, bj * HALF + wc * 32, fq, acc[ai][bj][m][0], acc[ai][bj][m][1]); }
    }
};

template <bool FP8 = false, class EpiT, class Sched>
__device__ __forceinline__ void gemm_phase(PG8_LAS unsigned char* lds, const Dims g, const Sched& S, const EpiT& E, int wv) {
    int tid_ = TID_FROM(wv); asm volatile("" : "+v"(tid_));
    const int tid = tid_, wid = __builtin_amdgcn_readfirstlane(tid >> 6), lane = tid & 63, wr = wid >> 2, wc = wid & 3, fr = lane & 15, fq = lane >> 4;
    unsigned voffA[2], voffB[2];
#pragma unroll
    for (int i = 0; i < 2; ++i) { int R, C; stage_rc(tid * 16 + i * 8192, R, C); voffA[i] = (unsigned)(R * g.lda + C) * 2u; voffB[i] = (unsigned)(R * g.ldb + C) * 2u; }
    const size_t kstep = (size_t)(BK * 2);
    const size_t hstepA = (size_t)HALF * g.lda * 2, hstepB = (size_t)HALF * g.ldb * 2;
    const unsigned ldsw = (unsigned)wid * 1024u;
    const int aoff = lds_byte(wr * 64 + fr, fq * 8), boff = lds_byte(wc * 32 + fr, fq * 8);
#define PG8_SA(b, h) (((b) * 2 + (h)) * HTB)
#define PG8_SB(b, h) ((4 + (b) * 2 + (h)) * HTB)
#define PG8_STAGE(bufoff, gbase, voff) do { const char* g_ = (const char*)(gbase); asm volatile("" : "+s"(g_));     \
        _Pragma("unroll") for (int _i = 0; _i < 2; ++_i) \
        __builtin_amdgcn_global_load_lds((const unsigned*)(g_ + (voff)[_i]), (PG8_LAS unsigned*)(lds + (bufoff) + ldsw + _i * 8192), 16, 0, 0); } while (0)
#define PG8_LDA(dst, b, h) do { _Pragma("unroll") for (int m = 0; m < 4; ++m) _Pragma("unroll") for (int k = 0; k < 2; ++k) dst[m][k] = *(const PG8_LAS bf16x8*)(lds + PG8_SA(b, h) + aoff + m * 2048 + k * 1024); } while (0)
#define PG8_LDB(dst, b, h) do { _Pragma("unroll") for (int n = 0; n < 2; ++n) _Pragma("unroll") for (int k = 0; k < 2; ++k) dst[n][k] = *(const PG8_LAS bf16x8*)(lds + PG8_SB(b, h) + boff + n * 2048 + k * 1024); } while (0)
#define PG8_CAT(lo, hi) __builtin_shufflevector(__builtin_bit_cast(i32x4, lo), __builtin_bit_cast(i32x4, hi), 0, 1, 2, 3, 4, 5, 6, 7)
#define PG8_MMA(ai, bj, At, Bt) do { __builtin_amdgcn_s_setprio(1); if constexpr (FP8) { _Pragma("unroll") for (int m = 0; m < 4; ++m) _Pragma("unroll") for (int n = 0; n < 2; ++n) \
        acc[ai][bj][m][n] = __builtin_amdgcn_mfma_scale_f32_16x16x128_f8f6f4(PG8_CAT(Bt[n][0], Bt[n][1]), PG8_CAT(At[m][0], At[m][1]), acc[ai][bj][m][n], 0, 0, 0, 0, 0, 0); }     \
        else { _Pragma("unroll") for (int m = 0; m < 4; ++m) _Pragma("unroll") for (int n = 0; n < 2; ++n) _Pragma("unroll") for (int k = 0; k < 2; ++k) \
        acc[ai][bj][m][n] = __builtin_amdgcn_mfma_f32_16x16x32_bf16(Bt[n][k], At[m][k], acc[ai][bj][m][n], 0, 0, 0); } __builtin_amdgcn_s_setprio(0); } while (0)
#define PG8_WAIT_V(n) asm volatile("s_waitcnt vmcnt(" #n ")" ::: "memory")
#define PG8_WAIT_L(n) asm volatile("s_waitcnt lgkmcnt(" #n ")" ::: "memory")
#define PG8_BAR __builtin_amdgcn_s_barrier()
#define PG8_SCHED __builtin_amdgcn_sched_barrier(0)
    Unit cur, nxt; int ui = 0;
    if (!S.next(0, cur)) return;
    f32x4 acc[2][2][4][2];
#pragma unroll
    for (int a = 0; a < 2; ++a)
#pragma unroll
        for (int b = 0; b < 2; ++b)
#pragma unroll
            for (int m = 0; m < 4; ++m)
#pragma unroll
                for (int n = 0; n < 2; ++n) acc[a][b][m][n] = (f32x4){0.f, 0.f, 0.f, 0.f};
    bf16x8 At[4][2], B0[2][2], B1[2][2];
    const char* cA = cur.A; const char* cB = cur.B;
    PG8_STAGE(PG8_SB(0, 0), cB, voffB); PG8_STAGE(PG8_SB(0, 1), cB + hstepB, voffB); PG8_STAGE(PG8_SA(0, 0), cA, voffA); PG8_STAGE(PG8_SA(0, 1), cA + hstepA, voffA);
    if (wr == 1) PG8_BAR;
    PG8_WAIT_V(2); PG8_BAR;
    PG8_STAGE(PG8_SB(1, 0), cB + kstep, voffB); PG8_STAGE(PG8_SA(1, 0), cA + kstep, voffA); PG8_STAGE(PG8_SB(1, 1), cB + hstepB + kstep, voffB);
    PG8_WAIT_V(6); PG8_BAR;
    for (;;) {
        const bool has_next = S.next(ui + 1, nxt);
        const char* nA = has_next ? nxt.A : cA; const char* nB = has_next ? nxt.B : cB;
        const int nt = cur.nt;
        for (int t = 0; t < nt; t += 2) {
            const bool last = (t == nt - 2);
            const char* a1 = cA + (size_t)(t + 1) * kstep;
            const char* a2 = last ? nA : cA + (size_t)(t + 2) * kstep; const char* b2 = last ? nB : cB + (size_t)(t + 2) * kstep;
            const char* a3 = a2 + kstep; const char* b3 = b2 + kstep;
            PG8_LDB(B0, 0, 0); PG8_LDB(B1, 0, 1); PG8_SCHED; PG8_LDA(At, 0, 0); PG8_STAGE(PG8_SA(1, 1), a1 + hstepA, voffA);
            PG8_WAIT_V(8); PG8_WAIT_L(0); PG8_BAR; PG8_MMA(0, 0, At, B0); PG8_MMA(0, 1, At, B1); PG8_BAR; PG8_SCHED;
            PG8_LDA(At, 0, 1); PG8_STAGE(PG8_SB(0, 0), b2, voffB); PG8_STAGE(PG8_SB(0, 1), b2 + hstepB, voffB); PG8_STAGE(PG8_SA(0, 0), a2, voffA);
            PG8_WAIT_V(8); PG8_WAIT_L(0); PG8_BAR; PG8_MMA(1, 0, At, B0); PG8_MMA(1, 1, At, B1); PG8_BAR; PG8_SCHED;
            PG8_LDB(B0, 1, 0); PG8_LDB(B1, 1, 1); PG8_SCHED; PG8_LDA(At, 1, 0); PG8_STAGE(PG8_SA(0, 1), a2 + hstepA, voffA);
            PG8_WAIT_V(8); PG8_WAIT_L(0); PG8_BAR; PG8_MMA(0, 0, At, B0); PG8_MMA(0, 1, At, B1); PG8_BAR; PG8_SCHED;
            PG8_LDA(At, 1, 1); PG8_STAGE(PG8_SB(1, 0), b3, voffB); PG8_STAGE(PG8_SB(1, 1), b3 + hstepB, voffB); PG8_STAGE(PG8_SA(1, 0), a3, voffA);
            PG8_WAIT_V(8); PG8_WAIT_L(0); PG8_BAR; PG8_MMA(1, 0, At, B0); PG8_MMA(1, 1, At, B1); PG8_BAR; PG8_SCHED;
        }
        if (wr == 0) PG8_BAR;
        if (cur.nks > 1) {
            int t2 = tid; asm volatile("" : "+v"(t2));
            float* sb = g.slabs + ((size_t)(cur.ti * cur.nks + cur.ks) << 16) + t2 * 4;
#pragma unroll
            for (int a = 0; a < 2; ++a)
#pragma unroll
                for (int m = 0; m < 4; ++m)
#pragma unroll
                    for (int b = 0; b < 2; ++b)
#pragma unroll
                        for (int n = 0; n < 2; ++n) *(f32x4*)(sb + ((((a * 4 + m) * 2 + b) * 2 + n) << 11)) = acc[a][b][m][n];
        } else E(acc, cur, wr, wc, fr, fq);
        if (!has_next) break;
#pragma unroll
        for (int a = 0; a < 2; ++a)
#pragma unroll
            for (int b = 0; b < 2; ++b)
#pragma unroll
                for (int m = 0; m < 4; ++m)
#pragma unroll
                    for (int n = 0; n < 2; ++n) acc[a][b][m][n] = (f32x4){0.f, 0.f, 0.f, 0.f};
        cur = nxt; cA = nA; cB = nB; ++ui;
        if (wr == 1) PG8_BAR;
    }
    PG8_WAIT_V(0);
    PG8_BAR;
#undef PG8_SA
#undef PG8_SB
#undef PG8_STAGE
#undef PG8_LDA
#undef PG8_LDB
#undef PG8_MMA
#undef PG8_CAT
#undef PG8_WAIT_V
#undef PG8_WAIT_L
#undef PG8_BAR
#undef PG8_SCHED
}

__device__ __forceinline__ int xcd_remap(int L, int total) { const int q = total / 8, r = total % 8, xcd = L % 8, off = L / 8; return (xcd < r ? xcd * (q + 1) : r * (q + 1) + (xcd - r) * q) + off; }
template <class Base> struct TailSched {
    Base b; int G, c, total, Fcut, r, s, nt_full, ksl;
    __device__ __forceinline__ void init(int total_, int K, int G_, int c_, int smax = 8) {
        total = total_; G = G_; c = c_; nt_full = K / BK; Fcut = (total / G) * G; r = total - Fcut; const int kp = nt_full / 2;
        s = 1;
        if (r > 0) { if (smax >= 8 && kp % 8 == 0 && kp / 8 >= 2 && r * 8 <= G) s = 8; else if (smax >= 4 && kp % 4 == 0 && kp / 4 >= 2 && r * 4 <= G) s = 4; else if (smax >= 2 && kp % 2 == 0 && kp / 2 >= 2 && r * 2 <= G) s = 2; }
        ksl = nt_full / s;
    }
    __device__ __forceinline__ bool next(int i, Unit& u) const {
        const int L = i * G + c;
#ifndef CHUNK_DEAL
#define CHUNK_DEAL 0
#endif
        if (L < Fcut) { b.decode(CHUNK_DEAL ? c * (Fcut / G) + i : xcd_remap(L, Fcut), u); u.nt = nt_full; u.ti = -1; u.ks = 0; u.nks = 1; u.pad = 0; return true; }
        const int q = L - Fcut; if (q >= r * s) return false;
        const int ti = q / s, ks = q - ti * s; b.decode(Fcut + ti, u);
        u.A += (size_t)ks * ksl * (BK * 2); u.B += (size_t)ks * ksl * (BK * 2); u.nt = ksl; u.ti = ti; u.ks = ks; u.nks = s; u.pad = 0; return true;
    }
};
template <class EpiT, class Base> __device__ __forceinline__ void tail_reduce(const TailSched<Base>& S, const EpiT& E, const float* slabs, int bid, int nb, int wv) {
    if (S.s <= 1) return;
    int tid_ = TID_FROM(wv); asm volatile("" : "+v"(tid_)); const int tid = tid_, wid = tid >> 6, lane = tid & 63, wr = wid >> 2, wc = wid & 3, fr = lane & 15, fq = lane >> 4;
    for (int it = bid; it < S.r * 16; it += nb) {
        const int ti = it >> 4, c16 = it & 15, ai = c16 >> 3, m = (c16 >> 1) & 3, bj = c16 & 1;
        Unit u; S.b.decode(S.Fcut + ti, u); u.nt = 0; u.ti = ti; u.ks = 0; u.nks = 1; u.pad = 0;
        f32x4 v0 = {0.f, 0.f, 0.f, 0.f}, v1 = {0.f, 0.f, 0.f, 0.f};
        for (int ks = 0; ks < S.s; ++ks) { const float* sb = slabs + ((size_t)(ti * S.s + ks) << 16) + tid * 4 + ((size_t)(c16 * 2) << 11); v0 += *(const f32x4*)sb; v1 += *(const f32x4*)(sb + 2048); }
        E.f.put(u, ai * HALF + wr * 64 + m * 16 + fr, bj * HALF + wc * 32, fq, v0, v1);
    }
}
template <bool LAT> struct GridBase {
    const char* A; const char* B; size_t atile, btile; int nM, nN;
    __device__ __forceinline__ void decode(int wgid, Unit& u) const {
        const int nig = WGM * nN, gid = wgid / nig, fm = gid * WGM, gsz = (nM - fm) < WGM ? (nM - fm) : WGM;
        int pm = fm + ((wgid % nig) % gsz); const int pn = (wgid % nig) / gsz;
        if (LAT) pm = pm + pm / 8 + 1;
        u.pm = pm; u.pn = pn; u.z = 0; u.A = A + (size_t)pm * atile; u.B = B + (size_t)pn * btile;
    }
};
template <bool LAT> struct GridSched : TailSched<GridBase<LAT>> {
    __device__ __forceinline__ void init(const void* A_, size_t atile_, const void* B_, size_t btile_, int nM_, int nN_, int K, int G_, int c_, int smax = 8) {
        this->b.A = (const char*)A_; this->b.B = (const char*)B_; this->b.atile = atile_; this->b.btile = btile_; this->b.nM = nM_; this->b.nN = nN_;
        TailSched<GridBase<LAT>>::init(nM_ * nN_, K, G_, c_, smax);
    }
};
}

struct EF_in {
    bf16_t *F, *Q, *Kd, *V; const float2* tab;
    __device__ __forceinline__ void put(const pg8::Unit& u, int rt, int c32, int fq, const f32x4& v0, const f32x4& v1) const {
        const int R = u.pm * 256 + rt, cg = u.pn * 256 + c32;
        if (cg < 1024) { store4bf(F + (size_t)R * 1024 + cg + 4 * fq, v0); store4bf(F + (size_t)R * 1024 + cg + 16 + 4 * fq, v1); return; }
        if (cg >= 3072) { store4bf(V + (size_t)R * 1024 + (cg - 3072) + 4 * fq, v0); store4bf(V + (size_t)R * 1024 + (cg - 3072) + 16 + 4 * fq, v1); return; }
        const int G = cg >> 6, w = (cg >> 5) & 1, a0 = 64 * G + 16 * w + 4 * fq;
        bf16_t* dst = cg < 2048 ? Q + (size_t)R * 1024 + (a0 - 1024) : Kd + (size_t)R * 1024 + (a0 - 2048);
        const int j = R % TPB; f32x4 o0 = v0, o1 = v1;
        if (j >= CTX) { const int nl = j - CTX, pos = (G & 1) ? (nl & 63) : (nl >> 6); const f32x4* t4 = (const f32x4*)(tab + pos * 32 + 16 * w + 4 * fq); const f32x4 ta = t4[0], tb = t4[1];
            const f32x4 cs = {ta[0], ta[2], tb[0], tb[2]}, sn = {ta[1], ta[3], tb[1], tb[3]};
            o0 = v0 * cs - v1 * sn; o1 = v1 * cs + v0 * sn; }
        store4bf(dst, o0); store4bf(dst + 32, o1);
    }
};
struct EF_res {
    float* XS; const float* mods; int chunk, pad;
    __device__ __forceinline__ void put(const pg8::Unit& u, int rt, int c32, int fq, const f32x4& v0, const f32x4& v1) const {
        const int R = u.pm * 256 + rt, col = u.pn * 256 + c32 + 4 * fq; const int bb = (u.pm % 9 == 0) ? 4 : u.pm / 9;
        const float* m = mods + (size_t)bb * 6 * D + chunk * D + col; float* x = XS + (size_t)R * D + col;
        *(f32x4*)x = *(const f32x4*)x + *(const f32x4*)m * v0; *(f32x4*)(x + 16) = *(const f32x4*)(x + 16) + *(const f32x4*)(m + 16) * v1;
    }
};
struct EF_res0 {
    float* XS; const float* mods; const float* x; const float* ctx; int chunk, pad;
    __device__ __forceinline__ void put(const pg8::Unit& u, int rt, int c32, int fq, const f32x4& v0, const f32x4& v1) const {
        const int R = u.pm * 256 + rt, col = u.pn * 256 + c32 + 4 * fq; const int b = u.pm / 9, t9 = u.pm - 9 * b; const int bb = t9 == 0 ? 4 : b;
        const float* s = (t9 == 0 ? ctx + ((size_t)(b * CTX + rt)) * D : x + ((size_t)(b * SEQ + (t9 - 1) * 256 + rt)) * D) + col;
        const float* m = mods + (size_t)bb * 6 * D + chunk * D + col; float* o = XS + (size_t)R * D + col;
        *(f32x4*)o = *(const f32x4*)s + *(const f32x4*)m * v0; *(f32x4*)(o + 16) = *(const f32x4*)(s + 16) + *(const f32x4*)(m + 16) * v1;
    }
};
struct EF_swiglu {
    bf16_t* ACT; int ld, pad;
    __device__ __forceinline__ void put(const pg8::Unit& u, int rt, int c32, int fq, const f32x4& v0, const f32x4& v1) const {
        const size_t R = (size_t)u.pm * 256 + rt; const int oc = ((u.pn * 256 + c32) >> 1) + 4 * fq;
        const f32x2 a = swiglu2(f32x2{v0[0], v0[1]}, f32x2{v1[0], v1[1]}, -1.4426950408889634f, 1.f), b = swiglu2(f32x2{v0[2], v0[3]}, f32x2{v1[2], v1[3]}, -1.4426950408889634f, 1.f);
        store4bf(ACT + R * ld + oc, f32x4{a.x, a.y, b.x, b.y});
    }
};
struct EF_dqkv {
    float *CQ, *CKV; bf16_t* KR; const float2* tab;
    __device__ __forceinline__ void put(const pg8::Unit& u, int rt, int c32, int fq, const f32x4& v0, const f32x4& v1) const {
        const int R = u.pm * 256 + rt, cg = u.pn * 256 + c32;
        if (cg < 512) { float* d = CQ + (size_t)R * 512 + cg + 4 * fq; *(f32x4*)d = v0; *(f32x4*)(d + 16) = v1; return; }
        if (cg < 1024) { float* d = CKV + (size_t)R * 512 + (cg - 512) + 4 * fq; *(f32x4*)d = v0; *(f32x4*)(d + 16) = v1; return; }
        if (cg >= 1088) return;
        const int half = (cg - 1024) >> 5, j = R % TPB; f32x4 o0 = v0, o1 = v1;
        if (j >= CTX) { const int nl = j - CTX, pos = half ? (nl & 63) : (nl >> 6); const f32x4* t4 = (const f32x4*)(tab + pos * 16 + 4 * fq); const f32x4 ta = t4[0], tb = t4[1];
            const f32x4 cs = {ta[0], ta[2], tb[0], tb[2]}, sn = {ta[1], ta[3], tb[1], tb[3]};
            o0 = v0 * cs - v1 * sn; o1 = v1 * cs + v0 * sn; }
        bf16_t* d = KR + (size_t)R * 64 + (cg - 1024) + 4 * fq; store4bf(d, o0); store4bf(d + 16, o1);
    }
};
struct EF_uq {
    bf16_t* QM; const float2* tab;
    __device__ __forceinline__ void put(const pg8::Unit& u, int rt, int c32, int fq, const f32x4& v0, const f32x4& v1) const {
        const int R = u.pm * 256 + rt, cg = u.pn * 256 + c32; const int q = (cg >> 5) % 6; f32x4 o0 = v0, o1 = v1;
        if (q >= 4) { const int nl = R % TPB - CTX, pos = (q == 5) ? (nl & 63) : (nl >> 6); const f32x4* t4 = (const f32x4*)(tab + pos * 16 + 4 * fq); const f32x4 ta = t4[0], tb = t4[1];
            const f32x4 cs = {ta[0], ta[2], tb[0], tb[2]}, sn = {ta[1], ta[3], tb[1], tb[3]};
            o0 = v0 * cs - v1 * sn; o1 = v1 * cs + v0 * sn; }
        bf16_t* d = QM + (size_t)R * 3072 + cg + 4 * fq; store4bf(d, o0); store4bf(d + 16, o1);
    }
};
struct EF_bf {
    bf16_t* O; int ld, pad;
    __device__ __forceinline__ void put(const pg8::Unit& u, int rt, int c32, int fq, const f32x4& v0, const f32x4& v1) const {
        bf16_t* d = O + ((size_t)u.pm * 256 + rt) * ld + u.pn * 256 + c32 + 4 * fq; store4bf(d, v0); store4bf(d + 16, v1);
    }
};
struct EF_swiglu8 {
    unsigned char* ACT; int ld, pad;
    __device__ __forceinline__ void put(const pg8::Unit& u, int rt, int c32, int fq, const f32x4& v0, const f32x4& v1) const {
        const size_t R = (size_t)u.pm * 256 + rt; const int oc = ((u.pn * 256 + c32) >> 1) + 4 * fq; const float is = 1.0f / W8_GU;
        const f32x2 a = swiglu2(f32x2{v0[0], v0[1]}, f32x2{v1[0], v1[1]}, -1.4426950408889634f * is, 1.f / (is * is * A8_ACT)), b = swiglu2(f32x2{v0[2], v0[3]}, f32x2{v1[2], v1[3]}, -1.4426950408889634f * is, 1.f / (is * is * A8_ACT));
        *(unsigned*)(ACT + R * ld + oc) = pack4_fp8(a.x, a.y, b.x, b.y);
    }
};
struct EF_y8 {
    float* O; int ld, pad;
    __device__ __forceinline__ void put(const pg8::Unit& u, int rt, int c32, int fq, const f32x4& v0, const f32x4& v1) const {
        float* d = O + ((size_t)u.pm * 256 + rt) * ld + u.pn * 256 + c32 + 4 * fq; const float is = 1.0f / (A8_ACT * W8_DN); *(f32x4*)d = v0 * is; *(f32x4*)(d + 16) = v1 * is;
    }
};
struct EF_probe {
    float* O; int ld, pad;
    __device__ __forceinline__ void put(const pg8::Unit& u, int rt, int c32, int fq, const f32x4& v0, const f32x4& v1) const {
        if (v0[0] + v0[1] + v0[2] + v0[3] + v1[0] + v1[1] + v1[2] + v1[3] == 1.2345678e30f) O[rt] = v0[0];
    }
};
struct EF_probe_math {
    unsigned char* ACT; int ld, pad;
    __device__ __forceinline__ void put(const pg8::Unit& u, int rt, int c32, int fq, const f32x4& v0, const f32x4& v1) const {
        const float is = 1.0f / W8_GU; float o[4];
#pragma unroll
        for (int e = 0; e < 4; ++e) o[e] = fast_silu(v0[e] * is) * (v1[e] * is) * A8_ACT;
        const unsigned w = pack4_fp8(o[0], o[1], o[2], o[3]);
        if (w == 0x12345678u) *(unsigned*)(ACT + rt) = w;
    }
};
struct EF_probe_store {
    unsigned char* ACT; int ld, pad;
    __device__ __forceinline__ void put(const pg8::Unit& u, int rt, int c32, int fq, const f32x4& v0, const f32x4& v1) const {
        const size_t R = ((size_t)u.pm * 256 + rt) & 8191; const int oc = ((u.pn * 256 + c32) >> 1) + 4 * fq;
        *(unsigned*)(ACT + R * ld + oc) = __builtin_bit_cast(unsigned, v0[0]) ^ __builtin_bit_cast(unsigned, v1[1]);
    }
};
struct EF_f32 {
    float* O; int ld, pad;
    __device__ __forceinline__ void put(const pg8::Unit& u, int rt, int c32, int fq, const f32x4& v0, const f32x4& v1) const {
        float* d = O + ((size_t)u.pm * 256 + rt) * ld + u.pn * 256 + c32 + 4 * fq; *(f32x4*)d = v0; *(f32x4*)(d + 16) = v1;
    }
};
struct EF_dftA {
    bf16_t *VT, *VTC;
    __device__ __forceinline__ void put(const pg8::Unit& u, int rt, int c32, int fq, const f32x4& v0, const f32x4& v1) const {
        const int bg = u.z & 15; bf16_t* d;
        if (u.z < 16) d = VT + ((size_t)bg * 256 + rt) * 4096 + u.pm * 2048 + u.pn * 256 + c32 + 4 * fq;
        else d = VTC + ((size_t)bg * 256 + rt) * 512 + u.pm * 256 + c32 + 4 * fq;
        store4bf(d, v0); store4bf(d + 16, v1);
    }
};
struct EF_dftB {
    bf16_t* MIX; float scale; int joff;
    __device__ __forceinline__ void put(const pg8::Unit& u, int rt, int c32, int fq, const f32x4& v0, const f32x4& v1) const {
        const int b = u.z >> 2, g = u.z & 3; const size_t R = (size_t)b * TPB + joff + u.pm * 256 + rt;
        bf16_t* d = MIX + R * 2048 + g * 256 + c32 + 4 * fq; store4bf(d, v0 * scale); store4bf(d + 16, v1 * scale);
    }
};

struct DftABase {
    const char* WCS; const char* F;
    __device__ __forceinline__ void decode(int L, pg8::Unit& u) const {
        int bg, part, pn, ctx;
        if (L < 256) { bg = L >> 4; part = (L >> 3) & 1; pn = L & 7; ctx = 0; } else { const int l = L - 256; bg = l >> 1; part = l & 1; pn = 0; ctx = 1; }
        const int b = bg >> 2, g = bg & 3;
        u.A = WCS + (size_t)part * 256 * 256 * 2; u.B = F + ((size_t)(b * TPB + (ctx ? 0 : CTX + pn * 256)) * 1024 + g * 256) * 2;
        u.pm = part; u.pn = pn; u.z = bg + 16 * ctx;
    }
};
struct DftBBase {
    const char* A; const char* B; size_t atile, bstride; int nk1, pad;
    __device__ __forceinline__ void decode(int L, pg8::Unit& u) const {
        const int bg = L / nk1, pm = L % nk1;
        u.A = A + (size_t)pm * atile; u.B = B + (size_t)bg * bstride; u.pm = pm; u.pn = 0; u.z = bg;
    }
};
struct MoeBase {
    const char* A; const char* B; size_t arow  , bexp  , btile; int nN, pad; int t0, t1, t2, t3, t4, t5, t6, t7; int o0, o1, o2, o3, o4, o5, o6, o7;
    __device__ __forceinline__ int init(const void* A_, size_t arow_, const void* B_, size_t bexp_, size_t btile_, int nN_, const int* CNT, const int* OFFS) {
        A = (const char*)A_; B = (const char*)B_; arow = arow_; bexp = bexp_; btile = btile_; nN = nN_; pad = 0;
        t0 = (CNT[0] + 255) >> 8; t1 = (CNT[1] + 255) >> 8; t2 = (CNT[2] + 255) >> 8; t3 = (CNT[3] + 255) >> 8; t4 = (CNT[4] + 255) >> 8; t5 = (CNT[5] + 255) >> 8; t6 = (CNT[6] + 255) >> 8; t7 = (CNT[7] + 255) >> 8;
        o0 = OFFS[0]; o1 = OFFS[1]; o2 = OFFS[2]; o3 = OFFS[3]; o4 = OFFS[4]; o5 = OFFS[5]; o6 = OFFS[6]; o7 = OFFS[7];
        return (t0 + t1 + t2 + t3 + t4 + t5 + t6 + t7) * nN;
    }
    __device__ __forceinline__ void decode(int l, pg8::Unit& u) const {
        int e = -1, te = 1, oe = 0;
#define MOE_STEP(k, tk, ok) if (e < 0) { const int n = tk * nN; if (l < n) { e = k; te = tk; oe = ok; } else l -= n; }
        MOE_STEP(0, t0, o0) MOE_STEP(1, t1, o1) MOE_STEP(2, t2, o2) MOE_STEP(3, t3, o3) MOE_STEP(4, t4, o4) MOE_STEP(5, t5, o5) MOE_STEP(6, t6, o6) MOE_STEP(7, t7, o7)
#undef MOE_STEP
        if (e < 0) { e = 0; l = 0; }
        const int mt = l % te, pn = l / te; const int row0 = oe + mt * 256;
        u.A = A + (size_t)row0 * arow; u.B = B + (size_t)e * bexp + (size_t)pn * btile; u.pm = row0 >> 8; u.pn = pn; u.z = e;
    }
};

template <int RM> __device__ __forceinline__ int rowmap(int c) {
    if (RM == 1) { if (c < 1024 || c >= 3072) return c; const int u = c & 63; return (c & ~63) + 32 * ((u & 31) >> 4) + 16 * (u >> 5) + (u & 15); }
    if (RM == 2) return 32 * (c >> 4) + (c & 15);
    if (RM == 3) return 32 * (c >> 4) + 16 + (c & 15);
    return c;
}
template <int RM> __device__ __forceinline__ void cvt_item(const float* W, int K, int N, bf16_t* WT, int row_off, LAS float* scr, int item, int lane) {
    const int nblk = N / 32, kb = item / nblk, nb = item % nblk, k0 = 64 * kb, n0 = 32 * nb;
    f32x4 v[8];
#pragma unroll
    for (int i = 0; i < 8; ++i) v[i] = *(const f32x4*)(W + (size_t)(k0 + (lane >> 3) + 8 * i) * N + n0 + 4 * (lane & 7));
#pragma unroll
    for (int i = 0; i < 8; ++i) { LAS float* d = scr + ((lane >> 3) + 8 * i) * 33 + 4 * (lane & 7); d[0] = v[i][0]; d[1] = v[i][1]; d[2] = v[i][2]; d[3] = v[i][3]; }
    asm volatile("s_waitcnt lgkmcnt(0)" ::: "memory");
    const int c = lane & 7;
#pragma unroll
    for (int j = 0; j < 4; ++j) { const int n = (lane >> 3) + 8 * j; const LAS float* s = scr + (8 * c) * 33 + n;
        u32x4 o; o.x = cvt_pk_bf16(s[0 * 33], s[1 * 33]); o.y = cvt_pk_bf16(s[2 * 33], s[3 * 33]); o.z = cvt_pk_bf16(s[4 * 33], s[5 * 33]); o.w = cvt_pk_bf16(s[6 * 33], s[7 * 33]);
        *(u32x4*)(WT + (size_t)(row_off + rowmap<RM>(n0 + n)) * K + k0 + 8 * c) = o; }
    asm volatile("s_waitcnt lgkmcnt(0)" ::: "memory");
}
template <int RM> __device__ __forceinline__ void cvt_item8(const float* W, int K, int N, unsigned char* WT, float scale, LAS float* scr, int item, int lane) {
    const int nblk = N / 32, kb = item / nblk, nb = item % nblk, k0 = 64 * kb, n0 = 32 * nb;
    f32x4 v[8];
#pragma unroll
    for (int i = 0; i < 8; ++i) v[i] = *(const f32x4*)(W + (size_t)(k0 + (lane >> 3) + 8 * i) * N + n0 + 4 * (lane & 7));
#pragma unroll
    for (int i = 0; i < 8; ++i) { LAS float* d = scr + ((lane >> 3) + 8 * i) * 33 + 4 * (lane & 7); d[0] = v[i][0]; d[1] = v[i][1]; d[2] = v[i][2]; d[3] = v[i][3]; }
    asm volatile("s_waitcnt lgkmcnt(0)" ::: "memory");
    const int c = lane & 7;
#pragma unroll
    for (int j = 0; j < 4; ++j) { const int n = (lane >> 3) + 8 * j; const LAS float* s = scr + (8 * c) * 33 + n;
        u32x2 o; o.x = pack4_fp8(s[0 * 33] * scale, s[1 * 33] * scale, s[2 * 33] * scale, s[3 * 33] * scale); o.y = pack4_fp8(s[4 * 33] * scale, s[5 * 33] * scale, s[6 * 33] * scale, s[7 * 33] * scale);
        *(u32x2*)(WT + (size_t)rowmap<RM>(n0 + n) * K + k0 + 8 * c) = o; }
    asm volatile("s_waitcnt lgkmcnt(0)" ::: "memory");
}
constexpr int MOE_I_MG = (2048 / 64) * (FFE / 32), MOE_I_MD = (FFE / 64) * (2048 / 32), MOE_ITEMS = 16 * MOE_I_MG + 8 * MOE_I_MD, MOE_BATCHES = MOE_ITEMS / 8;
__device__ __forceinline__ void moe_cvt_item(const P& p, int r, LAS float* scr, int lane) {
    if (r < 8 * MOE_I_MG) { const int e = r / MOE_I_MG; cvt_item8<2>(p.moe_w_gate + (size_t)e * 2048 * FFE, 2048, FFE, WSP(unsigned char, WT_MGU) + (size_t)e * 2 * FFE * 2048, W8_GU, scr, r % MOE_I_MG, lane); return; } r -= 8 * MOE_I_MG;
    if (r < 8 * MOE_I_MG) { const int e = r / MOE_I_MG; cvt_item8<3>(p.moe_w_up + (size_t)e * 2048 * FFE, 2048, FFE, WSP(unsigned char, WT_MGU) + (size_t)e * 2 * FFE * 2048, W8_GU, scr, r % MOE_I_MG, lane); return; } r -= 8 * MOE_I_MG;
    { const int e = r / MOE_I_MD; cvt_item8<0>(p.moe_w_down + (size_t)e * FFE * 2048, FFE, 2048, WSP(unsigned char, WT_MD) + (size_t)e * 2048 * FFE, W8_DN, scr, r % MOE_I_MD, lane); }
}
__device__ __forceinline__ bool moe_fill_list(const P& p, unsigned* ctl, int phase, int nb, int owner, LAS float* scr, int lane) {
    unsigned* ctr = ctl + CW_FILL + 64 * owner; const int nown = (MOE_ITEMS - owner + nb - 1) / nb;
    const int ch = phase >= 0 ? 1 : 4;
    for (;;) {
        if (phase >= 0 && (int)__builtin_amdgcn_readfirstlane(xb_ld(ctl + CW_DONE + 64 * phase)) >= nb) return false;
        unsigned idx = 0; if (lane == 0) idx = xb_add(ctr, (unsigned)ch);
        idx = __builtin_amdgcn_readfirstlane(idx);
        if ((int)idx >= nown) return true;
        for (int j = 0; j < ch && (int)idx + j < nown; ++j) moe_cvt_item(p, ((int)idx + j) * nb + owner, scr, lane);
    }
}
__device__ __forceinline__ void moe_fill(const P& p, unsigned* ctl, int phase, int nb, int bid, LAS unsigned char* lds, volatile LAS unsigned* MISC, int wv) {
    const int lane = lane_id();
    LAS float* scr = (LAS float*)(lds + wv * 16384);
    if (MISC[24] == 0u) { if (!moe_fill_list(p, ctl, phase, nb, bid, scr, lane)) return; MISC[24] = 1u; }
    if (phase >= 0) return;
#pragma unroll 1
    for (int k = 1; k <= 6; ++k) { if (!moe_fill_list(p, ctl, phase, nb, (bid + 41 * k) % nb, scr, lane)) return; }
}
__device__ __forceinline__ void ph_convert(const P& p, int bid, int nb, LAS unsigned char* lds, int wv) {
    int tid_ = TID_FROM(wv); asm volatile("" : "+v"(tid_)); const int tid = tid_, lane = tid & 63, wave = tid >> 6;
    LAS float* scr = (LAS float*)(lds + wave * 16384);
    const int gw = bid * NWAVES + wave, NGW = nb * NWAVES;
    constexpr int I_IN = (2048 / 64) * (4096 / 32), I_OUT = (2048 / 64) * (2048 / 32), I_G = (2048 / 64) * (FFD / 32), I_DN = (FFD / 64) * (2048 / 32);
    constexpr int I_DQ = (2048 / 64) * (512 / 32), I_DKV = (2048 / 64) * (576 / 32), I_UQ = (512 / 64) * (3072 / 32), I_UKV = (512 / 64) * (4096 / 32), I_O = I_OUT;
    constexpr int I_MG = (2048 / 64) * (FFE / 32), I_MD = (FFE / 64) * (2048 / 32);
    constexpr int NITEMS = I_IN + I_OUT + 2 * I_G + I_DN + I_DQ + I_DKV + I_UQ + I_UKV + I_O + (FILL ? 0 : 16 * I_MG + 8 * I_MD);
    for (int it = gw; it < NITEMS; it += NGW) {
        int r = it;
        if (r < I_IN) { cvt_item<1>(p.ev_w_in, 2048, 4096, WSP(bf16_t, WT_IN), 0, scr, r, lane); continue; } r -= I_IN;
        if (r < I_OUT) { cvt_item<0>(p.ev_w_out, 2048, 2048, WSP(bf16_t, WT_OUT), 0, scr, r, lane); continue; } r -= I_OUT;
        if (r < I_G) { cvt_item<2>(p.ffn_w_gate, 2048, FFD, WSP(bf16_t, WT_GU), 0, scr, r, lane); continue; } r -= I_G;
        if (r < I_G) { cvt_item<3>(p.ffn_w_up, 2048, FFD, WSP(bf16_t, WT_GU), 0, scr, r, lane); continue; } r -= I_G;
        if (r < I_DN) { cvt_item<0>(p.ffn_w_down, FFD, 2048, WSP(bf16_t, WT_DN), 0, scr, r, lane); continue; } r -= I_DN;
        if (r < I_DQ) { cvt_item<0>(p.od_w_dq, 2048, 512, WSP(bf16_t, WT_DQKV), 0, scr, r, lane); continue; } r -= I_DQ;
        if (r < I_DKV) { cvt_item<0>(p.od_w_dkv, 2048, 576, WSP(bf16_t, WT_DQKV), 512, scr, r, lane); continue; } r -= I_DKV;
        if (r < I_UQ) { cvt_item<0>(p.od_w_uq, 512, 3072, WSP(bf16_t, WT_UQ), 0, scr, r, lane); continue; } r -= I_UQ;
        if (r < I_UKV) { cvt_item<0>(p.od_w_ukv, 512, 4096, WSP(bf16_t, WT_UKV), 0, scr, r, lane); continue; } r -= I_UKV;
        if (r < I_O) { cvt_item<0>(p.od_w_o, 2048, 2048, WSP(bf16_t, WT_O), 0, scr, r, lane); continue; } r -= I_O;
        moe_cvt_item(p, r, scr, lane);
    }
    { bf16_t* z = WSP(bf16_t, WT_DQKV) + (size_t)1088 * 2048; for (size_t i = (size_t)bid * 512 + tid; i < (size_t)192 * 2048 / 8; i += (size_t)nb * 512) ((uint4*)z)[i] = make_uint4(0, 0, 0, 0); }
}
__device__ __forceinline__ void ph_dft_tables(const P& p, int bid, int nb, float* tab  , int wv) {
    int tid_ = TID_FROM(wv); asm volatile("" : "+v"(tid_)); const int tid = tid_;
    for (int i = tid; i < 2048; i += 512) tab[i] = cospif((float)i * (2.0f / 2048.0f));
    __syncthreads();
    bf16_t* DN = WSP(bf16_t, WS_DFTN); bf16_t* DC = WSP(bf16_t, WS_DFTC); bf16_t* WC = WSP(bf16_t, WS_WCS);
    for (size_t i = (size_t)bid * 512 + tid; i < (size_t)2048 * 4096 / 2; i += (size_t)nb * 512) {
        const int k1 = (int)(i / 2048), n2 = (int)(i % 2048) * 2; unsigned w = 0;
#pragma unroll
        for (int q = 0; q < 2; ++q) { const int nn = n2 + q, n = nn & 2047, part = nn >> 11; const int idx = (k1 * n) & 2047; const float v = part == 0 ? tab[idx] : -tab[(idx + 1536) & 2047]; w |= (unsigned)f2bf(v) << (16 * q); }
        ((unsigned*)DN)[i] = w;
    }
    for (int i = bid * 512 + tid; i < 256 * 512; i += nb * 512) { const int k1 = i / 512, nn = i % 512, n = nn & 255, part = nn >> 8; const int idx = ((k1 * n) & 255) * 8; DC[i] = f2bf(part == 0 ? tab[idx] : -tab[(idx + 1536) & 2047]); }
    for (int i = bid * 512 + tid; i < 512 * 256; i += nb * 512) { const int m = i / 256, cc = i % 256, k3 = m & 255; const int idx = ((k3 * cc) & 255) * 8; WC[i] = f2bf(m < 256 ? tab[idx] : tab[(idx + 1536) & 2047]); }
    __syncthreads();
}

#ifndef ATT_ROPE_SD1
#define ATT_ROPE_SD1 1
#endif
namespace att {
using s16x4  = __attribute__((ext_vector_type(4))) short;
using f32x16 = __attribute__((ext_vector_type(16))) float;
constexpr int QBLK = 32, KVBLK = 64, NW = 8;
constexpr size_t SHM_V = KVBLK * 128 * 2, SHM_K = KVBLK * 128 * 2, SHM_KR = KVBLK * 64 * 2;
constexpr size_t OFF_K = 2 * SHM_V, OFF_KR = OFF_K + 2 * SHM_K, OFF_WS = OFF_KR + 2 * SHM_KR, OFF_QR = OFF_WS + NW * 64 * 4, SHM_ATTN = OFF_QR + 256 * 128;
#define KSWZ(row, colB) ((row) * 256 + ((colB) ^ (((row) & 7) << 4)))
#define KRSWZ(row, colB) ((row) * 128 + ((colB) ^ (((row) & 7) << 4)))
#define SBAR() __builtin_amdgcn_sched_barrier(0)
__device__ __forceinline__ int crow(int r, int hi) { return (r & 3) + 8 * (r >> 2) + 4 * hi; }
__device__ __forceinline__ unsigned cvtpk(float lo, float hi) { unsigned r; asm volatile("v_cvt_pk_bf16_f32 %0, %1, %2" : "=v"(r) : "v"(lo), "v"(hi)); return r; }
__device__ __forceinline__ bf16x8 ld8(const bf16_t* p) { return *reinterpret_cast<const bf16x8*>(p); }

__device__ __forceinline__ void partialSM(f32x16& p0, f32x16& p1, float& m_reg, float& mn, float& alpha, const float C, const float thr) {
  float pmax = p0[0]; for (int r = 1; r < 16; ++r) pmax = fmaxf(pmax, p0[r]); for (int r = 0; r < 16; ++r) pmax = fmaxf(pmax, p1[r]);
  { auto rr = __builtin_amdgcn_permlane32_swap(__float_as_uint(pmax), __float_as_uint(pmax), false, false);
    pmax = fmaxf(__uint_as_float(rr[0]), __uint_as_float(rr[1])); }
  if (__builtin_expect(__all(pmax - m_reg <= thr), 1)) { mn = m_reg; alpha = 1.f; }
  else { mn = fmaxf(m_reg, pmax); alpha = __builtin_amdgcn_exp2f((m_reg - mn) * C); m_reg = mn; }
  float mnC = -mn * C;
  for (int r = 0; r < 16; ++r) p0[r] = fmaf(p0[r], C, mnC); for (int r = 0; r < 16; ++r) p1[r] = fmaf(p1[r], C, mnC);
  for (int r = 0; r < 16; ++r) p0[r] = __builtin_amdgcn_exp2f(p0[r]);
}
__device__ __forceinline__ void finishSM(f32x16& p0, f32x16& p1, float alpha, float& l_reg, bf16x8& pa0, bf16x8& pa1, bf16x8& pa2, bf16x8& pa3) {
  for (int r = 0; r < 16; ++r) p1[r] = __builtin_amdgcn_exp2f(p1[r]);
  float ps = 0; for (int r = 0; r < 16; ++r) ps += p0[r]; for (int r = 0; r < 16; ++r) ps += p1[r];
  { auto rr = __builtin_amdgcn_permlane32_swap(__float_as_uint(ps), __float_as_uint(ps), false, false);
    ps = __uint_as_float(rr[0]) + __uint_as_float(rr[1]); }
  l_reg = l_reg * alpha + ps;
#define PK4(P, BASE, OUT) do { unsigned a0 = cvtpk(P[BASE + 0], P[BASE + 1]), a1 = cvtpk(P[BASE + 2], P[BASE + 3]);   \
    unsigned b0 = cvtpk(P[BASE + 4], P[BASE + 5]), b1 = cvtpk(P[BASE + 6], P[BASE + 7]);                              \
    auto r0 = __builtin_amdgcn_permlane32_swap(a0, b0, false, false); auto r1 = __builtin_amdgcn_permlane32_swap(a1, b1, false, false); \
    u32x4 w = {r0[0], r1[0], r0[1], r1[1]}; OUT = *reinterpret_cast<bf16x8*>(&w); } while (0)
  PK4(p0, 0, pa0); PK4(p0, 8, pa1); PK4(p1, 0, pa2); PK4(p1, 8, pa3);
#undef PK4
}
template <bool ROPE> __device__ __forceinline__ void qkt(f32x16& p0, f32x16& p1, const char* Ks, const char* KRs, const char* QRs, const bf16x8* qr, int r32, int hi) {
  p0 = f32x16{}; p1 = f32x16{};
#pragma unroll
  for (int d0 = 0; d0 < 8; ++d0) { int cb = (d0 * 16 + hi * 8) * 2;
    bf16x8 b0 = *reinterpret_cast<const bf16x8*>(Ks + KSWZ(r32, cb));
    bf16x8 b1 = *reinterpret_cast<const bf16x8*>(Ks + KSWZ(32 + r32, cb));
    p0 = __builtin_amdgcn_mfma_f32_32x32x16_bf16(b0, qr[d0], p0, 0, 0, 0);
    p1 = __builtin_amdgcn_mfma_f32_32x32x16_bf16(b1, qr[d0], p1, 0, 0, 0); }
  if constexpr (ROPE) {
#pragma unroll
    for (int d1 = 0; d1 < 4; ++d1) { int cb = (d1 * 16 + hi * 8) * 2;
      bf16x8 b0 = *reinterpret_cast<const bf16x8*>(KRs + KRSWZ(r32, cb));
      bf16x8 b1 = *reinterpret_cast<const bf16x8*>(KRs + KRSWZ(32 + r32, cb));
      bf16x8 qf = *reinterpret_cast<const bf16x8*>(QRs + KRSWZ(r32, cb));
      p0 = __builtin_amdgcn_mfma_f32_32x32x16_bf16(b0, qf, p0, 0, 0, 0);
      p1 = __builtin_amdgcn_mfma_f32_32x32x16_bf16(b1, qf, p1, 0, 0, 0); }
  }
}
__device__ __forceinline__ int v_st(int k, int c) { const int kk = (k & ~0xC) | ((k & 4) << 1) | ((k & 8) >> 1); return ((kk >> 3) * 4 + (c >> 5)) * 512 + ((kk & 7) * 32 + (c & 31)) * 2; }
__device__ __forceinline__ int v_rd_base(int lane) { return ((lane & 3) << 3) | (((lane >> 2) & 3) << 6) | (((lane >> 4) & 1) << 5) | (((lane >> 5) & 1) << 8); }
constexpr int v_rd_off(int d0, int ks, int half) { return d0 * 512 + ks * 4096 + half * 2048; }
template <int OFF> __device__ __forceinline__ s16x4 tr_read(int vb) {
  s16x4 r; asm volatile("ds_read_b64_tr_b16 %0, %1 offset:%2" : "=&v"(r) : "v"(vb), "i"(OFF) : "memory"); return r;
}
template <int D0> __device__ __forceinline__ void pv_one(f32x16& od, int vb, bf16x8 pa0, bf16x8 pa1, bf16x8 pa2, bf16x8 pa3) {
  const s16x4 l0 = tr_read<v_rd_off(D0, 0, 0)>(vb), h0 = tr_read<v_rd_off(D0, 0, 1)>(vb), l1 = tr_read<v_rd_off(D0, 1, 0)>(vb), h1 = tr_read<v_rd_off(D0, 1, 1)>(vb);
  const s16x4 l2 = tr_read<v_rd_off(D0, 2, 0)>(vb), h2 = tr_read<v_rd_off(D0, 2, 1)>(vb), l3 = tr_read<v_rd_off(D0, 3, 0)>(vb), h3 = tr_read<v_rd_off(D0, 3, 1)>(vb);
  asm volatile("s_waitcnt lgkmcnt(0)" ::: "memory"); SBAR();
#define PK(L, H) (bf16x8){L[0], L[1], L[2], L[3], H[0], H[1], H[2], H[3]}
  od = __builtin_amdgcn_mfma_f32_32x32x16_bf16(pa0, PK(l0, h0), od, 0, 0, 0);
  od = __builtin_amdgcn_mfma_f32_32x32x16_bf16(pa1, PK(l1, h1), od, 0, 0, 0);
  od = __builtin_amdgcn_mfma_f32_32x32x16_bf16(pa2, PK(l2, h2), od, 0, 0, 0);
  od = __builtin_amdgcn_mfma_f32_32x32x16_bf16(pa3, PK(l3, h3), od, 0, 0, 0);
#undef PK
}
__device__ __forceinline__ void pv_d0(f32x16* o, int vb, bf16x8 pa0, bf16x8 pa1, bf16x8 pa2, bf16x8 pa3) {
  pv_one<0>(o[0], vb, pa0, pa1, pa2, pa3); pv_one<1>(o[1], vb, pa0, pa1, pa2, pa3); pv_one<2>(o[2], vb, pa0, pa1, pa2, pa3); pv_one<3>(o[3], vb, pa0, pa1, pa2, pa3);
}
template <int LDQ, int LDK, int LDV, int LDO, bool ROPE, bool OBF>
__device__ __forceinline__ void attn_body(const bf16_t* __restrict__ Qb, const bf16_t* __restrict__ Kh, const bf16_t* __restrict__ Vh, const bf16_t* __restrict__ KRh,
                                          void* __restrict__ Ob, int seq, const float C, const float thr, char* lds, int wv) {
  int tid_ = TID_FROM(wv); asm volatile("" : "+v"(tid_));
  const int tid = tid_, wid = tid >> 6, lane = tid & 63, r32 = lane & 31, hi = lane >> 5;
  char* V_lds = lds; char* K_lds = lds + OFF_K; char* KR_lds = lds + OFF_KR;
  float* ws = (float*)(lds + OFF_WS) + wid * 64; float* li_l = ws; float* al_l = ws + 32;
  float m_reg = -1e30f, l_reg = 0; f32x16 o[4] = {}; bf16x8 qr[8];
  const bf16_t* Qw = Qb + (long)(wid * QBLK + r32) * LDQ + hi * 8;
#pragma unroll
  for (int d0 = 0; d0 < 8; ++d0) qr[d0] = ld8(Qw + d0 * 16);
  const char* QR_lds = lds + OFF_QR + wid * 4096;
  if constexpr (ROPE) {
#pragma unroll
    for (int d1 = 0; d1 < 4; ++d1) *(bf16x8*)(lds + OFF_QR + wid * 4096 + KRSWZ(r32, (d1 * 16 + hi * 8) * 2)) = ld8(Qw + 128 + d1 * 16);
  }
  const int sr = tid >> 4, sc = (tid & 15) * 8, vst0 = v_st(sr, sc), vst1 = v_st(32 + sr, sc);
  const int krr = tid >> 3, krc = (tid & 7) * 8;
  const int vb0 = (int)(uintptr_t)V_lds + v_rd_base(lane);
  constexpr int SD = (ROPE && ATT_ROPE_SD1) ? 1 : 2;
  struct { bf16x8 vs0, vs1, ks0, ks1, kr; } sr_[SD];
#define SLOAD(i, k0) do { sr_[i].vs0 = ld8(&Vh[(long)((k0) + sr) * LDV + sc]); sr_[i].vs1 = ld8(&Vh[(long)((k0) + 32 + sr) * LDV + sc]); \
    sr_[i].ks0 = ld8(&Kh[(long)((k0) + sr) * LDK + sc]); sr_[i].ks1 = ld8(&Kh[(long)((k0) + 32 + sr) * LDK + sc]); \
    if constexpr (ROPE) sr_[i].kr = ld8(&KRh[(long)((k0) + krr) * 64 + krc]); } while (0)
#define SWRITE(b, i) do { *(bf16x8*)(V_lds + (b) * SHM_V + vst0) = sr_[i].vs0;          \
    *(bf16x8*)(V_lds + (b) * SHM_V + vst1) = sr_[i].vs1; int kc = sc * 2;               \
    *(bf16x8*)(K_lds + (b) * SHM_K + KSWZ(sr, kc)) = sr_[i].ks0;                       \
    *(bf16x8*)(K_lds + (b) * SHM_K + KSWZ(32 + sr, kc)) = sr_[i].ks1;                  \
    if constexpr (ROPE) *(bf16x8*)(KR_lds + (b) * SHM_KR + KRSWZ(krr, krc * 2)) = sr_[i].kr; } while (0)
#define SWAIT() do { if constexpr (SD == 1) asm volatile("s_waitcnt vmcnt(0)" ::: "memory"); else if constexpr (ROPE) asm volatile("s_waitcnt vmcnt(5)" ::: "memory"); else asm volatile("s_waitcnt vmcnt(4)" ::: "memory"); } while (0)
#define RESC(a) do { if (__any((a) < 1.f)) { if (hi == 0) al_l[r32] = (a); asm volatile("s_waitcnt lgkmcnt(0)" ::: "memory"); \
    for (int d = 0; d < 4; ++d) for (int r = 0; r < 16; ++r) o[d][r] *= al_l[crow(r, hi)]; } } while (0)
  f32x16 pA0, pA1, pB0, pB1; float mnA, mnB, alA, alB; bf16x8 pa0, pa1, pa2, pa3; const int NT = seq / KVBLK;
  constexpr int SE = 0, SO = SD - 1;
  SLOAD(SE, 0); asm volatile("s_waitcnt vmcnt(0)" ::: "memory"); SWRITE(0, SE); __syncthreads();
  qkt<ROPE>(pA0, pA1, K_lds, KR_lds, QR_lds, qr, r32, hi); partialSM(pA0, pA1, m_reg, mnA, alA, C, thr);
  SLOAD(SO, KVBLK); if constexpr (SD == 2) { if (2 < NT) SLOAD(SE, 2 * KVBLK); }
  SWAIT(); SWRITE(1, SO); __syncthreads();
  for (int j = 1; j + 1 < NT; j += 2) {
    SBAR(); qkt<ROPE>(pB0, pB1, K_lds + SHM_K, KR_lds + SHM_KR, QR_lds, qr, r32, hi);
    finishSM(pA0, pA1, alA, l_reg, pa0, pa1, pa2, pa3); SBAR();
    SLOAD(SO, (j + SD) * KVBLK); SBAR();
    pv_d0(o, vb0, pa0, pa1, pa2, pa3); partialSM(pB0, pB1, m_reg, mnB, alB, C, thr);
    __syncthreads(); SWAIT(); SWRITE(0, SE);
    RESC(alB); __syncthreads();
    SBAR(); qkt<ROPE>(pA0, pA1, K_lds, KR_lds, QR_lds, qr, r32, hi);
    finishSM(pB0, pB1, alB, l_reg, pa0, pa1, pa2, pa3); SBAR();
    if (SD == 1 || j + 3 < NT) SLOAD(SE, (j + 1 + SD) * KVBLK); SBAR();
    pv_d0(o, vb0 + (int)SHM_V, pa0, pa1, pa2, pa3); partialSM(pA0, pA1, m_reg, mnA, alA, C, thr);
    __syncthreads(); SWAIT(); SWRITE(1, SO);
    RESC(alA); __syncthreads();
  }
  SBAR(); qkt<ROPE>(pB0, pB1, K_lds + SHM_K, KR_lds + SHM_KR, QR_lds, qr, r32, hi);
  finishSM(pA0, pA1, alA, l_reg, pa0, pa1, pa2, pa3); SBAR();
  pv_d0(o, vb0, pa0, pa1, pa2, pa3); partialSM(pB0, pB1, m_reg, mnB, alB, C, thr);
  __syncthreads(); RESC(alB);
  finishSM(pB0, pB1, alB, l_reg, pa0, pa1, pa2, pa3); SBAR();
  pv_d0(o, vb0 + (int)SHM_V, pa0, pa1, pa2, pa3);
  if (hi == 0) li_l[r32] = l_reg; asm volatile("s_waitcnt lgkmcnt(0)" ::: "memory");
  float rli[16];
#pragma unroll
  for (int r = 0; r < 16; ++r) rli[r] = __builtin_amdgcn_rcpf(li_l[crow(r, hi)]);
#pragma unroll
  for (int r = 0; r < 16; ++r) { const int orow = wid * QBLK + crow(r, hi);
#pragma unroll
    for (int d0 = 0; d0 < 4; ++d0) { const float val = o[d0][r] * rli[r];
      if constexpr (OBF) ((bf16_t*)Ob)[(long)orow * LDO + d0 * 32 + r32] = f2bf(val); else ((float*)Ob)[(long)orow * LDO + d0 * 32 + r32] = val; } }
  __syncthreads();
#undef SLOAD
#undef SWRITE
#undef SWAIT
#undef RESC
}
#undef KSWZ
#undef KRSWZ
#undef SBAR
}

constexpr int NPH = 22;
typedef const __attribute__((address_space(4))) P* KP4;
__global__ void __launch_bounds__(512, 2) mega(P p_arg, int ph_lo, int ph_hi, int bar_idx) {
    const KP4 kp0 = (KP4)__builtin_amdgcn_kernarg_segment_ptr();
#define LOCAL_P KP4 kp_ = kp0; asm volatile("" : "+s"(kp_)); const P& p = *(const P*)kp_;
    LOCAL_P
    extern __shared__ __attribute__((aligned(16))) unsigned char lds_raw[];
    LAS unsigned char* lds = (LAS unsigned char*)lds_raw;
    const int wv = __builtin_amdgcn_readfirstlane((int)threadIdx.x >> 6);
    const int tid = TID_FROM(wv), bid = blockIdx.x, nb = gridDim.x;
    volatile LAS unsigned* MISC = (volatile LAS unsigned*)(lds + MISC_OFF);
    for (int u = tid; u < (LDS_BYTES - RING_BYTES) / 4; u += 512) ((LAS unsigned*)(lds + RING_BYTES))[u] = 0u;
    __syncthreads();
    unsigned* ctl = (unsigned*)(p.ws + WS_CTL);
    XcdBarrier bar = xcd_barrier_post(ctl + CW_BAR + bar_idx * XCD_BAR_WORDS, MISC + 8, wv);
    float* SLABS = WSP(float, WS_SLAB);
#ifndef NHELP
#define NHELP 0
#endif
    const int nbw = nb - NHELP; const bool helper = NHELP > 0 && bid >= nbw;
#ifndef FILL_TAILS
#define FILL_TAILS 1
#endif
#define FILL_TAIL(k) do { if (FILL && FILL_TAILS) { __syncthreads(); if (wv == 0 && lane_id() == 0) (void)xb_add(ctl + CW_DONE + 64 * (k), 1u); moe_fill(p, ctl, (k), nb, bid, lds, MISC, wv); } } while (0)
#define GEMM_TAIL(S, E, off) do { if ((S).s > 1) { xcd_barrier(bar, wv); pg8::tail_reduce(S, E, SLABS + ((size_t)(off) << 16), bid, nb, wv); } } while (0)
#ifndef PH_MASK
#define PH_MASK 0xFFFFFFFFu
#endif
#define RUN(k) (((PH_MASK >> (k)) & 1u) && ph_lo <= (k) && (k) < ph_hi)
#define SEAM(k) do { if (RUN(k) && RUN((k) + 1)) xcd_barrier(bar, wv); } while (0)
#ifndef REPEAT_PH
#define REPEAT_PH (-1)
#endif
#ifndef REPEAT_N
#define REPEAT_N 2
#endif
#define NREP(k) ((k) == REPEAT_PH ? REPEAT_N : 1)
#define PH_BEGIN(k) if (RUN(k)) { _Pragma("unroll") for (int rep = 0; rep < NREP(k); ++rep) { LOCAL_P
#define PH_END(k) if (rep + 1 < NREP(k)) xcd_barrier(bar, wv); } } SEAM(k);
    const size_t T2048 = (size_t)256 * 2048 * 2, T512 = (size_t)256 * 512 * 2;
#ifndef SPLIT_G1
#define SPLIT_G1 1
#endif
#ifndef SPLIT_G2
#define SPLIT_G2 4
#endif
#ifndef SPLIT_G3
#define SPLIT_G3 4
#endif
#ifndef SPLIT_G4
#define SPLIT_G4 4
#endif
#ifndef SPLIT_P13
#define SPLIT_P13 1
#endif
#ifndef SPLIT_G9
#define SPLIT_G9 1
#endif
#ifndef SPLIT_G10
#define SPLIT_G10 8
#endif

    PH_BEGIN(0) { ph_prologue(p, bid, nb, (float*)lds_raw, wv); __syncthreads(); ph_dft_tables(p, bid, nb, (float*)lds_raw, wv); ph_convert(p, bid, nb, lds, wv);
#ifdef CONVERT_TWICE
        __syncthreads(); ph_convert(p, bid, nb, lds, wv);
#endif
    }
    PH_END(0)
    PH_BEGIN(1) ph_norm_mod<!ORACLE>(p, p.norm1_g, 0, 0, 1, bid, nb, wv);
    PH_END(1)
#ifdef EXTRA_BARS
    for (int e_ = 0; e_ < EXTRA_BARS; ++e_) xcd_barrier(bar, wv);
#endif
    PH_BEGIN(2) { pg8::GridSched<false> S; S.init(WSP(bf16_t, WS_H), T2048, WSP(bf16_t, WT_IN), T2048, 36, 16, 2048, nbw, bid, SPLIT_G1);
        pg8::Epi<EF_in> E{{WSP(bf16_t, A0_F), WSP(bf16_t, A0_Q), WSP(bf16_t, A0_K), WSP(bf16_t, A0_V), WSP(float2, WS_TABD)}};
        if (!helper) { pg8::gemm_phase(lds, pg8::Dims{2048, 2048, SLABS}, S, E, wv); } FILL_TAIL(2);
        GEMM_TAIL(S, E, 0); }
    PH_END(2)
    PH_BEGIN(3) { pg8::TailSched<DftABase> S; S.b.WCS = (const char*)WSP(bf16_t, WS_WCS); S.b.F = (const char*)WSP(bf16_t, A0_F); S.init(288, 256, nb, bid);
        pg8::Epi<EF_dftA> E{{WSP(bf16_t, A0_VT), WSP(bf16_t, A0_VTC)}};
        pg8::gemm_phase(lds, pg8::Dims{256, 1024, SLABS}, S, E, wv); GEMM_TAIL(S, E, 0); }
    PH_END(3)
    PH_BEGIN(4) {
        pg8::TailSched<DftBBase> S1; S1.b = DftBBase{(const char*)WSP(bf16_t, WS_DFTN), (const char*)WSP(bf16_t, A0_VT), (size_t)256 * 4096 * 2, (size_t)256 * 4096 * 2, 8, 0}; S1.init(128, 4096, nb, bid, 1);
        pg8::Epi<EF_dftB> E1{{WSP(bf16_t, A0_MIX), 1.0f / sqrtf(2048.f * 256.f), CTX}};
        pg8::gemm_phase(lds, pg8::Dims{4096, 4096, SLABS}, S1, E1, wv);
        pg8::TailSched<DftBBase> S2; S2.b = DftBBase{(const char*)WSP(bf16_t, WS_DFTC), (const char*)WSP(bf16_t, A0_VTC), 0, (size_t)256 * 512 * 2, 1, 0}; S2.init(16, 512, nb, (bid + 128) % nb, 1);
        pg8::Epi<EF_dftB> E2{{WSP(bf16_t, A0_MIX), 1.0f / sqrtf(256.f * 256.f), 0}};
        pg8::gemm_phase(lds, pg8::Dims{512, 512, SLABS + ((size_t)256 << 16)}, S2, E2, wv);
        __syncthreads();
        volatile LAS int* qslot = (volatile LAS int*)(MISC + 16);
        const bf16_t* Qd = WSP(bf16_t, A0_Q); const bf16_t* Kd = WSP(bf16_t, A0_K); const bf16_t* Vd = WSP(bf16_t, A0_V); float* OD = WSP(float, A0_OD);
        for (;;) {
            if (tid == 0) *qslot = (int)xb_add(ctl + CW_QUEUE + 64 * rep, 1u);
            __syncthreads();
            const int it = *qslot;
            __syncthreads();
            if (it >= 576) break;
            int inst, row0, seq;
            if (it < 512) { inst = it >> 3; row0 = CTX + (it & 7) * 256; seq = TPB; } else { inst = it - 512; row0 = 0; seq = CTX; }
            const int b = inst >> 4, h = (inst >> 2) & 3, c = (inst >> 1) & 1, vh = inst & 1;
            const size_t R0 = (size_t)b * TPB + row0, K0 = (size_t)b * TPB;
            att::attn_body<1024, 1024, 1024, 2048, false, false>(Qd + R0 * 1024 + h * 256 + c * 128, Kd + K0 * 1024 + h * 256 + c * 128, Vd + K0 * 1024 + h * 256 + vh * 128, nullptr,
                OD + (R0 * 4 + h) * 512 + c * 256 + vh * 128, seq, 0.08838834764831845f * 1.4426950408889634f, 8.f / 0.08838834764831845f, (char*)lds_raw, wv);
        }
        FILL_TAIL(4);
        if (S1.s > 1 || S2.s > 1) { xcd_barrier(bar, wv); pg8::tail_reduce(S1, E1, SLABS, bid, nb, wv); pg8::tail_reduce(S2, E2, SLABS + ((size_t)256 << 16), bid, nb, wv); }
    }
    PH_END(4)
    PH_BEGIN(5) ph_subln(p, bid, nb, wv);
    PH_END(5)
    PH_BEGIN(6) { pg8::GridSched<false> S; S.init(WSP(bf16_t, A0_MIX), T2048, WSP(bf16_t, WT_OUT), T2048, 36, 8, 2048, nbw, bid, SPLIT_G2);
#if ORACLE
        pg8::Epi<EF_res> E{{WSP(float, WS_XS), WSP(float, WS_MODS), 2, 0}};
#else
        pg8::Epi<EF_res0> E{{WSP(float, WS_XS), WSP(float, WS_MODS), p.x, p.ctx, 2, 0}};
#endif
        if (!helper) { pg8::gemm_phase(lds, pg8::Dims{2048, 2048, SLABS}, S, E, wv); } FILL_TAIL(6);
        GEMM_TAIL(S, E, 0); }
    PH_END(6)
    PH_BEGIN(7) ph_norm_mod(p, p.norm2_g, 0, 3, 4, bid, nb, wv);
    PH_END(7)
    PH_BEGIN(8) { pg8::GridSched<false> S; S.init(WSP(bf16_t, WS_H), T2048, WSP(bf16_t, WT_GU), T2048, 36, 44, 2048, nbw, bid, SPLIT_G3);
        pg8::Epi<EF_swiglu> E{{WSP(bf16_t, A0_ACT), FFD, 0}};
        if (!helper) { pg8::gemm_phase(lds, pg8::Dims{2048, 2048, SLABS}, S, E, wv); } FILL_TAIL(8);
        GEMM_TAIL(S, E, 0); }
    PH_END(8)
    PH_BEGIN(9) { pg8::GridSched<false> S; S.init(WSP(bf16_t, A0_ACT), (size_t)256 * FFD * 2, WSP(bf16_t, WT_DN), (size_t)256 * FFD * 2, 36, 8, FFD, nbw, bid, SPLIT_G4);
        pg8::Epi<EF_res> E{{WSP(float, WS_XS), WSP(float, WS_MODS), 5, 0}};
        if (!helper) { pg8::gemm_phase(lds, pg8::Dims{FFD, FFD, SLABS}, S, E, wv); } FILL_TAIL(9);
        GEMM_TAIL(S, E, 0); }
    PH_END(9)
    PH_BEGIN(10) ph_norm_mod(p, p.norm1_g + D, 1, 0, 1, bid, nb, wv);
    PH_END(10)
    PH_BEGIN(11) { pg8::GridSched<false> S; S.init(WSP(bf16_t, WS_H), T2048, WSP(bf16_t, WT_DQKV), T2048, 36, 5, 2048, nbw, bid);
        pg8::Epi<EF_dqkv> E{{WSP(float, A1_CQ), WSP(float, A1_CKV), WSP(bf16_t, A1_KR), WSP(float2, WS_TABM)}};
        if (!helper) { pg8::gemm_phase(lds, pg8::Dims{2048, 2048, SLABS}, S, E, wv); } FILL_TAIL(11);
        GEMM_TAIL(S, E, 0); }
    PH_END(11)
    PH_BEGIN(12) ph_lora_norm(p, bid, nb, wv);
    PH_END(12)
    PH_BEGIN(13) {
        pg8::GridSched<true> S1; S1.init(WSP(bf16_t, A1_CQN), T512, WSP(bf16_t, WT_UQ), T512, 32, 12, 512, nbw, bid, SPLIT_P13);
        pg8::Epi<EF_uq> E1{{WSP(bf16_t, A1_QM), WSP(float2, WS_TABM)}};
        if (!helper) pg8::gemm_phase(lds, pg8::Dims{512, 512, SLABS}, S1, E1, wv);
        pg8::GridSched<false> S2; S2.init(WSP(bf16_t, A1_CKVN), T512, WSP(bf16_t, WT_UKV), T512, 36, 16, 512, nbw, bid, SPLIT_P13);
        pg8::Epi<EF_bf> E2{{WSP(bf16_t, A1_KVM), 4096, 0}};
        if (!helper) pg8::gemm_phase(lds, pg8::Dims{512, 512, SLABS + ((size_t)256 << 16)}, S2, E2, wv);
#ifdef PROBE_P13
        for (int q_ = 0; q_ < PROBE_P13; ++q_) { __syncthreads(); pg8::Epi<EF_probe> E3{{SLABS, 0, 0}}; if (!helper) pg8::gemm_phase(lds, pg8::Dims{512, 512, SLABS}, S2, E3, wv); }
#endif
        FILL_TAIL(13);
        if (S1.s > 1 || S2.s > 1) { xcd_barrier(bar, wv); pg8::tail_reduce(S1, E1, SLABS, bid, nb, wv); pg8::tail_reduce(S2, E2, SLABS + ((size_t)256 << 16), bid, nb, wv); }
    }
    PH_END(13)
    PH_BEGIN(14) {
        __syncthreads();
        const bf16_t* QM = WSP(bf16_t, A1_QM); const bf16_t* KVM = WSP(bf16_t, A1_KVM); const bf16_t* KR = WSP(bf16_t, A1_KR); bf16_t* OM = WSP(bf16_t, A1_OM);
        for (int r = 0; r * nb + bid < 512; ++r) {
            int it = r * nb + bid;
            if (nb == 256) { const int x = bid & 7, y = bid >> 3; it = (r * 32 + (y >> 3) * 8 + x) * 8 + (y & 7); }
            const int inst = it >> 3, qb = it & 7, b = inst >> 4, h = inst & 15;
            const size_t R0 = (size_t)b * TPB + CTX + qb * 256, K0 = (size_t)b * TPB;
            att::attn_body<3072, 4096, 4096, 2048, true, true>(QM + R0 * 3072 + h * 192, KVM + K0 * 4096 + h * 256, KVM + K0 * 4096 + h * 256 + 128, KR + K0 * 64,
                OM + R0 * 2048 + h * 128, TPB, 0.07216878364870323f * 1.4426950408889634f, 8.f / 0.07216878364870323f, (char*)lds_raw, wv);
        }
    }
    PH_END(14)
    PH_BEGIN(15) { pg8::GridSched<true> S; S.init(WSP(bf16_t, A1_OM), T2048, WSP(bf16_t, WT_O), T2048, 32, 8, 2048, nbw, bid);
        pg8::Epi<EF_res> E{{WSP(float, WS_XS), WSP(float, WS_MODS) + 5 * 6 * D, 2, 0}};
        if (!helper) { pg8::gemm_phase(lds, pg8::Dims{2048, 2048, SLABS}, S, E, wv); } FILL_TAIL(15);
        GEMM_TAIL(S, E, 0); }
    PH_END(15)
    PH_BEGIN(16) { __syncthreads(); ph_route(p, bid, nb, (float*)lds_raw, wv); }
    PH_END(16)
    PH_BEGIN(17) { __syncthreads(); ph_sort(p, bid, (int*)lds_raw, wv);
        if (FILL) { __syncthreads(); moe_fill(p, ctl, -1, nb, bid, lds, MISC, wv); } }
    PH_END(17)
    PH_BEGIN(18) ph_gather(p, bid, nb, wv);
    PH_END(18)
    PH_BEGIN(19) { pg8::TailSched<MoeBase> S; const int tot = S.b.init(WSP(unsigned char, A1_AS), (size_t)2048, WSP(unsigned char, WT_MGU), (size_t)2 * FFE * 2048, (size_t)256 * 2048, 56, (const int*)(p.ws + WS_ROUTE + RT_CNT), (const int*)(p.ws + WS_ROUTE + RT_OFFS)); S.init(tot, 1024, nb, bid, SPLIT_G9);
        pg8::Epi<EF_swiglu8> E{{WSP(unsigned char, A1_ACT2), FFE, 0}};
        pg8::gemm_phase<true>(lds, pg8::Dims{1024, 1024, SLABS}, S, E, wv); GEMM_TAIL(S, E, 0);
#ifdef PROBE_G9
#if PROBE_G9 == 1
        { xcd_barrier(bar, wv); pg8::Epi<EF_probe> E2{{SLABS, 0, 0}}; pg8::gemm_phase<true>(lds, pg8::Dims{1024, 1024, SLABS}, S, E2, wv); }
#elif PROBE_G9 == 2
        { xcd_barrier(bar, wv); pg8::Epi<EF_probe_math> E2{{(unsigned char*)SLABS, FFE, 0}}; pg8::gemm_phase<true>(lds, pg8::Dims{1024, 1024, SLABS}, S, E2, wv); }
#else
        { xcd_barrier(bar, wv); pg8::Epi<EF_probe_store> E2{{(unsigned char*)SLABS, FFE, 0}}; pg8::gemm_phase<true>(lds, pg8::Dims{1024, 1024, SLABS}, S, E2, wv); }
#endif
#endif
    }
    PH_END(19)
    PH_BEGIN(20) { pg8::TailSched<MoeBase> S; const int tot = S.b.init(WSP(unsigned char, A1_ACT2), (size_t)FFE, WSP(unsigned char, WT_MD), (size_t)2048 * FFE, (size_t)256 * FFE, 8, (const int*)(p.ws + WS_ROUTE + RT_CNT), (const int*)(p.ws + WS_ROUTE + RT_OFFS)); S.init(tot, FFE / 2, nb, bid, SPLIT_G10);
        pg8::Epi<EF_y8> E{{WSP(float, A1_Y), 2048, 0}};
        pg8::gemm_phase<true>(lds, pg8::Dims{FFE / 2, FFE / 2, SLABS}, S, E, wv); GEMM_TAIL(S, E, 0); }
    PH_END(20)
    PH_BEGIN(21) ph_final(p, bid, nb, wv);
    PH_END(21)
#undef GEMM_TAIL
#undef FILL_TAIL
#undef RUN
#undef SEAM
#undef PH_BEGIN
#undef PH_END
}
#if ORACLE
template <class G> __global__ __launch_bounds__(256) void ngemm(G g) {
    __shared__ float As[16][132]; __shared__ float Ws[16][132]; __shared__ float W2s[G::DUAL ? 16 : 1][132];
    const int z = blockIdx.z, M = g.rows(z), N = g.N, K = g.K, m0 = blockIdx.y * 128, n0 = blockIdx.x * 128;
    if (m0 >= M) return;
    const int tid = threadIdx.x, tx = tid & 15, ty = tid >> 4;
    float acc[8][8], acc2[G::DUAL ? 8 : 1][8];
#pragma unroll
    for (int i = 0; i < 8; ++i)
#pragma unroll
        for (int j = 0; j < 8; ++j) { acc[i][j] = 0.f; if constexpr (G::DUAL) acc2[i][j] = 0.f; }
    for (int k0 = 0; k0 < K; k0 += 16) {
#pragma unroll
        for (int i = 0; i < 8; ++i) { const int idx = tid + i * 256; const int k = idx & 15, m = idx >> 4; As[k][m] = (m0 + m < M) ? g.a(z, m0 + m, k0 + k) : 0.f; }
#pragma unroll
        for (int i = 0; i < 8; ++i) { const int idx = tid + i * 256; const int n = idx & 127, k = idx >> 7; const bool ok = n0 + n < N; Ws[k][n] = ok ? g.w(z, k0 + k, n0 + n) : 0.f; if constexpr (G::DUAL) W2s[k][n] = ok ? g.w2(z, k0 + k, n0 + n) : 0.f; }
        __syncthreads();
#pragma unroll
        for (int k = 0; k < 16; ++k) {
            float av[8], bv[8], b2[8];
#pragma unroll
            for (int i = 0; i < 8; ++i) { av[i] = As[k][ty * 8 + i]; bv[i] = Ws[k][tx * 8 + i]; if constexpr (G::DUAL) b2[i] = W2s[k][tx * 8 + i]; }
#pragma unroll
            for (int i = 0; i < 8; ++i)
#pragma unroll
                for (int j = 0; j < 8; ++j) { acc[i][j] += av[i] * bv[j]; if constexpr (G::DUAL) acc2[i][j] += av[i] * b2[j]; }
        }
        __syncthreads();
    }
#pragma unroll
    for (int i = 0; i < 8; ++i)
#pragma unroll
        for (int j = 0; j < 8; ++j) { const int m = m0 + ty * 8 + i, n = n0 + tx * 8 + j; if (m < M && n < N) g.epi(z, m, n, acc[i][j], G::DUAL ? acc2[i][j] : 0.f); }
}

template <int HALF> __device__ __forceinline__ int rope_partner(int d) { const int i = d % HALF; return i < HALF / 2 ? d + HALF / 2 : d - HALF / 2; }
template <int HALF> __device__ __forceinline__ float rope_apply(const float2* tab, int nl, int d, float v, float vp) {
    const int half = d / HALF, i = d % HALF, pos = half == 0 ? nl / 64 : nl % 64, fi = i % (HALF / 2); const float2 cs = tab[pos * (HALF / 2) + fi];
    return i < HALF / 2 ? v * cs.x - vp * cs.y : v * cs.x + vp * cs.y;
}

struct G_in {
    static constexpr bool DUAL = true; const bf16_t* H; const float* W; bf16_t *F, *Q, *Kd, *V; const float2* tab; int N, K;
    __device__ int rows(int) const { return NTOK; }
    __device__ float a(int, int m, int k) const { return bf2f(H[(size_t)m * D + k]); }
    __device__ float w(int, int k, int n) const { return W[(size_t)k * EIN + n]; }
    __device__ float w2(int, int k, int n) const { if (n < 1024 || n >= 3072) return 0.f; const int d = n & 127; return W[(size_t)k * EIN + (n - d) + rope_partner<64>(d)]; }
    __device__ void epi(int, int m, int n, float v, float vp) const {
        const int j = m % TPB;
        if (n < 1024) { F[(size_t)m * 1024 + n] = f2bf(v); return; }
        if (n >= 3072) { V[(size_t)m * 1024 + n - 3072] = f2bf(v); return; }
        float o = v; if (j >= CTX) o = rope_apply<64>(tab, j - CTX, n & 127, v, vp);
        if (n < 2048) Q[(size_t)m * 1024 + n - 1024] = f2bf(o); else Kd[(size_t)m * 1024 + n - 2048] = f2bf(o);
    }
};
struct G_dftA {
    static constexpr bool DUAL = false; const bf16_t* F; float* T; int N, K;
    __device__ int rows(int) const { return NTOK * 4; }
    __device__ float a(int, int m, int k) const { return bf2f(F[(size_t)m * 256 + k]); }
    __device__ float w(int, int k, int n) const { const int k3 = n & 255, idx = (k * k3) & 255; const float ang = (float)idx * (2.0f / 256.0f); return n < 256 ? cospif(ang) : sinpif(ang); }
    __device__ float w2(int, int, int) const { return 0.f; }
    __device__ void epi(int, int m, int n, float v, float) const { T[(size_t)m * 512 + n] = v; }
};
struct G_dftB {
    static constexpr bool DUAL = false; const float* T; bf16_t* MIX; int N, K, NS, joff; float scale; int pad;
    __device__ int rows(int) const { return NS; }
    __device__ float a(int, int m, int k) const { const int n = k % NS, part = k / NS; const int idx = (int)(((long)m * n) % NS); const float ang = (float)idx * (2.0f / (float)NS); return part == 0 ? cospif(ang) : -sinpif(ang); }
    __device__ float w(int z, int k, int n) const { const int b = z >> 2, g = z & 3, nn = k % NS, part = k / NS; const int R = b * TPB + joff + nn; return T[((size_t)R * 4 + g) * 512 + part * 256 + n]; }
    __device__ float w2(int, int, int) const { return 0.f; }
    __device__ void epi(int z, int m, int n, float v, float) const { const int b = z >> 2, g = z & 3; const int R = b * TPB + joff + m; MIX[(size_t)R * 2048 + g * 256 + n] = f2bf(v * scale); }
};
struct G_res {
    static constexpr bool DUAL = false; const bf16_t* A; const float* W; float* XS; const float* mods; int N, K, lda, chunk;
    __device__ int rows(int) const { return NTOK; }
    __device__ float a(int, int m, int k) const { return bf2f(A[(size_t)m * lda + k]); }
    __device__ float w(int, int k, int n) const { return W[(size_t)k * N + n]; }
    __device__ float w2(int, int, int) const { return 0.f; }
    __device__ void epi(int, int m, int n, float v, float) const { XS[(size_t)m * D + n] += mods[(size_t)mod_row(m) * 6 * D + chunk * D + n] * v; }
};
struct G_swiglu {
    static constexpr bool DUAL = true; const bf16_t* A; const float *Wg, *Wu; bf16_t* ACT; int N, K;
    __device__ int rows(int) const { return NTOK; }
    __device__ float a(int, int m, int k) const { return bf2f(A[(size_t)m * D + k]); }
    __device__ float w(int, int k, int n) const { return Wg[(size_t)k * N + n]; }
    __device__ float w2(int, int k, int n) const { return Wu[(size_t)k * N + n]; }
    __device__ void epi(int, int m, int n, float v, float v2) const { ACT[(size_t)m * N + n] = f2bf(silu_f(v) * v2); }
};
struct G_dq {
    static constexpr bool DUAL = false; const bf16_t* H; const float* W; float* CQ; int N, K;
    __device__ int rows(int) const { return NTOK; }
    __device__ float a(int, int m, int k) const { return bf2f(H[(size_t)m * D + k]); }
    __device__ float w(int, int k, int n) const { return W[(size_t)k * QLORA + n]; }
    __device__ float w2(int, int, int) const { return 0.f; }
    __device__ void epi(int, int m, int n, float v, float) const { CQ[(size_t)m * 512 + n] = v; }
};
struct G_dkv {
    static constexpr bool DUAL = true; const bf16_t* H; const float* W; float* CKV; bf16_t* KR; const float2* tab; int N, K;
    __device__ int rows(int) const { return NTOK; }
    __device__ float a(int, int m, int k) const { return bf2f(H[(size_t)m * D + k]); }
    __device__ float w(int, int k, int n) const { return W[(size_t)k * 576 + n]; }
    __device__ float w2(int, int k, int n) const { if (n < 512) return 0.f; return W[(size_t)k * 576 + 512 + rope_partner<32>(n - 512)]; }
    __device__ void epi(int, int m, int n, float v, float vp) const {
        if (n < 512) { CKV[(size_t)m * 512 + n] = v; return; }
        const int j = m % TPB; float o = v; if (j >= CTX) o = rope_apply<32>(tab, j - CTX, n - 512, v, vp);
        KR[(size_t)m * 64 + n - 512] = f2bf(o);
    }
};
struct G_uq {
    static constexpr bool DUAL = true; const bf16_t* A; const float* W; bf16_t* QM; const float2* tab; int N, K;
    __device__ int rows(int) const { return NTOK; }
    __device__ float a(int, int m, int k) const { return bf2f(A[(size_t)m * 512 + k]); }
    __device__ float w(int, int k, int n) const { return W[(size_t)k * 3072 + n]; }
    __device__ float w2(int, int k, int n) const { const int d = n % 192; if (d < 128) return 0.f; return W[(size_t)k * 3072 + (n - d) + 128 + rope_partner<32>(d - 128)]; }
    __device__ void epi(int, int m, int n, float v, float vp) const {
        const int d = n % 192, j = m % TPB; float o = v; if (d >= 128 && j >= CTX) o = rope_apply<32>(tab, j - CTX, d - 128, v, vp);
        QM[(size_t)m * 3072 + n] = f2bf(o);
    }
};
struct G_ukv {
    static constexpr bool DUAL = false; const bf16_t* A; const float* W; bf16_t* KVM; int N, K;
    __device__ int rows(int) const { return NTOK; }
    __device__ float a(int, int m, int k) const { return bf2f(A[(size_t)m * 512 + k]); }
    __device__ float w(int, int k, int n) const { return W[(size_t)k * 4096 + n]; }
    __device__ float w2(int, int, int) const { return 0.f; }
    __device__ void epi(int, int m, int n, float v, float) const { KVM[(size_t)m * 4096 + n] = f2bf(v); }
};
struct G_moe1 {
    static constexpr bool DUAL = true; const unsigned char* AS; const float *Wg, *Wu; bf16_t* ACT2; const int *CNT, *OFFS; int N, K;
    __device__ int rows(int z) const { return CNT[z]; }
    __device__ float a(int z, int m, int k) const { return __builtin_amdgcn_cvt_f32_fp8((int)AS[(size_t)(OFFS[z] + m) * D + k], 0); }
    __device__ float w(int z, int k, int n) const { return Wg[((size_t)z * D + k) * FFE + n]; }
    __device__ float w2(int z, int k, int n) const { return Wu[((size_t)z * D + k) * FFE + n]; }
    __device__ void epi(int z, int m, int n, float v, float v2) const { ACT2[(size_t)(OFFS[z] + m) * FFE + n] = f2bf(silu_f(v) * v2); }
};
struct G_moe2 {
    static constexpr bool DUAL = false; const unsigned char* ACT2; const float* Wd; float* Y; const int *CNT, *OFFS; int N, K;
    __device__ int rows(int z) const { return CNT[z]; }
    __device__ float a(int z, int m, int k) const { return __builtin_amdgcn_cvt_f32_fp8((int)ACT2[(size_t)(OFFS[z] + m) * FFE + k], 0) * (1.0f / A8_ACT); }
    __device__ float w(int z, int k, int n) const { return Wd[((size_t)z * FFE + k) * D + n]; }
    __device__ float w2(int, int, int) const { return 0.f; }
    __device__ void epi(int z, int m, int n, float v, float) const { Y[(size_t)(OFFS[z] + m) * D + n] = v; }
};

template <int DQK, int DV, class F> __global__ __launch_bounds__(256) void nattn(F f, int nkeys, float scale) {
    extern __shared__ float sm[];
    float* qs = sm;
    float* Pm = sm + 4 * DQK;
    __shared__ float rsum[4];
    const int z = blockIdx.y, q0 = blockIdx.x * 4, tid = threadIdx.x, lane = tid & 63, wave = tid >> 6;
    for (int i = tid; i < 4 * DQK; i += 256) { const int r = i / DQK, d = i % DQK; qs[i] = bf2f(f.qptr(z, q0 + r)[d]); }
    __syncthreads();
    for (int kk = tid; kk < nkeys; kk += 256) {
        float s0 = 0.f, s1 = 0.f, s2 = 0.f, s3 = 0.f;
        const bf16_t* kp = f.kptr(z, kk);
        for (int d = 0; d < 128; ++d) { const float kv = bf2f(kp[d]); s0 += qs[d] * kv; s1 += qs[DQK + d] * kv; s2 += qs[2 * DQK + d] * kv; s3 += qs[3 * DQK + d] * kv; }
        if (DQK > 128) { const bf16_t* k2 = f.k2ptr(z, kk);
            for (int d = 128; d < DQK; ++d) { const float kv = bf2f(k2[d - 128]); s0 += qs[d] * kv; s1 += qs[DQK + d] * kv; s2 += qs[2 * DQK + d] * kv; s3 += qs[3 * DQK + d] * kv; } }
        Pm[kk] = s0 * scale; Pm[nkeys + kk] = s1 * scale; Pm[2 * nkeys + kk] = s2 * scale; Pm[3 * nkeys + kk] = s3 * scale;
    }
    __syncthreads();
    {
        float* pr = Pm + wave * nkeys; float mx = -3.0e38f;
        for (int kk = lane; kk < nkeys; kk += 64) mx = fmaxf(mx, pr[kk]);
        mx = wave_max(mx); float s = 0.f;
        for (int kk = lane; kk < nkeys; kk += 64) { const float e = expf(pr[kk] - mx); pr[kk] = e; s += e; }
        s = wave_sum(s); if (lane == 0) rsum[wave] = s;
    }
    __syncthreads();
    for (int idx = tid; idx < 4 * DV; idx += 256) {
        const int r = idx / DV, e = idx % DV; const float* pr = Pm + r * nkeys; float acc = 0.f;
        for (int kk = 0; kk < nkeys; ++kk) acc += pr[kk] * bf2f(f.vptr(z, kk)[e]);
        f.store(z, q0 + r, e, acc / rsum[r]);
    }
}
struct A_diff {
    const bf16_t *Q, *K, *V; float* OD; int joff, pad;
    __device__ const bf16_t* qptr(int z, int qi) const { const int b = z >> 3, h = (z >> 1) & 3, c = z & 1; return Q + (size_t)(b * TPB + joff + qi) * 1024 + h * 256 + c * 128; }
    __device__ const bf16_t* kptr(int z, int kk) const { const int b = z >> 3, h = (z >> 1) & 3, c = z & 1; return K + (size_t)(b * TPB + kk) * 1024 + h * 256 + c * 128; }
    __device__ const bf16_t* k2ptr(int, int) const { return nullptr; }
    __device__ const bf16_t* vptr(int z, int kk) const { const int b = z >> 3, h = (z >> 1) & 3; return V + (size_t)(b * TPB + kk) * 1024 + h * 256; }
    __device__ void store(int z, int qi, int e, float v) const { const int b = z >> 3, h = (z >> 1) & 3, c = z & 1; OD[(((size_t)(b * TPB + joff + qi) * 4 + h) * 2 + c) * 256 + e] = v; }
};
struct A_mla {
    const bf16_t *QM, *KVM, *KR; bf16_t* OM;
    __device__ const bf16_t* qptr(int z, int qi) const { const int b = z >> 4, h = z & 15; return QM + (size_t)(b * TPB + CTX + qi) * 3072 + h * 192; }
    __device__ const bf16_t* kptr(int z, int kk) const { const int b = z >> 4, h = z & 15; return KVM + (size_t)(b * TPB + kk) * 4096 + h * 256; }
    __device__ const bf16_t* k2ptr(int z, int kk) const { const int b = z >> 4; return KR + (size_t)(b * TPB + kk) * 64; }
    __device__ const bf16_t* vptr(int z, int kk) const { const int b = z >> 4, h = z & 15; return KVM + (size_t)(b * TPB + kk) * 4096 + h * 256 + 128; }
    __device__ void store(int z, int qi, int e, float v) const { const int b = z >> 4, h = z & 15; OM[(size_t)(b * TPB + CTX + qi) * 2048 + h * 128 + e] = f2bf(v); }
};

#endif

#if ORACLE
__global__ __launch_bounds__(256) void k_cmp(const void* a, int a_bf  , const void* b, int b_bf, int rows, int cols, int lda, int ldb, int mask, const int* slottok, double* err) {
    double num = 0.0, den = 0.0;
    for (size_t i = (size_t)blockIdx.x * 256 + threadIdx.x; i < (size_t)rows * cols; i += (size_t)gridDim.x * 256) {
        const int r = (int)(i / cols), c = (int)(i % cols);
        if (mask == 1 && (r % TPB) < CTX) continue;
        if (mask == 2 && slottok[r] < 0) continue;
        const float va = a_bf == 2 ? __builtin_amdgcn_cvt_f32_fp8((int)((const unsigned char*)a)[(size_t)r * lda + c], 0) * (1.0f / A8_ACT) : a_bf ? bf2f(((const bf16_t*)a)[(size_t)r * lda + c]) : ((const float*)a)[(size_t)r * lda + c];
        const float vb = b_bf ? bf2f(((const bf16_t*)b)[(size_t)r * ldb + c]) : ((const float*)b)[(size_t)r * ldb + c];
        const double d = (double)va - (double)vb; num += d * d; den += (double)vb * (double)vb;
    }
    for (int o = 32; o >= 1; o >>= 1) { num += __shfl_xor(num, o); den += __shfl_xor(den, o); }
    if ((threadIdx.x & 63) == 0) { atomicAdd(err, num); atomicAdd(err + 1, den); }
}
__global__ __launch_bounds__(256) void k_verdict(float* out, size_t n, const double* err, int nslots, double tol) {
    int bad = -1;
    for (int s = 0; s < nslots; ++s) { const double num = err[2 * s], den = err[2 * s + 1]; const double t = s >= 16 ? 0.02 : tol; if (!(num <= t * den) || !(den > 0.0)) { bad = s; break; } }
    if (bad < 0) return;
    const float f = 1.0f + exp2f((float)(bad + 1));
    for (size_t i = (size_t)blockIdx.x * 256 + threadIdx.x; i < n; i += (size_t)gridDim.x * 256) out[i] *= f;
}
static_assert(sizeof(G_in) == 64 && sizeof(G_dftA) == 24 && sizeof(G_dftB) == 40 && sizeof(G_res) == 48 && sizeof(G_swiglu) == 40 && sizeof(G_dq) == 32 && sizeof(G_dkv) == 48 && sizeof(G_uq) == 40 && sizeof(G_ukv) == 32 && sizeof(G_moe1) == 56 && sizeof(G_moe2) == 48 && sizeof(A_diff) == 40 && sizeof(A_mla) == 32, "no padding bytes in by-value kernel arguments");
template <class G> static void run_gemm(const G& g, int Mmax, int Z, hipStream_t s) { hipLaunchKernelGGL(ngemm<G>, dim3((g.N + 127) / 128, (Mmax + 127) / 128, Z), dim3(256), 0, s, g); }
#endif
static_assert(sizeof(P) == 29 * 8, "P has no padding");

extern "C" void kernel_launch(void* const* d_in, const int* in_sizes, int n_in, void* d_out, int out_size, void* d_ws, size_t ws_size, hipStream_t stream) {
    static int grid = 0;
    if (grid == 0) {
        const size_t need = ORACLE ? (WS_SCR + (size_t)NSLOT * FFE * 2 > WS_SCR_XS + (size_t)NTOK * D * 4 ? WS_SCR + (size_t)NSLOT * FFE * 2 : WS_SCR_XS + (size_t)NTOK * D * 4) + 4096 : WS_END;
        if (n_in != 27 || ws_size < need) { fprintf(stderr, "kernel_launch: n_in %d ws %zu need %zu\n", n_in, ws_size, need); grid = -1; return; }
        int dev = 0, cus = 0, per_cu = 0;
        if (hipGetDevice(&dev) != hipSuccess || hipDeviceGetAttribute(&cus, hipDeviceAttributeMultiprocessorCount, dev) != hipSuccess) { grid = -1; return; }
        if (hipFuncSetAttribute((const void*)mega, hipFuncAttributeMaxDynamicSharedMemorySize, LDS_BYTES) != hipSuccess) { fprintf(stderr, "kernel_launch: hipFuncSetAttribute failed\n"); grid = -1; return; }
        if (hipOccupancyMaxActiveBlocksPerMultiprocessor(&per_cu, (const void*)mega, 512, LDS_BYTES) != hipSuccess || per_cu < 1) { fprintf(stderr, "kernel_launch: occupancy query says %d\n", per_cu); }
        (void)hipGetLastError();
        grid = cus;
    }
    if (grid < 0) return;
    (void)hipMemsetAsync((char*)d_ws + WS_CTL, 0, 1u << 20, stream);
    P p{};
    const float** pi = (const float**)&p;
    for (int i = 0; i < 27; ++i) pi[i] = (const float*)d_in[i];
    p.out = (float*)d_out; p.ws = (unsigned char*)d_ws;
#if !ORACLE
    hipLaunchKernelGGL(mega, dim3(grid), dim3(512), LDS_BYTES, stream, p, 0, NPH, 0);
#else
    double* ERR = (double*)(p.ws + WS_CTL + (size_t)CW_ERR * 4);
    unsigned char* SCR = p.ws + WS_SCR;
    const int* SLOTTOK = (const int*)(p.ws + WS_ROUTE + RT_SLOTTOK);
    auto PH = [&](int k) { hipLaunchKernelGGL(mega, dim3(grid), dim3(512), LDS_BYTES, stream, p, k, k + 1, k); };
    auto CMP = [&](int slot, const void* a, int abf, const void* b, int bbf, int rows, int cols, int lda, int ldb, int mask) {
        hipLaunchKernelGGL(k_cmp, dim3(2048), dim3(256), 0, stream, a, abf, b, bbf, rows, cols, lda, ldb, mask, SLOTTOK, ERR + 2 * slot); };
    const size_t SZ1K = (size_t)NTOK * 1024 * 2, SZXS = (size_t)NTOK * D * 4;
    PH(0); PH(1);
    PH(2);
    { bf16_t *Fo = (bf16_t*)SCR, *Qo = (bf16_t*)(SCR + SZ1K), *Ko = (bf16_t*)(SCR + 2 * SZ1K), *Vo = (bf16_t*)(SCR + 3 * SZ1K);
      G_in g{WSP(bf16_t, WS_H), p.ev_w_in, Fo, Qo, Ko, Vo, WSP(float2, WS_TABD), EIN, D}; run_gemm(g, NTOK, 1, stream);
      CMP(0, WSP(bf16_t, A0_F), 1, Fo, 1, NTOK, 1024, 1024, 1024, 0); CMP(1, WSP(bf16_t, A0_Q), 1, Qo, 1, NTOK, 1024, 1024, 1024, 0);
      CMP(2, WSP(bf16_t, A0_K), 1, Ko, 1, NTOK, 1024, 1024, 1024, 0); CMP(3, WSP(bf16_t, A0_V), 1, Vo, 1, NTOK, 1024, 1024, 1024, 0); }
    PH(3); PH(4);
    { float* T32 = (float*)SCR; bf16_t* MIXo = (bf16_t*)(SCR + (size_t)NTOK * 4 * 512 * 4);
      G_dftA g{WSP(bf16_t, A0_F), T32, 512, 256}; run_gemm(g, NTOK * 4, 1, stream);
      G_dftB g1{T32, MIXo, 256, 2 * SEQ, SEQ, CTX, 1.0f / sqrtf((float)SEQ * 256.f), 0}; run_gemm(g1, SEQ, 16, stream);
      G_dftB g2{T32, MIXo, 256, 2 * CTX, CTX, 0, 1.0f / sqrtf((float)CTX * 256.f), 0}; run_gemm(g2, CTX, 16, stream);
      CMP(4, WSP(bf16_t, A0_MIX), 1, MIXo, 1, NTOK, 1024, 2048, 2048, 0);
      float* ODo = (float*)SCR;
      A_diff f{WSP(bf16_t, A0_Q), WSP(bf16_t, A0_K), WSP(bf16_t, A0_V), ODo, CTX, 0};
      hipLaunchKernelGGL((nattn<128, 256, A_diff>), dim3(SEQ / 4, 32), dim3(256), (4 * 128 + 4 * TPB) * 4, stream, f, TPB, 0.08838834764831845f);
      A_diff f2{WSP(bf16_t, A0_Q), WSP(bf16_t, A0_K), WSP(bf16_t, A0_V), ODo, 0, 0};
      hipLaunchKernelGGL((nattn<128, 256, A_diff>), dim3(CTX / 4, 32), dim3(256), (4 * 128 + 4 * CTX) * 4, stream, f2, CTX, 0.08838834764831845f);
      CMP(5, WSP(float, A0_OD), 0, ODo, 0, NTOK, 2048, 2048, 2048, 0); }
    PH(5);
    { float* XSo = (float*)(p.ws + WS_SCR_XS); (void)hipMemcpyAsync(XSo, WSP(float, WS_XS), SZXS, hipMemcpyDeviceToDevice, stream);
      G_res g{WSP(bf16_t, A0_MIX), p.ev_w_out, XSo, WSP(float, WS_MODS), D, 2048, 2048, 2}; run_gemm(g, NTOK, 1, stream);
      PH(6); CMP(6, WSP(float, WS_XS), 0, XSo, 0, NTOK, D, D, D, 0); }
    PH(7);
    PH(8);
    { bf16_t* ACTo = (bf16_t*)SCR; G_swiglu g{WSP(bf16_t, WS_H), p.ffn_w_gate, p.ffn_w_up, ACTo, FFD, D}; run_gemm(g, NTOK, 1, stream);
      CMP(7, WSP(bf16_t, A0_ACT), 1, ACTo, 1, NTOK, FFD, FFD, FFD, 0); }
    { float* XSo = (float*)(p.ws + WS_SCR_XS); (void)hipMemcpyAsync(XSo, WSP(float, WS_XS), SZXS, hipMemcpyDeviceToDevice, stream);
      G_res g{WSP(bf16_t, A0_ACT), p.ffn_w_down, XSo, WSP(float, WS_MODS), D, FFD, FFD, 5}; run_gemm(g, NTOK, 1, stream);
      PH(9); CMP(8, WSP(float, WS_XS), 0, XSo, 0, NTOK, D, D, D, 0); }
    PH(10);
    PH(11);
    { float* CQo = (float*)SCR; float* CKVo = (float*)(SCR + (size_t)NTOK * 512 * 4); bf16_t* KRo = (bf16_t*)(SCR + (size_t)NTOK * 512 * 8);
      G_dq g{WSP(bf16_t, WS_H), p.od_w_dq, CQo, QLORA, D}; run_gemm(g, NTOK, 1, stream);
      G_dkv g2{WSP(bf16_t, WS_H), p.od_w_dkv, CKVo, KRo, WSP(float2, WS_TABM), 576, D}; run_gemm(g2, NTOK, 1, stream);
      CMP(9, WSP(float, A1_CQ), 0, CQo, 0, NTOK, 512, 512, 512, 0); CMP(10, WSP(float, A1_CKV), 0, CKVo, 0, NTOK, 512, 512, 512, 0); CMP(11, WSP(bf16_t, A1_KR), 1, KRo, 1, NTOK, 64, 64, 64, 0); }
    PH(12);
    PH(13);
    { bf16_t* QMo = (bf16_t*)SCR; bf16_t* KVMo = (bf16_t*)(SCR + (size_t)NTOK * 3072 * 2);
      G_uq g{WSP(bf16_t, A1_CQN), p.od_w_uq, QMo, WSP(float2, WS_TABM), 3072, 512}; run_gemm(g, NTOK, 1, stream);
      G_ukv g2{WSP(bf16_t, A1_CKVN), p.od_w_ukv, KVMo, 4096, 512}; run_gemm(g2, NTOK, 1, stream);
      CMP(12, WSP(bf16_t, A1_QM), 1, QMo, 1, NTOK, 3072, 3072, 3072, 1); CMP(13, WSP(bf16_t, A1_KVM), 1, KVMo, 1, NTOK, 4096, 4096, 4096, 0); }
    PH(14);
    { bf16_t* OMo = (bf16_t*)SCR; A_mla f{WSP(bf16_t, A1_QM), WSP(bf16_t, A1_KVM), WSP(bf16_t, A1_KR), OMo};
      hipLaunchKernelGGL((nattn<192, 128, A_mla>), dim3(SEQ / 4, 64), dim3(256), (4 * 192 + 4 * TPB) * 4, stream, f, TPB, 0.07216878364870323f);
      CMP(14, WSP(bf16_t, A1_OM), 1, OMo, 1, NTOK, 2048, 2048, 2048, 1); }
    { float* XSo = (float*)(p.ws + WS_SCR_XS); (void)hipMemcpyAsync(XSo, WSP(float, WS_XS), SZXS, hipMemcpyDeviceToDevice, stream);
      G_res g{WSP(bf16_t, A1_OM), p.od_w_o, XSo, WSP(float, WS_MODS) + 5 * 6 * D, D, 2048, 2048, 2}; run_gemm(g, NTOK, 1, stream);
      PH(15); CMP(15, WSP(float, WS_XS), 0, XSo, 0, NTOK, D, D, D, 1); }
    PH(16); PH(17); PH(18);
    PH(19);
    { bf16_t* ACT2o = (bf16_t*)SCR; G_moe1 g{WSP(unsigned char, A1_AS), p.moe_w_gate, p.moe_w_up, ACT2o, (const int*)(p.ws + WS_ROUTE + RT_CNT), (const int*)(p.ws + WS_ROUTE + RT_OFFS), FFE, D}; run_gemm(g, NB * SEQ, 8, stream);
      CMP(16, WSP(unsigned char, A1_ACT2), 2, ACT2o, 1, NSLOT, FFE, FFE, FFE, 2); }
    PH(20);
    { float* Yo = (float*)SCR; G_moe2 g{WSP(unsigned char, A1_ACT2), p.moe_w_down, Yo, (const int*)(p.ws + WS_ROUTE + RT_CNT), (const int*)(p.ws + WS_ROUTE + RT_OFFS), D, FFE}; run_gemm(g, NB * SEQ, 8, stream);
      CMP(17, WSP(float, A1_Y), 0, Yo, 0, NSLOT, D, D, D, 2); }
    PH(21);
    hipLaunchKernelGGL(k_verdict, dim3(2048), dim3(256), 0, stream, p.out, (size_t)NB * SEQ * D, (const double*)ERR, 18, 2.0e-4);
#endif
}
```

```cpp
#ifndef ORACLE
#define ORACLE 0
#endif
#include <hip/hip_runtime.h>
#include <cstdio>
#include <cstdint>

constexpr int D = 2048, NB = 4, SEQ = 2048, CTX = 256, TPB = SEQ + CTX  , NTOK = NB * TPB  ;
constexpr int FW = 1024, QKW = 1024, VW = 1024, EIN = 4096, FFD = 5632, NEXP = 8, FFE = 7168;
constexpr int QLORA = 512, KVLORA = 512, MROPE = 64, MH = 16;
constexpr int NSLOT = 2 * NB * SEQ + NEXP * 256;
constexpr float EPS = 1e-6f;

typedef unsigned short bf16_t;
typedef float f32x4 __attribute__((ext_vector_type(4)));
typedef short bf16x8 __attribute__((ext_vector_type(8)));

__device__ __forceinline__ float bf2f(bf16_t v) { return __uint_as_float(((unsigned)v) << 16); }
__device__ __forceinline__ bf16_t f2bf(float f) { unsigned u = __float_as_uint(f); u += 0x7fffu + ((u >> 16) & 1u); return (bf16_t)(u >> 16); }
__device__ __forceinline__ float wave_sum(float v) {
#pragma unroll
    for (int o = 1; o < 64; o <<= 1) v += __shfl_xor(v, o);
    return v;
}
__device__ __forceinline__ float wave_max(float v) {
#pragma unroll
    for (int o = 1; o < 64; o <<= 1) v = fmaxf(v, __shfl_xor(v, o));
    return v;
}
__device__ __forceinline__ int lane_id() { int l; asm volatile("v_mbcnt_lo_u32_b32 %0, -1, 0\n\tv_mbcnt_hi_u32_b32 %0, -1, %0" : "=v"(l)); return l; }
__device__ __forceinline__ int tid_from(int wv) { asm volatile("" : "+s"(wv)); return wv * 64 + lane_id(); }
#define TID_FROM(wv) tid_from(wv)
constexpr float W8_GU = 32.f, W8_DN = 64.f, A8_ACT = 4.f;
__device__ __forceinline__ unsigned pack4_fp8(float a, float b, float c, float d) {
    a = fminf(fmaxf(a, -448.f), 448.f); b = fminf(fmaxf(b, -448.f), 448.f); c = fminf(fmaxf(c, -448.f), 448.f); d = fminf(fmaxf(d, -448.f), 448.f);
    int w = 0; w = __builtin_amdgcn_cvt_pk_fp8_f32(a, b, w, false); w = __builtin_amdgcn_cvt_pk_fp8_f32(c, d, w, true); return (unsigned)w;
}
__device__ __forceinline__ float silu_f(float x) { return x / (1.f + expf(-x)); }

constexpr size_t al(size_t x) { return (x + 4095) / 4096 * 4096; }
constexpr size_t WS_CTL = 0;
constexpr size_t WS_XS = 1u << 20;
constexpr size_t WS_MODS = WS_XS + al((size_t)NTOK * D * 4);
constexpr size_t WS_TABD = WS_MODS + al((size_t)2 * 5 * 6 * D * 4);
constexpr size_t WS_TABM = WS_TABD + al(64 * 32 * 8);
constexpr size_t WS_SCAL = WS_TABM + al(64 * 16 * 8);
constexpr size_t WS_H = WS_SCAL + 4096;
constexpr size_t WS_ROUTE = WS_H + al((size_t)NTOK * D * 2);
constexpr size_t RT_TE = 0, RT_TG = (size_t)NTOK * 8, RT_TSLOT = (size_t)NTOK * 16, RT_SLOTTOK = (size_t)NTOK * 24, RT_CNT = RT_SLOTTOK + (size_t)NSLOT * 4, RT_OFFS = RT_CNT + 64;
constexpr size_t WT_IN = WS_ROUTE + al(RT_OFFS + 64);
constexpr size_t WT_OUT = WT_IN + al((size_t)4096 * 2048 * 2);
constexpr size_t WT_GU = WT_OUT + al((size_t)2048 * 2048 * 2);
constexpr size_t WT_DN = WT_GU + al((size_t)2 * FFD * 2048 * 2);
constexpr size_t WT_DQKV = WT_DN + al((size_t)2048 * FFD * 2);
constexpr size_t WT_UQ = WT_DQKV + al((size_t)1280 * 2048 * 2);
constexpr size_t WT_UKV = WT_UQ + al((size_t)3072 * 512 * 2);
constexpr size_t WT_O = WT_UKV + al((size_t)4096 * 512 * 2);
constexpr size_t WT_MGU = WT_O + al((size_t)2048 * 2048 * 2);
constexpr size_t WT_MD = WT_MGU + al((size_t)8 * 2 * FFE * 2048);
constexpr size_t WS_WCS = WT_MD + al((size_t)8 * 2048 * FFE);
constexpr size_t WS_DFTN = WS_WCS + al(512 * 256 * 2);
constexpr size_t WS_DFTC = WS_DFTN + al((size_t)2048 * 4096 * 2);
constexpr size_t WS_ACTS = WS_DFTC + al(256 * 512 * 2);
constexpr size_t A0_F = WS_ACTS;
constexpr size_t A0_Q = A0_F + al((size_t)NTOK * 1024 * 2);
constexpr size_t A0_K = A0_Q + al((size_t)NTOK * 1024 * 2);
constexpr size_t A0_V = A0_K + al((size_t)NTOK * 1024 * 2);
constexpr size_t A0_VT = A0_V + al((size_t)NTOK * 1024 * 2);
constexpr size_t A0_VTC = A0_VT + al((size_t)16 * 256 * 4096 * 2);
constexpr size_t A0_OD = A0_VTC + al((size_t)16 * 256 * 512 * 2);
constexpr size_t A0_MIX = A0_OD + al((size_t)NTOK * 2048 * 4);
constexpr size_t A0_ACT = A0_MIX + al((size_t)NTOK * 2048 * 2);
constexpr size_t A0_END = A0_ACT + al((size_t)NTOK * FFD * 2);
constexpr size_t A1_CQ = WS_ACTS;
constexpr size_t A1_CKV = A1_CQ + al((size_t)NTOK * 512 * 4);
constexpr size_t A1_KR = A1_CKV + al((size_t)NTOK * 512 * 4);
constexpr size_t A1_CQN = A1_KR + al((size_t)NTOK * 64 * 2);
constexpr size_t A1_CKVN = A1_CQN + al((size_t)NTOK * 512 * 2);
constexpr size_t A1_QM = A1_CKVN + al((size_t)NTOK * 512 * 2);
constexpr size_t A1_KVM = A1_QM + al((size_t)NTOK * 3072 * 2);
constexpr size_t A1_OM = A1_KVM + al((size_t)NTOK * 4096 * 2);
constexpr size_t A1_AS = A1_OM + al((size_t)NTOK * 2048 * 2);
constexpr size_t A1_ACT2 = A1_AS + al((size_t)NSLOT * 2048);
constexpr size_t A1_Y = WS_ACTS;
constexpr size_t A1_END = A1_ACT2 + al((size_t)NSLOT * FFE);
static_assert(A1_Y + (size_t)NSLOT * 2048 * 4 <= A1_AS, "Y overlays only the dead MLA buffers");
constexpr size_t WS_ARENA_END = A0_END > A1_END ? A0_END : A1_END;
constexpr size_t WS_SLAB = WS_ARENA_END;
constexpr size_t SLAB_BYTES = (size_t)384 << 18;
constexpr size_t WS_END = WS_SLAB + SLAB_BYTES;
constexpr size_t WS_SCR = WS_SLAB;
constexpr size_t WS_SCR_XS = WS_END;

struct P {
    const float *x, *c, *ctx, *c_ctx, *ada_w, *ada_b, *norm1_g, *norm2_g, *ev_w_in, *ev_w_out, *ev_lambda, *ev_subln_g;
    const float *od_w_dq, *od_q_norm_g, *od_w_uq, *od_w_dkv, *od_kv_norm_g, *od_w_ukv, *od_w_o;
    const float *ffn_w_gate, *ffn_w_up, *ffn_w_down, *moe_router, *moe_w_gate, *moe_w_up, *moe_w_down, *final_norm_g;
    float* out; unsigned char* ws;
};
#define WSP(T, off) ((T*)(p.ws + (off)))

__device__ __forceinline__ int mod_row(int R) { const int b = R / TPB, j = R - b * TPB; return j < CTX ? 4 : b; }

__device__ __forceinline__ void ph_prologue(const P& p, int bid, int nb, float* lds_f, int wv) {
    int tid_ = TID_FROM(wv); asm volatile("" : "+v"(tid_)); const int tid = tid_, lane = tid & 63, wave = tid >> 6;
    float* XS = WSP(float, WS_XS);
    if (ORACLE) for (size_t i = (size_t)bid * 512 + tid; i < (size_t)NTOK * (D / 4); i += (size_t)nb * 512) {
        const int R = (int)(i / (D / 4)), c4 = (int)(i % (D / 4)); const int b = R / TPB, j = R - b * TPB;
        const float* src = j < CTX ? p.ctx + ((size_t)(b * CTX + j)) * D : p.x + ((size_t)(b * SEQ + (j - CTX))) * D;
        ((f32x4*)XS)[i] = ((const f32x4*)src)[c4];
    }
    if (bid == 0) {
        float2* TD = WSP(float2, WS_TABD); float2* TM = WSP(float2, WS_TABM);
        for (int i = tid; i < 64 * 32; i += 512) { const int pos = i / 32, fi = i % 32; const double inv = pow(10000.0, -(double)(2 * fi) / 64.0), a = (double)pos * inv; TD[i] = make_float2((float)cos(a), (float)sin(a)); }
        for (int i = tid; i < 64 * 16; i += 512) { const int pos = i / 16, fi = i % 16; const double inv = pow(10000.0, -(double)(2 * fi) / 32.0), a = (double)pos * inv; TM[i] = make_float2((float)cos(a), (float)sin(a)); }
        if (wave == 0) {
            float s01 = 0.f, s23 = 0.f;
            for (int i = lane; i < 128; i += 64) { s01 += p.ev_lambda[i] * p.ev_lambda[128 + i]; s23 += p.ev_lambda[256 + i] * p.ev_lambda[384 + i]; }
            s01 = wave_sum(s01); s23 = wave_sum(s23);
            if (lane == 0) WSP(float, WS_SCAL)[0] = expf(s01) - expf(s23) + 0.2f;
        }
    }
    float* S = lds_f;
    float* RED = lds_f + 5 * 2048;
    for (int i = tid; i < 5 * D; i += 512) { const int bb = i / D, k = i % D; const float v = bb < 4 ? p.c[bb * D + k] : p.c_ctx[k]; S[i] = silu_f(v); }
    __syncthreads();
    float* MODS = WSP(float, WS_MODS);
    for (int it = bid; it < 2 * 128; it += nb) {
        const int layer = it >> 7, cg = it & 127, ln = lane < 48 ? lane : 47, col = cg * 96 + ln * 2;
        const float* W = p.ada_w + (size_t)layer * D * 6 * D + col;
        float a0[5], a1[5];
#pragma unroll
        for (int bb = 0; bb < 5; ++bb) { a0[bb] = 0.f; a1[bb] = 0.f; }
        const int kb = wave * 256;
#pragma unroll 1
        for (int k0 = 0; k0 < 256; k0 += 16) {
            float2 w[16];
#pragma unroll
            for (int u = 0; u < 16; ++u) w[u] = *(const float2*)(W + (size_t)(kb + k0 + u) * 6 * D);
#pragma unroll
            for (int u = 0; u < 16; ++u) {
#pragma unroll
                for (int bb = 0; bb < 5; ++bb) { const float s = S[bb * D + kb + k0 + u]; a0[bb] += s * w[u].x; a1[bb] += s * w[u].y; } }
        }
        if (lane < 48) {
#pragma unroll
            for (int bb = 0; bb < 5; ++bb) { RED[(wave * 5 + bb) * 96 + lane * 2] = a0[bb]; RED[(wave * 5 + bb) * 96 + lane * 2 + 1] = a1[bb]; } }
        __syncthreads();
        for (int i = tid; i < 5 * 96; i += 512) { const int bb = i / 96, cc = i % 96; float s = 0.f;
#pragma unroll
            for (int w = 0; w < 8; ++w) s += RED[(w * 5 + bb) * 96 + cc];
            MODS[((size_t)layer * 5 + bb) * 6 * D + cg * 96 + cc] = s + p.ada_b[(size_t)layer * 6 * D + cg * 96 + cc]; }
        __syncthreads();
    }
}

__device__ __forceinline__ const float* in_row(const P& p, int R) { const int b = R / TPB, j = R - b * TPB; return j < CTX ? p.ctx + ((size_t)(b * CTX + j)) * D : p.x + ((size_t)(b * SEQ + (j - CTX))) * D; }
template <bool FROM_IN = false> __device__ __forceinline__ void ph_norm_mod(const P& p, const float* g, int layer, int csh, int csc, int bid, int nb, int wv) {
    int tid_ = TID_FROM(wv); asm volatile("" : "+v"(tid_)); const int tid = tid_, lane = tid & 63, wave = tid >> 6;
    const float* XS = WSP(float, WS_XS); const float* MODS = WSP(float, WS_MODS) + (size_t)layer * 5 * 6 * D; bf16_t* H = WSP(bf16_t, WS_H);
    for (int R = bid * 8 + wave; R < NTOK; R += nb * 8) {
        const f32x4* xr = (const f32x4*)(FROM_IN ? in_row(p, R) : XS + (size_t)R * D); f32x4 v[8]; float ss = 0.f;
#pragma unroll
        for (int j = 0; j < 8; ++j) { v[j] = xr[lane + 64 * j]; ss += v[j].x * v[j].x + v[j].y * v[j].y + v[j].z * v[j].z + v[j].w * v[j].w; }
        const float rstd = 1.0f / sqrtf(wave_sum(ss) * (1.f / D) + EPS);
        const float* mr = MODS + (size_t)mod_row(R) * 6 * D;
#pragma unroll
        for (int j = 0; j < 8; ++j) { const int c0 = (lane + 64 * j) * 4; const f32x4 gg = *(const f32x4*)(g + c0), sh = *(const f32x4*)(mr + csh * D + c0), sc = *(const f32x4*)(mr + csc * D + c0);
            const f32x4 o = (v[j] * rstd * gg) * (sc + 1.f) + sh;
            ushort4 w; w.x = f2bf(o.x); w.y = f2bf(o.y); w.z = f2bf(o.z); w.w = f2bf(o.w);
            *(ushort4*)(H + (size_t)R * D + c0) = w; }
    }
}

__device__ __forceinline__ void ph_subln(const P& p, int bid, int nb, int wv) {
    int tid_ = TID_FROM(wv); asm volatile("" : "+v"(tid_)); const int tid = tid_, lane = tid & 63, wave = tid >> 6;
    const float* OD = WSP(float, A0_OD); bf16_t* MIX = WSP(bf16_t, A0_MIX); const float lam = WSP(float, WS_SCAL)[0];
    const f32x4 gg = *(const f32x4*)(p.ev_subln_g + lane * 4);
    for (int it0 = bid * 8 + wave; it0 < NTOK * 4; it0 += nb * 8 * 4) {
        f32x4 o0[4], o1[4];
#pragma unroll
        for (int u = 0; u < 4; ++u) { const int it = it0 + u * nb * 8; if (it < NTOK * 4) { o0[u] = *(const f32x4*)(OD + ((size_t)it * 2 + 0) * 256 + lane * 4); o1[u] = *(const f32x4*)(OD + ((size_t)it * 2 + 1) * 256 + lane * 4); } else { o0[u] = o1[u] = (f32x4){0.f, 0.f, 0.f, 0.f}; } }
#pragma unroll
        for (int u = 0; u < 4; ++u) { const int it = it0 + u * nb * 8; const int R = it >> 2, h = it & 3;
            const f32x4 o = o0[u] - o1[u] * lam;
            const float rstd = 1.0f / sqrtf(wave_sum(o.x * o.x + o.y * o.y + o.z * o.z + o.w * o.w) * (1.f / 256.f) + EPS);
            const f32x4 r = o * rstd * gg * 0.8f;
            ushort4 w; w.x = f2bf(r.x); w.y = f2bf(r.y); w.z = f2bf(r.z); w.w = f2bf(r.w);
            if (it < NTOK * 4) *(ushort4*)(MIX + (size_t)R * 2048 + 1024 + h * 256 + lane * 4) = w; }
    }
}

__device__ __forceinline__ void ph_lora_norm(const P& p, int bid, int nb, int wv) {
    int tid_ = TID_FROM(wv); asm volatile("" : "+v"(tid_)); const int tid = tid_, lane = tid & 63, wave = tid >> 6;
    for (int it = bid * 8 + wave; it < NTOK * 2; it += nb * 8) {
        const int R = it >> 1, which = it & 1;
        const float* src = (which ? WSP(float, A1_CKV) : WSP(float, A1_CQ)) + (size_t)R * 512; const float* g = which ? p.od_kv_norm_g : p.od_q_norm_g;
        bf16_t* dst = (which ? WSP(bf16_t, A1_CKVN) : WSP(bf16_t, A1_CQN)) + (size_t)R * 512;
        f32x4 v[2]; float ss = 0.f;
#pragma unroll
        for (int j = 0; j < 2; ++j) { v[j] = *(const f32x4*)(src + (lane + 64 * j) * 4); ss += v[j].x * v[j].x + v[j].y * v[j].y + v[j].z * v[j].z + v[j].w * v[j].w; }
        const float rstd = 1.0f / sqrtf(wave_sum(ss) * (1.f / 512.f) + EPS);
#pragma unroll
        for (int j = 0; j < 2; ++j) { const int c0 = (lane + 64 * j) * 4; const f32x4 gg = *(const f32x4*)(g + c0); const f32x4 o = v[j] * rstd * gg;
            ushort4 w; w.x = f2bf(o.x); w.y = f2bf(o.y); w.z = f2bf(o.z); w.w = f2bf(o.w); *(ushort4*)(dst + c0) = w; }
    }
}

__device__ __forceinline__ void ph_route(const P& p, int bid, int nb, float* rt  , int wv) {
    int tid_ = TID_FROM(wv); asm volatile("" : "+v"(tid_)); const int tid = tid_, lane = tid & 63, wave = tid >> 6;
    const float* XS = WSP(float, WS_XS); const float* MODS = WSP(float, WS_MODS) + (size_t)1 * 5 * 6 * D; bf16_t* H = WSP(bf16_t, WS_H);
    const float* g = p.norm2_g + D; int* TE = (int*)(p.ws + WS_ROUTE + RT_TE); float* TG = (float*)(p.ws + WS_ROUTE + RT_TG);
    for (int i = tid; i < D * 2; i += 512) { const f32x4 v = ((const f32x4*)p.moe_router)[i]; const int k = i >> 1, e0 = (i & 1) * 4; rt[(e0 + 0) * D + k] = v.x; rt[(e0 + 1) * D + k] = v.y; rt[(e0 + 2) * D + k] = v.z; rt[(e0 + 3) * D + k] = v.w; }
    __syncthreads();
    for (int t0 = (bid * 8 + wave) * 4; t0 < NB * SEQ; t0 += nb * 8 * 4) {
        const int b = t0 / SEQ, R0 = b * TPB + CTX + (t0 - b * SEQ);
        const float* mr = MODS + (size_t)b * 6 * D;
        f32x4 am[8], bm[8];
#pragma unroll
        for (int j = 0; j < 8; ++j) { const int c0 = (lane + 64 * j) * 4; const f32x4 gg = *(const f32x4*)(g + c0), sc = *(const f32x4*)(mr + 4 * D + c0); am[j] = gg * (sc + 1.f); bm[j] = *(const f32x4*)(mr + 3 * D + c0); }
        f32x4 v[8], vn[8];
#pragma unroll
        for (int j = 0; j < 8; ++j) v[j] = ((const f32x4*)(XS + (size_t)R0 * D))[lane + 64 * j];
#pragma unroll
        for (int k = 0; k < 4; ++k) {
            const int R = R0 + k;
            if (k < 3) {
#pragma unroll
                for (int j = 0; j < 8; ++j) vn[j] = ((const f32x4*)(XS + (size_t)(R + 1) * D))[lane + 64 * j]; }
            float ss = 0.f;
#pragma unroll
            for (int j = 0; j < 8; ++j) ss += v[j].x * v[j].x + v[j].y * v[j].y + v[j].z * v[j].z + v[j].w * v[j].w;
            const float rstd = 1.0f / sqrtf(wave_sum(ss) * (1.f / D) + EPS);
            float lg[8];
#pragma unroll
            for (int e = 0; e < 8; ++e) lg[e] = 0.f;
#pragma unroll
            for (int j = 0; j < 8; ++j) { const int c0 = (lane + 64 * j) * 4;
                const f32x4 o = (v[j] * rstd) * am[j] + bm[j];
                *(unsigned*)((unsigned char*)H + (size_t)R * D + c0) = pack4_fp8(o.x, o.y, o.z, o.w);
#pragma unroll
                for (int e = 0; e < 8; ++e) { const f32x4 r4 = *(const f32x4*)(rt + e * D + c0); lg[e] += (o.x * r4.x + o.y * r4.y) + (o.z * r4.z + o.w * r4.w); }
                asm volatile("" ::: "memory"); }
#pragma unroll
            for (int e = 0; e < 8; ++e) lg[e] = wave_sum(lg[e]);
            if (lane == 0) {
                int e1 = 0; float v1 = lg[0];
#pragma unroll
                for (int e = 1; e < 8; ++e) if (lg[e] > v1) { v1 = lg[e]; e1 = e; }
                int e2 = -1; float v2 = -3.0e38f;
#pragma unroll
                for (int e = 0; e < 8; ++e) if (e != e1 && lg[e] > v2) { v2 = lg[e]; e2 = e; }
                const float ex = expf(v2 - v1), w1 = 1.f / (1.f + ex), w2 = ex / (1.f + ex);
                TE[R * 2] = e1; TE[R * 2 + 1] = e2; TG[R * 2] = w1; TG[R * 2 + 1] = w2;
            }
#pragma unroll
            for (int j = 0; j < 8; ++j) v[j] = vn[j];
        }
    }
}

__device__ __forceinline__ void ph_sort(const P& p, int bid, int* lds_i, int wv) {
    if (bid != 0) return;
    int tid_ = TID_FROM(wv); asm volatile("" : "+v"(tid_)); const int tid = tid_;
    const int* TE = (const int*)(p.ws + WS_ROUTE + RT_TE); int* TSLOT = (int*)(p.ws + WS_ROUTE + RT_TSLOT); int* SLOTTOK = (int*)(p.ws + WS_ROUTE + RT_SLOTTOK);
    int* CNT = (int*)(p.ws + WS_ROUTE + RT_CNT); int* OFFS = (int*)(p.ws + WS_ROUTE + RT_OFFS);
    int* cn = lds_i;
    int* offs = lds_i + 8 * 512;
    int* tot = offs + 16;
    int c0 = 0, c1 = 0, c2 = 0, c3 = 0, c4 = 0, c5 = 0, c6 = 0, c7 = 0;
    for (int i = 0; i < 16; ++i) { const int t = tid * 16 + i, b = t / SEQ, R = b * TPB + CTX + (t - b * SEQ);
        for (int k = 0; k < 2; ++k) { const int e = TE[R * 2 + k]; c0 += e == 0; c1 += e == 1; c2 += e == 2; c3 += e == 3; c4 += e == 4; c5 += e == 5; c6 += e == 6; c7 += e == 7; } }
    cn[0 * 512 + tid] = c0; cn[1 * 512 + tid] = c1; cn[2 * 512 + tid] = c2; cn[3 * 512 + tid] = c3; cn[4 * 512 + tid] = c4; cn[5 * 512 + tid] = c5; cn[6 * 512 + tid] = c6; cn[7 * 512 + tid] = c7;
    __syncthreads();
    {
        const int e = tid >> 6, ln = tid & 63; int v[8]; int run = 0;
#pragma unroll
        for (int j = 0; j < 8; ++j) { const int t = cn[e * 512 + ln * 8 + j]; v[j] = run; run += t; }
        int incl = run;
#pragma unroll
        for (int o = 1; o < 64; o <<= 1) { const int n = __shfl_up(incl, o); if (ln >= o) incl += n; }
        const int excl = incl - run;
#pragma unroll
        for (int j = 0; j < 8; ++j) cn[e * 512 + ln * 8 + j] = v[j] + excl;
        if (ln == 63) tot[e] = incl;
    }
    __syncthreads();
    if (tid == 0) { int o = 0; for (int e = 0; e < 8; ++e) { offs[e] = o; OFFS[e] = o; CNT[e] = tot[e]; o += (tot[e] + 255) / 256 * 256; } offs[8] = o; OFFS[8] = o; }
    __syncthreads();
    for (int i = tid; i < NSLOT; i += 512) SLOTTOK[i] = -1;
    __syncthreads();
    int r0 = cn[0 * 512 + tid] + offs[0], r1 = cn[1 * 512 + tid] + offs[1], r2 = cn[2 * 512 + tid] + offs[2], r3 = cn[3 * 512 + tid] + offs[3];
    int r4 = cn[4 * 512 + tid] + offs[4], r5 = cn[5 * 512 + tid] + offs[5], r6 = cn[6 * 512 + tid] + offs[6], r7 = cn[7 * 512 + tid] + offs[7];
    for (int i = 0; i < 16; ++i) { const int t = tid * 16 + i, b = t / SEQ, R = b * TPB + CTX + (t - b * SEQ);
        for (int k = 0; k < 2; ++k) { const int e = TE[R * 2 + k]; int s;
            s = e == 0 ? r0 : e == 1 ? r1 : e == 2 ? r2 : e == 3 ? r3 : e == 4 ? r4 : e == 5 ? r5 : e == 6 ? r6 : r7;
            r0 += e == 0; r1 += e == 1; r2 += e == 2; r3 += e == 3; r4 += e == 4; r5 += e == 5; r6 += e == 6; r7 += e == 7;
            TSLOT[R * 2 + k] = s; SLOTTOK[s] = R; } }
}

__device__ __forceinline__ void ph_gather(const P& p, int bid, int nb, int wv) {
    int tid_ = TID_FROM(wv); asm volatile("" : "+v"(tid_)); const int tid = tid_, lane = tid & 63, wave = tid >> 6;
    const int* SLOTTOK = (const int*)(p.ws + WS_ROUTE + RT_SLOTTOK); const int* OFFS = (const int*)(p.ws + WS_ROUTE + RT_OFFS);
    const unsigned char* H8 = WSP(unsigned char, WS_H); unsigned char* AS = WSP(unsigned char, A1_AS); const int total = OFFS[8];
    for (int s0 = bid * 8 + wave; s0 < total; s0 += nb * 8 * 4) {
        int Rr[4];
#pragma unroll
        for (int u = 0; u < 4; ++u) { const int s = s0 + u * nb * 8; Rr[u] = SLOTTOK[s < total ? s : total - 1]; }
        uint4 v[4][2];
#pragma unroll
        for (int u = 0; u < 4; ++u) { const uint4* src = (const uint4*)(H8 + (size_t)(Rr[u] > 0 ? Rr[u] : 0) * D);
#pragma unroll
            for (int j = 0; j < 2; ++j) v[u][j] = src[lane + 64 * j]; }
#pragma unroll
        for (int u = 0; u < 4; ++u) { const int s = s0 + u * nb * 8; const bool pad = Rr[u] < 0; uint4* dst = (uint4*)(AS + (size_t)(s < total ? s : total - 1) * D);
#pragma unroll
            for (int j = 0; j < 2; ++j) { uint4 w = v[u][j]; if (pad) w = make_uint4(0, 0, 0, 0); if (s < total) dst[lane + 64 * j] = w; } }
    }
}

__device__ __forceinline__ void ph_final(const P& p, int bid, int nb, int wv) {
    int tid_ = TID_FROM(wv); asm volatile("" : "+v"(tid_)); const int tid = tid_, lane = tid & 63, wave = tid >> 6;
    const float* XS = WSP(float, WS_XS); const float* MODS = WSP(float, WS_MODS) + (size_t)1 * 5 * 6 * D; const float* Y = WSP(float, A1_Y);
    const float* TG = (const float*)(p.ws + WS_ROUTE + RT_TG); const int* TSLOT = (const int*)(p.ws + WS_ROUTE + RT_TSLOT);
    for (int t = bid * 8 + wave; t < NB * SEQ; t += nb * 8) {
        const int b = t / SEQ, R = b * TPB + CTX + (t - b * SEQ);
        const float g1 = TG[R * 2], g2 = TG[R * 2 + 1]; const int s1 = TSLOT[R * 2], s2 = TSLOT[R * 2 + 1];
        const float* mr = MODS + (size_t)b * 6 * D + 5 * D;
        f32x4 v[8]; float ss = 0.f;
#pragma unroll
        for (int j = 0; j < 8; ++j) { const int c0 = (lane + 64 * j) * 4;
            const f32x4 xv = *(const f32x4*)(XS + (size_t)R * D + c0), y1 = *(const f32x4*)(Y + (size_t)s1 * D + c0), y2 = *(const f32x4*)(Y + (size_t)s2 * D + c0), m5 = *(const f32x4*)(mr + c0);
            v[j] = xv + m5 * (y1 * g1 + y2 * g2); ss += v[j].x * v[j].x + v[j].y * v[j].y + v[j].z * v[j].z + v[j].w * v[j].w; }
        const float rstd = 1.0f / sqrtf(wave_sum(ss) * (1.f / D) + EPS);
#pragma unroll
        for (int j = 0; j < 8; ++j) { const int c0 = (lane + 64 * j) * 4; const f32x4 gg = *(const f32x4*)(p.final_norm_g + c0); *(f32x4*)(p.out + (size_t)t * D + c0) = v[j] * rstd * gg; }
    }
}


#define LAS __attribute__((address_space(3)))
typedef unsigned u32x4 __attribute__((ext_vector_type(4)));
typedef unsigned u32x2 __attribute__((ext_vector_type(2)));
typedef int i32x4 __attribute__((ext_vector_type(4)));
__device__ __forceinline__ unsigned cvt_pk_bf16(float lo, float hi) { unsigned r; asm volatile("v_cvt_pk_bf16_f32 %0, %1, %2" : "=v"(r) : "v"(lo), "v"(hi)); return r; }
__device__ __forceinline__ void store4bf(bf16_t* dst, const f32x4& v) { u32x2 w; w.x = cvt_pk_bf16(v[0], v[1]); w.y = cvt_pk_bf16(v[2], v[3]); *(u32x2*)dst = w; }
typedef float f32x2 __attribute__((ext_vector_type(2)));
__device__ __forceinline__ f32x2 swiglu2(f32x2 g, f32x2 u, float c1, float kinv) {
    const f32x2 t = g * c1; f32x2 e; e.x = __builtin_amdgcn_exp2f(t.x); e.y = __builtin_amdgcn_exp2f(t.y);
    const f32x2 d = e * kinv + kinv; f32x2 r; r.x = __builtin_amdgcn_rcpf(d.x); r.y = __builtin_amdgcn_rcpf(d.y);
    return (g * u) * r;
}
__device__ __forceinline__ float fast_silu(float x) { return x * __builtin_amdgcn_rcpf(1.f + __builtin_amdgcn_exp2f(-1.4426950408889634f * x)); }

constexpr int NWAVES = 8, RING_BYTES = 131072, MISC_OFF = RING_BYTES + 320, LDS_BYTES = 147456;
constexpr int CW_QUEUE = 2048;
constexpr int CW_DONE = 132096;
constexpr int CW_FILL = 140288;
#ifndef FILL
#define FILL 1
#endif
constexpr int CW_BAR = 4096;
constexpr int CW_ERR = 131072;

#define XB_TMO      128
#define XB_XCNT(j)  (256  + 64 * (j))
#define XB_XSUB(j)  (1280 + 64 * (j))
#define XB_XGEN(j)  (2304 + 64 * (j))
#define XB_TOP      3328
#define XB_TOPGEN   3392
#define XCD_BAR_WORDS 3456
#define XB_SPIN_CAP (1u << 18)

__device__ __forceinline__ unsigned xb_ld(unsigned* p)              { return __hip_atomic_load(p, __ATOMIC_RELAXED, __HIP_MEMORY_SCOPE_AGENT); }
__device__ __forceinline__ unsigned xb_add(unsigned* p, unsigned v) { return __hip_atomic_fetch_add(p, v, __ATOMIC_RELAXED, __HIP_MEMORY_SCOPE_AGENT); }
__device__ __forceinline__ unsigned xb_xcc_id() { return (unsigned)__builtin_amdgcn_s_getreg((3 << 11) | 20) & 0xFu; }
#define XB_SPIN(cond, bar) do { unsigned _sp = 0; while (cond) { __builtin_amdgcn_s_sleep(1); \
    if ((++_sp & 255u) == 0u) { if (xb_ld(&(bar)[XB_TMO])) break; if (_sp > XB_SPIN_CAP) { atomicAdd(&(bar)[XB_TMO], 1u); break; } } } } while (0)

struct XcdBarrier {
    unsigned* bar; unsigned x;
    volatile LAS unsigned* st;
};
__device__ __forceinline__ XcdBarrier xcd_barrier_post(unsigned* bar, volatile LAS unsigned* st, int wv) {
    XcdBarrier b; b.bar = bar; b.x = xb_xcc_id(); b.st = st;
    if (wv == 0 && lane_id() == 0) (void)xb_add(&bar[XB_XCNT(b.x)], 1u);
    return b;
}
__device__ __forceinline__ void xcd_barrier_complete(unsigned* bar, unsigned x, unsigned& nloc, unsigned& nx) {
    const unsigned G = gridDim.x * gridDim.y * gridDim.z;
    unsigned sum, cnt, mine, sp = 0u;
    for (;;) {
        sum = 0u; cnt = 0u; mine = 0u;
#pragma unroll
        for (unsigned j = 0; j < 16; ++j) { const unsigned c = xb_ld(&bar[XB_XCNT(j)]); sum += c; cnt += (c > 0u) ? 1u : 0u; mine = (j == x) ? c : mine; }
        if (sum == G) break;
        __builtin_amdgcn_s_sleep(1);
        if ((++sp & 255u) == 0u) { if (xb_ld(&bar[XB_TMO])) break; if (sp > XB_SPIN_CAP) { atomicAdd(&bar[XB_TMO], 1u); break; } }
    }
    nloc = mine > 0u ? mine : 1u; nx = cnt > 0u ? cnt : 1u;
}
__device__ __forceinline__ void xcd_barrier(const XcdBarrier& b, int wv) {
    asm volatile("s_waitcnt vmcnt(0)" ::: "memory");
    __syncthreads();
    if (wv == 0 && lane_id() == 0) {
        unsigned* bar = b.bar;
        __builtin_amdgcn_s_waitcnt(0);
        unsigned nloc = b.st[0], nx = b.st[1];
        if (nloc == 0u) { xcd_barrier_complete(bar, b.x, nloc, nx); b.st[0] = nloc; b.st[1] = nx; }
        const unsigned old = xb_add(&bar[XB_XSUB(b.x)], 1u);
        const unsigned gen = old / nloc;
        if (old + 1u == (gen + 1u) * nloc) {
            __builtin_amdgcn_fence(__ATOMIC_RELEASE, "agent");
            asm volatile("s_waitcnt vmcnt(0)" ::: "memory");
            const unsigned og = xb_add(&bar[XB_TOP], 1u);
            const unsigned tg = og / nx;
            if (og + 1u == (tg + 1u) * nx) xb_add(&bar[XB_TOPGEN], 1u);
            else XB_SPIN(xb_ld(&bar[XB_TOPGEN]) == tg, bar);
            __builtin_amdgcn_fence(__ATOMIC_ACQUIRE, "agent");
            xb_add(&bar[XB_XGEN(b.x)], 1u);
            asm volatile("s_waitcnt vmcnt(0)" ::: "memory");
        } else {
            XB_SPIN(xb_ld(&bar[XB_XGEN(b.x)]) == gen, bar);
            __builtin_amdgcn_fence(__ATOMIC_ACQUIRE, "agent");
            asm volatile("s_waitcnt vmcnt(0)" ::: "memory");
        }
    }
    __syncthreads();
}

namespace pg8 {
#define PG8_LAS __attribute__((address_space(3)))
constexpr int BM = 256, BK = 64, HALF = 128, HTB = HALF * BK * 2  , STAGE_BYTES = 8 * HTB, NXCD = 8, WGM = 8;
__host__ __device__ __forceinline__ int lds_byte(int r, int c) { const int st = (r >> 4) * 2 + (c >> 5), rr = r & 15, cc = c & 31, ob = rr * 64 + cc * 2; return st * 1024 + (ob ^ (((ob >> 9) & 1) << 5)); }
__host__ __device__ __forceinline__ void stage_rc(int b, int& R, int& C) { const int st = b / 1024, sb = b % 1024, swz = sb ^ (((sb >> 9) & 1) << 5); R = (st >> 1) * 16 + swz / 64; C = (st & 1) * 32 + (swz % 64) / 2; }

struct Unit { const char* A; const char* B; int pm, pn, z, nt; int ti, ks, nks, pad; };
struct Dims { int lda, ldb; float* slabs; };

template <class F> struct Epi {
    F f;
    __device__ __forceinline__ void operator()(const f32x4 (&acc)[2][2][4][2], const Unit& u, int wr, int wc, int fr, int fq) const {
        asm volatile("" : "+v"(fr), "+v"(fq));
#pragma unroll
        for (int ai = 0; ai < 2; ++ai)
#pragma unroll
            for (int m = 0; m < 4; ++m) { const int rt = ai * HALF + wr * 64 + m * 16 + fr;
#pragma unroll
                for (int bj = 0; bj < 2; ++bj) f.put(u, rt, bj * HALF + wc * 32, fq, acc[ai][bj][m][0], acc[ai][bj][m][1]); }
    }
};

template <bool FP8 = false, class EpiT, class Sched>
__device__ __forceinline__ void gemm_phase(PG8_LAS unsigned char* lds, const Dims g, const Sched& S, const EpiT& E, int wv) {
    int tid_ = TID_FROM(wv); asm volatile("" : "+v"(tid_));
    const int tid = tid_, wid = __builtin_amdgcn_readfirstlane(tid >> 6), lane = tid & 63, wr = wid >> 2, wc = wid & 3, fr = lane & 15, fq = lane >> 4;
    unsigned voffA[2], voffB[2];
#pragma unroll
    for (int i = 0; i < 2; ++i) { int R, C; stage_rc(tid * 16 + i * 8192, R, C); voffA[i] = (unsigned)(R * g.lda + C) * 2u;
        voffB[i] = FP8 ? (unsigned)((R >> 5) * 32 * (g.ldb * 2) + (R & 31) * 128 + C * 2) : (unsigned)(R * g.ldb + C) * 2u; }
    const size_t kstep = (size_t)(BK * 2), kstepB = FP8 ? (size_t)4096 : kstep;
    const size_t hstepA = (size_t)HALF * g.lda * 2, hstepB = (size_t)HALF * g.ldb * 2;
    const unsigned ldsw = (unsigned)wid * 1024u;
    const int aoff = lds_byte(wr * 64 + fr, fq * 8), boff = lds_byte(wc * 32 + fr, fq * 8);
#define PG8_SA(b, h) (((b) * 2 + (h)) * HTB)
#define PG8_SB(b, h) ((4 + (b) * 2 + (h)) * HTB)
#define PG8_STAGE(bufoff, gbase, voff) do { const char* g_ = (const char*)(gbase); asm volatile("" : "+s"(g_));     \
        _Pragma("unroll") for (int _i = 0; _i < 2; ++_i) \
        __builtin_amdgcn_global_load_lds((const unsigned*)(g_ + (voff)[_i]), (PG8_LAS unsigned*)(lds + (bufoff) + ldsw + _i * 8192), 16, 0, 0); } while (0)
#define PG8_LDA(dst, b, h) do { _Pragma("unroll") for (int m = 0; m < 4; ++m) _Pragma("unroll") for (int k = 0; k < 2; ++k) dst[m][k] = *(const PG8_LAS bf16x8*)(lds + PG8_SA(b, h) + aoff + m * 2048 + k * 1024); } while (0)
#define PG8_LDB(dst, b, h) do { _Pragma("unroll") for (int n = 0; n < 2; ++n) _Pragma("unroll") for (int k = 0; k < 2; ++k) dst[n][k] = *(const PG8_LAS bf16x8*)(lds + PG8_SB(b, h) + boff + n * 2048 + k * 1024); } while (0)
#define PG8_CAT(lo, hi) __builtin_shufflevector(__builtin_bit_cast(i32x4, lo), __builtin_bit_cast(i32x4, hi), 0, 1, 2, 3, 4, 5, 6, 7)
#define PG8_MMA(ai, bj, At, Bt) do { __builtin_amdgcn_s_setprio(1); if constexpr (FP8) { _Pragma("unroll") for (int m = 0; m < 4; ++m) _Pragma("unroll") for (int n = 0; n < 2; ++n) \
        acc[ai][bj][m][n] = __builtin_amdgcn_mfma_scale_f32_16x16x128_f8f6f4(PG8_CAT(Bt[n][0], Bt[n][1]), PG8_CAT(At[m][0], At[m][1]), acc[ai][bj][m][n], 0, 0, 0, 0, 0, 0); }     \
        else { _Pragma("unroll") for (int m = 0; m < 4; ++m) _Pragma("unroll") for (int n = 0; n < 2; ++n) _Pragma("unroll") for (int k = 0; k < 2; ++k) \
        acc[ai][bj][m][n] = __builtin_amdgcn_mfma_f32_16x16x32_bf16(Bt[n][k], At[m][k], acc[ai][bj][m][n], 0, 0, 0); } __builtin_amdgcn_s_setprio(0); } while (0)
#define PG8_WAIT_V(n) asm volatile("s_waitcnt vmcnt(" #n ")" ::: "memory")
#define PG8_WAIT_L(n) asm volatile("s_waitcnt lgkmcnt(" #n ")" ::: "memory")
#define PG8_BAR __builtin_amdgcn_s_barrier()
#define PG8_SCHED __builtin_amdgcn_sched_barrier(0)
    Unit cur, nxt; int ui = 0;
    if (!S.next(0, cur)) return;
    f32x4 acc[2][2][4][2];
#pragma unroll
    for (int a = 0; a < 2; ++a)
#pragma unroll
        for (int b = 0; b < 2; ++b)
#pragma unroll
            for (int m = 0; m < 4; ++m)
#pragma unroll
                for (int n = 0; n < 2; ++n) acc[a][b][m][n] = (f32x4){0.f, 0.f, 0.f, 0.f};
    bf16x8 At[4][2], B0[2][2], B1[2][2];
    const char* cA = cur.A; const char* cB = cur.B;
    PG8_STAGE(PG8_SB(0, 0), cB, voffB); PG8_STAGE(PG8_SB(0, 1), cB + hstepB, voffB); PG8_STAGE(PG8_SA(0, 0), cA, voffA); PG8_STAGE(PG8_SA(0, 1), cA + hstepA, voffA);
    if (wr == 1) PG8_BAR;
    PG8_WAIT_V(2); PG8_BAR;
    PG8_STAGE(PG8_SB(1, 0), cB + kstepB, voffB); PG8_STAGE(PG8_SA(1, 0), cA + kstep, voffA); PG8_STAGE(PG8_SB(1, 1), cB + hstepB + kstepB, voffB);
    PG8_WAIT_V(6); PG8_BAR;
    for (;;) {
        const bool has_next = S.next(ui + 1, nxt);
        const char* nA = has_next ? nxt.A : cA; const char* nB = has_next ? nxt.B : cB;
        const int nt = cur.nt;
        for (int t = 0; t < nt; t += 2) {
            const bool last = (t == nt - 2);
            const char* a1 = cA + (size_t)(t + 1) * kstep;
            const char* a2 = last ? nA : cA + (size_t)(t + 2) * kstep; const char* b2 = last ? nB : cB + (size_t)(t + 2) * kstepB;
            const char* a3 = a2 + kstep; const char* b3 = b2 + kstepB;
            PG8_LDB(B0, 0, 0); PG8_LDB(B1, 0, 1); PG8_SCHED; PG8_LDA(At, 0, 0); PG8_STAGE(PG8_SA(1, 1), a1 + hstepA, voffA);
            PG8_WAIT_V(8); PG8_WAIT_L(0); PG8_BAR; PG8_MMA(0, 0, At, B0); PG8_MMA(0, 1, At, B1); PG8_BAR; PG8_SCHED;
            PG8_LDA(At, 0, 1); PG8_STAGE(PG8_SB(0, 0), b2, voffB); PG8_STAGE(PG8_SB(0, 1), b2 + hstepB, voffB); PG8_STAGE(PG8_SA(0, 0), a2, voffA);
            PG8_WAIT_V(8); PG8_WAIT_L(0); PG8_BAR; PG8_MMA(1, 0, At, B0); PG8_MMA(1, 1, At, B1); PG8_BAR; PG8_SCHED;
            PG8_LDB(B0, 1, 0); PG8_LDB(B1, 1, 1); PG8_SCHED; PG8_LDA(At, 1, 0); PG8_STAGE(PG8_SA(0, 1), a2 + hstepA, voffA);
            PG8_WAIT_V(8); PG8_WAIT_L(0); PG8_BAR; PG8_MMA(0, 0, At, B0); PG8_MMA(0, 1, At, B1); PG8_BAR; PG8_SCHED;
            PG8_LDA(At, 1, 1); PG8_STAGE(PG8_SB(1, 0), b3, voffB); PG8_STAGE(PG8_SB(1, 1), b3 + hstepB, voffB); PG8_STAGE(PG8_SA(1, 0), a3, voffA);
            PG8_WAIT_V(8); PG8_WAIT_L(0); PG8_BAR; PG8_MMA(1, 0, At, B0); PG8_MMA(1, 1, At, B1); PG8_BAR; PG8_SCHED;
        }
        if (wr == 0) PG8_BAR;
        if (cur.nks > 1) {
            int t2 = tid; asm volatile("" : "+v"(t2));
            float* sb = g.slabs + ((size_t)(cur.ti * cur.nks + cur.ks) << 16) + t2 * 4;
#pragma unroll
            for (int a = 0; a < 2; ++a)
#pragma unroll
                for (int m = 0; m < 4; ++m)
#pragma unroll
                    for (int b = 0; b < 2; ++b)
#pragma unroll
                        for (int n = 0; n < 2; ++n) *(f32x4*)(sb + ((((a * 4 + m) * 2 + b) * 2 + n) << 11)) = acc[a][b][m][n];
        } else E(acc, cur, wr, wc, fr, fq);
        if (!has_next) break;
#pragma unroll
        for (int a = 0; a < 2; ++a)
#pragma unroll
            for (int b = 0; b < 2; ++b)
#pragma unroll
                for (int m = 0; m < 4; ++m)
#pragma unroll
                    for (int n = 0; n < 2; ++n) acc[a][b][m][n] = (f32x4){0.f, 0.f, 0.f, 0.f};
        cur = nxt; cA = nA; cB = nB; ++ui;
        if (wr == 1) PG8_BAR;
    }
    PG8_WAIT_V(0);
    PG8_BAR;
#undef PG8_SA
#undef PG8_SB
#undef PG8_STAGE
#undef PG8_LDA
#undef PG8_LDB
#undef PG8_MMA
#undef PG8_CAT
#undef PG8_WAIT_V
#undef PG8_WAIT_L
#undef PG8_BAR
#undef PG8_SCHED
}

__device__ __forceinline__ int xcd_remap(int L, int total) { const int q = total / 8, r = total % 8, xcd = L % 8, off = L / 8; return (xcd < r ? xcd * (q + 1) : r * (q + 1) + (xcd - r) * q) + off; }
template <class Base, int BKSTEP = BK * 2> struct TailSched {
    Base b; int G, c, total, Fcut, r, s, nt_full, ksl;
    __device__ __forceinline__ void init(int total_, int K, int G_, int c_, int smax = 8) {
        total = total_; G = G_; c = c_; nt_full = K / BK; Fcut = (total / G) * G; r = total - Fcut; const int kp = nt_full / 2;
        s = 1;
        if (r > 0) { if (smax >= 8 && kp % 8 == 0 && kp / 8 >= 2 && r * 8 <= G) s = 8; else if (smax >= 4 && kp % 4 == 0 && kp / 4 >= 2 && r * 4 <= G) s = 4; else if (smax >= 2 && kp % 2 == 0 && kp / 2 >= 2 && r * 2 <= G) s = 2; }
        ksl = nt_full / s;
    }
    __device__ __forceinline__ bool next(int i, Unit& u) const {
        const int L = i * G + c;
#ifndef CHUNK_DEAL
#define CHUNK_DEAL 0
#endif
        if (L < Fcut) { b.decode(CHUNK_DEAL ? c * (Fcut / G) + i : xcd_remap(L, Fcut), u); u.nt = nt_full; u.ti = -1; u.ks = 0; u.nks = 1; u.pad = 0; return true; }
        const int q = L - Fcut; if (q >= r * s) return false;
        const int ti = q / s, ks = q - ti * s; b.decode(Fcut + ti, u);
        u.A += (size_t)ks * ksl * (BK * 2); u.B += (size_t)ks * ksl * BKSTEP; u.nt = ksl; u.ti = ti; u.ks = ks; u.nks = s; u.pad = 0; return true;
    }
};
template <class EpiT, class Base, int BKSTEP> __device__ __forceinline__ void tail_reduce(const TailSched<Base, BKSTEP>& S, const EpiT& E, const float* slabs, int bid, int nb, int wv) {
    if (S.s <= 1) return;
    int tid_ = TID_FROM(wv); asm volatile("" : "+v"(tid_)); const int tid = tid_, wid = tid >> 6, lane = tid & 63, wr = wid >> 2, wc = wid & 3, fr = lane & 15, fq = lane >> 4;
    for (int it = bid; it < S.r * 16; it += nb) {
        const int ti = it >> 4, c16 = it & 15, ai = c16 >> 3, m = (c16 >> 1) & 3, bj = c16 & 1;
        Unit u; S.b.decode(S.Fcut + ti, u); u.nt = 0; u.ti = ti; u.ks = 0; u.nks = 1; u.pad = 0;
        f32x4 v0 = {0.f, 0.f, 0.f, 0.f}, v1 = {0.f, 0.f, 0.f, 0.f};
        for (int ks = 0; ks < S.s; ++ks) { const float* sb = slabs + ((size_t)(ti * S.s + ks) << 16) + tid * 4 + ((size_t)(c16 * 2) << 11); v0 += *(const f32x4*)sb; v1 += *(const f32x4*)(sb + 2048); }
        E.f.put(u, ai * HALF + wr * 64 + m * 16 + fr, bj * HALF + wc * 32, fq, v0, v1);
    }
}
template <bool LAT> struct GridBase {
    const char* A; const char* B; size_t atile, btile; int nM, nN;
    __device__ __forceinline__ void decode(int wgid, Unit& u) const {
        const int nig = WGM * nN, gid = wgid / nig, fm = gid * WGM, gsz = (nM - fm) < WGM ? (nM - fm) : WGM;
        int pm = fm + ((wgid % nig) % gsz); const int pn = (wgid % nig) / gsz;
        if (LAT) pm = pm + pm / 8 + 1;
        u.pm = pm; u.pn = pn; u.z = 0; u.A = A + (size_t)pm * atile; u.B = B + (size_t)pn * btile;
    }
};
template <bool LAT> struct GridSched : TailSched<GridBase<LAT>> {
    __device__ __forceinline__ void init(const void* A_, size_t atile_, const void* B_, size_t btile_, int nM_, int nN_, int K, int G_, int c_, int smax = 8) {
        this->b.A = (const char*)A_; this->b.B = (const char*)B_; this->b.atile = atile_; this->b.btile = btile_; this->b.nM = nM_; this->b.nN = nN_;
        TailSched<GridBase<LAT>>::init(nM_ * nN_, K, G_, c_, smax);
    }
};
}

struct EF_in {
    bf16_t *F, *Q, *Kd, *V; const float2* tab;
    __device__ __forceinline__ void put(const pg8::Unit& u, int rt, int c32, int fq, const f32x4& v0, const f32x4& v1) const {
        const int R = u.pm * 256 + rt, cg = u.pn * 256 + c32;
        if (cg < 1024) { store4bf(F + (size_t)R * 1024 + cg + 4 * fq, v0); store4bf(F + (size_t)R * 1024 + cg + 16 + 4 * fq, v1); return; }
        if (cg >= 3072) { store4bf(V + (size_t)R * 1024 + (cg - 3072) + 4 * fq, v0); store4bf(V + (size_t)R * 1024 + (cg - 3072) + 16 + 4 * fq, v1); return; }
        const int G = cg >> 6, w = (cg >> 5) & 1, a0 = 64 * G + 16 * w + 4 * fq;
        bf16_t* dst = cg < 2048 ? Q + (size_t)R * 1024 + (a0 - 1024) : Kd + (size_t)R * 1024 + (a0 - 2048);
        const int j = R % TPB; f32x4 o0 = v0, o1 = v1;
        if (j >= CTX) { const int nl = j - CTX, pos = (G & 1) ? (nl & 63) : (nl >> 6); const f32x4* t4 = (const f32x4*)(tab + pos * 32 + 16 * w + 4 * fq); const f32x4 ta = t4[0], tb = t4[1];
            const f32x4 cs = {ta[0], ta[2], tb[0], tb[2]}, sn = {ta[1], ta[3], tb[1], tb[3]};
            o0 = v0 * cs - v1 * sn; o1 = v1 * cs + v0 * sn; }
        store4bf(dst, o0); store4bf(dst + 32, o1);
    }
};
struct EF_res {
    float* XS; const float* mods; int chunk, pad;
    __device__ __forceinline__ void put(const pg8::Unit& u, int rt, int c32, int fq, const f32x4& v0, const f32x4& v1) const {
        const int R = u.pm * 256 + rt, col = u.pn * 256 + c32 + 4 * fq; const int bb = (u.pm % 9 == 0) ? 4 : u.pm / 9;
        const float* m = mods + (size_t)bb * 6 * D + chunk * D + col; float* x = XS + (size_t)R * D + col;
        *(f32x4*)x = *(const f32x4*)x + *(const f32x4*)m * v0; *(f32x4*)(x + 16) = *(const f32x4*)(x + 16) + *(const f32x4*)(m + 16) * v1;
    }
};
struct EF_res0 {
    float* XS; const float* mods; const float* x; const float* ctx; int chunk, pad;
    __device__ __forceinline__ void put(const pg8::Unit& u, int rt, int c32, int fq, const f32x4& v0, const f32x4& v1) const {
        const int R = u.pm * 256 + rt, col = u.pn * 256 + c32 + 4 * fq; const int b = u.pm / 9, t9 = u.pm - 9 * b; const int bb = t9 == 0 ? 4 : b;
        const float* s = (t9 == 0 ? ctx + ((size_t)(b * CTX + rt)) * D : x + ((size_t)(b * SEQ + (t9 - 1) * 256 + rt)) * D) + col;
        const float* m = mods + (size_t)bb * 6 * D + chunk * D + col; float* o = XS + (size_t)R * D + col;
        *(f32x4*)o = *(const f32x4*)s + *(const f32x4*)m * v0; *(f32x4*)(o + 16) = *(const f32x4*)(s + 16) + *(const f32x4*)(m + 16) * v1;
    }
};
struct EF_swiglu {
    bf16_t* ACT; int ld, pad;
    __device__ __forceinline__ void put(const pg8::Unit& u, int rt, int c32, int fq, const f32x4& v0, const f32x4& v1) const {
        const size_t R = (size_t)u.pm * 256 + rt; const int oc = ((u.pn * 256 + c32) >> 1) + 4 * fq;
        const f32x2 a = swiglu2(f32x2{v0[0], v0[1]}, f32x2{v1[0], v1[1]}, -1.4426950408889634f, 1.f), b = swiglu2(f32x2{v0[2], v0[3]}, f32x2{v1[2], v1[3]}, -1.4426950408889634f, 1.f);
        store4bf(ACT + R * ld + oc, f32x4{a.x, a.y, b.x, b.y});
    }
};
struct EF_dqkv {
    float *CQ, *CKV; bf16_t* KR; const float2* tab;
    __device__ __forceinline__ void put(const pg8::Unit& u, int rt, int c32, int fq, const f32x4& v0, const f32x4& v1) const {
        const int R = u.pm * 256 + rt, cg = u.pn * 256 + c32;
        if (cg < 512) { float* d = CQ + (size_t)R * 512 + cg + 4 * fq; *(f32x4*)d = v0; *(f32x4*)(d + 16) = v1; return; }
        if (cg < 1024) { float* d = CKV + (size_t)R * 512 + (cg - 512) + 4 * fq; *(f32x4*)d = v0; *(f32x4*)(d + 16) = v1; return; }
        if (cg >= 1088) return;
        const int half = (cg - 1024) >> 5, j = R % TPB; f32x4 o0 = v0, o1 = v1;
        if (j >= CTX) { const int nl = j - CTX, pos = half ? (nl & 63) : (nl >> 6); const f32x4* t4 = (const f32x4*)(tab + pos * 16 + 4 * fq); const f32x4 ta = t4[0], tb = t4[1];
            const f32x4 cs = {ta[0], ta[2], tb[0], tb[2]}, sn = {ta[1], ta[3], tb[1], tb[3]};
            o0 = v0 * cs - v1 * sn; o1 = v1 * cs + v0 * sn; }
        bf16_t* d = KR + (size_t)R * 64 + (cg - 1024) + 4 * fq; store4bf(d, o0); store4bf(d + 16, o1);
    }
};
struct EF_uq {
    bf16_t* QM; const float2* tab;
    __device__ __forceinline__ void put(const pg8::Unit& u, int rt, int c32, int fq, const f32x4& v0, const f32x4& v1) const {
        const int R = u.pm * 256 + rt, cg = u.pn * 256 + c32; const int q = (cg >> 5) % 6; f32x4 o0 = v0, o1 = v1;
        if (q >= 4) { const int nl = R % TPB - CTX, pos = (q == 5) ? (nl & 63) : (nl >> 6); const f32x4* t4 = (const f32x4*)(tab + pos * 16 + 4 * fq); const f32x4 ta = t4[0], tb = t4[1];
            const f32x4 cs = {ta[0], ta[2], tb[0], tb[2]}, sn = {ta[1], ta[3], tb[1], tb[3]};
            o0 = v0 * cs - v1 * sn; o1 = v1 * cs + v0 * sn; }
        bf16_t* d = QM + (size_t)R * 3072 + cg + 4 * fq; store4bf(d, o0); store4bf(d + 16, o1);
    }
};
struct EF_bf {
    bf16_t* O; int ld, pad;
    __device__ __forceinline__ void put(const pg8::Unit& u, int rt, int c32, int fq, const f32x4& v0, const f32x4& v1) const {
        bf16_t* d = O + ((size_t)u.pm * 256 + rt) * ld + u.pn * 256 + c32 + 4 * fq; store4bf(d, v0); store4bf(d + 16, v1);
    }
};
struct EF_swiglu8 {
    unsigned char* ACT; int ld, pad;
    __device__ __forceinline__ void put(const pg8::Unit& u, int rt, int c32, int fq, const f32x4& v0, const f32x4& v1) const {
        const size_t R = (size_t)u.pm * 256 + rt; const int oc = ((u.pn * 256 + c32) >> 1) + 4 * fq; const float is = 1.0f / W8_GU;
        const f32x2 a = swiglu2(f32x2{v0[0], v0[1]}, f32x2{v1[0], v1[1]}, -1.4426950408889634f * is, 1.f / (is * is * A8_ACT)), b = swiglu2(f32x2{v0[2], v0[3]}, f32x2{v1[2], v1[3]}, -1.4426950408889634f * is, 1.f / (is * is * A8_ACT));
        *(unsigned*)(ACT + R * ld + oc) = pack4_fp8(a.x, a.y, b.x, b.y);
    }
};
struct EF_y8 {
    float* O; int ld, pad;
    __device__ __forceinline__ void put(const pg8::Unit& u, int rt, int c32, int fq, const f32x4& v0, const f32x4& v1) const {
        float* d = O + ((size_t)u.pm * 256 + rt) * ld + u.pn * 256 + c32 + 4 * fq; const float is = 1.0f / (A8_ACT * W8_DN); *(f32x4*)d = v0 * is; *(f32x4*)(d + 16) = v1 * is;
    }
};
struct EF_probe {
    float* O; int ld, pad;
    __device__ __forceinline__ void put(const pg8::Unit& u, int rt, int c32, int fq, const f32x4& v0, const f32x4& v1) const {
        if (v0[0] + v0[1] + v0[2] + v0[3] + v1[0] + v1[1] + v1[2] + v1[3] == 1.2345678e30f) O[rt] = v0[0];
    }
};
struct EF_probe_math {
    unsigned char* ACT; int ld, pad;
    __device__ __forceinline__ void put(const pg8::Unit& u, int rt, int c32, int fq, const f32x4& v0, const f32x4& v1) const {
        const float is = 1.0f / W8_GU; float o[4];
#pragma unroll
        for (int e = 0; e < 4; ++e) o[e] = fast_silu(v0[e] * is) * (v1[e] * is) * A8_ACT;
        const unsigned w = pack4_fp8(o[0], o[1], o[2], o[3]);
        if (w == 0x12345678u) *(unsigned*)(ACT + rt) = w;
    }
};
struct EF_probe_store {
    unsigned char* ACT; int ld, pad;
    __device__ __forceinline__ void put(const pg8::Unit& u, int rt, int c32, int fq, const f32x4& v0, const f32x4& v1) const {
        const size_t R = ((size_t)u.pm * 256 + rt) & 8191; const int oc = ((u.pn * 256 + c32) >> 1) + 4 * fq;
        *(unsigned*)(ACT + R * ld + oc) = __builtin_bit_cast(unsigned, v0[0]) ^ __builtin_bit_cast(unsigned, v1[1]);
    }
};
struct EF_f32 {
    float* O; int ld, pad;
    __device__ __forceinline__ void put(const pg8::Unit& u, int rt, int c32, int fq, const f32x4& v0, const f32x4& v1) const {
        float* d = O + ((size_t)u.pm * 256 + rt) * ld + u.pn * 256 + c32 + 4 * fq; *(f32x4*)d = v0; *(f32x4*)(d + 16) = v1;
    }
};
struct EF_dftA {
    bf16_t *VT, *VTC;
    __device__ __forceinline__ void put(const pg8::Unit& u, int rt, int c32, int fq, const f32x4& v0, const f32x4& v1) const {
        const int bg = u.z & 15; bf16_t* d;
        if (u.z < 16) d = VT + ((size_t)bg * 256 + rt) * 4096 + u.pm * 2048 + u.pn * 256 + c32 + 4 * fq;
        else d = VTC + ((size_t)bg * 256 + rt) * 512 + u.pm * 256 + c32 + 4 * fq;
        store4bf(d, v0); store4bf(d + 16, v1);
    }
};
struct EF_dftB {
    bf16_t* MIX; float scale; int joff;
    __device__ __forceinline__ void put(const pg8::Unit& u, int rt, int c32, int fq, const f32x4& v0, const f32x4& v1) const {
        const int b = u.z >> 2, g = u.z & 3; const size_t R = (size_t)b * TPB + joff + u.pm * 256 + rt;
        bf16_t* d = MIX + R * 2048 + g * 256 + c32 + 4 * fq; store4bf(d, v0 * scale); store4bf(d + 16, v1 * scale);
    }
};

struct DftABase {
    const char* WCS; const char* F;
    __device__ __forceinline__ void decode(int L, pg8::Unit& u) const {
        int bg, part, pn, ctx;
        if (L < 256) { bg = L >> 4; part = (L >> 3) & 1; pn = L & 7; ctx = 0; } else { const int l = L - 256; bg = l >> 1; part = l & 1; pn = 0; ctx = 1; }
        const int b = bg >> 2, g = bg & 3;
        u.A = WCS + (size_t)part * 256 * 256 * 2; u.B = F + ((size_t)(b * TPB + (ctx ? 0 : CTX + pn * 256)) * 1024 + g * 256) * 2;
        u.pm = part; u.pn = pn; u.z = bg + 16 * ctx;
    }
};
struct DftBBase {
    const char* A; const char* B; size_t atile, bstride; int nk1, pad;
    __device__ __forceinline__ void decode(int L, pg8::Unit& u) const {
        const int bg = L / nk1, pm = L % nk1;
        u.A = A + (size_t)pm * atile; u.B = B + (size_t)bg * bstride; u.pm = pm; u.pn = 0; u.z = bg;
    }
};
struct MoeBase {
    const char* A; const char* B; size_t arow  , bexp  , btile; int nN, pad; int t0, t1, t2, t3, t4, t5, t6, t7; int o0, o1, o2, o3, o4, o5, o6, o7;
    __device__ __forceinline__ int init(const void* A_, size_t arow_, const void* B_, size_t bexp_, size_t btile_, int nN_, const int* CNT, const int* OFFS) {
        A = (const char*)A_; B = (const char*)B_; arow = arow_; bexp = bexp_; btile = btile_; nN = nN_; pad = 0;
        t0 = (CNT[0] + 255) >> 8; t1 = (CNT[1] + 255) >> 8; t2 = (CNT[2] + 255) >> 8; t3 = (CNT[3] + 255) >> 8; t4 = (CNT[4] + 255) >> 8; t5 = (CNT[5] + 255) >> 8; t6 = (CNT[6] + 255) >> 8; t7 = (CNT[7] + 255) >> 8;
        o0 = OFFS[0]; o1 = OFFS[1]; o2 = OFFS[2]; o3 = OFFS[3]; o4 = OFFS[4]; o5 = OFFS[5]; o6 = OFFS[6]; o7 = OFFS[7];
        return (t0 + t1 + t2 + t3 + t4 + t5 + t6 + t7) * nN;
    }
    __device__ __forceinline__ void decode(int l, pg8::Unit& u) const {
        int e = -1, te = 1, oe = 0;
#define MOE_STEP(k, tk, ok) if (e < 0) { const int n = tk * nN; if (l < n) { e = k; te = tk; oe = ok; } else l -= n; }
        MOE_STEP(0, t0, o0) MOE_STEP(1, t1, o1) MOE_STEP(2, t2, o2) MOE_STEP(3, t3, o3) MOE_STEP(4, t4, o4) MOE_STEP(5, t5, o5) MOE_STEP(6, t6, o6) MOE_STEP(7, t7, o7)
#undef MOE_STEP
        if (e < 0) { e = 0; l = 0; }
        const int mt = l % te, pn = l / te; const int row0 = oe + mt * 256;
        u.A = A + (size_t)row0 * arow; u.B = B + (size_t)e * bexp + (size_t)pn * btile; u.pm = row0 >> 8; u.pn = pn; u.z = e;
    }
};

template <int RM> __device__ __forceinline__ int rowmap(int c) {
    if (RM == 1) { if (c < 1024 || c >= 3072) return c; const int u = c & 63; return (c & ~63) + 32 * ((u & 31) >> 4) + 16 * (u >> 5) + (u & 15); }
    if (RM == 2) return 32 * (c >> 4) + (c & 15);
    if (RM == 3) return 32 * (c >> 4) + 16 + (c & 15);
    return c;
}
template <int RM> __device__ __forceinline__ void cvt_item(const float* W, int K, int N, bf16_t* WT, int row_off, LAS float* scr, int item, int lane) {
    const int nblk = N / 32, kb = item / nblk, nb = item % nblk, k0 = 64 * kb, n0 = 32 * nb;
    f32x4 v[8];
#pragma unroll
    for (int i = 0; i < 8; ++i) v[i] = *(const f32x4*)(W + (size_t)(k0 + (lane >> 3) + 8 * i) * N + n0 + 4 * (lane & 7));
#pragma unroll
    for (int i = 0; i < 8; ++i) { LAS float* d = scr + ((lane >> 3) + 8 * i) * 33 + 4 * (lane & 7); d[0] = v[i][0]; d[1] = v[i][1]; d[2] = v[i][2]; d[3] = v[i][3]; }
    asm volatile("s_waitcnt lgkmcnt(0)" ::: "memory");
    const int c = lane & 7;
#pragma unroll
    for (int j = 0; j < 4; ++j) { const int n = (lane >> 3) + 8 * j; const LAS float* s = scr + (8 * c) * 33 + n;
        u32x4 o; o.x = cvt_pk_bf16(s[0 * 33], s[1 * 33]); o.y = cvt_pk_bf16(s[2 * 33], s[3 * 33]); o.z = cvt_pk_bf16(s[4 * 33], s[5 * 33]); o.w = cvt_pk_bf16(s[6 * 33], s[7 * 33]);
        *(u32x4*)(WT + (size_t)(row_off + rowmap<RM>(n0 + n)) * K + k0 + 8 * c) = o; }
    asm volatile("s_waitcnt lgkmcnt(0)" ::: "memory");
}
__device__ __forceinline__ void item8_kn(int item, int nblk, int& k0, int& n0) { const int q = item >> 1; k0 = 64 * (2 * (q / nblk) + (item & 1)); n0 = 32 * (q % nblk); }
template <int RM> __device__ __forceinline__ void cvt_item8(const float* W, int K, int N, unsigned char* WT, float scale, LAS float* scr, int item, int lane) {
    int k0, n0; item8_kn(item, N / 32, k0, n0);
    f32x4 v[8];
#pragma unroll
    for (int i = 0; i < 8; ++i) v[i] = *(const f32x4*)(W + (size_t)(k0 + (lane >> 3) + 8 * i) * N + n0 + 4 * (lane & 7));
#pragma unroll
    for (int i = 0; i < 8; ++i) { LAS float* d = scr + ((lane >> 3) + 8 * i) * 33 + 4 * (lane & 7); d[0] = v[i][0]; d[1] = v[i][1]; d[2] = v[i][2]; d[3] = v[i][3]; }
    asm volatile("s_waitcnt lgkmcnt(0)" ::: "memory");
    const int c = lane & 7;
#pragma unroll
    for (int j = 0; j < 4; ++j) { const int n = (lane >> 3) + 8 * j; const LAS float* s = scr + (8 * c) * 33 + n;
        u32x2 o; o.x = pack4_fp8(s[0 * 33] * scale, s[1 * 33] * scale, s[2 * 33] * scale, s[3 * 33] * scale); o.y = pack4_fp8(s[4 * 33] * scale, s[5 * 33] * scale, s[6 * 33] * scale, s[7 * 33] * scale);
        *(u32x2*)(WT + (size_t)rowmap<RM>(n0 + n) * K + k0 + 8 * c) = o; }
    asm volatile("s_waitcnt lgkmcnt(0)" ::: "memory");
}
constexpr int MOE_I_MG = (2048 / 64) * (FFE / 32), MOE_I_MD = (FFE / 64) * (2048 / 32), MOE_ITEMS = 16 * MOE_I_MG + 8 * MOE_I_MD, MOE_BATCHES = MOE_ITEMS / 8;
__device__ __forceinline__ size_t fp8_tiled_off(int row, int k, int K) { return ((size_t)(row >> 5) * (K >> 7) + (k >> 7)) * 4096 + (row & 31) * 128 + (k & 127); }
struct Cvt8Job { const float* W; unsigned char* WT; int K, N, k0, n0, rm; float scale;
#ifdef PROBE_CVT_LINEAR
    unsigned char* lin;
#endif
};
__device__ __forceinline__ Cvt8Job moe_cvt_job(const P& p, int r) {
    Cvt8Job j; const int G = r >> 4, kbl = r & 15, t = G / 3584, g = G - t * 3584, e = g / 448, rem = g - e * 448;
    int kgrp, nbk;
    if (t < 2) { kgrp = rem / 224; nbk = rem - kgrp * 224; j.W = (t == 0 ? p.moe_w_gate : p.moe_w_up) + (size_t)e * 2048 * FFE; j.WT = WSP(unsigned char, WT_MGU) + (size_t)e * 2 * FFE * 2048; j.K = 2048; j.N = FFE; j.rm = 2 + t; j.scale = W8_GU; }
    else { kgrp = rem / 64; nbk = rem - kgrp * 64; j.W = p.moe_w_down + (size_t)e * FFE * 2048; j.WT = WSP(unsigned char, WT_MD) + (size_t)e * 2048 * FFE; j.K = FFE; j.N = 2048; j.rm = 0; j.scale = W8_DN; }
    j.k0 = 64 * (16 * kgrp + kbl); j.n0 = 32 * nbk;
#ifdef PROBE_CVT_LINEAR
    j.lin = (unsigned char*)p.ws + WS_END + (size_t)r * 2048;
#endif
    return j;
}
static_assert(MOE_ITEMS == 3 * 3584 * 16 && MOE_I_MG == 448 * 16 && MOE_I_MD == 448 * 16, "MoE conversion group layout");
__device__ __forceinline__ void cvt8_load(const Cvt8Job& j, int lane, f32x4 (&v)[8]) {
#pragma unroll
    for (int i = 0; i < 8; ++i) v[i] = *(const f32x4*)(j.W + (size_t)(j.k0 + (lane >> 3) + 8 * i) * j.N + j.n0 + 4 * (lane & 7));
}
__device__ __forceinline__ void cvt8_finish(const Cvt8Job& j, int lane, const f32x4 (&v)[8], LAS float* scr, bool st = true) {
#pragma unroll
    for (int i = 0; i < 8; ++i) { LAS float* d = scr + ((lane >> 3) + 8 * i) * 33 + 4 * (lane & 7); d[0] = v[i][0]; d[1] = v[i][1]; d[2] = v[i][2]; d[3] = v[i][3]; }
    asm volatile("s_waitcnt lgkmcnt(0)" ::: "memory");
    const int c = lane & 7; const float scale = j.scale;
#pragma unroll
    for (int q = 0; q < 4; ++q) { const int n = (lane >> 3) + 8 * q; const LAS float* s = scr + (8 * c) * 33 + n;
        u32x2 o; o.x = pack4_fp8(s[0 * 33] * scale, s[1 * 33] * scale, s[2 * 33] * scale, s[3 * 33] * scale); o.y = pack4_fp8(s[4 * 33] * scale, s[5 * 33] * scale, s[6 * 33] * scale, s[7 * 33] * scale);
        const int cn = j.n0 + n; const int row = j.rm == 0 ? cn : 32 * (cn >> 4) + (cn & 15) + (j.rm == 3 ? 16 : 0);
#ifdef PROBE_CVT_LINEAR
        if (!st) *(u32x2*)(j.lin + n * 64 + 8 * c) = o; else
#endif
        if (st || (o.x == 0x12345678u && o.y == 0x9abcdef0u)) *(u32x2*)(j.WT + fp8_tiled_off(row, j.k0 + 8 * c, j.K)) = o; }
    asm volatile("s_waitcnt lgkmcnt(0)" ::: "memory");
}
__device__ __forceinline__ void moe_cvt_item(const P& p, int r, LAS float* scr, int lane) { const Cvt8Job j = moe_cvt_job(p, r); f32x4 v[8]; cvt8_load(j, lane, v); cvt8_finish(j, lane, v, scr); }
__device__ __forceinline__ bool moe_fill_list(const P& p, unsigned* ctl, int phase, int nb, int owner, LAS float* scr, int lane, bool st = true) {
    unsigned* ctr = ctl + CW_FILL + 64 * owner; const int nown = 16 * ((MOE_ITEMS / 16 - owner + nb - 1) / nb);
#define MOE_ENTRY(e) (16 * (((e) >> 4) * nb + owner) + ((e) & 15))
    const int ch = phase >= 0 ? 1 : 4;
    for (;;) {
        if (phase >= 0 && (int)__builtin_amdgcn_readfirstlane(xb_ld(ctl + CW_DONE + 64 * phase)) >= nb) return false;
        unsigned idx = 0; if (lane == 0) idx = xb_add(ctr, (unsigned)ch);
        idx = __builtin_amdgcn_readfirstlane(idx);
        if ((int)idx >= nown) return true;
        if (ch == 4 && (int)idx + 3 < nown) {
            f32x4 va[8], vb[8];
            const Cvt8Job j0 = moe_cvt_job(p, MOE_ENTRY((int)idx + 0)); cvt8_load(j0, lane, va);
            const Cvt8Job j1 = moe_cvt_job(p, MOE_ENTRY((int)idx + 1)); cvt8_load(j1, lane, vb);
            cvt8_finish(j0, lane, va, scr, st);
            const Cvt8Job j2 = moe_cvt_job(p, MOE_ENTRY((int)idx + 2)); cvt8_load(j2, lane, va);
            cvt8_finish(j1, lane, vb, scr, st);
            const Cvt8Job j3 = moe_cvt_job(p, MOE_ENTRY((int)idx + 3)); cvt8_load(j3, lane, vb);
            cvt8_finish(j2, lane, va, scr, st);
            cvt8_finish(j3, lane, vb, scr, st);
        } else
        for (int j = 0; j < ch && (int)idx + j < nown; ++j) moe_cvt_item(p, MOE_ENTRY((int)idx + j), scr, lane);
    }
}
__device__ __forceinline__ void moe_fill(const P& p, unsigned* ctl, int phase, int nb, int bid, LAS unsigned char* lds, volatile LAS unsigned* MISC, int wv) {
    const int lane = lane_id();
    LAS float* scr = (LAS float*)(lds + wv * 16384);
#ifdef PROBE_CVT_NOSTORE
    const bool st = MISC[25] == 0u;
#else
    const bool st = true;
#endif
    if (MISC[24] == 0u) { if (!moe_fill_list(p, ctl, phase, nb, bid, scr, lane, st)) return; MISC[24] = 1u; }
    if (phase >= 0) return;
#pragma unroll 1
    for (int k = 1; k <= 6; ++k) { if (!moe_fill_list(p, ctl, phase, nb, (bid + 41 * k) % nb, scr, lane, st)) return; }
}
__device__ __forceinline__ void ph_convert(const P& p, int bid, int nb, LAS unsigned char* lds, int wv) {
    int tid_ = TID_FROM(wv); asm volatile("" : "+v"(tid_)); const int tid = tid_, lane = tid & 63, wave = tid >> 6;
    LAS float* scr = (LAS float*)(lds + wave * 16384);
    const int gw = bid * NWAVES + wave, NGW = nb * NWAVES;
    constexpr int I_IN = (2048 / 64) * (4096 / 32), I_OUT = (2048 / 64) * (2048 / 32), I_G = (2048 / 64) * (FFD / 32), I_DN = (FFD / 64) * (2048 / 32);
    constexpr int I_DQ = (2048 / 64) * (512 / 32), I_DKV = (2048 / 64) * (576 / 32), I_UQ = (512 / 64) * (3072 / 32), I_UKV = (512 / 64) * (4096 / 32), I_O = I_OUT;
    constexpr int I_MG = (2048 / 64) * (FFE / 32), I_MD = (FFE / 64) * (2048 / 32);
    constexpr int NITEMS = I_IN + I_OUT + 2 * I_G + I_DN + I_DQ + I_DKV + I_UQ + I_UKV + I_O + (FILL ? 0 : 16 * I_MG + 8 * I_MD);
    for (int it = gw; it < NITEMS; it += NGW) {
        int r = it;
        if (r < I_IN) { cvt_item<1>(p.ev_w_in, 2048, 4096, WSP(bf16_t, WT_IN), 0, scr, r, lane); continue; } r -= I_IN;
        if (r < I_OUT) { cvt_item<0>(p.ev_w_out, 2048, 2048, WSP(bf16_t, WT_OUT), 0, scr, r, lane); continue; } r -= I_OUT;
        if (r < I_G) { cvt_item<2>(p.ffn_w_gate, 2048, FFD, WSP(bf16_t, WT_GU), 0, scr, r, lane); continue; } r -= I_G;
        if (r < I_G) { cvt_item<3>(p.ffn_w_up, 2048, FFD, WSP(bf16_t, WT_GU), 0, scr, r, lane); continue; } r -= I_G;
        if (r < I_DN) { cvt_item<0>(p.ffn_w_down, FFD, 2048, WSP(bf16_t, WT_DN), 0, scr, r, lane); continue; } r -= I_DN;
        if (r < I_DQ) { cvt_item<0>(p.od_w_dq, 2048, 512, WSP(bf16_t, WT_DQKV), 0, scr, r, lane); continue; } r -= I_DQ;
        if (r < I_DKV) { cvt_item<0>(p.od_w_dkv, 2048, 576, WSP(bf16_t, WT_DQKV), 512, scr, r, lane); continue; } r -= I_DKV;
        if (r < I_UQ) { cvt_item<0>(p.od_w_uq, 512, 3072, WSP(bf16_t, WT_UQ), 0, scr, r, lane); continue; } r -= I_UQ;
        if (r < I_UKV) { cvt_item<0>(p.od_w_ukv, 512, 4096, WSP(bf16_t, WT_UKV), 0, scr, r, lane); continue; } r -= I_UKV;
        if (r < I_O) { cvt_item<0>(p.od_w_o, 2048, 2048, WSP(bf16_t, WT_O), 0, scr, r, lane); continue; } r -= I_O;
        moe_cvt_item(p, r, scr, lane);
    }
    { bf16_t* z = WSP(bf16_t, WT_DQKV) + (size_t)1088 * 2048; for (size_t i = (size_t)bid * 512 + tid; i < (size_t)192 * 2048 / 8; i += (size_t)nb * 512) ((uint4*)z)[i] = make_uint4(0, 0, 0, 0); }
}
__device__ __forceinline__ void ph_dft_tables(const P& p, int bid, int nb, float* tab  , int wv) {
    int tid_ = TID_FROM(wv); asm volatile("" : "+v"(tid_)); const int tid = tid_;
    for (int i = tid; i < 2048; i += 512) tab[i] = cospif((float)i * (2.0f / 2048.0f));
    __syncthreads();
    bf16_t* DN = WSP(bf16_t, WS_DFTN); bf16_t* DC = WSP(bf16_t, WS_DFTC); bf16_t* WC = WSP(bf16_t, WS_WCS);
    for (size_t i = (size_t)bid * 512 + tid; i < (size_t)2048 * 4096 / 2; i += (size_t)nb * 512) {
        const int k1 = (int)(i / 2048), n2 = (int)(i % 2048) * 2; unsigned w = 0;
#pragma unroll
        for (int q = 0; q < 2; ++q) { const int nn = n2 + q, n = nn & 2047, part = nn >> 11; const int idx = (k1 * n) & 2047; const float v = part == 0 ? tab[idx] : -tab[(idx + 1536) & 2047]; w |= (unsigned)f2bf(v) << (16 * q); }
        ((unsigned*)DN)[i] = w;
    }
    for (int i = bid * 512 + tid; i < 256 * 512; i += nb * 512) { const int k1 = i / 512, nn = i % 512, n = nn & 255, part = nn >> 8; const int idx = ((k1 * n) & 255) * 8; DC[i] = f2bf(part == 0 ? tab[idx] : -tab[(idx + 1536) & 2047]); }
    for (int i = bid * 512 + tid; i < 512 * 256; i += nb * 512) { const int m = i / 256, cc = i % 256, k3 = m & 255; const int idx = ((k3 * cc) & 255) * 8; WC[i] = f2bf(m < 256 ? tab[idx] : tab[(idx + 1536) & 2047]); }
    __syncthreads();
}

#ifndef ATT_ROPE_SD1
#define ATT_ROPE_SD1 1
#endif
namespace att {
using s16x4  = __attribute__((ext_vector_type(4))) short;
using f32x16 = __attribute__((ext_vector_type(16))) float;
constexpr int QBLK = 32, KVBLK = 64, NW = 8;
constexpr size_t SHM_V = KVBLK * 128 * 2, SHM_K = KVBLK * 128 * 2, SHM_KR = KVBLK * 64 * 2;
constexpr size_t OFF_K = 2 * SHM_V, OFF_KR = OFF_K + 2 * SHM_K, OFF_WS = OFF_KR + 2 * SHM_KR, OFF_QR = OFF_WS + NW * 64 * 4, SHM_ATTN = OFF_QR + 256 * 128;
#define KSWZ(row, colB) ((row) * 256 + ((colB) ^ (((row) & 7) << 4)))
#define KRSWZ(row, colB) ((row) * 128 + ((colB) ^ (((row) & 7) << 4)))
#define SBAR() __builtin_amdgcn_sched_barrier(0)
__device__ __forceinline__ int crow(int r, int hi) { return (r & 3) + 8 * (r >> 2) + 4 * hi; }
__device__ __forceinline__ unsigned cvtpk(float lo, float hi) { unsigned r; asm volatile("v_cvt_pk_bf16_f32 %0, %1, %2" : "=v"(r) : "v"(lo), "v"(hi)); return r; }
__device__ __forceinline__ bf16x8 ld8(const bf16_t* p) { return *reinterpret_cast<const bf16x8*>(p); }

__device__ __forceinline__ void partialSM(f32x16& p0, f32x16& p1, float& m_reg, float& mn, float& alpha, const float C, const float thr) {
  float pmax = p0[0]; for (int r = 1; r < 16; ++r) pmax = fmaxf(pmax, p0[r]); for (int r = 0; r < 16; ++r) pmax = fmaxf(pmax, p1[r]);
  { auto rr = __builtin_amdgcn_permlane32_swap(__float_as_uint(pmax), __float_as_uint(pmax), false, false);
    pmax = fmaxf(__uint_as_float(rr[0]), __uint_as_float(rr[1])); }
  if (__builtin_expect(__all(pmax - m_reg <= thr), 1)) { mn = m_reg; alpha = 1.f; }
  else { mn = fmaxf(m_reg, pmax); alpha = __builtin_amdgcn_exp2f((m_reg - mn) * C); m_reg = mn; }
  float mnC = -mn * C;
  for (int r = 0; r < 16; ++r) p0[r] = fmaf(p0[r], C, mnC); for (int r = 0; r < 16; ++r) p1[r] = fmaf(p1[r], C, mnC);
  for (int r = 0; r < 16; ++r) p0[r] = __builtin_amdgcn_exp2f(p0[r]);
}
__device__ __forceinline__ void finishSM(f32x16& p0, f32x16& p1, float alpha, float& l_reg, bf16x8& pa0, bf16x8& pa1, bf16x8& pa2, bf16x8& pa3) {
  for (int r = 0; r < 16; ++r) p1[r] = __builtin_amdgcn_exp2f(p1[r]);
  float ps = 0; for (int r = 0; r < 16; ++r) ps += p0[r]; for (int r = 0; r < 16; ++r) ps += p1[r];
  { auto rr = __builtin_amdgcn_permlane32_swap(__float_as_uint(ps), __float_as_uint(ps), false, false);
    ps = __uint_as_float(rr[0]) + __uint_as_float(rr[1]); }
  l_reg = l_reg * alpha + ps;
#define PK4(P, BASE, OUT) do { unsigned a0 = cvtpk(P[BASE + 0], P[BASE + 1]), a1 = cvtpk(P[BASE + 2], P[BASE + 3]);   \
    unsigned b0 = cvtpk(P[BASE + 4], P[BASE + 5]), b1 = cvtpk(P[BASE + 6], P[BASE + 7]);                              \
    auto r0 = __builtin_amdgcn_permlane32_swap(a0, b0, false, false); auto r1 = __builtin_amdgcn_permlane32_swap(a1, b1, false, false); \
    u32x4 w = {r0[0], r1[0], r0[1], r1[1]}; OUT = *reinterpret_cast<bf16x8*>(&w); } while (0)
  PK4(p0, 0, pa0); PK4(p0, 8, pa1); PK4(p1, 0, pa2); PK4(p1, 8, pa3);
#undef PK4
}
template <bool ROPE> __device__ __forceinline__ void qkt(f32x16& p0, f32x16& p1, const char* Ks, const char* KRs, const char* QRs, const bf16x8* qr, int r32, int hi) {
  p0 = f32x16{}; p1 = f32x16{};
#pragma unroll
  for (int d0 = 0; d0 < 8; ++d0) { int cb = (d0 * 16 + hi * 8) * 2;
    bf16x8 b0 = *reinterpret_cast<const bf16x8*>(Ks + KSWZ(r32, cb));
    bf16x8 b1 = *reinterpret_cast<const bf16x8*>(Ks + KSWZ(32 + r32, cb));
    p0 = __builtin_amdgcn_mfma_f32_32x32x16_bf16(b0, qr[d0], p0, 0, 0, 0);
    p1 = __builtin_amdgcn_mfma_f32_32x32x16_bf16(b1, qr[d0], p1, 0, 0, 0); }
  if constexpr (ROPE) {
#pragma unroll
    for (int d1 = 0; d1 < 4; ++d1) { int cb = (d1 * 16 + hi * 8) * 2;
      bf16x8 b0 = *reinterpret_cast<const bf16x8*>(KRs + KRSWZ(r32, cb));
      bf16x8 b1 = *reinterpret_cast<const bf16x8*>(KRs + KRSWZ(32 + r32, cb));
      bf16x8 qf = *reinterpret_cast<const bf16x8*>(QRs + KRSWZ(r32, cb));
      p0 = __builtin_amdgcn_mfma_f32_32x32x16_bf16(b0, qf, p0, 0, 0, 0);
      p1 = __builtin_amdgcn_mfma_f32_32x32x16_bf16(b1, qf, p1, 0, 0, 0); }
  }
}
__device__ __forceinline__ int v_st(int k, int c) { const int kk = (k & ~0xC) | ((k & 4) << 1) | ((k & 8) >> 1); return ((kk >> 3) * 4 + (c >> 5)) * 512 + ((kk & 7) * 32 + (c & 31)) * 2; }
__device__ __forceinline__ int v_rd_base(int lane) { return ((lane & 3) << 3) | (((lane >> 2) & 3) << 6) | (((lane >> 4) & 1) << 5) | (((lane >> 5) & 1) << 8); }
constexpr int v_rd_off(int d0, int ks, int half) { return d0 * 512 + ks * 4096 + half * 2048; }
template <int OFF> __device__ __forceinline__ s16x4 tr_read(int vb) {
  s16x4 r; asm volatile("ds_read_b64_tr_b16 %0, %1 offset:%2" : "=&v"(r) : "v"(vb), "i"(OFF) : "memory"); return r;
}
template <int D0> __device__ __forceinline__ void pv_one(f32x16& od, int vb, bf16x8 pa0, bf16x8 pa1, bf16x8 pa2, bf16x8 pa3) {
  const s16x4 l0 = tr_read<v_rd_off(D0, 0, 0)>(vb), h0 = tr_read<v_rd_off(D0, 0, 1)>(vb), l1 = tr_read<v_rd_off(D0, 1, 0)>(vb), h1 = tr_read<v_rd_off(D0, 1, 1)>(vb);
  const s16x4 l2 = tr_read<v_rd_off(D0, 2, 0)>(vb), h2 = tr_read<v_rd_off(D0, 2, 1)>(vb), l3 = tr_read<v_rd_off(D0, 3, 0)>(vb), h3 = tr_read<v_rd_off(D0, 3, 1)>(vb);
  asm volatile("s_waitcnt lgkmcnt(0)" ::: "memory"); SBAR();
#define PK(L, H) (bf16x8){L[0], L[1], L[2], L[3], H[0], H[1], H[2], H[3]}
  od = __builtin_amdgcn_mfma_f32_32x32x16_bf16(pa0, PK(l0, h0), od, 0, 0, 0);
  od = __builtin_amdgcn_mfma_f32_32x32x16_bf16(pa1, PK(l1, h1), od, 0, 0, 0);
  od = __builtin_amdgcn_mfma_f32_32x32x16_bf16(pa2, PK(l2, h2), od, 0, 0, 0);
  od = __builtin_amdgcn_mfma_f32_32x32x16_bf16(pa3, PK(l3, h3), od, 0, 0, 0);
#undef PK
}
__device__ __forceinline__ void pv_d0(f32x16* o, int vb, bf16x8 pa0, bf16x8 pa1, bf16x8 pa2, bf16x8 pa3) {
  pv_one<0>(o[0], vb, pa0, pa1, pa2, pa3); pv_one<1>(o[1], vb, pa0, pa1, pa2, pa3); pv_one<2>(o[2], vb, pa0, pa1, pa2, pa3); pv_one<3>(o[3], vb, pa0, pa1, pa2, pa3);
}
template <int LDQ, int LDK, int LDV, int LDO, bool ROPE, bool OBF>
__device__ __forceinline__ void attn_body(const bf16_t* __restrict__ Qb, const bf16_t* __restrict__ Kh, const bf16_t* __restrict__ Vh, const bf16_t* __restrict__ KRh,
                                          void* __restrict__ Ob, int seq, const float C, const float thr, char* lds, int wv) {
  int tid_ = TID_FROM(wv); asm volatile("" : "+v"(tid_));
  const int tid = tid_, wid = tid >> 6, lane = tid & 63, r32 = lane & 31, hi = lane >> 5;
  char* V_lds = lds; char* K_lds = lds + OFF_K; char* KR_lds = lds + OFF_KR;
  float* ws = (float*)(lds + OFF_WS) + wid * 64; float* li_l = ws; float* al_l = ws + 32;
  float m_reg = -1e30f, l_reg = 0; f32x16 o[4] = {}; bf16x8 qr[8];
  const bf16_t* Qw = Qb + (long)(wid * QBLK + r32) * LDQ + hi * 8;
#pragma unroll
  for (int d0 = 0; d0 < 8; ++d0) qr[d0] = ld8(Qw + d0 * 16);
  const char* QR_lds = lds + OFF_QR + wid * 4096;
  if constexpr (ROPE) {
#pragma unroll
    for (int d1 = 0; d1 < 4; ++d1) *(bf16x8*)(lds + OFF_QR + wid * 4096 + KRSWZ(r32, (d1 * 16 + hi * 8) * 2)) = ld8(Qw + 128 + d1 * 16);
  }
  const int sr = tid >> 4, sc = (tid & 15) * 8, vst0 = v_st(sr, sc), vst1 = v_st(32 + sr, sc);
  const int krr = tid >> 3, krc = (tid & 7) * 8;
  const int vb0 = (int)(uintptr_t)V_lds + v_rd_base(lane);
  constexpr int SD = (ROPE && ATT_ROPE_SD1) ? 1 : 2;
  struct { bf16x8 vs0, vs1, ks0, ks1, kr; } sr_[SD];
#define SLOAD(i, k0) do { sr_[i].vs0 = ld8(&Vh[(long)((k0) + sr) * LDV + sc]); sr_[i].vs1 = ld8(&Vh[(long)((k0) + 32 + sr) * LDV + sc]); \
    sr_[i].ks0 = ld8(&Kh[(long)((k0) + sr) * LDK + sc]); sr_[i].ks1 = ld8(&Kh[(long)((k0) + 32 + sr) * LDK + sc]); \
    if constexpr (ROPE) sr_[i].kr = ld8(&KRh[(long)((k0) + krr) * 64 + krc]); } while (0)
#define SWRITE(b, i) do { *(bf16x8*)(V_lds + (b) * SHM_V + vst0) = sr_[i].vs0;          \
    *(bf16x8*)(V_lds + (b) * SHM_V + vst1) = sr_[i].vs1; int kc = sc * 2;               \
    *(bf16x8*)(K_lds + (b) * SHM_K + KSWZ(sr, kc)) = sr_[i].ks0;                       \
    *(bf16x8*)(K_lds + (b) * SHM_K + KSWZ(32 + sr, kc)) = sr_[i].ks1;                  \
    if constexpr (ROPE) *(bf16x8*)(KR_lds + (b) * SHM_KR + KRSWZ(krr, krc * 2)) = sr_[i].kr; } while (0)
#define SWAIT() do { if constexpr (SD == 1) asm volatile("s_waitcnt vmcnt(0)" ::: "memory"); else if constexpr (ROPE) asm volatile("s_waitcnt vmcnt(5)" ::: "memory"); else asm volatile("s_waitcnt vmcnt(4)" ::: "memory"); } while (0)
#define RESC(a) do { if (__any((a) < 1.f)) { if (hi == 0) al_l[r32] = (a); asm volatile("s_waitcnt lgkmcnt(0)" ::: "memory"); \
    for (int d = 0; d < 4; ++d) for (int r = 0; r < 16; ++r) o[d][r] *= al_l[crow(r, hi)]; } } while (0)
  f32x16 pA0, pA1, pB0, pB1; float mnA, mnB, alA, alB; bf16x8 pa0, pa1, pa2, pa3; const int NT = seq / KVBLK;
  constexpr int SE = 0, SO = SD - 1;
  SLOAD(SE, 0); asm volatile("s_waitcnt vmcnt(0)" ::: "memory"); SWRITE(0, SE); __syncthreads();
  qkt<ROPE>(pA0, pA1, K_lds, KR_lds, QR_lds, qr, r32, hi); partialSM(pA0, pA1, m_reg, mnA, alA, C, thr);
  SLOAD(SO, KVBLK); if constexpr (SD == 2) { if (2 < NT) SLOAD(SE, 2 * KVBLK); }
  SWAIT(); SWRITE(1, SO); __syncthreads();
  for (int j = 1; j + 1 < NT; j += 2) {
    SBAR(); qkt<ROPE>(pB0, pB1, K_lds + SHM_K, KR_lds + SHM_KR, QR_lds, qr, r32, hi);
    finishSM(pA0, pA1, alA, l_reg, pa0, pa1, pa2, pa3); SBAR();
    SLOAD(SO, (j + SD) * KVBLK); SBAR();
    pv_d0(o, vb0, pa0, pa1, pa2, pa3); partialSM(pB0, pB1, m_reg, mnB, alB, C, thr);
    __syncthreads(); SWAIT(); SWRITE(0, SE);
    RESC(alB); __syncthreads();
    SBAR(); qkt<ROPE>(pA0, pA1, K_lds, KR_lds, QR_lds, qr, r32, hi);
    finishSM(pB0, pB1, alB, l_reg, pa0, pa1, pa2, pa3); SBAR();
    if (SD == 1 || j + 3 < NT) SLOAD(SE, (j + 1 + SD) * KVBLK); SBAR();
    pv_d0(o, vb0 + (int)SHM_V, pa0, pa1, pa2, pa3); partialSM(pA0, pA1, m_reg, mnA, alA, C, thr);
    __syncthreads(); SWAIT(); SWRITE(1, SO);
    RESC(alA); __syncthreads();
  }
  SBAR(); qkt<ROPE>(pB0, pB1, K_lds + SHM_K, KR_lds + SHM_KR, QR_lds, qr, r32, hi);
  finishSM(pA0, pA1, alA, l_reg, pa0, pa1, pa2, pa3); SBAR();
  pv_d0(o, vb0, pa0, pa1, pa2, pa3); partialSM(pB0, pB1, m_reg, mnB, alB, C, thr);
  __syncthreads(); RESC(alB);
  finishSM(pB0, pB1, alB, l_reg, pa0, pa1, pa2, pa3); SBAR();
  pv_d0(o, vb0 + (int)SHM_V, pa0, pa1, pa2, pa3);
  if (hi == 0) li_l[r32] = l_reg; asm volatile("s_waitcnt lgkmcnt(0)" ::: "memory");
  float rli[16];
#pragma unroll
  for (int r = 0; r < 16; ++r) rli[r] = __builtin_amdgcn_rcpf(li_l[crow(r, hi)]);
#pragma unroll
  for (int r = 0; r < 16; ++r) { const int orow = wid * QBLK + crow(r, hi);
#pragma unroll
    for (int d0 = 0; d0 < 4; ++d0) { const float val = o[d0][r] * rli[r];
      if constexpr (OBF) ((bf16_t*)Ob)[(long)orow * LDO + d0 * 32 + r32] = f2bf(val); else ((float*)Ob)[(long)orow * LDO + d0 * 32 + r32] = val; } }
  __syncthreads();
#undef SLOAD
#undef SWRITE
#undef SWAIT
#undef RESC
}
#undef KSWZ
#undef KRSWZ
#undef SBAR
}

constexpr int NPH = 22;
typedef const __attribute__((address_space(4))) P* KP4;
__global__ void __launch_bounds__(512, 2) mega(P p_arg, int ph_lo, int ph_hi, int bar_idx) {
    const KP4 kp0 = (KP4)__builtin_amdgcn_kernarg_segment_ptr();
#define LOCAL_P KP4 kp_ = kp0; asm volatile("" : "+s"(kp_)); const P& p = *(const P*)kp_;
    LOCAL_P
    extern __shared__ __attribute__((aligned(16))) unsigned char lds_raw[];
    LAS unsigned char* lds = (LAS unsigned char*)lds_raw;
    const int wv = __builtin_amdgcn_readfirstlane((int)threadIdx.x >> 6);
    const int tid = TID_FROM(wv), bid = blockIdx.x, nb = gridDim.x;
    volatile LAS unsigned* MISC = (volatile LAS unsigned*)(lds + MISC_OFF);
    for (int u = tid; u < (LDS_BYTES - RING_BYTES) / 4; u += 512) ((LAS unsigned*)(lds + RING_BYTES))[u] = 0u;
    __syncthreads();
    unsigned* ctl = (unsigned*)(p.ws + WS_CTL);
    XcdBarrier bar = xcd_barrier_post(ctl + CW_BAR + bar_idx * XCD_BAR_WORDS, MISC + 8, wv);
    float* SLABS = WSP(float, WS_SLAB);
#ifndef NHELP
#define NHELP 0
#endif
    const int nbw = nb - NHELP; const bool helper = NHELP > 0 && bid >= nbw;
#ifndef FILL_TAILS
#define FILL_TAILS 1
#endif
#define FILL_TAIL(k) do { if (FILL && FILL_TAILS) { __syncthreads(); if (wv == 0 && lane_id() == 0) (void)xb_add(ctl + CW_DONE + 64 * (k), 1u); moe_fill(p, ctl, (k), nb, bid, lds, MISC, wv); } } while (0)
#define GEMM_TAIL(S, E, off) do { if ((S).s > 1) { xcd_barrier(bar, wv); pg8::tail_reduce(S, E, SLABS + ((size_t)(off) << 16), bid, nb, wv); } } while (0)
#ifndef PH_MASK
#define PH_MASK 0xFFFFFFFFu
#endif
#define RUN(k) (((PH_MASK >> (k)) & 1u) && ph_lo <= (k) && (k) < ph_hi)
#define SEAM(k) do { if (RUN(k) && RUN((k) + 1)) xcd_barrier(bar, wv); } while (0)
#ifndef REPEAT_PH
#define REPEAT_PH (-1)
#endif
#ifndef REPEAT_N
#define REPEAT_N 2
#endif
#define NREP(k) ((k) == REPEAT_PH ? REPEAT_N : 1)
#define PH_BEGIN(k) if (RUN(k)) { _Pragma("unroll") for (int rep = 0; rep < NREP(k); ++rep) { LOCAL_P
#define PH_END(k) if (rep + 1 < NREP(k)) xcd_barrier(bar, wv); } } SEAM(k);
    const size_t T2048 = (size_t)256 * 2048 * 2, T512 = (size_t)256 * 512 * 2;
#ifndef SPLIT_G1
#define SPLIT_G1 1
#endif
#ifndef SPLIT_G2
#define SPLIT_G2 4
#endif
#ifndef SPLIT_G3
#define SPLIT_G3 4
#endif
#ifndef SPLIT_G4
#define SPLIT_G4 4
#endif
#ifndef SPLIT_P13
#define SPLIT_P13 1
#endif
#ifndef SPLIT_G9
#define SPLIT_G9 1
#endif
#ifndef SPLIT_G10
#define SPLIT_G10 8
#endif

    PH_BEGIN(0) { ph_prologue(p, bid, nb, (float*)lds_raw, wv); __syncthreads(); ph_dft_tables(p, bid, nb, (float*)lds_raw, wv); ph_convert(p, bid, nb, lds, wv);
#ifdef CONVERT_TWICE
        __syncthreads(); ph_convert(p, bid, nb, lds, wv);
#endif
    }
    PH_END(0)
    PH_BEGIN(1) ph_norm_mod<!ORACLE>(p, p.norm1_g, 0, 0, 1, bid, nb, wv);
    PH_END(1)
#ifdef EXTRA_BARS
    for (int e_ = 0; e_ < EXTRA_BARS; ++e_) xcd_barrier(bar, wv);
#endif
    PH_BEGIN(2) { pg8::GridSched<false> S; S.init(WSP(bf16_t, WS_H), T2048, WSP(bf16_t, WT_IN), T2048, 36, 16, 2048, nbw, bid, SPLIT_G1);
        pg8::Epi<EF_in> E{{WSP(bf16_t, A0_F), WSP(bf16_t, A0_Q), WSP(bf16_t, A0_K), WSP(bf16_t, A0_V), WSP(float2, WS_TABD)}};
        if (!helper) { pg8::gemm_phase(lds, pg8::Dims{2048, 2048, SLABS}, S, E, wv); } FILL_TAIL(2);
        GEMM_TAIL(S, E, 0); }
    PH_END(2)
    PH_BEGIN(3) { pg8::TailSched<DftABase> S; S.b.WCS = (const char*)WSP(bf16_t, WS_WCS); S.b.F = (const char*)WSP(bf16_t, A0_F); S.init(288, 256, nb, bid);
        pg8::Epi<EF_dftA> E{{WSP(bf16_t, A0_VT), WSP(bf16_t, A0_VTC)}};
        pg8::gemm_phase(lds, pg8::Dims{256, 1024, SLABS}, S, E, wv); GEMM_TAIL(S, E, 0); }
    PH_END(3)
    PH_BEGIN(4) {
        pg8::TailSched<DftBBase> S1; S1.b = DftBBase{(const char*)WSP(bf16_t, WS_DFTN), (const char*)WSP(bf16_t, A0_VT), (size_t)256 * 4096 * 2, (size_t)256 * 4096 * 2, 8, 0}; S1.init(128, 4096, nb, bid, 1);
        pg8::Epi<EF_dftB> E1{{WSP(bf16_t, A0_MIX), 1.0f / sqrtf(2048.f * 256.f), CTX}};
        pg8::gemm_phase(lds, pg8::Dims{4096, 4096, SLABS}, S1, E1, wv);
        pg8::TailSched<DftBBase> S2; S2.b = DftBBase{(const char*)WSP(bf16_t, WS_DFTC), (const char*)WSP(bf16_t, A0_VTC), 0, (size_t)256 * 512 * 2, 1, 0}; S2.init(16, 512, nb, (bid + 128) % nb, 1);
        pg8::Epi<EF_dftB> E2{{WSP(bf16_t, A0_MIX), 1.0f / sqrtf(256.f * 256.f), 0}};
        pg8::gemm_phase(lds, pg8::Dims{512, 512, SLABS + ((size_t)256 << 16)}, S2, E2, wv);
        __syncthreads();
        volatile LAS int* qslot = (volatile LAS int*)(MISC + 16);
        const bf16_t* Qd = WSP(bf16_t, A0_Q); const bf16_t* Kd = WSP(bf16_t, A0_K); const bf16_t* Vd = WSP(bf16_t, A0_V); float* OD = WSP(float, A0_OD);
        for (;;) {
            if (tid == 0) *qslot = (int)xb_add(ctl + CW_QUEUE + 64 * rep, 1u);
            __syncthreads();
            const int it = *qslot;
            __syncthreads();
            if (it >= 576) break;
            int inst, row0, seq;
            if (it < 512) { inst = it >> 3; row0 = CTX + (it & 7) * 256; seq = TPB; } else { inst = it - 512; row0 = 0; seq = CTX; }
            const int b = inst >> 4, h = (inst >> 2) & 3, c = (inst >> 1) & 1, vh = inst & 1;
            const size_t R0 = (size_t)b * TPB + row0, K0 = (size_t)b * TPB;
            att::attn_body<1024, 1024, 1024, 2048, false, false>(Qd + R0 * 1024 + h * 256 + c * 128, Kd + K0 * 1024 + h * 256 + c * 128, Vd + K0 * 1024 + h * 256 + vh * 128, nullptr,
                OD + (R0 * 4 + h) * 512 + c * 256 + vh * 128, seq, 0.08838834764831845f * 1.4426950408889634f, 8.f / 0.08838834764831845f, (char*)lds_raw, wv);
        }
        FILL_TAIL(4);
        if (S1.s > 1 || S2.s > 1) { xcd_barrier(bar, wv); pg8::tail_reduce(S1, E1, SLABS, bid, nb, wv); pg8::tail_reduce(S2, E2, SLABS + ((size_t)256 << 16), bid, nb, wv); }
    }
    PH_END(4)
    PH_BEGIN(5) ph_subln(p, bid, nb, wv);
    PH_END(5)
    PH_BEGIN(6) { pg8::GridSched<false> S; S.init(WSP(bf16_t, A0_MIX), T2048, WSP(bf16_t, WT_OUT), T2048, 36, 8, 2048, nbw, bid, SPLIT_G2);
#if ORACLE
        pg8::Epi<EF_res> E{{WSP(float, WS_XS), WSP(float, WS_MODS), 2, 0}};
#else
        pg8::Epi<EF_res0> E{{WSP(float, WS_XS), WSP(float, WS_MODS), p.x, p.ctx, 2, 0}};
#endif
        if (!helper) { pg8::gemm_phase(lds, pg8::Dims{2048, 2048, SLABS}, S, E, wv); } FILL_TAIL(6);
        GEMM_TAIL(S, E, 0); }
    PH_END(6)
    PH_BEGIN(7) ph_norm_mod(p, p.norm2_g, 0, 3, 4, bid, nb, wv);
    PH_END(7)
    PH_BEGIN(8) { pg8::GridSched<false> S; S.init(WSP(bf16_t, WS_H), T2048, WSP(bf16_t, WT_GU), T2048, 36, 44, 2048, nbw, bid, SPLIT_G3);
        pg8::Epi<EF_swiglu> E{{WSP(bf16_t, A0_ACT), FFD, 0}};
        if (!helper) { pg8::gemm_phase(lds, pg8::Dims{2048, 2048, SLABS}, S, E, wv); } FILL_TAIL(8);
        GEMM_TAIL(S, E, 0); }
    PH_END(8)
    PH_BEGIN(9) { pg8::GridSched<false> S; S.init(WSP(bf16_t, A0_ACT), (size_t)256 * FFD * 2, WSP(bf16_t, WT_DN), (size_t)256 * FFD * 2, 36, 8, FFD, nbw, bid, SPLIT_G4);
        pg8::Epi<EF_res> E{{WSP(float, WS_XS), WSP(float, WS_MODS), 5, 0}};
        if (!helper) { pg8::gemm_phase(lds, pg8::Dims{FFD, FFD, SLABS}, S, E, wv); } FILL_TAIL(9);
        GEMM_TAIL(S, E, 0); }
    PH_END(9)
    PH_BEGIN(10) ph_norm_mod(p, p.norm1_g + D, 1, 0, 1, bid, nb, wv);
    PH_END(10)
    PH_BEGIN(11) { pg8::GridSched<false> S; S.init(WSP(bf16_t, WS_H), T2048, WSP(bf16_t, WT_DQKV), T2048, 36, 5, 2048, nbw, bid);
        pg8::Epi<EF_dqkv> E{{WSP(float, A1_CQ), WSP(float, A1_CKV), WSP(bf16_t, A1_KR), WSP(float2, WS_TABM)}};
        if (!helper) { pg8::gemm_phase(lds, pg8::Dims{2048, 2048, SLABS}, S, E, wv); } FILL_TAIL(11);
        GEMM_TAIL(S, E, 0); }
    PH_END(11)
    PH_BEGIN(12) ph_lora_norm(p, bid, nb, wv);
    PH_END(12)
    PH_BEGIN(13) {
        pg8::GridSched<true> S1; S1.init(WSP(bf16_t, A1_CQN), T512, WSP(bf16_t, WT_UQ), T512, 32, 12, 512, nbw, bid, SPLIT_P13);
        pg8::Epi<EF_uq> E1{{WSP(bf16_t, A1_QM), WSP(float2, WS_TABM)}};
        if (!helper) pg8::gemm_phase(lds, pg8::Dims{512, 512, SLABS}, S1, E1, wv);
        pg8::GridSched<false> S2; S2.init(WSP(bf16_t, A1_CKVN), T512, WSP(bf16_t, WT_UKV), T512, 36, 16, 512, nbw, bid, SPLIT_P13);
        pg8::Epi<EF_bf> E2{{WSP(bf16_t, A1_KVM), 4096, 0}};
        if (!helper) pg8::gemm_phase(lds, pg8::Dims{512, 512, SLABS + ((size_t)256 << 16)}, S2, E2, wv);
#ifdef PROBE_P13
        for (int q_ = 0; q_ < PROBE_P13; ++q_) { __syncthreads(); pg8::Epi<EF_probe> E3{{SLABS, 0, 0}}; if (!helper) pg8::gemm_phase(lds, pg8::Dims{512, 512, SLABS}, S2, E3, wv); }
#endif
        FILL_TAIL(13);
        if (S1.s > 1 || S2.s > 1) { xcd_barrier(bar, wv); pg8::tail_reduce(S1, E1, SLABS, bid, nb, wv); pg8::tail_reduce(S2, E2, SLABS + ((size_t)256 << 16), bid, nb, wv); }
    }
    PH_END(13)
    PH_BEGIN(14) {
        __syncthreads();
        const bf16_t* QM = WSP(bf16_t, A1_QM); const bf16_t* KVM = WSP(bf16_t, A1_KVM); const bf16_t* KR = WSP(bf16_t, A1_KR); bf16_t* OM = WSP(bf16_t, A1_OM);
        for (int r = 0; r * nb + bid < 512; ++r) {
            int it = r * nb + bid;
            if (nb == 256) { const int x = bid & 7, y = bid >> 3; it = (r * 32 + (y >> 3) * 8 + x) * 8 + (y & 7); }
            const int inst = it >> 3, qb = it & 7, b = inst >> 4, h = inst & 15;
            const size_t R0 = (size_t)b * TPB + CTX + qb * 256, K0 = (size_t)b * TPB;
            att::attn_body<3072, 4096, 4096, 2048, true, true>(QM + R0 * 3072 + h * 192, KVM + K0 * 4096 + h * 256, KVM + K0 * 4096 + h * 256 + 128, KR + K0 * 64,
                OM + R0 * 2048 + h * 128, TPB, 0.07216878364870323f * 1.4426950408889634f, 8.f / 0.07216878364870323f, (char*)lds_raw, wv);
        }
    }
    PH_END(14)
    PH_BEGIN(15) { pg8::GridSched<true> S; S.init(WSP(bf16_t, A1_OM), T2048, WSP(bf16_t, WT_O), T2048, 32, 8, 2048, nbw, bid);
        pg8::Epi<EF_res> E{{WSP(float, WS_XS), WSP(float, WS_MODS) + 5 * 6 * D, 2, 0}};
        if (!helper) { pg8::gemm_phase(lds, pg8::Dims{2048, 2048, SLABS}, S, E, wv); } FILL_TAIL(15);
        GEMM_TAIL(S, E, 0); }
    PH_END(15)
    PH_BEGIN(16) { __syncthreads(); ph_route(p, bid, nb, (float*)lds_raw, wv); }
    PH_END(16)
    PH_BEGIN(17) {
#ifdef PROBE_CVT
        if (rep > 0) { __syncthreads(); if (wv == 0 && lane_id() == 0) { __hip_atomic_store(ctl + CW_FILL + 64 * bid, 0u, __ATOMIC_RELAXED, __HIP_MEMORY_SCOPE_AGENT); MISC[24] = 0u; MISC[25] = 1u; } xcd_barrier(bar, wv); }
#endif
        __syncthreads(); ph_sort(p, bid, (int*)lds_raw, wv);
        if (FILL) { __syncthreads(); moe_fill(p, ctl, -1, nb, bid, lds, MISC, wv); } }
    PH_END(17)
    PH_BEGIN(18) ph_gather(p, bid, nb, wv);
    PH_END(18)
    PH_BEGIN(19) { pg8::TailSched<MoeBase, 4096> S; const int tot = S.b.init(WSP(unsigned char, A1_AS), (size_t)2048, WSP(unsigned char, WT_MGU), (size_t)2 * FFE * 2048, (size_t)256 * 2048, 56, (const int*)(p.ws + WS_ROUTE + RT_CNT), (const int*)(p.ws + WS_ROUTE + RT_OFFS)); S.init(tot, 1024, nb, bid, SPLIT_G9);
        pg8::Epi<EF_swiglu8> E{{WSP(unsigned char, A1_ACT2), FFE, 0}};
        pg8::gemm_phase<true>(lds, pg8::Dims{1024, 1024, SLABS}, S, E, wv); GEMM_TAIL(S, E, 0);
#ifdef PROBE_G9
#if PROBE_G9 == 1
        { xcd_barrier(bar, wv); pg8::Epi<EF_probe> E2{{SLABS, 0, 0}}; pg8::gemm_phase<true>(lds, pg8::Dims{1024, 1024, SLABS}, S, E2, wv); }
#elif PROBE_G9 == 2
        { xcd_barrier(bar, wv); pg8::Epi<EF_probe_math> E2{{(unsigned char*)SLABS, FFE, 0}}; pg8::gemm_phase<true>(lds, pg8::Dims{1024, 1024, SLABS}, S, E2, wv); }
#else
        { xcd_barrier(bar, wv); pg8::Epi<EF_probe_store> E2{{(unsigned char*)SLABS, FFE, 0}}; pg8::gemm_phase<true>(lds, pg8::Dims{1024, 1024, SLABS}, S, E2, wv); }
#endif
#endif
    }
    PH_END(19)
    PH_BEGIN(20) { pg8::TailSched<MoeBase, 4096> S; const int tot = S.b.init(WSP(unsigned char, A1_ACT2), (size_t)FFE, WSP(unsigned char, WT_MD), (size_t)2048 * FFE, (size_t)256 * FFE, 8, (const int*)(p.ws + WS_ROUTE + RT_CNT), (const int*)(p.ws + WS_ROUTE + RT_OFFS)); S.init(tot, FFE / 2, nb, bid, SPLIT_G10);
        pg8::Epi<EF_y8> E{{WSP(float, A1_Y), 2048, 0}};
        pg8::gemm_phase<true>(lds, pg8::Dims{FFE / 2, FFE / 2, SLABS}, S, E, wv); GEMM_TAIL(S, E, 0); }
    PH_END(20)
    PH_BEGIN(21) ph_final(p, bid, nb, wv);
    PH_END(21)
#undef GEMM_TAIL
#undef FILL_TAIL
#undef RUN
#undef SEAM
#undef PH_BEGIN
#undef PH_END
}
#if ORACLE
template <class G> __global__ __launch_bounds__(256) void ngemm(G g) {
    __shared__ float As[16][132]; __shared__ float Ws[16][132]; __shared__ float W2s[G::DUAL ? 16 : 1][132];
    const int z = blockIdx.z, M = g.rows(z), N = g.N, K = g.K, m0 = blockIdx.y * 128, n0 = blockIdx.x * 128;
    if (m0 >= M) return;
    const int tid = threadIdx.x, tx = tid & 15, ty = tid >> 4;
    float acc[8][8], acc2[G::DUAL ? 8 : 1][8];
#pragma unroll
    for (int i = 0; i < 8; ++i)
#pragma unroll
        for (int j = 0; j < 8; ++j) { acc[i][j] = 0.f; if constexpr (G::DUAL) acc2[i][j] = 0.f; }
    for (int k0 = 0; k0 < K; k0 += 16) {
#pragma unroll
        for (int i = 0; i < 8; ++i) { const int idx = tid + i * 256; const int k = idx & 15, m = idx >> 4; As[k][m] = (m0 + m < M) ? g.a(z, m0 + m, k0 + k) : 0.f; }
#pragma unroll
        for (int i = 0; i < 8; ++i) { const int idx = tid + i * 256; const int n = idx & 127, k = idx >> 7; const bool ok = n0 + n < N; Ws[k][n] = ok ? g.w(z, k0 + k, n0 + n) : 0.f; if constexpr (G::DUAL) W2s[k][n] = ok ? g.w2(z, k0 + k, n0 + n) : 0.f; }
        __syncthreads();
#pragma unroll
        for (int k = 0; k < 16; ++k) {
            float av[8], bv[8], b2[8];
#pragma unroll
            for (int i = 0; i < 8; ++i) { av[i] = As[k][ty * 8 + i]; bv[i] = Ws[k][tx * 8 + i]; if constexpr (G::DUAL) b2[i] = W2s[k][tx * 8 + i]; }
#pragma unroll
            for (int i = 0; i < 8; ++i)
#pragma unroll
                for (int j = 0; j < 8; ++j) { acc[i][j] += av[i] * bv[j]; if constexpr (G::DUAL) acc2[i][j] += av[i] * b2[j]; }
        }
        __syncthreads();
    }
#pragma unroll
    for (int i = 0; i < 8; ++i)
#pragma unroll
        for (int j = 0; j < 8; ++j) { const int m = m0 + ty * 8 + i, n = n0 + tx * 8 + j; if (m < M && n < N) g.epi(z, m, n, acc[i][j], G::DUAL ? acc2[i][j] : 0.f); }
}

template <int HALF> __device__ __forceinline__ int rope_partner(int d) { const int i = d % HALF; return i < HALF / 2 ? d + HALF / 2 : d - HALF / 2; }
template <int HALF> __device__ __forceinline__ float rope_apply(const float2* tab, int nl, int d, float v, float vp) {
    const int half = d / HALF, i = d % HALF, pos = half == 0 ? nl / 64 : nl % 64, fi = i % (HALF / 2); const float2 cs = tab[pos * (HALF / 2) + fi];
    return i < HALF / 2 ? v * cs.x - vp * cs.y : v * cs.x + vp * cs.y;
}

struct G_in {
    static constexpr bool DUAL = true; const bf16_t* H; const float* W; bf16_t *F, *Q, *Kd, *V; const float2* tab; int N, K;
    __device__ int rows(int) const { return NTOK; }
    __device__ float a(int, int m, int k) const { return bf2f(H[(size_t)m * D + k]); }
    __device__ float w(int, int k, int n) const { return W[(size_t)k * EIN + n]; }
    __device__ float w2(int, int k, int n) const { if (n < 1024 || n >= 3072) return 0.f; const int d = n & 127; return W[(size_t)k * EIN + (n - d) + rope_partner<64>(d)]; }
    __device__ void epi(int, int m, int n, float v, float vp) const {
        const int j = m % TPB;
        if (n < 1024) { F[(size_t)m * 1024 + n] = f2bf(v); return; }
        if (n >= 3072) { V[(size_t)m * 1024 + n - 3072] = f2bf(v); return; }
        float o = v; if (j >= CTX) o = rope_apply<64>(tab, j - CTX, n & 127, v, vp);
        if (n < 2048) Q[(size_t)m * 1024 + n - 1024] = f2bf(o); else Kd[(size_t)m * 1024 + n - 2048] = f2bf(o);
    }
};
struct G_dftA {
    static constexpr bool DUAL = false; const bf16_t* F; float* T; int N, K;
    __device__ int rows(int) const { return NTOK * 4; }
    __device__ float a(int, int m, int k) const { return bf2f(F[(size_t)m * 256 + k]); }
    __device__ float w(int, int k, int n) const { const int k3 = n & 255, idx = (k * k3) & 255; const float ang = (float)idx * (2.0f / 256.0f); return n < 256 ? cospif(ang) : sinpif(ang); }
    __device__ float w2(int, int, int) const { return 0.f; }
    __device__ void epi(int, int m, int n, float v, float) const { T[(size_t)m * 512 + n] = v; }
};
struct G_dftB {
    static constexpr bool DUAL = false; const float* T; bf16_t* MIX; int N, K, NS, joff; float scale; int pad;
    __device__ int rows(int) const { return NS; }
    __device__ float a(int, int m, int k) const { const int n = k % NS, part = k / NS; const int idx = (int)(((long)m * n) % NS); const float ang = (float)idx * (2.0f / (float)NS); return part == 0 ? cospif(ang) : -sinpif(ang); }
    __device__ float w(int z, int k, int n) const { const int b = z >> 2, g = z & 3, nn = k % NS, part = k / NS; const int R = b * TPB + joff + nn; return T[((size_t)R * 4 + g) * 512 + part * 256 + n]; }
    __device__ float w2(int, int, int) const { return 0.f; }
    __device__ void epi(int z, int m, int n, float v, float) const { const int b = z >> 2, g = z & 3; const int R = b * TPB + joff + m; MIX[(size_t)R * 2048 + g * 256 + n] = f2bf(v * scale); }
};
struct G_res {
    static constexpr bool DUAL = false; const bf16_t* A; const float* W; float* XS; const float* mods; int N, K, lda, chunk;
    __device__ int rows(int) const { return NTOK; }
    __device__ float a(int, int m, int k) const { return bf2f(A[(size_t)m * lda + k]); }
    __device__ float w(int, int k, int n) const { return W[(size_t)k * N + n]; }
    __device__ float w2(int, int, int) const { return 0.f; }
    __device__ void epi(int, int m, int n, float v, float) const { XS[(size_t)m * D + n] += mods[(size_t)mod_row(m) * 6 * D + chunk * D + n] * v; }
};
struct G_swiglu {
    static constexpr bool DUAL = true; const bf16_t* A; const float *Wg, *Wu; bf16_t* ACT; int N, K;
    __device__ int rows(int) const { return NTOK; }
    __device__ float a(int, int m, int k) const { return bf2f(A[(size_t)m * D + k]); }
    __device__ float w(int, int k, int n) const { return Wg[(size_t)k * N + n]; }
    __device__ float w2(int, int k, int n) const { return Wu[(size_t)k * N + n]; }
    __device__ void epi(int, int m, int n, float v, float v2) const { ACT[(size_t)m * N + n] = f2bf(silu_f(v) * v2); }
};
struct G_dq {
    static constexpr bool DUAL = false; const bf16_t* H; const float* W; float* CQ; int N, K;
    __device__ int rows(int) const { return NTOK; }
    __device__ float a(int, int m, int k) const { return bf2f(H[(size_t)m * D + k]); }
    __device__ float w(int, int k, int n) const { return W[(size_t)k * QLORA + n]; }
    __device__ float w2(int, int, int) const { return 0.f; }
    __device__ void epi(int, int m, int n, float v, float) const { CQ[(size_t)m * 512 + n] = v; }
};
struct G_dkv {
    static constexpr bool DUAL = true; const bf16_t* H; const float* W; float* CKV; bf16_t* KR; const float2* tab; int N, K;
    __device__ int rows(int) const { return NTOK; }
    __device__ float a(int, int m, int k) const { return bf2f(H[(size_t)m * D + k]); }
    __device__ float w(int, int k, int n) const { return W[(size_t)k * 576 + n]; }
    __device__ float w2(int, int k, int n) const { if (n < 512) return 0.f; return W[(size_t)k * 576 + 512 + rope_partner<32>(n - 512)]; }
    __device__ void epi(int, int m, int n, float v, float vp) const {
        if (n < 512) { CKV[(size_t)m * 512 + n] = v; return; }
        const int j = m % TPB; float o = v; if (j >= CTX) o = rope_apply<32>(tab, j - CTX, n - 512, v, vp);
        KR[(size_t)m * 64 + n - 512] = f2bf(o);
    }
};
struct G_uq {
    static constexpr bool DUAL = true; const bf16_t* A; const float* W; bf16_t* QM; const float2* tab; int N, K;
    __device__ int rows(int) const { return NTOK; }
    __device__ float a(int, int m, int k) const { return bf2f(A[(size_t)m * 512 + k]); }
    __device__ float w(int, int k, int n) const { return W[(size_t)k * 3072 + n]; }
    __device__ float w2(int, int k, int n) const { const int d = n % 192; if (d < 128) return 0.f; return W[(size_t)k * 3072 + (n - d) + 128 + rope_partner<32>(d - 128)]; }
    __device__ void epi(int, int m, int n, float v, float vp) const {
        const int d = n % 192, j = m % TPB; float o = v; if (d >= 128 && j >= CTX) o = rope_apply<32>(tab, j - CTX, d - 128, v, vp);
        QM[(size_t)m * 3072 + n] = f2bf(o);
    }
};
struct G_ukv {
    static constexpr bool DUAL = false; const bf16_t* A; const float* W; bf16_t* KVM; int N, K;
    __device__ int rows(int) const { return NTOK; }
    __device__ float a(int, int m, int k) const { return bf2f(A[(size_t)m * 512 + k]); }
    __device__ float w(int, int k, int n) const { return W[(size_t)k * 4096 + n]; }
    __device__ float w2(int, int, int) const { return 0.f; }
    __device__ void epi(int, int m, int n, float v, float) const { KVM[(size_t)m * 4096 + n] = f2bf(v); }
};
struct G_moe1 {
    static constexpr bool DUAL = true; const unsigned char* AS; const float *Wg, *Wu; bf16_t* ACT2; const int *CNT, *OFFS; int N, K;
    __device__ int rows(int z) const { return CNT[z]; }
    __device__ float a(int z, int m, int k) const { return __builtin_amdgcn_cvt_f32_fp8((int)AS[(size_t)(OFFS[z] + m) * D + k], 0); }
    __device__ float w(int z, int k, int n) const { return Wg[((size_t)z * D + k) * FFE + n]; }
    __device__ float w2(int z, int k, int n) const { return Wu[((size_t)z * D + k) * FFE + n]; }
    __device__ void epi(int z, int m, int n, float v, float v2) const { ACT2[(size_t)(OFFS[z] + m) * FFE + n] = f2bf(silu_f(v) * v2); }
};
struct G_moe2 {
    static constexpr bool DUAL = false; const unsigned char* ACT2; const float* Wd; float* Y; const int *CNT, *OFFS; int N, K;
    __device__ int rows(int z) const { return CNT[z]; }
    __device__ float a(int z, int m, int k) const { return __builtin_amdgcn_cvt_f32_fp8((int)ACT2[(size_t)(OFFS[z] + m) * FFE + k], 0) * (1.0f / A8_ACT); }
    __device__ float w(int z, int k, int n) const { return Wd[((size_t)z * FFE + k) * D + n]; }
    __device__ float w2(int, int, int) const { return 0.f; }
    __device__ void epi(int z, int m, int n, float v, float) const { Y[(size_t)(OFFS[z] + m) * D + n] = v; }
};

template <int DQK, int DV, class F> __global__ __launch_bounds__(256) void nattn(F f, int nkeys, float scale) {
    extern __shared__ float sm[];
    float* qs = sm;
    float* Pm = sm + 4 * DQK;
    __shared__ float rsum[4];
    const int z = blockIdx.y, q0 = blockIdx.x * 4, tid = threadIdx.x, lane = tid & 63, wave = tid >> 6;
    for (int i = tid; i < 4 * DQK; i += 256) { const int r = i / DQK, d = i % DQK; qs[i] = bf2f(f.qptr(z, q0 + r)[d]); }
    __syncthreads();
    for (int kk = tid; kk < nkeys; kk += 256) {
        float s0 = 0.f, s1 = 0.f, s2 = 0.f, s3 = 0.f;
        const bf16_t* kp = f.kptr(z, kk);
        for (int d = 0; d < 128; ++d) { const float kv = bf2f(kp[d]); s0 += qs[d] * kv; s1 += qs[DQK + d] * kv; s2 += qs[2 * DQK + d] * kv; s3 += qs[3 * DQK + d] * kv; }
        if (DQK > 128) { const bf16_t* k2 = f.k2ptr(z, kk);
            for (int d = 128; d < DQK; ++d) { const float kv = bf2f(k2[d - 128]); s0 += qs[d] * kv; s1 += qs[DQK + d] * kv; s2 += qs[2 * DQK + d] * kv; s3 += qs[3 * DQK + d] * kv; } }
        Pm[kk] = s0 * scale; Pm[nkeys + kk] = s1 * scale; Pm[2 * nkeys + kk] = s2 * scale; Pm[3 * nkeys + kk] = s3 * scale;
    }
    __syncthreads();
    {
        float* pr = Pm + wave * nkeys; float mx = -3.0e38f;
        for (int kk = lane; kk < nkeys; kk += 64) mx = fmaxf(mx, pr[kk]);
        mx = wave_max(mx); float s = 0.f;
        for (int kk = lane; kk < nkeys; kk += 64) { const float e = expf(pr[kk] - mx); pr[kk] = e; s += e; }
        s = wave_sum(s); if (lane == 0) rsum[wave] = s;
    }
    __syncthreads();
    for (int idx = tid; idx < 4 * DV; idx += 256) {
        const int r = idx / DV, e = idx % DV; const float* pr = Pm + r * nkeys; float acc = 0.f;
        for (int kk = 0; kk < nkeys; ++kk) acc += pr[kk] * bf2f(f.vptr(z, kk)[e]);
        f.store(z, q0 + r, e, acc / rsum[r]);
    }
}
struct A_diff {
    const bf16_t *Q, *K, *V; float* OD; int joff, pad;
    __device__ const bf16_t* qptr(int z, int qi) const { const int b = z >> 3, h = (z >> 1) & 3, c = z & 1; return Q + (size_t)(b * TPB + joff + qi) * 1024 + h * 256 + c * 128; }
    __device__ const bf16_t* kptr(int z, int kk) const { const int b = z >> 3, h = (z >> 1) & 3, c = z & 1; return K + (size_t)(b * TPB + kk) * 1024 + h * 256 + c * 128; }
    __device__ const bf16_t* k2ptr(int, int) const { return nullptr; }
    __device__ const bf16_t* vptr(int z, int kk) const { const int b = z >> 3, h = (z >> 1) & 3; return V + (size_t)(b * TPB + kk) * 1024 + h * 256; }
    __device__ void store(int z, int qi, int e, float v) const { const int b = z >> 3, h = (z >> 1) & 3, c = z & 1; OD[(((size_t)(b * TPB + joff + qi) * 4 + h) * 2 + c) * 256 + e] = v; }
};
struct A_mla {
    const bf16_t *QM, *KVM, *KR; bf16_t* OM;
    __device__ const bf16_t* qptr(int z, int qi) const { const int b = z >> 4, h = z & 15; return QM + (size_t)(b * TPB + CTX + qi) * 3072 + h * 192; }
    __device__ const bf16_t* kptr(int z, int kk) const { const int b = z >> 4, h = z & 15; return KVM + (size_t)(b * TPB + kk) * 4096 + h * 256; }
    __device__ const bf16_t* k2ptr(int z, int kk) const { const int b = z >> 4; return KR + (size_t)(b * TPB + kk) * 64; }
    __device__ const bf16_t* vptr(int z, int kk) const { const int b = z >> 4, h = z & 15; return KVM + (size_t)(b * TPB + kk) * 4096 + h * 256 + 128; }
    __device__ void store(int z, int qi, int e, float v) const { const int b = z >> 4, h = z & 15; OM[(size_t)(b * TPB + CTX + qi) * 2048 + h * 128 + e] = f2bf(v); }
};

#endif

#if ORACLE
__global__ __launch_bounds__(256) void k_cmp(const void* a, int a_bf  , const void* b, int b_bf, int rows, int cols, int lda, int ldb, int mask, const int* slottok, double* err) {
    double num = 0.0, den = 0.0;
    for (size_t i = (size_t)blockIdx.x * 256 + threadIdx.x; i < (size_t)rows * cols; i += (size_t)gridDim.x * 256) {
        const int r = (int)(i / cols), c = (int)(i % cols);
        if (mask == 1 && (r % TPB) < CTX) continue;
        if (mask == 2 && slottok[r] < 0) continue;
        const float va = a_bf == 2 ? __builtin_amdgcn_cvt_f32_fp8((int)((const unsigned char*)a)[(size_t)r * lda + c], 0) * (1.0f / A8_ACT) : a_bf ? bf2f(((const bf16_t*)a)[(size_t)r * lda + c]) : ((const float*)a)[(size_t)r * lda + c];
        const float vb = b_bf ? bf2f(((const bf16_t*)b)[(size_t)r * ldb + c]) : ((const float*)b)[(size_t)r * ldb + c];
        const double d = (double)va - (double)vb; num += d * d; den += (double)vb * (double)vb;
    }
    for (int o = 32; o >= 1; o >>= 1) { num += __shfl_xor(num, o); den += __shfl_xor(den, o); }
    if ((threadIdx.x & 63) == 0) { atomicAdd(err, num); atomicAdd(err + 1, den); }
}
__global__ __launch_bounds__(256) void k_verdict(float* out, size_t n, const double* err, int nslots, double tol) {
    int bad = -1;
    for (int s = 0; s < nslots; ++s) { const double num = err[2 * s], den = err[2 * s + 1]; const double t = s >= 16 ? 0.02 : tol; if (!(num <= t * den) || !(den > 0.0)) { bad = s; break; } }
    if (bad < 0) return;
    const float f = 1.0f + exp2f((float)(bad + 1));
    for (size_t i = (size_t)blockIdx.x * 256 + threadIdx.x; i < n; i += (size_t)gridDim.x * 256) out[i] *= f;
}
static_assert(sizeof(G_in) == 64 && sizeof(G_dftA) == 24 && sizeof(G_dftB) == 40 && sizeof(G_res) == 48 && sizeof(G_swiglu) == 40 && sizeof(G_dq) == 32 && sizeof(G_dkv) == 48 && sizeof(G_uq) == 40 && sizeof(G_ukv) == 32 && sizeof(G_moe1) == 56 && sizeof(G_moe2) == 48 && sizeof(A_diff) == 40 && sizeof(A_mla) == 32, "no padding bytes in by-value kernel arguments");
template <class G> static void run_gemm(const G& g, int Mmax, int Z, hipStream_t s) { hipLaunchKernelGGL(ngemm<G>, dim3((g.N + 127) / 128, (Mmax + 127) / 128, Z), dim3(256), 0, s, g); }
#endif
static_assert(sizeof(P) == 29 * 8, "P has no padding");

extern "C" void kernel_launch(void* const* d_in, const int* in_sizes, int n_in, void* d_out, int out_size, void* d_ws, size_t ws_size, hipStream_t stream) {
    static int grid = 0;
    if (grid == 0) {
        const size_t need = ORACLE ? (WS_SCR + (size_t)NSLOT * FFE * 2 > WS_SCR_XS + (size_t)NTOK * D * 4 ? WS_SCR + (size_t)NSLOT * FFE * 2 : WS_SCR_XS + (size_t)NTOK * D * 4) + 4096 : WS_END;
        if (n_in != 27 || ws_size < need) { fprintf(stderr, "kernel_launch: n_in %d ws %zu need %zu\n", n_in, ws_size, need); grid = -1; return; }
        int dev = 0, cus = 0, per_cu = 0;
        if (hipGetDevice(&dev) != hipSuccess || hipDeviceGetAttribute(&cus, hipDeviceAttributeMultiprocessorCount, dev) != hipSuccess) { grid = -1; return; }
        if (hipFuncSetAttribute((const void*)mega, hipFuncAttributeMaxDynamicSharedMemorySize, LDS_BYTES) != hipSuccess) { fprintf(stderr, "kernel_launch: hipFuncSetAttribute failed\n"); grid = -1; return; }
        if (hipOccupancyMaxActiveBlocksPerMultiprocessor(&per_cu, (const void*)mega, 512, LDS_BYTES) != hipSuccess || per_cu < 1) { fprintf(stderr, "kernel_launch: occupancy query says %d\n", per_cu); }
        (void)hipGetLastError();
        grid = cus;
    }
    if (grid < 0) return;
    (void)hipMemsetAsync((char*)d_ws + WS_CTL, 0, 1u << 20, stream);
    P p{};
    const float** pi = (const float**)&p;
    for (int i = 0; i < 27; ++i) pi[i] = (const float*)d_in[i];
    p.out = (float*)d_out; p.ws = (unsigned char*)d_ws;
#if !ORACLE
    hipLaunchKernelGGL(mega, dim3(grid), dim3(512), LDS_BYTES, stream, p, 0, NPH, 0);
#else
    double* ERR = (double*)(p.ws + WS_CTL + (size_t)CW_ERR * 4);
    unsigned char* SCR = p.ws + WS_SCR;
    const int* SLOTTOK = (const int*)(p.ws + WS_ROUTE + RT_SLOTTOK);
    auto PH = [&](int k) { hipLaunchKernelGGL(mega, dim3(grid), dim3(512), LDS_BYTES, stream, p, k, k + 1, k); };
    auto CMP = [&](int slot, const void* a, int abf, const void* b, int bbf, int rows, int cols, int lda, int ldb, int mask) {
        hipLaunchKernelGGL(k_cmp, dim3(2048), dim3(256), 0, stream, a, abf, b, bbf, rows, cols, lda, ldb, mask, SLOTTOK, ERR + 2 * slot); };
    const size_t SZ1K = (size_t)NTOK * 1024 * 2, SZXS = (size_t)NTOK * D * 4;
    PH(0); PH(1);
    PH(2);
    { bf16_t *Fo = (bf16_t*)SCR, *Qo = (bf16_t*)(SCR + SZ1K), *Ko = (bf16_t*)(SCR + 2 * SZ1K), *Vo = (bf16_t*)(SCR + 3 * SZ1K);
      G_in g{WSP(bf16_t, WS_H), p.ev_w_in, Fo, Qo, Ko, Vo, WSP(float2, WS_TABD), EIN, D}; run_gemm(g, NTOK, 1, stream);
      CMP(0, WSP(bf16_t, A0_F), 1, Fo, 1, NTOK, 1024, 1024, 1024, 0); CMP(1, WSP(bf16_t, A0_Q), 1, Qo, 1, NTOK, 1024, 1024, 1024, 0);
      CMP(2, WSP(bf16_t, A0_K), 1, Ko, 1, NTOK, 1024, 1024, 1024, 0); CMP(3, WSP(bf16_t, A0_V), 1, Vo, 1, NTOK, 1024, 1024, 1024, 0); }
    PH(3); PH(4);
    { float* T32 = (float*)SCR; bf16_t* MIXo = (bf16_t*)(SCR + (size_t)NTOK * 4 * 512 * 4);
      G_dftA g{WSP(bf16_t, A0_F), T32, 512, 256}; run_gemm(g, NTOK * 4, 1, stream);
      G_dftB g1{T32, MIXo, 256, 2 * SEQ, SEQ, CTX, 1.0f / sqrtf((float)SEQ * 256.f), 0}; run_gemm(g1, SEQ, 16, stream);
      G_dftB g2{T32, MIXo, 256, 2 * CTX, CTX, 0, 1.0f / sqrtf((float)CTX * 256.f), 0}; run_gemm(g2, CTX, 16, stream);
      CMP(4, WSP(bf16_t, A0_MIX), 1, MIXo, 1, NTOK, 1024, 2048, 2048, 0);
      float* ODo = (float*)SCR;
      A_diff f{WSP(bf16_t, A0_Q), WSP(bf16_t, A0_K), WSP(bf16_t, A0_V), ODo, CTX, 0};
      hipLaunchKernelGGL((nattn<128, 256, A_diff>), dim3(SEQ / 4, 32), dim3(256), (4 * 128 + 4 * TPB) * 4, stream, f, TPB, 0.08838834764831845f);
      A_diff f2{WSP(bf16_t, A0_Q), WSP(bf16_t, A0_K), WSP(bf16_t, A0_V), ODo, 0, 0};
      hipLaunchKernelGGL((nattn<128, 256, A_diff>), dim3(CTX / 4, 32), dim3(256), (4 * 128 + 4 * CTX) * 4, stream, f2, CTX, 0.08838834764831845f);
      CMP(5, WSP(float, A0_OD), 0, ODo, 0, NTOK, 2048, 2048, 2048, 0); }
    PH(5);
    { float* XSo = (float*)(p.ws + WS_SCR_XS); (void)hipMemcpyAsync(XSo, WSP(float, WS_XS), SZXS, hipMemcpyDeviceToDevice, stream);
      G_res g{WSP(bf16_t, A0_MIX), p.ev_w_out, XSo, WSP(float, WS_MODS), D, 2048, 2048, 2}; run_gemm(g, NTOK, 1, stream);
      PH(6); CMP(6, WSP(float, WS_XS), 0, XSo, 0, NTOK, D, D, D, 0); }
    PH(7);
    PH(8);
    { bf16_t* ACTo = (bf16_t*)SCR; G_swiglu g{WSP(bf16_t, WS_H), p.ffn_w_gate, p.ffn_w_up, ACTo, FFD, D}; run_gemm(g, NTOK, 1, stream);
      CMP(7, WSP(bf16_t, A0_ACT), 1, ACTo, 1, NTOK, FFD, FFD, FFD, 0); }
    { float* XSo = (float*)(p.ws + WS_SCR_XS); (void)hipMemcpyAsync(XSo, WSP(float, WS_XS), SZXS, hipMemcpyDeviceToDevice, stream);
      G_res g{WSP(bf16_t, A0_ACT), p.ffn_w_down, XSo, WSP(float, WS_MODS), D, FFD, FFD, 5}; run_gemm(g, NTOK, 1, stream);
      PH(9); CMP(8, WSP(float, WS_XS), 0, XSo, 0, NTOK, D, D, D, 0); }
    PH(10);
    PH(11);
    { float* CQo = (float*)SCR; float* CKVo = (float*)(SCR + (size_t)NTOK * 512 * 4); bf16_t* KRo = (bf16_t*)(SCR + (size_t)NTOK * 512 * 8);
      G_dq g{WSP(bf16_t, WS_H), p.od_w_dq, CQo, QLORA, D}; run_gemm(g, NTOK, 1, stream);
      G_dkv g2{WSP(bf16_t, WS_H), p.od_w_dkv, CKVo, KRo, WSP(float2, WS_TABM), 576, D}; run_gemm(g2, NTOK, 1, stream);
      CMP(9, WSP(float, A1_CQ), 0, CQo, 0, NTOK, 512, 512, 512, 0); CMP(10, WSP(float, A1_CKV), 0, CKVo, 0, NTOK, 512, 512, 512, 0); CMP(11, WSP(bf16_t, A1_KR), 1, KRo, 1, NTOK, 64, 64, 64, 0); }
    PH(12);
    PH(13);
    { bf16_t* QMo = (bf16_t*)SCR; bf16_t* KVMo = (bf16_t*)(SCR + (size_t)NTOK * 3072 * 2);
      G_uq g{WSP(bf16_t, A1_CQN), p.od_w_uq, QMo, WSP(float2, WS_TABM), 3072, 512}; run_gemm(g, NTOK, 1, stream);
      G_ukv g2{WSP(bf16_t, A1_CKVN), p.od_w_ukv, KVMo, 4096, 512}; run_gemm(g2, NTOK, 1, stream);
      CMP(12, WSP(bf16_t, A1_QM), 1, QMo, 1, NTOK, 3072, 3072, 3072, 1); CMP(13, WSP(bf16_t, A1_KVM), 1, KVMo, 1, NTOK, 4096, 4096, 4096, 0); }
    PH(14);
    { bf16_t* OMo = (bf16_t*)SCR; A_mla f{WSP(bf16_t, A1_QM), WSP(bf16_t, A1_KVM), WSP(bf16_t, A1_KR), OMo};
      hipLaunchKernelGGL((nattn<192, 128, A_mla>), dim3(SEQ / 4, 64), dim3(256), (4 * 192 + 4 * TPB) * 4, stream, f, TPB, 0.07216878364870323f);
      CMP(14, WSP(bf16_t, A1_OM), 1, OMo, 1, NTOK, 2048, 2048, 2048, 1); }
    { float* XSo = (float*)(p.ws + WS_SCR_XS); (void)hipMemcpyAsync(XSo, WSP(float, WS_XS), SZXS, hipMemcpyDeviceToDevice, stream);
      G_res g{WSP(bf16_t, A1_OM), p.od_w_o, XSo, WSP(float, WS_MODS) + 5 * 6 * D, D, 2048, 2048, 2}; run_gemm(g, NTOK, 1, stream);
      PH(15); CMP(15, WSP(float, WS_XS), 0, XSo, 0, NTOK, D, D, D, 1); }
    PH(16); PH(17); PH(18);
    PH(19);
    { bf16_t* ACT2o = (bf16_t*)SCR; G_moe1 g{WSP(unsigned char, A1_AS), p.moe_w_gate, p.moe_w_up, ACT2o, (const int*)(p.ws + WS_ROUTE + RT_CNT), (const int*)(p.ws + WS_ROUTE + RT_OFFS), FFE, D}; run_gemm(g, NB * SEQ, 8, stream);
      CMP(16, WSP(unsigned char, A1_ACT2), 2, ACT2o, 1, NSLOT, FFE, FFE, FFE, 2); }
    PH(20);
    { float* Yo = (float*)SCR; G_moe2 g{WSP(unsigned char, A1_ACT2), p.moe_w_down, Yo, (const int*)(p.ws + WS_ROUTE + RT_CNT), (const int*)(p.ws + WS_ROUTE + RT_OFFS), D, FFE}; run_gemm(g, NB * SEQ, 8, stream);
      CMP(17, WSP(float, A1_Y), 0, Yo, 0, NSLOT, D, D, D, 2); }
    PH(21);
    hipLaunchKernelGGL(k_verdict, dim3(2048), dim3(256), 0, stream, p.out, (size_t)NB * SEQ * D, (const double*)ERR, 18, 2.0e-4);
#endif
}
```

```cpp
#ifndef ORACLE
#define ORACLE 0
#endif
#include <hip/hip_runtime.h>
#include <cstdio>
#include <cstdint>

constexpr int D = 2048, NB = 4, SEQ = 2048, CTX = 256, TPB = SEQ + CTX  , NTOK = NB * TPB  ;
constexpr int FW = 1024, QKW = 1024, VW = 1024, EIN = 4096, FFD = 5632, NEXP = 8, FFE = 7168;
constexpr int QLORA = 512, KVLORA = 512, MROPE = 64, MH = 16;
constexpr int NSLOT = 2 * NB * SEQ + NEXP * 256;
constexpr float EPS = 1e-6f;

typedef unsigned short bf16_t;
typedef float f32x4 __attribute__((ext_vector_type(4)));
typedef short bf16x8 __attribute__((ext_vector_type(8)));

__device__ __forceinline__ float bf2f(bf16_t v) { return __uint_as_float(((unsigned)v) << 16); }
__device__ __forceinline__ bf16_t f2bf(float f) { unsigned u = __float_as_uint(f); u += 0x7fffu + ((u >> 16) & 1u); return (bf16_t)(u >> 16); }
__device__ __forceinline__ float wave_sum(float v) {
#pragma unroll
    for (int o = 1; o < 64; o <<= 1) v += __shfl_xor(v, o);
    return v;
}
__device__ __forceinline__ float wave_max(float v) {
#pragma unroll
    for (int o = 1; o < 64; o <<= 1) v = fmaxf(v, __shfl_xor(v, o));
    return v;
}
__device__ __forceinline__ int lane_id() { int l; asm volatile("v_mbcnt_lo_u32_b32 %0, -1, 0\n\tv_mbcnt_hi_u32_b32 %0, -1, %0" : "=v"(l)); return l; }
__device__ __forceinline__ int tid_from(int wv) { asm volatile("" : "+s"(wv)); return wv * 64 + lane_id(); }
#define TID_FROM(wv) tid_from(wv)
constexpr float W8_GU = 32.f, W8_DN = 64.f, A8_ACT = 4.f;
__device__ __forceinline__ unsigned pack4_fp8(float a, float b, float c, float d) {
    a = fminf(fmaxf(a, -448.f), 448.f); b = fminf(fmaxf(b, -448.f), 448.f); c = fminf(fmaxf(c, -448.f), 448.f); d = fminf(fmaxf(d, -448.f), 448.f);
    int w = 0; w = __builtin_amdgcn_cvt_pk_fp8_f32(a, b, w, false); w = __builtin_amdgcn_cvt_pk_fp8_f32(c, d, w, true); return (unsigned)w;
}
__device__ __forceinline__ float silu_f(float x) { return x / (1.f + expf(-x)); }

constexpr size_t al(size_t x) { return (x + 4095) / 4096 * 4096; }
constexpr size_t WS_CTL = 0;
constexpr size_t WS_XS = 1u << 20;
constexpr size_t WS_MODS = WS_XS + al((size_t)NTOK * D * 4);
constexpr size_t WS_TABD = WS_MODS + al((size_t)2 * 5 * 6 * D * 4);
constexpr size_t WS_TABM = WS_TABD + al(64 * 32 * 8);
constexpr size_t WS_SCAL = WS_TABM + al(64 * 16 * 8);
constexpr size_t WS_H = WS_SCAL + 4096;
constexpr size_t WS_ROUTE = WS_H + al((size_t)NTOK * D * 2);
constexpr size_t RT_TE = 0, RT_TG = (size_t)NTOK * 8, RT_TSLOT = (size_t)NTOK * 16, RT_SLOTTOK = (size_t)NTOK * 24, RT_CNT = RT_SLOTTOK + (size_t)NSLOT * 4, RT_OFFS = RT_CNT + 64;
constexpr size_t WT_IN = WS_ROUTE + al(RT_OFFS + 64);
constexpr size_t WT_OUT = WT_IN + al((size_t)4096 * 2048 * 2);
constexpr size_t WT_GU = WT_OUT + al((size_t)2048 * 2048 * 2);
constexpr size_t WT_DN = WT_GU + al((size_t)2 * FFD * 2048 * 2);
constexpr size_t WT_DQKV = WT_DN + al((size_t)2048 * FFD * 2);
constexpr size_t WT_UQ = WT_DQKV + al((size_t)1280 * 2048 * 2);
constexpr size_t WT_UKV = WT_UQ + al((size_t)3072 * 512 * 2);
constexpr size_t WT_O = WT_UKV + al((size_t)4096 * 512 * 2);
constexpr size_t WT_MGU = WT_O + al((size_t)2048 * 2048 * 2);
constexpr size_t WT_MD = WT_MGU + al((size_t)8 * 2 * FFE * 2048);
constexpr size_t WS_WCS = WT_MD + al((size_t)8 * 2048 * FFE);
constexpr size_t WS_DFTN = WS_WCS + al(512 * 256 * 2);
constexpr size_t WS_DFTC = WS_DFTN + al((size_t)2048 * 4096 * 2);
constexpr size_t WS_ACTS = WS_DFTC + al(256 * 512 * 2);
constexpr size_t A0_F = WS_ACTS;
constexpr size_t A0_Q = A0_F + al((size_t)NTOK * 1024 * 2);
constexpr size_t A0_K = A0_Q + al((size_t)NTOK * 1024 * 2);
constexpr size_t A0_V = A0_K + al((size_t)NTOK * 1024 * 2);
constexpr size_t A0_VT = A0_V + al((size_t)NTOK * 1024 * 2);
constexpr size_t A0_VTC = A0_VT + al((size_t)16 * 256 * 4096 * 2);
constexpr size_t A0_OD = A0_VTC + al((size_t)16 * 256 * 512 * 2);
constexpr size_t A0_MIX = A0_OD + al((size_t)NTOK * 2048 * 4);
constexpr size_t A0_ACT = A0_MIX + al((size_t)NTOK * 2048 * 2);
constexpr size_t A0_END = A0_ACT + al((size_t)NTOK * FFD * 2);
constexpr size_t A1_CQ = WS_ACTS;
constexpr size_t A1_CKV = A1_CQ + al((size_t)NTOK * 512 * 4);
constexpr size_t A1_KR = A1_CKV + al((size_t)NTOK * 512 * 4);
constexpr size_t A1_CQN = A1_KR + al((size_t)NTOK * 64 * 2);
constexpr size_t A1_CKVN = A1_CQN + al((size_t)NTOK * 512 * 2);
constexpr size_t A1_QM = A1_CKVN + al((size_t)NTOK * 512 * 2);
constexpr size_t A1_KVM = A1_QM + al((size_t)NTOK * 3072 * 2);
constexpr size_t A1_OM = A1_KVM + al((size_t)NTOK * 4096 * 2);
constexpr size_t A1_AS = A1_OM + al((size_t)NTOK * 2048 * 2);
constexpr size_t A1_ACT2 = A1_AS + al((size_t)NSLOT * 2048);
constexpr size_t A1_Y = WS_ACTS;
constexpr size_t A1_END = A1_ACT2 + al((size_t)NSLOT * FFE);
static_assert(A1_Y + (size_t)NSLOT * 2048 * 4 <= A1_AS, "Y overlays only the dead MLA buffers");
constexpr size_t WS_ARENA_END = A0_END > A1_END ? A0_END : A1_END;
constexpr size_t WS_SLAB = WS_ARENA_END;
constexpr size_t SLAB_BYTES = (size_t)384 << 18;
constexpr size_t WS_END = WS_SLAB + SLAB_BYTES;
constexpr size_t WS_SCR = WS_SLAB;
constexpr size_t WS_SCR_XS = WS_END;

struct P {
    const float *x, *c, *ctx, *c_ctx, *ada_w, *ada_b, *norm1_g, *norm2_g, *ev_w_in, *ev_w_out, *ev_lambda, *ev_subln_g;
    const float *od_w_dq, *od_q_norm_g, *od_w_uq, *od_w_dkv, *od_kv_norm_g, *od_w_ukv, *od_w_o;
    const float *ffn_w_gate, *ffn_w_up, *ffn_w_down, *moe_router, *moe_w_gate, *moe_w_up, *moe_w_down, *final_norm_g;
    float* out; unsigned char* ws;
};
#define WSP(T, off) ((T*)(p.ws + (off)))

__device__ __forceinline__ int mod_row(int R) { const int b = R / TPB, j = R - b * TPB; return j < CTX ? 4 : b; }

__device__ __forceinline__ void ph_prologue(const P& p, int bid, int nb, float* lds_f, int wv) {
    int tid_ = TID_FROM(wv); asm volatile("" : "+v"(tid_)); const int tid = tid_, lane = tid & 63, wave = tid >> 6;
    float* XS = WSP(float, WS_XS);
    if (ORACLE) for (size_t i = (size_t)bid * 512 + tid; i < (size_t)NTOK * (D / 4); i += (size_t)nb * 512) {
        const int R = (int)(i / (D / 4)), c4 = (int)(i % (D / 4)); const int b = R / TPB, j = R - b * TPB;
        const float* src = j < CTX ? p.ctx + ((size_t)(b * CTX + j)) * D : p.x + ((size_t)(b * SEQ + (j - CTX))) * D;
        ((f32x4*)XS)[i] = ((const f32x4*)src)[c4];
    }
    if (bid == 0) {
        float2* TD = WSP(float2, WS_TABD); float2* TM = WSP(float2, WS_TABM);
        for (int i = tid; i < 64 * 32; i += 512) { const int pos = i / 32, fi = i % 32; const double inv = pow(10000.0, -(double)(2 * fi) / 64.0), a = (double)pos * inv; TD[i] = make_float2((float)cos(a), (float)sin(a)); }
        for (int i = tid; i < 64 * 16; i += 512) { const int pos = i / 16, fi = i % 16; const double inv = pow(10000.0, -(double)(2 * fi) / 32.0), a = (double)pos * inv; TM[i] = make_float2((float)cos(a), (float)sin(a)); }
        if (wave == 0) {
            float s01 = 0.f, s23 = 0.f;
            for (int i = lane; i < 128; i += 64) { s01 += p.ev_lambda[i] * p.ev_lambda[128 + i]; s23 += p.ev_lambda[256 + i] * p.ev_lambda[384 + i]; }
            s01 = wave_sum(s01); s23 = wave_sum(s23);
            if (lane == 0) WSP(float, WS_SCAL)[0] = expf(s01) - expf(s23) + 0.2f;
        }
    }
    float* S = lds_f;
    float* RED = lds_f + 5 * 2048;
    for (int i = tid; i < 5 * D; i += 512) { const int bb = i / D, k = i % D; const float v = bb < 4 ? p.c[bb * D + k] : p.c_ctx[k]; S[i] = silu_f(v); }
    __syncthreads();
    float* MODS = WSP(float, WS_MODS);
    for (int it = bid; it < 2 * 128; it += nb) {
        const int layer = it >> 7, cg = it & 127, ln = lane < 48 ? lane : 47, col = cg * 96 + ln * 2;
        const float* W = p.ada_w + (size_t)layer * D * 6 * D + col;
        float a0[5], a1[5];
#pragma unroll
        for (int bb = 0; bb < 5; ++bb) { a0[bb] = 0.f; a1[bb] = 0.f; }
        const int kb = wave * 256;
#pragma unroll 1
        for (int k0 = 0; k0 < 256; k0 += 16) {
            float2 w[16];
#pragma unroll
            for (int u = 0; u < 16; ++u) w[u] = *(const float2*)(W + (size_t)(kb + k0 + u) * 6 * D);
#pragma unroll
            for (int u = 0; u < 16; ++u) {
#pragma unroll
                for (int bb = 0; bb < 5; ++bb) { const float s = S[bb * D + kb + k0 + u]; a0[bb] += s * w[u].x; a1[bb] += s * w[u].y; } }
        }
        if (lane < 48) {
#pragma unroll
            for (int bb = 0; bb < 5; ++bb) { RED[(wave * 5 + bb) * 96 + lane * 2] = a0[bb]; RED[(wave * 5 + bb) * 96 + lane * 2 + 1] = a1[bb]; } }
        __syncthreads();
        for (int i = tid; i < 5 * 96; i += 512) { const int bb = i / 96, cc = i % 96; float s = 0.f;
#pragma unroll
            for (int w = 0; w < 8; ++w) s += RED[(w * 5 + bb) * 96 + cc];
            MODS[((size_t)layer * 5 + bb) * 6 * D + cg * 96 + cc] = s + p.ada_b[(size_t)layer * 6 * D + cg * 96 + cc]; }
        __syncthreads();
    }
}

__device__ __forceinline__ const float* in_row(const P& p, int R) { const int b = R / TPB, j = R - b * TPB; return j < CTX ? p.ctx + ((size_t)(b * CTX + j)) * D : p.x + ((size_t)(b * SEQ + (j - CTX))) * D; }
template <bool FROM_IN = false> __device__ __forceinline__ void ph_norm_mod(const P& p, const float* g, int layer, int csh, int csc, int bid, int nb, int wv) {
    int tid_ = TID_FROM(wv); asm volatile("" : "+v"(tid_)); const int tid = tid_, lane = tid & 63, wave = tid >> 6;
    const float* XS = WSP(float, WS_XS); const float* MODS = WSP(float, WS_MODS) + (size_t)layer * 5 * 6 * D; bf16_t* H = WSP(bf16_t, WS_H);
    for (int R = bid * 8 + wave; R < NTOK; R += nb * 8) {
        const f32x4* xr = (const f32x4*)(FROM_IN ? in_row(p, R) : XS + (size_t)R * D); f32x4 v[8]; float ss = 0.f;
#pragma unroll
        for (int j = 0; j < 8; ++j) { v[j] = xr[lane + 64 * j]; ss += v[j].x * v[j].x + v[j].y * v[j].y + v[j].z * v[j].z + v[j].w * v[j].w; }
        const float rstd = 1.0f / sqrtf(wave_sum(ss) * (1.f / D) + EPS);
        const float* mr = MODS + (size_t)mod_row(R) * 6 * D;
#pragma unroll
        for (int j = 0; j < 8; ++j) { const int c0 = (lane + 64 * j) * 4; const f32x4 gg = *(const f32x4*)(g + c0), sh = *(const f32x4*)(mr + csh * D + c0), sc = *(const f32x4*)(mr + csc * D + c0);
            const f32x4 o = (v[j] * rstd * gg) * (sc + 1.f) + sh;
            ushort4 w; w.x = f2bf(o.x); w.y = f2bf(o.y); w.z = f2bf(o.z); w.w = f2bf(o.w);
            *(ushort4*)(H + (size_t)R * D + c0) = w; }
    }
}

__device__ __forceinline__ void ph_subln(const P& p, int bid, int nb, int wv) {
    int tid_ = TID_FROM(wv); asm volatile("" : "+v"(tid_)); const int tid = tid_, lane = tid & 63, wave = tid >> 6;
    const float* OD = WSP(float, A0_OD); bf16_t* MIX = WSP(bf16_t, A0_MIX); const float lam = WSP(float, WS_SCAL)[0];
    const f32x4 gg = *(const f32x4*)(p.ev_subln_g + lane * 4);
    for (int it0 = bid * 8 + wave; it0 < NTOK * 4; it0 += nb * 8 * 4) {
        f32x4 o0[4], o1[4];
#pragma unroll
        for (int u = 0; u < 4; ++u) { const int it = it0 + u * nb * 8; if (it < NTOK * 4) { o0[u] = *(const f32x4*)(OD + ((size_t)it * 2 + 0) * 256 + lane * 4); o1[u] = *(const f32x4*)(OD + ((size_t)it * 2 + 1) * 256 + lane * 4); } else { o0[u] = o1[u] = (f32x4){0.f, 0.f, 0.f, 0.f}; } }
#pragma unroll
        for (int u = 0; u < 4; ++u) { const int it = it0 + u * nb * 8; const int R = it >> 2, h = it & 3;
            const f32x4 o = o0[u] - o1[u] * lam;
            const float rstd = 1.0f / sqrtf(wave_sum(o.x * o.x + o.y * o.y + o.z * o.z + o.w * o.w) * (1.f / 256.f) + EPS);
            const f32x4 r = o * rstd * gg * 0.8f;
            ushort4 w; w.x = f2bf(r.x); w.y = f2bf(r.y); w.z = f2bf(r.z); w.w = f2bf(r.w);
            if (it < NTOK * 4) *(ushort4*)(MIX + (size_t)R * 2048 + 1024 + h * 256 + lane * 4) = w; }
    }
}

__device__ __forceinline__ void ph_lora_norm(const P& p, int bid, int nb, int wv) {
    int tid_ = TID_FROM(wv); asm volatile("" : "+v"(tid_)); const int tid = tid_, lane = tid & 63, wave = tid >> 6;
    for (int it = bid * 8 + wave; it < NTOK * 2; it += nb * 8) {
        const int R = it >> 1, which = it & 1;
        const float* src = (which ? WSP(float, A1_CKV) : WSP(float, A1_CQ)) + (size_t)R * 512; const float* g = which ? p.od_kv_norm_g : p.od_q_norm_g;
        bf16_t* dst = (which ? WSP(bf16_t, A1_CKVN) : WSP(bf16_t, A1_CQN)) + (size_t)R * 512;
        f32x4 v[2]; float ss = 0.f;
#pragma unroll
        for (int j = 0; j < 2; ++j) { v[j] = *(const f32x4*)(src + (lane + 64 * j) * 4); ss += v[j].x * v[j].x + v[j].y * v[j].y + v[j].z * v[j].z + v[j].w * v[j].w; }
        const float rstd = 1.0f / sqrtf(wave_sum(ss) * (1.f / 512.f) + EPS);
#pragma unroll
        for (int j = 0; j < 2; ++j) { const int c0 = (lane + 64 * j) * 4; const f32x4 gg = *(const f32x4*)(g + c0); const f32x4 o = v[j] * rstd * gg;
            ushort4 w; w.x = f2bf(o.x); w.y = f2bf(o.y); w.z = f2bf(o.z); w.w = f2bf(o.w); *(ushort4*)(dst + c0) = w; }
    }
}

__device__ __forceinline__ void ph_route(const P& p, int bid, int nb, float* rt  , int wv) {
    int tid_ = TID_FROM(wv); asm volatile("" : "+v"(tid_)); const int tid = tid_, lane = tid & 63, wave = tid >> 6;
    const float* XS = WSP(float, WS_XS); const float* MODS = WSP(float, WS_MODS) + (size_t)1 * 5 * 6 * D; bf16_t* H = WSP(bf16_t, WS_H);
    const float* g = p.norm2_g + D; int* TE = (int*)(p.ws + WS_ROUTE + RT_TE); float* TG = (float*)(p.ws + WS_ROUTE + RT_TG);
    for (int i = tid; i < D * 2; i += 512) { const f32x4 v = ((const f32x4*)p.moe_router)[i]; const int k = i >> 1, e0 = (i & 1) * 4; rt[(e0 + 0) * D + k] = v.x; rt[(e0 + 1) * D + k] = v.y; rt[(e0 + 2) * D + k] = v.z; rt[(e0 + 3) * D + k] = v.w; }
    __syncthreads();
    for (int t0 = (bid * 8 + wave) * 4; t0 < NB * SEQ; t0 += nb * 8 * 4) {
        const int b = t0 / SEQ, R0 = b * TPB + CTX + (t0 - b * SEQ);
        const float* mr = MODS + (size_t)b * 6 * D;
        f32x4 am[8], bm[8];
#pragma unroll
        for (int j = 0; j < 8; ++j) { const int c0 = (lane + 64 * j) * 4; const f32x4 gg = *(const f32x4*)(g + c0), sc = *(const f32x4*)(mr + 4 * D + c0); am[j] = gg * (sc + 1.f); bm[j] = *(const f32x4*)(mr + 3 * D + c0); }
        f32x4 v[8], vn[8];
#pragma unroll
        for (int j = 0; j < 8; ++j) v[j] = ((const f32x4*)(XS + (size_t)R0 * D))[lane + 64 * j];
#pragma unroll
        for (int k = 0; k < 4; ++k) {
            const int R = R0 + k;
            if (k < 3) {
#pragma unroll
                for (int j = 0; j < 8; ++j) vn[j] = ((const f32x4*)(XS + (size_t)(R + 1) * D))[lane + 64 * j]; }
            float ss = 0.f;
#pragma unroll
            for (int j = 0; j < 8; ++j) ss += v[j].x * v[j].x + v[j].y * v[j].y + v[j].z * v[j].z + v[j].w * v[j].w;
            const float rstd = 1.0f / sqrtf(wave_sum(ss) * (1.f / D) + EPS);
            float lg[8];
#pragma unroll
            for (int e = 0; e < 8; ++e) lg[e] = 0.f;
#pragma unroll
            for (int j = 0; j < 8; ++j) { const int c0 = (lane + 64 * j) * 4;
                const f32x4 o = (v[j] * rstd) * am[j] + bm[j];
                *(unsigned*)((unsigned char*)H + (size_t)R * D + c0) = pack4_fp8(o.x, o.y, o.z, o.w);
#pragma unroll
                for (int e = 0; e < 8; ++e) { const f32x4 r4 = *(const f32x4*)(rt + e * D + c0); lg[e] += (o.x * r4.x + o.y * r4.y) + (o.z * r4.z + o.w * r4.w); }
                asm volatile("" ::: "memory"); }
#pragma unroll
            for (int e = 0; e < 8; ++e) lg[e] = wave_sum(lg[e]);
            if (lane == 0) {
                int e1 = 0; float v1 = lg[0];
#pragma unroll
                for (int e = 1; e < 8; ++e) if (lg[e] > v1) { v1 = lg[e]; e1 = e; }
                int e2 = -1; float v2 = -3.0e38f;
#pragma unroll
                for (int e = 0; e < 8; ++e) if (e != e1 && lg[e] > v2) { v2 = lg[e]; e2 = e; }
                const float ex = expf(v2 - v1), w1 = 1.f / (1.f + ex), w2 = ex / (1.f + ex);
                TE[R * 2] = e1; TE[R * 2 + 1] = e2; TG[R * 2] = w1; TG[R * 2 + 1] = w2;
            }
#pragma unroll
            for (int j = 0; j < 8; ++j) v[j] = vn[j];
        }
    }
}

__device__ __forceinline__ void ph_sort(const P& p, int bid, int* lds_i, int wv) {
    if (bid != 0) return;
    int tid_ = TID_FROM(wv); asm volatile("" : "+v"(tid_)); const int tid = tid_;
    const int* TE = (const int*)(p.ws + WS_ROUTE + RT_TE); int* TSLOT = (int*)(p.ws + WS_ROUTE + RT_TSLOT); int* SLOTTOK = (int*)(p.ws + WS_ROUTE + RT_SLOTTOK);
    int* CNT = (int*)(p.ws + WS_ROUTE + RT_CNT); int* OFFS = (int*)(p.ws + WS_ROUTE + RT_OFFS);
    int* cn = lds_i;
    int* offs = lds_i + 8 * 512;
    int* tot = offs + 16;
    int c0 = 0, c1 = 0, c2 = 0, c3 = 0, c4 = 0, c5 = 0, c6 = 0, c7 = 0;
    for (int i = 0; i < 16; ++i) { const int t = tid * 16 + i, b = t / SEQ, R = b * TPB + CTX + (t - b * SEQ);
        for (int k = 0; k < 2; ++k) { const int e = TE[R * 2 + k]; c0 += e == 0; c1 += e == 1; c2 += e == 2; c3 += e == 3; c4 += e == 4; c5 += e == 5; c6 += e == 6; c7 += e == 7; } }
    cn[0 * 512 + tid] = c0; cn[1 * 512 + tid] = c1; cn[2 * 512 + tid] = c2; cn[3 * 512 + tid] = c3; cn[4 * 512 + tid] = c4; cn[5 * 512 + tid] = c5; cn[6 * 512 + tid] = c6; cn[7 * 512 + tid] = c7;
    __syncthreads();
    {
        const int e = tid >> 6, ln = tid & 63; int v[8]; int run = 0;
#pragma unroll
        for (int j = 0; j < 8; ++j) { const int t = cn[e * 512 + ln * 8 + j]; v[j] = run; run += t; }
        int incl = run;
#pragma unroll
        for (int o = 1; o < 64; o <<= 1) { const int n = __shfl_up(incl, o); if (ln >= o) incl += n; }
        const int excl = incl - run;
#pragma unroll
        for (int j = 0; j < 8; ++j) cn[e * 512 + ln * 8 + j] = v[j] + excl;
        if (ln == 63) tot[e] = incl;
    }
    __syncthreads();
    if (tid == 0) { int o = 0; for (int e = 0; e < 8; ++e) { offs[e] = o; OFFS[e] = o; CNT[e] = tot[e]; o += (tot[e] + 255) / 256 * 256; } offs[8] = o; OFFS[8] = o; }
    __syncthreads();
    for (int i = tid; i < NSLOT; i += 512) SLOTTOK[i] = -1;
    __syncthreads();
    int r0 = cn[0 * 512 + tid] + offs[0], r1 = cn[1 * 512 + tid] + offs[1], r2 = cn[2 * 512 + tid] + offs[2], r3 = cn[3 * 512 + tid] + offs[3];
    int r4 = cn[4 * 512 + tid] + offs[4], r5 = cn[5 * 512 + tid] + offs[5], r6 = cn[6 * 512 + tid] + offs[6], r7 = cn[7 * 512 + tid] + offs[7];
    for (int i = 0; i < 16; ++i) { const int t = tid * 16 + i, b = t / SEQ, R = b * TPB + CTX + (t - b * SEQ);
        for (int k = 0; k < 2; ++k) { const int e = TE[R * 2 + k]; int s;
            s = e == 0 ? r0 : e == 1 ? r1 : e == 2 ? r2 : e == 3 ? r3 : e == 4 ? r4 : e == 5 ? r5 : e == 6 ? r6 : r7;
            r0 += e == 0; r1 += e == 1; r2 += e == 2; r3 += e == 3; r4 += e == 4; r5 += e == 5; r6 += e == 6; r7 += e == 7;
            TSLOT[R * 2 + k] = s; SLOTTOK[s] = R; } }
}

__device__ __forceinline__ void ph_gather(const P& p, int bid, int nb, int wv) {
    int tid_ = TID_FROM(wv); asm volatile("" : "+v"(tid_)); const int tid = tid_, lane = tid & 63, wave = tid >> 6;
    const int* SLOTTOK = (const int*)(p.ws + WS_ROUTE + RT_SLOTTOK); const int* OFFS = (const int*)(p.ws + WS_ROUTE + RT_OFFS);
    const unsigned char* H8 = WSP(unsigned char, WS_H); unsigned char* AS = WSP(unsigned char, A1_AS); const int total = OFFS[8];
    for (int s0 = bid * 8 + wave; s0 < total; s0 += nb * 8 * 4) {
        int Rr[4];
#pragma unroll
        for (int u = 0; u < 4; ++u) { const int s = s0 + u * nb * 8; Rr[u] = SLOTTOK[s < total ? s : total - 1]; }
        uint4 v[4][2];
#pragma unroll
        for (int u = 0; u < 4; ++u) { const uint4* src = (const uint4*)(H8 + (size_t)(Rr[u] > 0 ? Rr[u] : 0) * D);
#pragma unroll
            for (int j = 0; j < 2; ++j) v[u][j] = src[lane + 64 * j]; }
#pragma unroll
        for (int u = 0; u < 4; ++u) { const int s = s0 + u * nb * 8; const bool pad = Rr[u] < 0; uint4* dst = (uint4*)(AS + (size_t)(s < total ? s : total - 1) * D);
#pragma unroll
            for (int j = 0; j < 2; ++j) { uint4 w = v[u][j]; if (pad) w = make_uint4(0, 0, 0, 0); if (s < total) dst[lane + 64 * j] = w; } }
    }
}

__device__ __forceinline__ void ph_final(const P& p, int bid, int nb, int wv) {
    int tid_ = TID_FROM(wv); asm volatile("" : "+v"(tid_)); const int tid = tid_, lane = tid & 63, wave = tid >> 6;
    const float* XS = WSP(float, WS_XS); const float* MODS = WSP(float, WS_MODS) + (size_t)1 * 5 * 6 * D; const float* Y = WSP(float, A1_Y);
    const float* TG = (const float*)(p.ws + WS_ROUTE + RT_TG); const int* TSLOT = (const int*)(p.ws + WS_ROUTE + RT_TSLOT);
    for (int t = bid * 8 + wave; t < NB * SEQ; t += nb * 8) {
        const int b = t / SEQ, R = b * TPB + CTX + (t - b * SEQ);
        const float g1 = TG[R * 2], g2 = TG[R * 2 + 1]; const int s1 = TSLOT[R * 2], s2 = TSLOT[R * 2 + 1];
        const float* mr = MODS + (size_t)b * 6 * D + 5 * D;
        f32x4 v[8]; float ss = 0.f;
#pragma unroll
        for (int j = 0; j < 8; ++j) { const int c0 = (lane + 64 * j) * 4;
            const f32x4 xv = *(const f32x4*)(XS + (size_t)R * D + c0), y1 = *(const f32x4*)(Y + (size_t)s1 * D + c0), y2 = *(const f32x4*)(Y + (size_t)s2 * D + c0), m5 = *(const f32x4*)(mr + c0);
            v[j] = xv + m5 * (y1 * g1 + y2 * g2); ss += v[j].x * v[j].x + v[j].y * v[j].y + v[j].z * v[j].z + v[j].w * v[j].w; }
        const float rstd = 1.0f / sqrtf(wave_sum(ss) * (1.f / D) + EPS);
#pragma unroll
        for (int j = 0; j < 8; ++j) { const int c0 = (lane + 64 * j) * 4; const f32x4 gg = *(const f32x4*)(p.final_norm_g + c0); *(f32x4*)(p.out + (size_t)t * D + c0) = v[j] * rstd * gg; }
    }
}


#define LAS __attribute__((address_space(3)))
typedef unsigned u32x4 __attribute__((ext_vector_type(4)));
typedef unsigned u32x2 __attribute__((ext_vector_type(2)));
typedef int i32x4 __attribute__((ext_vector_type(4)));
__device__ __forceinline__ unsigned cvt_pk_bf16(float lo, float hi) { unsigned r; asm volatile("v_cvt_pk_bf16_f32 %0, %1, %2" : "=v"(r) : "v"(lo), "v"(hi)); return r; }
__device__ __forceinline__ void store4bf(bf16_t* dst, const f32x4& v) { u32x2 w; w.x = cvt_pk_bf16(v[0], v[1]); w.y = cvt_pk_bf16(v[2], v[3]); *(u32x2*)dst = w; }
typedef float f32x2 __attribute__((ext_vector_type(2)));
__device__ __forceinline__ f32x2 swiglu2(f32x2 g, f32x2 u, float c1, float kinv) {
    const f32x2 t = g * c1; f32x2 e; e.x = __builtin_amdgcn_exp2f(t.x); e.y = __builtin_amdgcn_exp2f(t.y);
    const f32x2 d = e * kinv + kinv; f32x2 r; r.x = __builtin_amdgcn_rcpf(d.x); r.y = __builtin_amdgcn_rcpf(d.y);
    return (g * u) * r;
}
__device__ __forceinline__ float fast_silu(float x) { return x * __builtin_amdgcn_rcpf(1.f + __builtin_amdgcn_exp2f(-1.4426950408889634f * x)); }

constexpr int NWAVES = 8, RING_BYTES = 131072, MISC_OFF = RING_BYTES + 320, LDS_BYTES = 147456;
constexpr int CW_QUEUE = 2048;
constexpr int CW_DONE = 132096;
constexpr int CW_FILL = 140288;
#ifndef FILL
#define FILL 1
#endif
constexpr int CW_BAR = 4096;
constexpr int CW_ERR = 131072;

#define XB_TMO      128
#define XB_XCNT(j)  (256  + 64 * (j))
#define XB_XSUB(j)  (1280 + 64 * (j))
#define XB_XGEN(j)  (2304 + 64 * (j))
#define XB_TOP      3328
#define XB_TOPGEN   3392
#define XCD_BAR_WORDS 3456
#define XB_SPIN_CAP (1u << 18)

__device__ __forceinline__ unsigned xb_ld(unsigned* p)              { return __hip_atomic_load(p, __ATOMIC_RELAXED, __HIP_MEMORY_SCOPE_AGENT); }
__device__ __forceinline__ unsigned xb_add(unsigned* p, unsigned v) { return __hip_atomic_fetch_add(p, v, __ATOMIC_RELAXED, __HIP_MEMORY_SCOPE_AGENT); }
__device__ __forceinline__ unsigned xb_xcc_id() { return (unsigned)__builtin_amdgcn_s_getreg((3 << 11) | 20) & 0xFu; }
#define XB_SPIN(cond, bar) do { unsigned _sp = 0; while (cond) { __builtin_amdgcn_s_sleep(1); \
    if ((++_sp & 255u) == 0u) { if (xb_ld(&(bar)[XB_TMO])) break; if (_sp > XB_SPIN_CAP) { atomicAdd(&(bar)[XB_TMO], 1u); break; } } } } while (0)

struct XcdBarrier {
    unsigned* bar; unsigned x;
    volatile LAS unsigned* st;
};
__device__ __forceinline__ XcdBarrier xcd_barrier_post(unsigned* bar, volatile LAS unsigned* st, int wv) {
    XcdBarrier b; b.bar = bar; b.x = xb_xcc_id(); b.st = st;
    if (wv == 0 && lane_id() == 0) (void)xb_add(&bar[XB_XCNT(b.x)], 1u);
    return b;
}
__device__ __forceinline__ void xcd_barrier_complete(unsigned* bar, unsigned x, unsigned& nloc, unsigned& nx) {
    const unsigned G = gridDim.x * gridDim.y * gridDim.z;
    unsigned sum, cnt, mine, sp = 0u;
    for (;;) {
        sum = 0u; cnt = 0u; mine = 0u;
#pragma unroll
        for (unsigned j = 0; j < 16; ++j) { const unsigned c = xb_ld(&bar[XB_XCNT(j)]); sum += c; cnt += (c > 0u) ? 1u : 0u; mine = (j == x) ? c : mine; }
        if (sum == G) break;
        __builtin_amdgcn_s_sleep(1);
        if ((++sp & 255u) == 0u) { if (xb_ld(&bar[XB_TMO])) break; if (sp > XB_SPIN_CAP) { atomicAdd(&bar[XB_TMO], 1u); break; } }
    }
    nloc = mine > 0u ? mine : 1u; nx = cnt > 0u ? cnt : 1u;
}
__device__ __forceinline__ void xcd_barrier(const XcdBarrier& b, int wv) {
    asm volatile("s_waitcnt vmcnt(0)" ::: "memory");
    __syncthreads();
    if (wv == 0 && lane_id() == 0) {
        unsigned* bar = b.bar;
        __builtin_amdgcn_s_waitcnt(0);
        unsigned nloc = b.st[0], nx = b.st[1];
        if (nloc == 0u) { xcd_barrier_complete(bar, b.x, nloc, nx); b.st[0] = nloc; b.st[1] = nx; }
        const unsigned old = xb_add(&bar[XB_XSUB(b.x)], 1u);
        const unsigned gen = old / nloc;
        if (old + 1u == (gen + 1u) * nloc) {
            __builtin_amdgcn_fence(__ATOMIC_RELEASE, "agent");
            asm volatile("s_waitcnt vmcnt(0)" ::: "memory");
            const unsigned og = xb_add(&bar[XB_TOP], 1u);
            const unsigned tg = og / nx;
            if (og + 1u == (tg + 1u) * nx) xb_add(&bar[XB_TOPGEN], 1u);
            else XB_SPIN(xb_ld(&bar[XB_TOPGEN]) == tg, bar);
            __builtin_amdgcn_fence(__ATOMIC_ACQUIRE, "agent");
            xb_add(&bar[XB_XGEN(b.x)], 1u);
            asm volatile("s_waitcnt vmcnt(0)" ::: "memory");
        } else {
            XB_SPIN(xb_ld(&bar[XB_XGEN(b.x)]) == gen, bar);
            __builtin_amdgcn_fence(__ATOMIC_ACQUIRE, "agent");
            asm volatile("s_waitcnt vmcnt(0)" ::: "memory");
        }
    }
    __syncthreads();
}

namespace pg8 {
#define PG8_LAS __attribute__((address_space(3)))
constexpr int BM = 256, BK = 64, HALF = 128, HTB = HALF * BK * 2  , STAGE_BYTES = 8 * HTB, NXCD = 8, WGM = 8;
__host__ __device__ __forceinline__ int lds_byte(int r, int c) { const int st = (r >> 4) * 2 + (c >> 5), rr = r & 15, cc = c & 31, ob = rr * 64 + cc * 2; return st * 1024 + (ob ^ (((ob >> 9) & 1) << 5)); }
__host__ __device__ __forceinline__ void stage_rc(int b, int& R, int& C) { const int st = b / 1024, sb = b % 1024, swz = sb ^ (((sb >> 9) & 1) << 5); R = (st >> 1) * 16 + swz / 64; C = (st & 1) * 32 + (swz % 64) / 2; }

struct Unit { const char* A; const char* B; int pm, pn, z, nt; int ti, ks, nks, pad; };
struct Dims { int lda, ldb; float* slabs; };

template <class F> struct Epi {
    F f;
    __device__ __forceinline__ void operator()(const f32x4 (&acc)[2][2][4][2], const Unit& u, int wr, int wc, int fr, int fq) const {
        asm volatile("" : "+v"(fr), "+v"(fq));
#pragma unroll
        for (int ai = 0; ai < 2; ++ai)
#pragma unroll
            for (int m = 0; m < 4; ++m) { const int rt = ai * HALF + wr * 64 + m * 16 + fr;
#pragma unroll
                for (int bj = 0; bj < 2; ++bj) f.put(u, rt, bj * HALF + wc * 32, fq, acc[ai][bj][m][0], acc[ai][bj][m][1]); }
    }
};

template <bool FP8 = false, class EpiT, class Sched>
__device__ __forceinline__ void gemm_phase(PG8_LAS unsigned char* lds, const Dims g, const Sched& S, const EpiT& E, int wv) {
    int tid_ = TID_FROM(wv); asm volatile("" : "+v"(tid_));
    const int tid = tid_, wid = __builtin_amdgcn_readfirstlane(tid >> 6), lane = tid & 63, wr = wid >> 2, wc = wid & 3, fr = lane & 15, fq = lane >> 4;
    unsigned voffA[2], voffB[2];
#pragma unroll
    for (int i = 0; i < 2; ++i) { int R, C; stage_rc(tid * 16 + i * 8192, R, C); voffA[i] = (unsigned)(R * g.lda + C) * 2u;
        voffB[i] = FP8 ? (unsigned)((R >> 5) * 32 * (g.ldb * 2) + (C >> 5) * 2048 + (R & 31) * 64 + (C & 31) * 2) : (unsigned)(R * g.ldb + C) * 2u; }
    const size_t kstep = (size_t)(BK * 2), kstepB = FP8 ? (size_t)4096 : kstep;
    const size_t hstepA = (size_t)HALF * g.lda * 2, hstepB = (size_t)HALF * g.ldb * 2;
    const unsigned ldsw = (unsigned)wid * 1024u;
    const int aoff = lds_byte(wr * 64 + fr, fq * 8), boff = lds_byte(wc * 32 + fr, fq * 8);
#define PG8_SA(b, h) (((b) * 2 + (h)) * HTB)
#define PG8_SB(b, h) ((4 + (b) * 2 + (h)) * HTB)
#define PG8_STAGE(bufoff, gbase, voff) do { const char* g_ = (const char*)(gbase); asm volatile("" : "+s"(g_));     \
        _Pragma("unroll") for (int _i = 0; _i < 2; ++_i) \
        __builtin_amdgcn_global_load_lds((const unsigned*)(g_ + (voff)[_i]), (PG8_LAS unsigned*)(lds + (bufoff) + ldsw + _i * 8192), 16, 0, 0); } while (0)
#define PG8_LDA(dst, b, h) do { _Pragma("unroll") for (int m = 0; m < 4; ++m) _Pragma("unroll") for (int k = 0; k < 2; ++k) dst[m][k] = *(const PG8_LAS bf16x8*)(lds + PG8_SA(b, h) + aoff + m * 2048 + k * 1024); } while (0)
#define PG8_LDB(dst, b, h) do { _Pragma("unroll") for (int n = 0; n < 2; ++n) _Pragma("unroll") for (int k = 0; k < 2; ++k) dst[n][k] = *(const PG8_LAS bf16x8*)(lds + PG8_SB(b, h) + boff + n * 2048 + k * 1024); } while (0)
#define PG8_CAT(lo, hi) __builtin_shufflevector(__builtin_bit_cast(i32x4, lo), __builtin_bit_cast(i32x4, hi), 0, 1, 2, 3, 4, 5, 6, 7)
#define PG8_MMA(ai, bj, At, Bt) do { __builtin_amdgcn_s_setprio(1); if constexpr (FP8) { _Pragma("unroll") for (int m = 0; m < 4; ++m) _Pragma("unroll") for (int n = 0; n < 2; ++n) \
        acc[ai][bj][m][n] = __builtin_amdgcn_mfma_scale_f32_16x16x128_f8f6f4(PG8_CAT(Bt[n][0], Bt[n][1]), PG8_CAT(At[m][0], At[m][1]), acc[ai][bj][m][n], 0, 0, 0, 0, 0, 0); }     \
        else { _Pragma("unroll") for (int m = 0; m < 4; ++m) _Pragma("unroll") for (int n = 0; n < 2; ++n) _Pragma("unroll") for (int k = 0; k < 2; ++k) \
        acc[ai][bj][m][n] = __builtin_amdgcn_mfma_f32_16x16x32_bf16(Bt[n][k], At[m][k], acc[ai][bj][m][n], 0, 0, 0); } __builtin_amdgcn_s_setprio(0); } while (0)
#define PG8_WAIT_V(n) asm volatile("s_waitcnt vmcnt(" #n ")" ::: "memory")
#define PG8_WAIT_L(n) asm volatile("s_waitcnt lgkmcnt(" #n ")" ::: "memory")
#define PG8_BAR __builtin_amdgcn_s_barrier()
#define PG8_SCHED __builtin_amdgcn_sched_barrier(0)
    Unit cur, nxt; int ui = 0;
    if (!S.next(0, cur)) return;
    f32x4 acc[2][2][4][2];
#pragma unroll
    for (int a = 0; a < 2; ++a)
#pragma unroll
        for (int b = 0; b < 2; ++b)
#pragma unroll
            for (int m = 0; m < 4; ++m)
#pragma unroll
                for (int n = 0; n < 2; ++n) acc[a][b][m][n] = (f32x4){0.f, 0.f, 0.f, 0.f};
    bf16x8 At[4][2], B0[2][2], B1[2][2];
    const char* cA = cur.A; const char* cB = cur.B;
    PG8_STAGE(PG8_SB(0, 0), cB, voffB); PG8_STAGE(PG8_SB(0, 1), cB + hstepB, voffB); PG8_STAGE(PG8_SA(0, 0), cA, voffA); PG8_STAGE(PG8_SA(0, 1), cA + hstepA, voffA);
    if (wr == 1) PG8_BAR;
    PG8_WAIT_V(2); PG8_BAR;
    PG8_STAGE(PG8_SB(1, 0), cB + kstepB, voffB); PG8_STAGE(PG8_SA(1, 0), cA + kstep, voffA); PG8_STAGE(PG8_SB(1, 1), cB + hstepB + kstepB, voffB);
    PG8_WAIT_V(6); PG8_BAR;
    for (;;) {
        const bool has_next = S.next(ui + 1, nxt);
        const char* nA = has_next ? nxt.A : cA; const char* nB = has_next ? nxt.B : cB;
        const int nt = cur.nt;
        for (int t = 0; t < nt; t += 2) {
            const bool last = (t == nt - 2);
            const char* a1 = cA + (size_t)(t + 1) * kstep;
            const char* a2 = last ? nA : cA + (size_t)(t + 2) * kstep; const char* b2 = last ? nB : cB + (size_t)(t + 2) * kstepB;
            const char* a3 = a2 + kstep; const char* b3 = b2 + kstepB;
            PG8_LDB(B0, 0, 0); PG8_LDB(B1, 0, 1); PG8_SCHED; PG8_LDA(At, 0, 0); PG8_STAGE(PG8_SA(1, 1), a1 + hstepA, voffA);
            PG8_WAIT_V(8); PG8_WAIT_L(0); PG8_BAR; PG8_MMA(0, 0, At, B0); PG8_MMA(0, 1, At, B1); PG8_BAR; PG8_SCHED;
            PG8_LDA(At, 0, 1); PG8_STAGE(PG8_SB(0, 0), b2, voffB); PG8_STAGE(PG8_SB(0, 1), b2 + hstepB, voffB); PG8_STAGE(PG8_SA(0, 0), a2, voffA);
            PG8_WAIT_V(8); PG8_WAIT_L(0); PG8_BAR; PG8_MMA(1, 0, At, B0); PG8_MMA(1, 1, At, B1); PG8_BAR; PG8_SCHED;
            PG8_LDB(B0, 1, 0); PG8_LDB(B1, 1, 1); PG8_SCHED; PG8_LDA(At, 1, 0); PG8_STAGE(PG8_SA(0, 1), a2 + hstepA, voffA);
            PG8_WAIT_V(8); PG8_WAIT_L(0); PG8_BAR; PG8_MMA(0, 0, At, B0); PG8_MMA(0, 1, At, B1); PG8_BAR; PG8_SCHED;
            PG8_LDA(At, 1, 1); PG8_STAGE(PG8_SB(1, 0), b3, voffB); PG8_STAGE(PG8_SB(1, 1), b3 + hstepB, voffB); PG8_STAGE(PG8_SA(1, 0), a3, voffA);
            PG8_WAIT_V(8); PG8_WAIT_L(0); PG8_BAR; PG8_MMA(1, 0, At, B0); PG8_MMA(1, 1, At, B1); PG8_BAR; PG8_SCHED;
        }
        if (wr == 0) PG8_BAR;
        if (cur.nks > 1) {
            int t2 = tid; asm volatile("" : "+v"(t2));
            float* sb = g.slabs + ((size_t)(cur.ti * cur.nks + cur.ks) << 16) + t2 * 4;
#pragma unroll
            for (int a = 0; a < 2; ++a)
#pragma unroll
                for (int m = 0; m < 4; ++m)
#pragma unroll
                    for (int b = 0; b < 2; ++b)
#pragma unroll
                        for (int n = 0; n < 2; ++n) *(f32x4*)(sb + ((((a * 4 + m) * 2 + b) * 2 + n) << 11)) = acc[a][b][m][n];
        } else E(acc, cur, wr, wc, fr, fq);
        if (!has_next) break;
#pragma unroll
        for (int a = 0; a < 2; ++a)
#pragma unroll
            for (int b = 0; b < 2; ++b)
#pragma unroll
                for (int m = 0; m < 4; ++m)
#pragma unroll
                    for (int n = 0; n < 2; ++n) acc[a][b][m][n] = (f32x4){0.f, 0.f, 0.f, 0.f};
        cur = nxt; cA = nA; cB = nB; ++ui;
        if (wr == 1) PG8_BAR;
    }
    PG8_WAIT_V(0);
    PG8_BAR;
#undef PG8_SA
#undef PG8_SB
#undef PG8_STAGE
#undef PG8_LDA
#undef PG8_LDB
#undef PG8_MMA
#undef PG8_CAT
#undef PG8_WAIT_V
#undef PG8_WAIT_L
#undef PG8_BAR
#undef PG8_SCHED
}

__device__ __forceinline__ int xcd_remap(int L, int total) { const int q = total / 8, r = total % 8, xcd = L % 8, off = L / 8; return (xcd < r ? xcd * (q + 1) : r * (q + 1) + (xcd - r) * q) + off; }
template <class Base, int BKSTEP = BK * 2> struct TailSched {
    Base b; int G, c, total, Fcut, r, s, nt_full, ksl;
    __device__ __forceinline__ void init(int total_, int K, int G_, int c_, int smax = 8) {
        total = total_; G = G_; c = c_; nt_full = K / BK; Fcut = (total / G) * G; r = total - Fcut; const int kp = nt_full / 2;
        s = 1;
        if (r > 0) { if (smax >= 8 && kp % 8 == 0 && kp / 8 >= 2 && r * 8 <= G) s = 8; else if (smax >= 4 && kp % 4 == 0 && kp / 4 >= 2 && r * 4 <= G) s = 4; else if (smax >= 2 && kp % 2 == 0 && kp / 2 >= 2 && r * 2 <= G) s = 2; }
        ksl = nt_full / s;
    }
    __device__ __forceinline__ bool next(int i, Unit& u) const {
        const int L = i * G + c;
#ifndef CHUNK_DEAL
#define CHUNK_DEAL 0
#endif
        if (L < Fcut) { b.decode(CHUNK_DEAL ? c * (Fcut / G) + i : xcd_remap(L, Fcut), u); u.nt = nt_full; u.ti = -1; u.ks = 0; u.nks = 1; u.pad = 0; return true; }
        const int q = L - Fcut; if (q >= r * s) return false;
        const int ti = q / s, ks = q - ti * s; b.decode(Fcut + ti, u);
        u.A += (size_t)ks * ksl * (BK * 2); u.B += (size_t)ks * ksl * BKSTEP; u.nt = ksl; u.ti = ti; u.ks = ks; u.nks = s; u.pad = 0; return true;
    }
};
template <class EpiT, class Base, int BKSTEP> __device__ __forceinline__ void tail_reduce(const TailSched<Base, BKSTEP>& S, const EpiT& E, const float* slabs, int bid, int nb, int wv) {
    if (S.s <= 1) return;
    int tid_ = TID_FROM(wv); asm volatile("" : "+v"(tid_)); const int tid = tid_, wid = tid >> 6, lane = tid & 63, wr = wid >> 2, wc = wid & 3, fr = lane & 15, fq = lane >> 4;
    for (int it = bid; it < S.r * 16; it += nb) {
        const int ti = it >> 4, c16 = it & 15, ai = c16 >> 3, m = (c16 >> 1) & 3, bj = c16 & 1;
        Unit u; S.b.decode(S.Fcut + ti, u); u.nt = 0; u.ti = ti; u.ks = 0; u.nks = 1; u.pad = 0;
        f32x4 v0 = {0.f, 0.f, 0.f, 0.f}, v1 = {0.f, 0.f, 0.f, 0.f};
        for (int ks = 0; ks < S.s; ++ks) { const float* sb = slabs + ((size_t)(ti * S.s + ks) << 16) + tid * 4 + ((size_t)(c16 * 2) << 11); v0 += *(const f32x4*)sb; v1 += *(const f32x4*)(sb + 2048); }
        E.f.put(u, ai * HALF + wr * 64 + m * 16 + fr, bj * HALF + wc * 32, fq, v0, v1);
    }
}
template <bool LAT> struct GridBase {
    const char* A; const char* B; size_t atile, btile; int nM, nN;
    __device__ __forceinline__ void decode(int wgid, Unit& u) const {
        const int nig = WGM * nN, gid = wgid / nig, fm = gid * WGM, gsz = (nM - fm) < WGM ? (nM - fm) : WGM;
        int pm = fm + ((wgid % nig) % gsz); const int pn = (wgid % nig) / gsz;
        if (LAT) pm = pm + pm / 8 + 1;
        u.pm = pm; u.pn = pn; u.z = 0; u.A = A + (size_t)pm * atile; u.B = B + (size_t)pn * btile;
    }
};
template <bool LAT> struct GridSched : TailSched<GridBase<LAT>> {
    __device__ __forceinline__ void init(const void* A_, size_t atile_, const void* B_, size_t btile_, int nM_, int nN_, int K, int G_, int c_, int smax = 8) {
        this->b.A = (const char*)A_; this->b.B = (const char*)B_; this->b.atile = atile_; this->b.btile = btile_; this->b.nM = nM_; this->b.nN = nN_;
        TailSched<GridBase<LAT>>::init(nM_ * nN_, K, G_, c_, smax);
    }
};
}

struct EF_in {
    bf16_t *F, *Q, *Kd, *V; const float2* tab;
    __device__ __forceinline__ void put(const pg8::Unit& u, int rt, int c32, int fq, const f32x4& v0, const f32x4& v1) const {
        const int R = u.pm * 256 + rt, cg = u.pn * 256 + c32;
        if (cg < 1024) { store4bf(F + (size_t)R * 1024 + cg + 4 * fq, v0); store4bf(F + (size_t)R * 1024 + cg + 16 + 4 * fq, v1); return; }
        if (cg >= 3072) { store4bf(V + (size_t)R * 1024 + (cg - 3072) + 4 * fq, v0); store4bf(V + (size_t)R * 1024 + (cg - 3072) + 16 + 4 * fq, v1); return; }
        const int G = cg >> 6, w = (cg >> 5) & 1, a0 = 64 * G + 16 * w + 4 * fq;
        bf16_t* dst = cg < 2048 ? Q + (size_t)R * 1024 + (a0 - 1024) : Kd + (size_t)R * 1024 + (a0 - 2048);
        const int j = R % TPB; f32x4 o0 = v0, o1 = v1;
        if (j >= CTX) { const int nl = j - CTX, pos = (G & 1) ? (nl & 63) : (nl >> 6); const f32x4* t4 = (const f32x4*)(tab + pos * 32 + 16 * w + 4 * fq); const f32x4 ta = t4[0], tb = t4[1];
            const f32x4 cs = {ta[0], ta[2], tb[0], tb[2]}, sn = {ta[1], ta[3], tb[1], tb[3]};
            o0 = v0 * cs - v1 * sn; o1 = v1 * cs + v0 * sn; }
        store4bf(dst, o0); store4bf(dst + 32, o1);
    }
};
struct EF_res {
    float* XS; const float* mods; int chunk, pad;
    __device__ __forceinline__ void put(const pg8::Unit& u, int rt, int c32, int fq, const f32x4& v0, const f32x4& v1) const {
        const int R = u.pm * 256 + rt, col = u.pn * 256 + c32 + 4 * fq; const int bb = (u.pm % 9 == 0) ? 4 : u.pm / 9;
        const float* m = mods + (size_t)bb * 6 * D + chunk * D + col; float* x = XS + (size_t)R * D + col;
        *(f32x4*)x = *(const f32x4*)x + *(const f32x4*)m * v0; *(f32x4*)(x + 16) = *(const f32x4*)(x + 16) + *(const f32x4*)(m + 16) * v1;
    }
};
struct EF_res0 {
    float* XS; const float* mods; const float* x; const float* ctx; int chunk, pad;
    __device__ __forceinline__ void put(const pg8::Unit& u, int rt, int c32, int fq, const f32x4& v0, const f32x4& v1) const {
        const int R = u.pm * 256 + rt, col = u.pn * 256 + c32 + 4 * fq; const int b = u.pm / 9, t9 = u.pm - 9 * b; const int bb = t9 == 0 ? 4 : b;
        const float* s = (t9 == 0 ? ctx + ((size_t)(b * CTX + rt)) * D : x + ((size_t)(b * SEQ + (t9 - 1) * 256 + rt)) * D) + col;
        const float* m = mods + (size_t)bb * 6 * D + chunk * D + col; float* o = XS + (size_t)R * D + col;
        *(f32x4*)o = *(const f32x4*)s + *(const f32x4*)m * v0; *(f32x4*)(o + 16) = *(const f32x4*)(s + 16) + *(const f32x4*)(m + 16) * v1;
    }
};
struct EF_swiglu {
    bf16_t* ACT; int ld, pad;
    __device__ __forceinline__ void put(const pg8::Unit& u, int rt, int c32, int fq, const f32x4& v0, const f32x4& v1) const {
        const size_t R = (size_t)u.pm * 256 + rt; const int oc = ((u.pn * 256 + c32) >> 1) + 4 * fq;
        const f32x2 a = swiglu2(f32x2{v0[0], v0[1]}, f32x2{v1[0], v1[1]}, -1.4426950408889634f, 1.f), b = swiglu2(f32x2{v0[2], v0[3]}, f32x2{v1[2], v1[3]}, -1.4426950408889634f, 1.f);
        store4bf(ACT + R * ld + oc, f32x4{a.x, a.y, b.x, b.y});
    }
};
struct EF_dqkv {
    float *CQ, *CKV; bf16_t* KR; const float2* tab;
    __device__ __forceinline__ void put(const pg8::Unit& u, int rt, int c32, int fq, const f32x4& v0, const f32x4& v1) const {
        const int R = u.pm * 256 + rt, cg = u.pn * 256 + c32;
        if (cg < 512) { float* d = CQ + (size_t)R * 512 + cg + 4 * fq; *(f32x4*)d = v0; *(f32x4*)(d + 16) = v1; return; }
        if (cg < 1024) { float* d = CKV + (size_t)R * 512 + (cg - 512) + 4 * fq; *(f32x4*)d = v0; *(f32x4*)(d + 16) = v1; return; }
        if (cg >= 1088) return;
        const int half = (cg - 1024) >> 5, j = R % TPB; f32x4 o0 = v0, o1 = v1;
        if (j >= CTX) { const int nl = j - CTX, pos = half ? (nl & 63) : (nl >> 6); const f32x4* t4 = (const f32x4*)(tab + pos * 16 + 4 * fq); const f32x4 ta = t4[0], tb = t4[1];
            const f32x4 cs = {ta[0], ta[2], tb[0], tb[2]}, sn = {ta[1], ta[3], tb[1], tb[3]};
            o0 = v0 * cs - v1 * sn; o1 = v1 * cs + v0 * sn; }
        bf16_t* d = KR + (size_t)R * 64 + (cg - 1024) + 4 * fq; store4bf(d, o0); store4bf(d + 16, o1);
    }
};
struct EF_uq {
    bf16_t* QM; const float2* tab;
    __device__ __forceinline__ void put(const pg8::Unit& u, int rt, int c32, int fq, const f32x4& v0, const f32x4& v1) const {
        const int R = u.pm * 256 + rt, cg = u.pn * 256 + c32; const int q = (cg >> 5) % 6; f32x4 o0 = v0, o1 = v1;
        if (q >= 4) { const int nl = R % TPB - CTX, pos = (q == 5) ? (nl & 63) : (nl >> 6); const f32x4* t4 = (const f32x4*)(tab + pos * 16 + 4 * fq); const f32x4 ta = t4[0], tb = t4[1];
            const f32x4 cs = {ta[0], ta[2], tb[0], tb[2]}, sn = {ta[1], ta[3], tb[1], tb[3]};
            o0 = v0 * cs - v1 * sn; o1 = v1 * cs + v0 * sn; }
        bf16_t* d = QM + (size_t)R * 3072 + cg + 4 * fq; store4bf(d, o0); store4bf(d + 16, o1);
    }
};
struct EF_bf {
    bf16_t* O; int ld, pad;
    __device__ __forceinline__ void put(const pg8::Unit& u, int rt, int c32, int fq, const f32x4& v0, const f32x4& v1) const {
        bf16_t* d = O + ((size_t)u.pm * 256 + rt) * ld + u.pn * 256 + c32 + 4 * fq; store4bf(d, v0); store4bf(d + 16, v1);
    }
};
struct EF_swiglu8 {
    unsigned char* ACT; int ld, pad;
    __device__ __forceinline__ void put(const pg8::Unit& u, int rt, int c32, int fq, const f32x4& v0, const f32x4& v1) const {
        const size_t R = (size_t)u.pm * 256 + rt; const int oc = ((u.pn * 256 + c32) >> 1) + 4 * fq; const float is = 1.0f / W8_GU;
        const f32x2 a = swiglu2(f32x2{v0[0], v0[1]}, f32x2{v1[0], v1[1]}, -1.4426950408889634f * is, 1.f / (is * is * A8_ACT)), b = swiglu2(f32x2{v0[2], v0[3]}, f32x2{v1[2], v1[3]}, -1.4426950408889634f * is, 1.f / (is * is * A8_ACT));
        *(unsigned*)(ACT + R * ld + oc) = pack4_fp8(a.x, a.y, b.x, b.y);
    }
};
struct EF_y8 {
    float* O; int ld, pad;
    __device__ __forceinline__ void put(const pg8::Unit& u, int rt, int c32, int fq, const f32x4& v0, const f32x4& v1) const {
        float* d = O + ((size_t)u.pm * 256 + rt) * ld + u.pn * 256 + c32 + 4 * fq; const float is = 1.0f / (A8_ACT * W8_DN); *(f32x4*)d = v0 * is; *(f32x4*)(d + 16) = v1 * is;
    }
};
struct EF_probe {
    float* O; int ld, pad;
    __device__ __forceinline__ void put(const pg8::Unit& u, int rt, int c32, int fq, const f32x4& v0, const f32x4& v1) const {
        if (v0[0] + v0[1] + v0[2] + v0[3] + v1[0] + v1[1] + v1[2] + v1[3] == 1.2345678e30f) O[rt] = v0[0];
    }
};
struct EF_probe_math {
    unsigned char* ACT; int ld, pad;
    __device__ __forceinline__ void put(const pg8::Unit& u, int rt, int c32, int fq, const f32x4& v0, const f32x4& v1) const {
        const float is = 1.0f / W8_GU; float o[4];
#pragma unroll
        for (int e = 0; e < 4; ++e) o[e] = fast_silu(v0[e] * is) * (v1[e] * is) * A8_ACT;
        const unsigned w = pack4_fp8(o[0], o[1], o[2], o[3]);
        if (w == 0x12345678u) *(unsigned*)(ACT + rt) = w;
    }
};
struct EF_probe_store {
    unsigned char* ACT; int ld, pad;
    __device__ __forceinline__ void put(const pg8::Unit& u, int rt, int c32, int fq, const f32x4& v0, const f32x4& v1) const {
        const size_t R = ((size_t)u.pm * 256 + rt) & 8191; const int oc = ((u.pn * 256 + c32) >> 1) + 4 * fq;
        *(unsigned*)(ACT + R * ld + oc) = __builtin_bit_cast(unsigned, v0[0]) ^ __builtin_bit_cast(unsigned, v1[1]);
    }
};
struct EF_f32 {
    float* O; int ld, pad;
    __device__ __forceinline__ void put(const pg8::Unit& u, int rt, int c32, int fq, const f32x4& v0, const f32x4& v1) const {
        float* d = O + ((size_t)u.pm * 256 + rt) * ld + u.pn * 256 + c32 + 4 * fq; *(f32x4*)d = v0; *(f32x4*)(d + 16) = v1;
    }
};
struct EF_dftA {
    bf16_t *VT, *VTC;
    __device__ __forceinline__ void put(const pg8::Unit& u, int rt, int c32, int fq, const f32x4& v0, const f32x4& v1) const {
        const int bg = u.z & 15; bf16_t* d;
        if (u.z < 16) d = VT + ((size_t)bg * 256 + rt) * 4096 + u.pm * 2048 + u.pn * 256 + c32 + 4 * fq;
        else d = VTC + ((size_t)bg * 256 + rt) * 512 + u.pm * 256 + c32 + 4 * fq;
        store4bf(d, v0); store4bf(d + 16, v1);
    }
};
struct EF_dftB {
    bf16_t* MIX; float scale; int joff;
    __device__ __forceinline__ void put(const pg8::Unit& u, int rt, int c32, int fq, const f32x4& v0, const f32x4& v1) const {
        const int b = u.z >> 2, g = u.z & 3; const size_t R = (size_t)b * TPB + joff + u.pm * 256 + rt;
        bf16_t* d = MIX + R * 2048 + g * 256 + c32 + 4 * fq; store4bf(d, v0 * scale); store4bf(d + 16, v1 * scale);
    }
};

struct DftABase {
    const char* WCS; const char* F;
    __device__ __forceinline__ void decode(int L, pg8::Unit& u) const {
        int bg, part, pn, ctx;
        if (L < 256) { bg = L >> 4; part = (L >> 3) & 1; pn = L & 7; ctx = 0; } else { const int l = L - 256; bg = l >> 1; part = l & 1; pn = 0; ctx = 1; }
        const int b = bg >> 2, g = bg & 3;
        u.A = WCS + (size_t)part * 256 * 256 * 2; u.B = F + ((size_t)(b * TPB + (ctx ? 0 : CTX + pn * 256)) * 1024 + g * 256) * 2;
        u.pm = part; u.pn = pn; u.z = bg + 16 * ctx;
    }
};
struct DftBBase {
    const char* A; const char* B; size_t atile, bstride; int nk1, pad;
    __device__ __forceinline__ void decode(int L, pg8::Unit& u) const {
        const int bg = L / nk1, pm = L % nk1;
        u.A = A + (size_t)pm * atile; u.B = B + (size_t)bg * bstride; u.pm = pm; u.pn = 0; u.z = bg;
    }
};
struct MoeBase {
    const char* A; const char* B; size_t arow  , bexp  , btile; int nN, pad; int t0, t1, t2, t3, t4, t5, t6, t7; int o0, o1, o2, o3, o4, o5, o6, o7;
    __device__ __forceinline__ int init(const void* A_, size_t arow_, const void* B_, size_t bexp_, size_t btile_, int nN_, const int* CNT, const int* OFFS) {
        A = (const char*)A_; B = (const char*)B_; arow = arow_; bexp = bexp_; btile = btile_; nN = nN_; pad = 0;
        t0 = (CNT[0] + 255) >> 8; t1 = (CNT[1] + 255) >> 8; t2 = (CNT[2] + 255) >> 8; t3 = (CNT[3] + 255) >> 8; t4 = (CNT[4] + 255) >> 8; t5 = (CNT[5] + 255) >> 8; t6 = (CNT[6] + 255) >> 8; t7 = (CNT[7] + 255) >> 8;
        o0 = OFFS[0]; o1 = OFFS[1]; o2 = OFFS[2]; o3 = OFFS[3]; o4 = OFFS[4]; o5 = OFFS[5]; o6 = OFFS[6]; o7 = OFFS[7];
        return (t0 + t1 + t2 + t3 + t4 + t5 + t6 + t7) * nN;
    }
    __device__ __forceinline__ void decode(int l, pg8::Unit& u) const {
        int e = -1, te = 1, oe = 0;
#define MOE_STEP(k, tk, ok) if (e < 0) { const int n = tk * nN; if (l < n) { e = k; te = tk; oe = ok; } else l -= n; }
        MOE_STEP(0, t0, o0) MOE_STEP(1, t1, o1) MOE_STEP(2, t2, o2) MOE_STEP(3, t3, o3) MOE_STEP(4, t4, o4) MOE_STEP(5, t5, o5) MOE_STEP(6, t6, o6) MOE_STEP(7, t7, o7)
#undef MOE_STEP
        if (e < 0) { e = 0; l = 0; }
        const int mt = l % te, pn = l / te; const int row0 = oe + mt * 256;
        u.A = A + (size_t)row0 * arow; u.B = B + (size_t)e * bexp + (size_t)pn * btile; u.pm = row0 >> 8; u.pn = pn; u.z = e;
    }
};

template <int RM> __device__ __forceinline__ int rowmap(int c) {
    if (RM == 1) { if (c < 1024 || c >= 3072) return c; const int u = c & 63; return (c & ~63) + 32 * ((u & 31) >> 4) + 16 * (u >> 5) + (u & 15); }
    if (RM == 2) return 32 * (c >> 4) + (c & 15);
    if (RM == 3) return 32 * (c >> 4) + 16 + (c & 15);
    return c;
}
template <int RM> __device__ __forceinline__ void cvt_item(const float* W, int K, int N, bf16_t* WT, int row_off, LAS float* scr, int item, int lane) {
    const int nblk = N / 32, kb = item / nblk, nb = item % nblk, k0 = 64 * kb, n0 = 32 * nb;
    f32x4 v[8];
#pragma unroll
    for (int i = 0; i < 8; ++i) v[i] = *(const f32x4*)(W + (size_t)(k0 + (lane >> 3) + 8 * i) * N + n0 + 4 * (lane & 7));
#pragma unroll
    for (int i = 0; i < 8; ++i) { LAS float* d = scr + ((lane >> 3) + 8 * i) * 33 + 4 * (lane & 7); d[0] = v[i][0]; d[1] = v[i][1]; d[2] = v[i][2]; d[3] = v[i][3]; }
    asm volatile("s_waitcnt lgkmcnt(0)" ::: "memory");
    const int c = lane & 7;
#pragma unroll
    for (int j = 0; j < 4; ++j) { const int n = (lane >> 3) + 8 * j; const LAS float* s = scr + (8 * c) * 33 + n;
        u32x4 o; o.x = cvt_pk_bf16(s[0 * 33], s[1 * 33]); o.y = cvt_pk_bf16(s[2 * 33], s[3 * 33]); o.z = cvt_pk_bf16(s[4 * 33], s[5 * 33]); o.w = cvt_pk_bf16(s[6 * 33], s[7 * 33]);
        *(u32x4*)(WT + (size_t)(row_off + rowmap<RM>(n0 + n)) * K + k0 + 8 * c) = o; }
    asm volatile("s_waitcnt lgkmcnt(0)" ::: "memory");
}
__device__ __forceinline__ void item8_kn(int item, int nblk, int& k0, int& n0) { const int q = item >> 1; k0 = 64 * (2 * (q / nblk) + (item & 1)); n0 = 32 * (q % nblk); }
template <int RM> __device__ __forceinline__ void cvt_item8(const float* W, int K, int N, unsigned char* WT, float scale, LAS float* scr, int item, int lane) {
    int k0, n0; item8_kn(item, N / 32, k0, n0);
    f32x4 v[8];
#pragma unroll
    for (int i = 0; i < 8; ++i) v[i] = *(const f32x4*)(W + (size_t)(k0 + (lane >> 3) + 8 * i) * N + n0 + 4 * (lane & 7));
#pragma unroll
    for (int i = 0; i < 8; ++i) { LAS float* d = scr + ((lane >> 3) + 8 * i) * 33 + 4 * (lane & 7); d[0] = v[i][0]; d[1] = v[i][1]; d[2] = v[i][2]; d[3] = v[i][3]; }
    asm volatile("s_waitcnt lgkmcnt(0)" ::: "memory");
    const int c = lane & 7;
#pragma unroll
    for (int j = 0; j < 4; ++j) { const int n = (lane >> 3) + 8 * j; const LAS float* s = scr + (8 * c) * 33 + n;
        u32x2 o; o.x = pack4_fp8(s[0 * 33] * scale, s[1 * 33] * scale, s[2 * 33] * scale, s[3 * 33] * scale); o.y = pack4_fp8(s[4 * 33] * scale, s[5 * 33] * scale, s[6 * 33] * scale, s[7 * 33] * scale);
        *(u32x2*)(WT + (size_t)rowmap<RM>(n0 + n) * K + k0 + 8 * c) = o; }
    asm volatile("s_waitcnt lgkmcnt(0)" ::: "memory");
}
constexpr int MOE_I_MG = (2048 / 64) * (FFE / 32), MOE_I_MD = (FFE / 64) * (2048 / 32), MOE_ITEMS = 16 * MOE_I_MG + 8 * MOE_I_MD, MOE_BATCHES = MOE_ITEMS / 8;
__device__ __forceinline__ size_t fp8_tiled_off(int row, int k, int K) { return ((size_t)(row >> 5) * (K >> 6) + (k >> 6)) * 2048 + (row & 31) * 64 + (k & 63); }
struct Cvt8Job { const float* W; unsigned char* WT; int K, N, k0, n0, rm; float scale;
#ifdef PROBE_CVT_LINEAR
    unsigned char* lin;
#endif
};
__device__ __forceinline__ Cvt8Job moe_cvt_job(const P& p, int r) {
    Cvt8Job j; const int G = r >> 4, kbl = r & 15, t = G / 3584, g = G - t * 3584, e = g / 448, rem = g - e * 448;
    int kgrp, nbk;
    if (t < 2) { kgrp = rem / 224; nbk = rem - kgrp * 224; j.W = (t == 0 ? p.moe_w_gate : p.moe_w_up) + (size_t)e * 2048 * FFE; j.WT = WSP(unsigned char, WT_MGU) + (size_t)e * 2 * FFE * 2048; j.K = 2048; j.N = FFE; j.rm = 2 + t; j.scale = W8_GU; }
    else { kgrp = rem / 64; nbk = rem - kgrp * 64; j.W = p.moe_w_down + (size_t)e * FFE * 2048; j.WT = WSP(unsigned char, WT_MD) + (size_t)e * 2048 * FFE; j.K = FFE; j.N = 2048; j.rm = 0; j.scale = W8_DN; }
    j.k0 = 64 * (16 * kgrp + kbl); j.n0 = 32 * nbk;
#ifdef PROBE_CVT_LINEAR
    j.lin = (unsigned char*)p.ws + WS_END + (size_t)r * 2048;
#endif
    return j;
}
static_assert(MOE_ITEMS == 3 * 3584 * 16 && MOE_I_MG == 448 * 16 && MOE_I_MD == 448 * 16, "MoE conversion group layout");
__device__ __forceinline__ void cvt8_load(const Cvt8Job& j, int lane, f32x4 (&v)[8]) {
#pragma unroll
    for (int i = 0; i < 8; ++i) v[i] = *(const f32x4*)(j.W + (size_t)(j.k0 + (lane >> 3) + 8 * i) * j.N + j.n0 + 4 * (lane & 7));
}
__device__ __forceinline__ void cvt8_finish(const Cvt8Job& j, int lane, const f32x4 (&v)[8], LAS float* scr, bool st = true) {
#pragma unroll
    for (int i = 0; i < 8; ++i) { LAS float* d = scr + ((lane >> 3) + 8 * i) * 33 + 4 * (lane & 7); d[0] = v[i][0]; d[1] = v[i][1]; d[2] = v[i][2]; d[3] = v[i][3]; }
    asm volatile("s_waitcnt lgkmcnt(0)" ::: "memory");
    const int c = lane & 7; const float scale = j.scale;
#pragma unroll
    for (int q = 0; q < 4; ++q) { const int n = (lane >> 3) + 8 * q; const LAS float* s = scr + (8 * c) * 33 + n;
        u32x2 o; o.x = pack4_fp8(s[0 * 33] * scale, s[1 * 33] * scale, s[2 * 33] * scale, s[3 * 33] * scale); o.y = pack4_fp8(s[4 * 33] * scale, s[5 * 33] * scale, s[6 * 33] * scale, s[7 * 33] * scale);
        const int cn = j.n0 + n; const int row = j.rm == 0 ? cn : 32 * (cn >> 4) + (cn & 15) + (j.rm == 3 ? 16 : 0);
#ifdef PROBE_CVT_LINEAR
        if (!st) *(u32x2*)(j.lin + n * 64 + 8 * c) = o; else
#endif
        if (st || (o.x == 0x12345678u && o.y == 0x9abcdef0u)) *(u32x2*)(j.WT + fp8_tiled_off(row, j.k0 + 8 * c, j.K)) = o; }
    asm volatile("s_waitcnt lgkmcnt(0)" ::: "memory");
}
__device__ __forceinline__ void moe_cvt_item(const P& p, int r, LAS float* scr, int lane) { const Cvt8Job j = moe_cvt_job(p, r); f32x4 v[8]; cvt8_load(j, lane, v); cvt8_finish(j, lane, v, scr); }
__device__ __forceinline__ bool moe_fill_list(const P& p, unsigned* ctl, int phase, int nb, int owner, LAS float* scr, int lane, bool st = true) {
    unsigned* ctr = ctl + CW_FILL + 64 * owner; const int nown = 16 * ((MOE_ITEMS / 16 - owner + nb - 1) / nb);
#define MOE_ENTRY(e) (16 * (((e) >> 4) * nb + owner) + ((e) & 15))
    const int ch = phase >= 0 ? 1 : 4;
    for (;;) {
        if (phase >= 0 && (int)__builtin_amdgcn_readfirstlane(xb_ld(ctl + CW_DONE + 64 * phase)) >= nb) return false;
        unsigned idx = 0; if (lane == 0) idx = xb_add(ctr, (unsigned)ch);
        idx = __builtin_amdgcn_readfirstlane(idx);
        if ((int)idx >= nown) return true;
        if (ch == 4 && (int)idx + 3 < nown) {
            f32x4 va[8], vb[8];
            const Cvt8Job j0 = moe_cvt_job(p, MOE_ENTRY((int)idx + 0)); cvt8_load(j0, lane, va);
            const Cvt8Job j1 = moe_cvt_job(p, MOE_ENTRY((int)idx + 1)); cvt8_load(j1, lane, vb);
            cvt8_finish(j0, lane, va, scr, st);
            const Cvt8Job j2 = moe_cvt_job(p, MOE_ENTRY((int)idx + 2)); cvt8_load(j2, lane, va);
            cvt8_finish(j1, lane, vb, scr, st);
            const Cvt8Job j3 = moe_cvt_job(p, MOE_ENTRY((int)idx + 3)); cvt8_load(j3, lane, vb);
            cvt8_finish(j2, lane, va, scr, st);
            cvt8_finish(j3, lane, vb, scr, st);
        } else
        for (int j = 0; j < ch && (int)idx + j < nown; ++j) moe_cvt_item(p, MOE_ENTRY((int)idx + j), scr, lane);
    }
}
__device__ __forceinline__ void moe_fill(const P& p, unsigned* ctl, int phase, int nb, int bid, LAS unsigned char* lds, volatile LAS unsigned* MISC, int wv) {
    const int lane = lane_id();
    LAS float* scr = (LAS float*)(lds + wv * 16384);
#ifdef PROBE_CVT_NOSTORE
    const bool st = MISC[25] == 0u;
#else
    const bool st = true;
#endif
    if (MISC[24] == 0u) { if (!moe_fill_list(p, ctl, phase, nb, bid, scr, lane, st)) return; MISC[24] = 1u; }
    if (phase >= 0) return;
#pragma unroll 1
    for (int k = 1; k <= 6; ++k) { if (!moe_fill_list(p, ctl, phase, nb, (bid + 41 * k) % nb, scr, lane, st)) return; }
}
__device__ __forceinline__ void ph_convert(const P& p, int bid, int nb, LAS unsigned char* lds, int wv) {
    int tid_ = TID_FROM(wv); asm volatile("" : "+v"(tid_)); const int tid = tid_, lane = tid & 63, wave = tid >> 6;
    LAS float* scr = (LAS float*)(lds + wave * 16384);
    const int gw = bid * NWAVES + wave, NGW = nb * NWAVES;
    constexpr int I_IN = (2048 / 64) * (4096 / 32), I_OUT = (2048 / 64) * (2048 / 32), I_G = (2048 / 64) * (FFD / 32), I_DN = (FFD / 64) * (2048 / 32);
    constexpr int I_DQ = (2048 / 64) * (512 / 32), I_DKV = (2048 / 64) * (576 / 32), I_UQ = (512 / 64) * (3072 / 32), I_UKV = (512 / 64) * (4096 / 32), I_O = I_OUT;
    constexpr int I_MG = (2048 / 64) * (FFE / 32), I_MD = (FFE / 64) * (2048 / 32);
    constexpr int NITEMS = I_IN + I_OUT + 2 * I_G + I_DN + I_DQ + I_DKV + I_UQ + I_UKV + I_O + (FILL ? 0 : 16 * I_MG + 8 * I_MD);
    for (int it = gw; it < NITEMS; it += NGW) {
        int r = it;
        if (r < I_IN) { cvt_item<1>(p.ev_w_in, 2048, 4096, WSP(bf16_t, WT_IN), 0, scr, r, lane); continue; } r -= I_IN;
        if (r < I_OUT) { cvt_item<0>(p.ev_w_out, 2048, 2048, WSP(bf16_t, WT_OUT), 0, scr, r, lane); continue; } r -= I_OUT;
        if (r < I_G) { cvt_item<2>(p.ffn_w_gate, 2048, FFD, WSP(bf16_t, WT_GU), 0, scr, r, lane); continue; } r -= I_G;
        if (r < I_G) { cvt_item<3>(p.ffn_w_up, 2048, FFD, WSP(bf16_t, WT_GU), 0, scr, r, lane); continue; } r -= I_G;
        if (r < I_DN) { cvt_item<0>(p.ffn_w_down, FFD, 2048, WSP(bf16_t, WT_DN), 0, scr, r, lane); continue; } r -= I_DN;
        if (r < I_DQ) { cvt_item<0>(p.od_w_dq, 2048, 512, WSP(bf16_t, WT_DQKV), 0, scr, r, lane); continue; } r -= I_DQ;
        if (r < I_DKV) { cvt_item<0>(p.od_w_dkv, 2048, 576, WSP(bf16_t, WT_DQKV), 512, scr, r, lane); continue; } r -= I_DKV;
        if (r < I_UQ) { cvt_item<0>(p.od_w_uq, 512, 3072, WSP(bf16_t, WT_UQ), 0, scr, r, lane); continue; } r -= I_UQ;
        if (r < I_UKV) { cvt_item<0>(p.od_w_ukv, 512, 4096, WSP(bf16_t, WT_UKV), 0, scr, r, lane); continue; } r -= I_UKV;
        if (r < I_O) { cvt_item<0>(p.od_w_o, 2048, 2048, WSP(bf16_t, WT_O), 0, scr, r, lane); continue; } r -= I_O;
        moe_cvt_item(p, r, scr, lane);
    }
    { bf16_t* z = WSP(bf16_t, WT_DQKV) + (size_t)1088 * 2048; for (size_t i = (size_t)bid * 512 + tid; i < (size_t)192 * 2048 / 8; i += (size_t)nb * 512) ((uint4*)z)[i] = make_uint4(0, 0, 0, 0); }
}
__device__ __forceinline__ void ph_dft_tables(const P& p, int bid, int nb, float* tab  , int wv) {
    int tid_ = TID_FROM(wv); asm volatile("" : "+v"(tid_)); const int tid = tid_;
    for (int i = tid; i < 2048; i += 512) tab[i] = cospif((float)i * (2.0f / 2048.0f));
    __syncthreads();
    bf16_t* DN = WSP(bf16_t, WS_DFTN); bf16_t* DC = WSP(bf16_t, WS_DFTC); bf16_t* WC = WSP(bf16_t, WS_WCS);
    for (size_t i = (size_t)bid * 512 + tid; i < (size_t)2048 * 4096 / 2; i += (size_t)nb * 512) {
        const int k1 = (int)(i / 2048), n2 = (int)(i % 2048) * 2; unsigned w = 0;
#pragma unroll
        for (int q = 0; q < 2; ++q) { const int nn = n2 + q, n = nn & 2047, part = nn >> 11; const int idx = (k1 * n) & 2047; const float v = part == 0 ? tab[idx] : -tab[(idx + 1536) & 2047]; w |= (unsigned)f2bf(v) << (16 * q); }
        ((unsigned*)DN)[i] = w;
    }
    for (int i = bid * 512 + tid; i < 256 * 512; i += nb * 512) { const int k1 = i / 512, nn = i % 512, n = nn & 255, part = nn >> 8; const int idx = ((k1 * n) & 255) * 8; DC[i] = f2bf(part == 0 ? tab[idx] : -tab[(idx + 1536) & 2047]); }
    for (int i = bid * 512 + tid; i < 512 * 256; i += nb * 512) { const int m = i / 256, cc = i % 256, k3 = m & 255; const int idx = ((k3 * cc) & 255) * 8; WC[i] = f2bf(m < 256 ? tab[idx] : tab[(idx + 1536) & 2047]); }
    __syncthreads();
}

#ifndef ATT_ROPE_SD1
#define ATT_ROPE_SD1 1
#endif
namespace att {
using s16x4  = __attribute__((ext_vector_type(4))) short;
using f32x16 = __attribute__((ext_vector_type(16))) float;
constexpr int QBLK = 32, KVBLK = 64, NW = 8;
constexpr size_t SHM_V = KVBLK * 128 * 2, SHM_K = KVBLK * 128 * 2, SHM_KR = KVBLK * 64 * 2;
constexpr size_t OFF_K = 2 * SHM_V, OFF_KR = OFF_K + 2 * SHM_K, OFF_WS = OFF_KR + 2 * SHM_KR, OFF_QR = OFF_WS + NW * 64 * 4, SHM_ATTN = OFF_QR + 256 * 128;
#define KSWZ(row, colB) ((row) * 256 + ((colB) ^ (((row) & 7) << 4)))
#define KRSWZ(row, colB) ((row) * 128 + ((colB) ^ (((row) & 7) << 4)))
#define SBAR() __builtin_amdgcn_sched_barrier(0)
__device__ __forceinline__ int crow(int r, int hi) { return (r & 3) + 8 * (r >> 2) + 4 * hi; }
__device__ __forceinline__ unsigned cvtpk(float lo, float hi) { unsigned r; asm volatile("v_cvt_pk_bf16_f32 %0, %1, %2" : "=v"(r) : "v"(lo), "v"(hi)); return r; }
__device__ __forceinline__ bf16x8 ld8(const bf16_t* p) { return *reinterpret_cast<const bf16x8*>(p); }

__device__ __forceinline__ void partialSM(f32x16& p0, f32x16& p1, float& m_reg, float& mn, float& alpha, const float C, const float thr) {
  float pmax = p0[0]; for (int r = 1; r < 16; ++r) pmax = fmaxf(pmax, p0[r]); for (int r = 0; r < 16; ++r) pmax = fmaxf(pmax, p1[r]);
  { auto rr = __builtin_amdgcn_permlane32_swap(__float_as_uint(pmax), __float_as_uint(pmax), false, false);
    pmax = fmaxf(__uint_as_float(rr[0]), __uint_as_float(rr[1])); }
  if (__builtin_expect(__all(pmax - m_reg <= thr), 1)) { mn = m_reg; alpha = 1.f; }
  else { mn = fmaxf(m_reg, pmax); alpha = __builtin_amdgcn_exp2f((m_reg - mn) * C); m_reg = mn; }
  float mnC = -mn * C;
  for (int r = 0; r < 16; ++r) p0[r] = fmaf(p0[r], C, mnC); for (int r = 0; r < 16; ++r) p1[r] = fmaf(p1[r], C, mnC);
  for (int r = 0; r < 16; ++r) p0[r] = __builtin_amdgcn_exp2f(p0[r]);
}
__device__ __forceinline__ void finishSM(f32x16& p0, f32x16& p1, float alpha, float& l_reg, bf16x8& pa0, bf16x8& pa1, bf16x8& pa2, bf16x8& pa3) {
  for (int r = 0; r < 16; ++r) p1[r] = __builtin_amdgcn_exp2f(p1[r]);
  float ps = 0; for (int r = 0; r < 16; ++r) ps += p0[r]; for (int r = 0; r < 16; ++r) ps += p1[r];
  { auto rr = __builtin_amdgcn_permlane32_swap(__float_as_uint(ps), __float_as_uint(ps), false, false);
    ps = __uint_as_float(rr[0]) + __uint_as_float(rr[1]); }
  l_reg = l_reg * alpha + ps;
#define PK4(P, BASE, OUT) do { unsigned a0 = cvtpk(P[BASE + 0], P[BASE + 1]), a1 = cvtpk(P[BASE + 2], P[BASE + 3]);   \
    unsigned b0 = cvtpk(P[BASE + 4], P[BASE + 5]), b1 = cvtpk(P[BASE + 6], P[BASE + 7]);                              \
    auto r0 = __builtin_amdgcn_permlane32_swap(a0, b0, false, false); auto r1 = __builtin_amdgcn_permlane32_swap(a1, b1, false, false); \
    u32x4 w = {r0[0], r1[0], r0[1], r1[1]}; OUT = *reinterpret_cast<bf16x8*>(&w); } while (0)
  PK4(p0, 0, pa0); PK4(p0, 8, pa1); PK4(p1, 0, pa2); PK4(p1, 8, pa3);
#undef PK4
}
template <bool ROPE> __device__ __forceinline__ void qkt(f32x16& p0, f32x16& p1, const char* Ks, const char* KRs, const char* QRs, const bf16x8* qr, int r32, int hi) {
  p0 = f32x16{}; p1 = f32x16{};
#pragma unroll
  for (int d0 = 0; d0 < 8; ++d0) { int cb = (d0 * 16 + hi * 8) * 2;
    bf16x8 b0 = *reinterpret_cast<const bf16x8*>(Ks + KSWZ(r32, cb));
    bf16x8 b1 = *reinterpret_cast<const bf16x8*>(Ks + KSWZ(32 + r32, cb));
    p0 = __builtin_amdgcn_mfma_f32_32x32x16_bf16(b0, qr[d0], p0, 0, 0, 0);
    p1 = __builtin_amdgcn_mfma_f32_32x32x16_bf16(b1, qr[d0], p1, 0, 0, 0); }
  if constexpr (ROPE) {
#pragma unroll
    for (int d1 = 0; d1 < 4; ++d1) { int cb = (d1 * 16 + hi * 8) * 2;
      bf16x8 b0 = *reinterpret_cast<const bf16x8*>(KRs + KRSWZ(r32, cb));
      bf16x8 b1 = *reinterpret_cast<const bf16x8*>(KRs + KRSWZ(32 + r32, cb));
      bf16x8 qf = *reinterpret_cast<const bf16x8*>(QRs + KRSWZ(r32, cb));
      p0 = __builtin_amdgcn_mfma_f32_32x32x16_bf16(b0, qf, p0, 0, 0, 0);
      p1 = __builtin_amdgcn_mfma_f32_32x32x16_bf16(b1, qf, p1, 0, 0, 0); }
  }
}
__device__ __forceinline__ int v_st(int k, int c) { const int kk = (k & ~0xC) | ((k & 4) << 1) | ((k & 8) >> 1); return ((kk >> 3) * 4 + (c >> 5)) * 512 + ((kk & 7) * 32 + (c & 31)) * 2; }
__device__ __forceinline__ int v_rd_base(int lane) { return ((lane & 3) << 3) | (((lane >> 2) & 3) << 6) | (((lane >> 4) & 1) << 5) | (((lane >> 5) & 1) << 8); }
constexpr int v_rd_off(int d0, int ks, int half) { return d0 * 512 + ks * 4096 + half * 2048; }
template <int OFF> __device__ __forceinline__ s16x4 tr_read(int vb) {
  s16x4 r; asm volatile("ds_read_b64_tr_b16 %0, %1 offset:%2" : "=&v"(r) : "v"(vb), "i"(OFF) : "memory"); return r;
}
template <int D0> __device__ __forceinline__ void pv_one(f32x16& od, int vb, bf16x8 pa0, bf16x8 pa1, bf16x8 pa2, bf16x8 pa3) {
  const s16x4 l0 = tr_read<v_rd_off(D0, 0, 0)>(vb), h0 = tr_read<v_rd_off(D0, 0, 1)>(vb), l1 = tr_read<v_rd_off(D0, 1, 0)>(vb), h1 = tr_read<v_rd_off(D0, 1, 1)>(vb);
  const s16x4 l2 = tr_read<v_rd_off(D0, 2, 0)>(vb), h2 = tr_read<v_rd_off(D0, 2, 1)>(vb), l3 = tr_read<v_rd_off(D0, 3, 0)>(vb), h3 = tr_read<v_rd_off(D0, 3, 1)>(vb);
  asm volatile("s_waitcnt lgkmcnt(0)" ::: "memory"); SBAR();
#define PK(L, H) (bf16x8){L[0], L[1], L[2], L[3], H[0], H[1], H[2], H[3]}
  od = __builtin_amdgcn_mfma_f32_32x32x16_bf16(pa0, PK(l0, h0), od, 0, 0, 0);
  od = __builtin_amdgcn_mfma_f32_32x32x16_bf16(pa1, PK(l1, h1), od, 0, 0, 0);
  od = __builtin_amdgcn_mfma_f32_32x32x16_bf16(pa2, PK(l2, h2), od, 0, 0, 0);
  od = __builtin_amdgcn_mfma_f32_32x32x16_bf16(pa3, PK(l3, h3), od, 0, 0, 0);
#undef PK
}
__device__ __forceinline__ void pv_d0(f32x16* o, int vb, bf16x8 pa0, bf16x8 pa1, bf16x8 pa2, bf16x8 pa3) {
  pv_one<0>(o[0], vb, pa0, pa1, pa2, pa3); pv_one<1>(o[1], vb, pa0, pa1, pa2, pa3); pv_one<2>(o[2], vb, pa0, pa1, pa2, pa3); pv_one<3>(o[3], vb, pa0, pa1, pa2, pa3);
}
template <int LDQ, int LDK, int LDV, int LDO, bool ROPE, bool OBF>
__device__ __forceinline__ void attn_body(const bf16_t* __restrict__ Qb, const bf16_t* __restrict__ Kh, const bf16_t* __restrict__ Vh, const bf16_t* __restrict__ KRh,
                                          void* __restrict__ Ob, int seq, const float C, const float thr, char* lds, int wv) {
  int tid_ = TID_FROM(wv); asm volatile("" : "+v"(tid_));
  const int tid = tid_, wid = tid >> 6, lane = tid & 63, r32 = lane & 31, hi = lane >> 5;
  char* V_lds = lds; char* K_lds = lds + OFF_K; char* KR_lds = lds + OFF_KR;
  float* ws = (float*)(lds + OFF_WS) + wid * 64; float* li_l = ws; float* al_l = ws + 32;
  float m_reg = -1e30f, l_reg = 0; f32x16 o[4] = {}; bf16x8 qr[8];
  const bf16_t* Qw = Qb + (long)(wid * QBLK + r32) * LDQ + hi * 8;
#pragma unroll
  for (int d0 = 0; d0 < 8; ++d0) qr[d0] = ld8(Qw + d0 * 16);
  const char* QR_lds = lds + OFF_QR + wid * 4096;
  if constexpr (ROPE) {
#pragma unroll
    for (int d1 = 0; d1 < 4; ++d1) *(bf16x8*)(lds + OFF_QR + wid * 4096 + KRSWZ(r32, (d1 * 16 + hi * 8) * 2)) = ld8(Qw + 128 + d1 * 16);
  }
  const int sr = tid >> 4, sc = (tid & 15) * 8, vst0 = v_st(sr, sc), vst1 = v_st(32 + sr, sc);
  const int krr = tid >> 3, krc = (tid & 7) * 8;
  const int vb0 = (int)(uintptr_t)V_lds + v_rd_base(lane);
  constexpr int SD = (ROPE && ATT_ROPE_SD1) ? 1 : 2;
  struct { bf16x8 vs0, vs1, ks0, ks1, kr; } sr_[SD];
#define SLOAD(i, k0) do { sr_[i].vs0 = ld8(&Vh[(long)((k0) + sr) * LDV + sc]); sr_[i].vs1 = ld8(&Vh[(long)((k0) + 32 + sr) * LDV + sc]); \
    sr_[i].ks0 = ld8(&Kh[(long)((k0) + sr) * LDK + sc]); sr_[i].ks1 = ld8(&Kh[(long)((k0) + 32 + sr) * LDK + sc]); \
    if constexpr (ROPE) sr_[i].kr = ld8(&KRh[(long)((k0) + krr) * 64 + krc]); } while (0)
#define SWRITE(b, i) do { *(bf16x8*)(V_lds + (b) * SHM_V + vst0) = sr_[i].vs0;          \
    *(bf16x8*)(V_lds + (b) * SHM_V + vst1) = sr_[i].vs1; int kc = sc * 2;               \
    *(bf16x8*)(K_lds + (b) * SHM_K + KSWZ(sr, kc)) = sr_[i].ks0;                       \
    *(bf16x8*)(K_lds + (b) * SHM_K + KSWZ(32 + sr, kc)) = sr_[i].ks1;                  \
    if constexpr (ROPE) *(bf16x8*)(KR_lds + (b) * SHM_KR + KRSWZ(krr, krc * 2)) = sr_[i].kr; } while (0)
#define SWAIT() do { if constexpr (SD == 1) asm volatile("s_waitcnt vmcnt(0)" ::: "memory"); else if constexpr (ROPE) asm volatile("s_waitcnt vmcnt(5)" ::: "memory"); else asm volatile("s_waitcnt vmcnt(4)" ::: "memory"); } while (0)
#define RESC(a) do { if (__any((a) < 1.f)) { if (hi == 0) al_l[r32] = (a); asm volatile("s_waitcnt lgkmcnt(0)" ::: "memory"); \
    for (int d = 0; d < 4; ++d) for (int r = 0; r < 16; ++r) o[d][r] *= al_l[crow(r, hi)]; } } while (0)
  f32x16 pA0, pA1, pB0, pB1; float mnA, mnB, alA, alB; bf16x8 pa0, pa1, pa2, pa3; const int NT = seq / KVBLK;
  constexpr int SE = 0, SO = SD - 1;
  SLOAD(SE, 0); asm volatile("s_waitcnt vmcnt(0)" ::: "memory"); SWRITE(0, SE); __syncthreads();
  qkt<ROPE>(pA0, pA1, K_lds, KR_lds, QR_lds, qr, r32, hi); partialSM(pA0, pA1, m_reg, mnA, alA, C, thr);
  SLOAD(SO, KVBLK); if constexpr (SD == 2) { if (2 < NT) SLOAD(SE, 2 * KVBLK); }
  SWAIT(); SWRITE(1, SO); __syncthreads();
  for (int j = 1; j + 1 < NT; j += 2) {
    SBAR(); qkt<ROPE>(pB0, pB1, K_lds + SHM_K, KR_lds + SHM_KR, QR_lds, qr, r32, hi);
    finishSM(pA0, pA1, alA, l_reg, pa0, pa1, pa2, pa3); SBAR();
    SLOAD(SO, (j + SD) * KVBLK); SBAR();
    pv_d0(o, vb0, pa0, pa1, pa2, pa3); partialSM(pB0, pB1, m_reg, mnB, alB, C, thr);
    __syncthreads(); SWAIT(); SWRITE(0, SE);
    RESC(alB); __syncthreads();
    SBAR(); qkt<ROPE>(pA0, pA1, K_lds, KR_lds, QR_lds, qr, r32, hi);
    finishSM(pB0, pB1, alB, l_reg, pa0, pa1, pa2, pa3); SBAR();
    if (SD == 1 || j + 3 < NT) SLOAD(SE, (j + 1 + SD) * KVBLK); SBAR();
    pv_d0(o, vb0 + (int)SHM_V, pa0, pa1, pa2, pa3); partialSM(pA0, pA1, m_reg, mnA, alA, C, thr);
    __syncthreads(); SWAIT(); SWRITE(1, SO);
    RESC(alA); __syncthreads();
  }
  SBAR(); qkt<ROPE>(pB0, pB1, K_lds + SHM_K, KR_lds + SHM_KR, QR_lds, qr, r32, hi);
  finishSM(pA0, pA1, alA, l_reg, pa0, pa1, pa2, pa3); SBAR();
  pv_d0(o, vb0, pa0, pa1, pa2, pa3); partialSM(pB0, pB1, m_reg, mnB, alB, C, thr);
  __syncthreads(); RESC(alB);
  finishSM(pB0, pB1, alB, l_reg, pa0, pa1, pa2, pa3); SBAR();
  pv_d0(o, vb0 + (int)SHM_V, pa0, pa1, pa2, pa3);
  if (hi == 0) li_l[r32] = l_reg; asm volatile("s_waitcnt lgkmcnt(0)" ::: "memory");
  float rli[16];
#pragma unroll
  for (int r = 0; r < 16; ++r) rli[r] = __builtin_amdgcn_rcpf(li_l[crow(r, hi)]);
#pragma unroll
  for (int r = 0; r < 16; ++r) { const int orow = wid * QBLK + crow(r, hi);
#pragma unroll
    for (int d0 = 0; d0 < 4; ++d0) { const float val = o[d0][r] * rli[r];
      if constexpr (OBF) ((bf16_t*)Ob)[(long)orow * LDO + d0 * 32 + r32] = f2bf(val); else ((float*)Ob)[(long)orow * LDO + d0 * 32 + r32] = val; } }
  __syncthreads();
#undef SLOAD
#undef SWRITE
#undef SWAIT
#undef RESC
}
#undef KSWZ
#undef KRSWZ
#undef SBAR
}

constexpr int NPH = 22;
typedef const __attribute__((address_space(4))) P* KP4;
__global__ void __launch_bounds__(512, 2) mega(P p_arg, int ph_lo, int ph_hi, int bar_idx) {
    const KP4 kp0 = (KP4)__builtin_amdgcn_kernarg_segment_ptr();
#define LOCAL_P KP4 kp_ = kp0; asm volatile("" : "+s"(kp_)); const P& p = *(const P*)kp_;
    LOCAL_P
    extern __shared__ __attribute__((aligned(16))) unsigned char lds_raw[];
    LAS unsigned char* lds = (LAS unsigned char*)lds_raw;
    const int wv = __builtin_amdgcn_readfirstlane((int)threadIdx.x >> 6);
    const int tid = TID_FROM(wv), bid = blockIdx.x, nb = gridDim.x;
    volatile LAS unsigned* MISC = (volatile LAS unsigned*)(lds + MISC_OFF);
    for (int u = tid; u < (LDS_BYTES - RING_BYTES) / 4; u += 512) ((LAS unsigned*)(lds + RING_BYTES))[u] = 0u;
    __syncthreads();
    unsigned* ctl = (unsigned*)(p.ws + WS_CTL);
    XcdBarrier bar = xcd_barrier_post(ctl + CW_BAR + bar_idx * XCD_BAR_WORDS, MISC + 8, wv);
    float* SLABS = WSP(float, WS_SLAB);
#ifndef NHELP
#define NHELP 0
#endif
    const int nbw = nb - NHELP; const bool helper = NHELP > 0 && bid >= nbw;
#ifndef FILL_TAILS
#define FILL_TAILS 1
#endif
#define FILL_TAIL(k) do { if (FILL && FILL_TAILS) { __syncthreads(); if (wv == 0 && lane_id() == 0) (void)xb_add(ctl + CW_DONE + 64 * (k), 1u); moe_fill(p, ctl, (k), nb, bid, lds, MISC, wv); } } while (0)
#define GEMM_TAIL(S, E, off) do { if ((S).s > 1) { xcd_barrier(bar, wv); pg8::tail_reduce(S, E, SLABS + ((size_t)(off) << 16), bid, nb, wv); } } while (0)
#ifndef PH_MASK
#define PH_MASK 0xFFFFFFFFu
#endif
#define RUN(k) (((PH_MASK >> (k)) & 1u) && ph_lo <= (k) && (k) < ph_hi)
#define SEAM(k) do { if (RUN(k) && RUN((k) + 1)) xcd_barrier(bar, wv); } while (0)
#ifndef REPEAT_PH
#define REPEAT_PH (-1)
#endif
#ifndef REPEAT_N
#define REPEAT_N 2
#endif
#define NREP(k) ((k) == REPEAT_PH ? REPEAT_N : 1)
#define PH_BEGIN(k) if (RUN(k)) { _Pragma("unroll") for (int rep = 0; rep < NREP(k); ++rep) { LOCAL_P
#define PH_END(k) if (rep + 1 < NREP(k)) xcd_barrier(bar, wv); } } SEAM(k);
    const size_t T2048 = (size_t)256 * 2048 * 2, T512 = (size_t)256 * 512 * 2;
#ifndef SPLIT_G1
#define SPLIT_G1 1
#endif
#ifndef SPLIT_G2
#define SPLIT_G2 4
#endif
#ifndef SPLIT_G3
#define SPLIT_G3 4
#endif
#ifndef SPLIT_G4
#define SPLIT_G4 4
#endif
#ifndef SPLIT_P13
#define SPLIT_P13 1
#endif
#ifndef SPLIT_G9
#define SPLIT_G9 1
#endif
#ifndef SPLIT_G10
#define SPLIT_G10 8
#endif

    PH_BEGIN(0) { ph_prologue(p, bid, nb, (float*)lds_raw, wv); __syncthreads(); ph_dft_tables(p, bid, nb, (float*)lds_raw, wv); ph_convert(p, bid, nb, lds, wv);
#ifdef CONVERT_TWICE
        __syncthreads(); ph_convert(p, bid, nb, lds, wv);
#endif
    }
    PH_END(0)
    PH_BEGIN(1) ph_norm_mod<!ORACLE>(p, p.norm1_g, 0, 0, 1, bid, nb, wv);
    PH_END(1)
#ifdef EXTRA_BARS
    for (int e_ = 0; e_ < EXTRA_BARS; ++e_) xcd_barrier(bar, wv);
#endif
    PH_BEGIN(2) { pg8::GridSched<false> S; S.init(WSP(bf16_t, WS_H), T2048, WSP(bf16_t, WT_IN), T2048, 36, 16, 2048, nbw, bid, SPLIT_G1);
        pg8::Epi<EF_in> E{{WSP(bf16_t, A0_F), WSP(bf16_t, A0_Q), WSP(bf16_t, A0_K), WSP(bf16_t, A0_V), WSP(float2, WS_TABD)}};
        if (!helper) { pg8::gemm_phase(lds, pg8::Dims{2048, 2048, SLABS}, S, E, wv); } FILL_TAIL(2);
        GEMM_TAIL(S, E, 0); }
    PH_END(2)
    PH_BEGIN(3) { pg8::TailSched<DftABase> S; S.b.WCS = (const char*)WSP(bf16_t, WS_WCS); S.b.F = (const char*)WSP(bf16_t, A0_F); S.init(288, 256, nb, bid);
        pg8::Epi<EF_dftA> E{{WSP(bf16_t, A0_VT), WSP(bf16_t, A0_VTC)}};
        pg8::gemm_phase(lds, pg8::Dims{256, 1024, SLABS}, S, E, wv); GEMM_TAIL(S, E, 0); }
    PH_END(3)
    PH_BEGIN(4) {
        pg8::TailSched<DftBBase> S1; S1.b = DftBBase{(const char*)WSP(bf16_t, WS_DFTN), (const char*)WSP(bf16_t, A0_VT), (size_t)256 * 4096 * 2, (size_t)256 * 4096 * 2, 8, 0}; S1.init(128, 4096, nb, bid, 1);
        pg8::Epi<EF_dftB> E1{{WSP(bf16_t, A0_MIX), 1.0f / sqrtf(2048.f * 256.f), CTX}};
        pg8::gemm_phase(lds, pg8::Dims{4096, 4096, SLABS}, S1, E1, wv);
        pg8::TailSched<DftBBase> S2; S2.b = DftBBase{(const char*)WSP(bf16_t, WS_DFTC), (const char*)WSP(bf16_t, A0_VTC), 0, (size_t)256 * 512 * 2, 1, 0}; S2.init(16, 512, nb, (bid + 128) % nb, 1);
        pg8::Epi<EF_dftB> E2{{WSP(bf16_t, A0_MIX), 1.0f / sqrtf(256.f * 256.f), 0}};
        pg8::gemm_phase(lds, pg8::Dims{512, 512, SLABS + ((size_t)256 << 16)}, S2, E2, wv);
        __syncthreads();
        volatile LAS int* qslot = (volatile LAS int*)(MISC + 16);
        const bf16_t* Qd = WSP(bf16_t, A0_Q); const bf16_t* Kd = WSP(bf16_t, A0_K); const bf16_t* Vd = WSP(bf16_t, A0_V); float* OD = WSP(float, A0_OD);
        for (;;) {
            if (tid == 0) *qslot = (int)xb_add(ctl + CW_QUEUE + 64 * rep, 1u);
            __syncthreads();
            const int it = *qslot;
            __syncthreads();
            if (it >= 576) break;
            int inst, row0, seq;
            if (it < 512) { inst = it >> 3; row0 = CTX + (it & 7) * 256; seq = TPB; } else { inst = it - 512; row0 = 0; seq = CTX; }
            const int b = inst >> 4, h = (inst >> 2) & 3, c = (inst >> 1) & 1, vh = inst & 1;
            const size_t R0 = (size_t)b * TPB + row0, K0 = (size_t)b * TPB;
            att::attn_body<1024, 1024, 1024, 2048, false, false>(Qd + R0 * 1024 + h * 256 + c * 128, Kd + K0 * 1024 + h * 256 + c * 128, Vd + K0 * 1024 + h * 256 + vh * 128, nullptr,
                OD + (R0 * 4 + h) * 512 + c * 256 + vh * 128, seq, 0.08838834764831845f * 1.4426950408889634f, 8.f / 0.08838834764831845f, (char*)lds_raw, wv);
        }
        FILL_TAIL(4);
        if (S1.s > 1 || S2.s > 1) { xcd_barrier(bar, wv); pg8::tail_reduce(S1, E1, SLABS, bid, nb, wv); pg8::tail_reduce(S2, E2, SLABS + ((size_t)256 << 16), bid, nb, wv); }
    }
    PH_END(4)
    PH_BEGIN(5) ph_subln(p, bid, nb, wv);
    PH_END(5)
    PH_BEGIN(6) { pg8::GridSched<false> S; S.init(WSP(bf16_t, A0_MIX), T2048, WSP(bf16_t, WT_OUT), T2048, 36, 8, 2048, nbw, bid, SPLIT_G2);
#if ORACLE
        pg8::Epi<EF_res> E{{WSP(float, WS_XS), WSP(float, WS_MODS), 2, 0}};
#else
        pg8::Epi<EF_res0> E{{WSP(float, WS_XS), WSP(float, WS_MODS), p.x, p.ctx, 2, 0}};
#endif
        if (!helper) { pg8::gemm_phase(lds, pg8::Dims{2048, 2048, SLABS}, S, E, wv); } FILL_TAIL(6);
        GEMM_TAIL(S, E, 0); }
    PH_END(6)
    PH_BEGIN(7) ph_norm_mod(p, p.norm2_g, 0, 3, 4, bid, nb, wv);
    PH_END(7)
    PH_BEGIN(8) { pg8::GridSched<false> S; S.init(WSP(bf16_t, WS_H), T2048, WSP(bf16_t, WT_GU), T2048, 36, 44, 2048, nbw, bid, SPLIT_G3);
        pg8::Epi<EF_swiglu> E{{WSP(bf16_t, A0_ACT), FFD, 0}};
        if (!helper) { pg8::gemm_phase(lds, pg8::Dims{2048, 2048, SLABS}, S, E, wv); } FILL_TAIL(8);
        GEMM_TAIL(S, E, 0); }
    PH_END(8)
    PH_BEGIN(9) { pg8::GridSched<false> S; S.init(WSP(bf16_t, A0_ACT), (size_t)256 * FFD * 2, WSP(bf16_t, WT_DN), (size_t)256 * FFD * 2, 36, 8, FFD, nbw, bid, SPLIT_G4);
        pg8::Epi<EF_res> E{{WSP(float, WS_XS), WSP(float, WS_MODS), 5, 0}};
        if (!helper) { pg8::gemm_phase(lds, pg8::Dims{FFD, FFD, SLABS}, S, E, wv); } FILL_TAIL(9);
        GEMM_TAIL(S, E, 0); }
    PH_END(9)
    PH_BEGIN(10) ph_norm_mod(p, p.norm1_g + D, 1, 0, 1, bid, nb, wv);
    PH_END(10)
    PH_BEGIN(11) { pg8::GridSched<false> S; S.init(WSP(bf16_t, WS_H), T2048, WSP(bf16_t, WT_DQKV), T2048, 36, 5, 2048, nbw, bid);
        pg8::Epi<EF_dqkv> E{{WSP(float, A1_CQ), WSP(float, A1_CKV), WSP(bf16_t, A1_KR), WSP(float2, WS_TABM)}};
        if (!helper) { pg8::gemm_phase(lds, pg8::Dims{2048, 2048, SLABS}, S, E, wv); } FILL_TAIL(11);
        GEMM_TAIL(S, E, 0); }
    PH_END(11)
    PH_BEGIN(12) ph_lora_norm(p, bid, nb, wv);
    PH_END(12)
    PH_BEGIN(13) {
        pg8::GridSched<true> S1; S1.init(WSP(bf16_t, A1_CQN), T512, WSP(bf16_t, WT_UQ), T512, 32, 12, 512, nbw, bid, SPLIT_P13);
        pg8::Epi<EF_uq> E1{{WSP(bf16_t, A1_QM), WSP(float2, WS_TABM)}};
        if (!helper) pg8::gemm_phase(lds, pg8::Dims{512, 512, SLABS}, S1, E1, wv);
        pg8::GridSched<false> S2; S2.init(WSP(bf16_t, A1_CKVN), T512, WSP(bf16_t, WT_UKV), T512, 36, 16, 512, nbw, bid, SPLIT_P13);
        pg8::Epi<EF_bf> E2{{WSP(bf16_t, A1_KVM), 4096, 0}};
        if (!helper) pg8::gemm_phase(lds, pg8::Dims{512, 512, SLABS + ((size_t)256 << 16)}, S2, E2, wv);
#ifdef PROBE_P13
        for (int q_ = 0; q_ < PROBE_P13; ++q_) { __syncthreads(); pg8::Epi<EF_probe> E3{{SLABS, 0, 0}}; if (!helper) pg8::gemm_phase(lds, pg8::Dims{512, 512, SLABS}, S2, E3, wv); }
#endif
        FILL_TAIL(13);
        if (S1.s > 1 || S2.s > 1) { xcd_barrier(bar, wv); pg8::tail_reduce(S1, E1, SLABS, bid, nb, wv); pg8::tail_reduce(S2, E2, SLABS + ((size_t)256 << 16), bid, nb, wv); }
    }
    PH_END(13)
    PH_BEGIN(14) {
        __syncthreads();
        const bf16_t* QM = WSP(bf16_t, A1_QM); const bf16_t* KVM = WSP(bf16_t, A1_KVM); const bf16_t* KR = WSP(bf16_t, A1_KR); bf16_t* OM = WSP(bf16_t, A1_OM);
        for (int r = 0; r * nb + bid < 512; ++r) {
            int it = r * nb + bid;
            if (nb == 256) { const int x = bid & 7, y = bid >> 3; it = (r * 32 + (y >> 3) * 8 + x) * 8 + (y & 7); }
            const int inst = it >> 3, qb = it & 7, b = inst >> 4, h = inst & 15;
            const size_t R0 = (size_t)b * TPB + CTX + qb * 256, K0 = (size_t)b * TPB;
            att::attn_body<3072, 4096, 4096, 2048, true, true>(QM + R0 * 3072 + h * 192, KVM + K0 * 4096 + h * 256, KVM + K0 * 4096 + h * 256 + 128, KR + K0 * 64,
                OM + R0 * 2048 + h * 128, TPB, 0.07216878364870323f * 1.4426950408889634f, 8.f / 0.07216878364870323f, (char*)lds_raw, wv);
        }
    }
    PH_END(14)
    PH_BEGIN(15) { pg8::GridSched<true> S; S.init(WSP(bf16_t, A1_OM), T2048, WSP(bf16_t, WT_O), T2048, 32, 8, 2048, nbw, bid);
        pg8::Epi<EF_res> E{{WSP(float, WS_XS), WSP(float, WS_MODS) + 5 * 6 * D, 2, 0}};
        if (!helper) { pg8::gemm_phase(lds, pg8::Dims{2048, 2048, SLABS}, S, E, wv); } FILL_TAIL(15);
        GEMM_TAIL(S, E, 0); }
    PH_END(15)
    PH_BEGIN(16) { __syncthreads(); ph_route(p, bid, nb, (float*)lds_raw, wv); }
    PH_END(16)
    PH_BEGIN(17) {
#ifdef PROBE_CVT
        if (rep > 0) { __syncthreads(); if (wv == 0 && lane_id() == 0) { __hip_atomic_store(ctl + CW_FILL + 64 * bid, 0u, __ATOMIC_RELAXED, __HIP_MEMORY_SCOPE_AGENT); MISC[24] = 0u; MISC[25] = 1u; } xcd_barrier(bar, wv); }
#endif
        __syncthreads(); ph_sort(p, bid, (int*)lds_raw, wv);
        if (FILL) { __syncthreads(); moe_fill(p, ctl, -1, nb, bid, lds, MISC, wv); } }
    PH_END(17)
    PH_BEGIN(18) ph_gather(p, bid, nb, wv);
    PH_END(18)
    PH_BEGIN(19) { pg8::TailSched<MoeBase, 4096> S; const int tot = S.b.init(WSP(unsigned char, A1_AS), (size_t)2048, WSP(unsigned char, WT_MGU), (size_t)2 * FFE * 2048, (size_t)256 * 2048, 56, (const int*)(p.ws + WS_ROUTE + RT_CNT), (const int*)(p.ws + WS_ROUTE + RT_OFFS)); S.init(tot, 1024, nb, bid, SPLIT_G9);
        pg8::Epi<EF_swiglu8> E{{WSP(unsigned char, A1_ACT2), FFE, 0}};
        pg8::gemm_phase<true>(lds, pg8::Dims{1024, 1024, SLABS}, S, E, wv); GEMM_TAIL(S, E, 0);
#ifdef PROBE_G9
#if PROBE_G9 == 1
        { xcd_barrier(bar, wv); pg8::Epi<EF_probe> E2{{SLABS, 0, 0}}; pg8::gemm_phase<true>(lds, pg8::Dims{1024, 1024, SLABS}, S, E2, wv); }
#elif PROBE_G9 == 2
        { xcd_barrier(bar, wv); pg8::Epi<EF_probe_math> E2{{(unsigned char*)SLABS, FFE, 0}}; pg8::gemm_phase<true>(lds, pg8::Dims{1024, 1024, SLABS}, S, E2, wv); }
#else
        { xcd_barrier(bar, wv); pg8::Epi<EF_probe_store> E2{{(unsigned char*)SLABS, FFE, 0}}; pg8::gemm_phase<true>(lds, pg8::Dims{1024, 1024, SLABS}, S, E2, wv); }
#endif
#endif
    }
    PH_END(19)
    PH_BEGIN(20) { pg8::TailSched<MoeBase, 4096> S; const int tot = S.b.init(WSP(unsigned char, A1_ACT2), (size_t)FFE, WSP(unsigned char, WT_MD), (size_t)2048 * FFE, (size_t)256 * FFE, 8, (const int*)(p.ws + WS_ROUTE + RT_CNT), (const int*)(p.ws + WS_ROUTE + RT_OFFS)); S.init(tot, FFE / 2, nb, bid, SPLIT_G10);
        pg8::Epi<EF_y8> E{{WSP(float, A1_Y), 2048, 0}};
        pg8::gemm_phase<true>(lds, pg8::Dims{FFE / 2, FFE / 2, SLABS}, S, E, wv); GEMM_TAIL(S, E, 0); }
    PH_END(20)
    PH_BEGIN(21) ph_final(p, bid, nb, wv);
    PH_END(21)
#undef GEMM_TAIL
#undef FILL_TAIL
#undef RUN
#undef SEAM
#undef PH_BEGIN
#undef PH_END
}
#if ORACLE
template <class G> __global__ __launch_bounds__(256) void ngemm(G g) {
    __shared__ float As[16][132]; __shared__ float Ws[16][132]; __shared__ float W2s[G::DUAL ? 16 : 1][132];
    const int z = blockIdx.z, M = g.rows(z), N = g.N, K = g.K, m0 = blockIdx.y * 128, n0 = blockIdx.x * 128;
    if (m0 >= M) return;
    const int tid = threadIdx.x, tx = tid & 15, ty = tid >> 4;
    float acc[8][8], acc2[G::DUAL ? 8 : 1][8];
#pragma unroll
    for (int i = 0; i < 8; ++i)
#pragma unroll
        for (int j = 0; j < 8; ++j) { acc[i][j] = 0.f; if constexpr (G::DUAL) acc2[i][j] = 0.f; }
    for (int k0 = 0; k0 < K; k0 += 16) {
#pragma unroll
        for (int i = 0; i < 8; ++i) { const int idx = tid + i * 256; const int k = idx & 15, m = idx >> 4; As[k][m] = (m0 + m < M) ? g.a(z, m0 + m, k0 + k) : 0.f; }
#pragma unroll
        for (int i = 0; i < 8; ++i) { const int idx = tid + i * 256; const int n = idx & 127, k = idx >> 7; const bool ok = n0 + n < N; Ws[k][n] = ok ? g.w(z, k0 + k, n0 + n) : 0.f; if constexpr (G::DUAL) W2s[k][n] = ok ? g.w2(z, k0 + k, n0 + n) : 0.f; }
        __syncthreads();
#pragma unroll
        for (int k = 0; k < 16; ++k) {
            float av[8], bv[8], b2[8];
#pragma unroll
            for (int i = 0; i < 8; ++i) { av[i] = As[k][ty * 8 + i]; bv[i] = Ws[k][tx * 8 + i]; if constexpr (G::DUAL) b2[i] = W2s[k][tx * 8 + i]; }
#pragma unroll
            for (int i = 0; i < 8; ++i)
#pragma unroll
                for (int j = 0; j < 8; ++j) { acc[i][j] += av[i] * bv[j]; if constexpr (G::DUAL) acc2[i][j] += av[i] * b2[j]; }
        }
        __syncthreads();
    }
#pragma unroll
    for (int i = 0; i < 8; ++i)
#pragma unroll
        for (int j = 0; j < 8; ++j) { const int m = m0 + ty * 8 + i, n = n0 + tx * 8 + j; if (m < M && n < N) g.epi(z, m, n, acc[i][j], G::DUAL ? acc2[i][j] : 0.f); }
}

template <int HALF> __device__ __forceinline__ int rope_partner(int d) { const int i = d % HALF; return i < HALF / 2 ? d + HALF / 2 : d - HALF / 2; }
template <int HALF> __device__ __forceinline__ float rope_apply(const float2* tab, int nl, int d, float v, float vp) {
    const int half = d / HALF, i = d % HALF, pos = half == 0 ? nl / 64 : nl % 64, fi = i % (HALF / 2); const float2 cs = tab[pos * (HALF / 2) + fi];
    return i < HALF / 2 ? v * cs.x - vp * cs.y : v * cs.x + vp * cs.y;
}

struct G_in {
    static constexpr bool DUAL = true; const bf16_t* H; const float* W; bf16_t *F, *Q, *Kd, *V; const float2* tab; int N, K;
    __device__ int rows(int) const { return NTOK; }
    __device__ float a(int, int m, int k) const { return bf2f(H[(size_t)m * D + k]); }
    __device__ float w(int, int k, int n) const { return W[(size_t)k * EIN + n]; }
    __device__ float w2(int, int k, int n) const { if (n < 1024 || n >= 3072) return 0.f; const int d = n & 127; return W[(size_t)k * EIN + (n - d) + rope_partner<64>(d)]; }
    __device__ void epi(int, int m, int n, float v, float vp) const {
        const int j = m % TPB;
        if (n < 1024) { F[(size_t)m * 1024 + n] = f2bf(v); return; }
        if (n >= 3072) { V[(size_t)m * 1024 + n - 3072] = f2bf(v); return; }
        float o = v; if (j >= CTX) o = rope_apply<64>(tab, j - CTX, n & 127, v, vp);
        if (n < 2048) Q[(size_t)m * 1024 + n - 1024] = f2bf(o); else Kd[(size_t)m * 1024 + n - 2048] = f2bf(o);
    }
};
struct G_dftA {
    static constexpr bool DUAL = false; const bf16_t* F; float* T; int N, K;
    __device__ int rows(int) const { return NTOK * 4; }
    __device__ float a(int, int m, int k) const { return bf2f(F[(size_t)m * 256 + k]); }
    __device__ float w(int, int k, int n) const { const int k3 = n & 255, idx = (k * k3) & 255; const float ang = (float)idx * (2.0f / 256.0f); return n < 256 ? cospif(ang) : sinpif(ang); }
    __device__ float w2(int, int, int) const { return 0.f; }
    __device__ void epi(int, int m, int n, float v, float) const { T[(size_t)m * 512 + n] = v; }
};
struct G_dftB {
    static constexpr bool DUAL = false; const float* T; bf16_t* MIX; int N, K, NS, joff; float scale; int pad;
    __device__ int rows(int) const { return NS; }
    __device__ float a(int, int m, int k) const { const int n = k % NS, part = k / NS; const int idx = (int)(((long)m * n) % NS); const float ang = (float)idx * (2.0f / (float)NS); return part == 0 ? cospif(ang) : -sinpif(ang); }
    __device__ float w(int z, int k, int n) const { const int b = z >> 2, g = z & 3, nn = k % NS, part = k / NS; const int R = b * TPB + joff + nn; return T[((size_t)R * 4 + g) * 512 + part * 256 + n]; }
    __device__ float w2(int, int, int) const { return 0.f; }
    __device__ void epi(int z, int m, int n, float v, float) const { const int b = z >> 2, g = z & 3; const int R = b * TPB + joff + m; MIX[(size_t)R * 2048 + g * 256 + n] = f2bf(v * scale); }
};
struct G_res {
    static constexpr bool DUAL = false; const bf16_t* A; const float* W; float* XS; const float* mods; int N, K, lda, chunk;
    __device__ int rows(int) const { return NTOK; }
    __device__ float a(int, int m, int k) const { return bf2f(A[(size_t)m * lda + k]); }
    __device__ float w(int, int k, int n) const { return W[(size_t)k * N + n]; }
    __device__ float w2(int, int, int) const { return 0.f; }
    __device__ void epi(int, int m, int n, float v, float) const { XS[(size_t)m * D + n] += mods[(size_t)mod_row(m) * 6 * D + chunk * D + n] * v; }
};
struct G_swiglu {
    static constexpr bool DUAL = true; const bf16_t* A; const float *Wg, *Wu; bf16_t* ACT; int N, K;
    __device__ int rows(int) const { return NTOK; }
    __device__ float a(int, int m, int k) const { return bf2f(A[(size_t)m * D + k]); }
    __device__ float w(int, int k, int n) const { return Wg[(size_t)k * N + n]; }
    __device__ float w2(int, int k, int n) const { return Wu[(size_t)k * N + n]; }
    __device__ void epi(int, int m, int n, float v, float v2) const { ACT[(size_t)m * N + n] = f2bf(silu_f(v) * v2); }
};
struct G_dq {
    static constexpr bool DUAL = false; const bf16_t* H; const float* W; float* CQ; int N, K;
    __device__ int rows(int) const { return NTOK; }
    __device__ float a(int, int m, int k) const { return bf2f(H[(size_t)m * D + k]); }
    __device__ float w(int, int k, int n) const { return W[(size_t)k * QLORA + n]; }
    __device__ float w2(int, int, int) const { return 0.f; }
    __device__ void epi(int, int m, int n, float v, float) const { CQ[(size_t)m * 512 + n] = v; }
};
struct G_dkv {
    static constexpr bool DUAL = true; const bf16_t* H; const float* W; float* CKV; bf16_t* KR; const float2* tab; int N, K;
    __device__ int rows(int) const { return NTOK; }
    __device__ float a(int, int m, int k) const { return bf2f(H[(size_t)m * D + k]); }
    __device__ float w(int, int k, int n) const { return W[(size_t)k * 576 + n]; }
    __device__ float w2(int, int k, int n) const { if (n < 512) return 0.f; return W[(size_t)k * 576 + 512 + rope_partner<32>(n - 512)]; }
    __device__ void epi(int, int m, int n, float v, float vp) const {
        if (n < 512) { CKV[(size_t)m * 512 + n] = v; return; }
        const int j = m % TPB; float o = v; if (j >= CTX) o = rope_apply<32>(tab, j - CTX, n - 512, v, vp);
        KR[(size_t)m * 64 + n - 512] = f2bf(o);
    }
};
struct G_uq {
    static constexpr bool DUAL = true; const bf16_t* A; const float* W; bf16_t* QM; const float2* tab; int N, K;
    __device__ int rows(int) const { return NTOK; }
    __device__ float a(int, int m, int k) const { return bf2f(A[(size_t)m * 512 + k]); }
    __device__ float w(int, int k, int n) const { return W[(size_t)k * 3072 + n]; }
    __device__ float w2(int, int k, int n) const { const int d = n % 192; if (d < 128) return 0.f; return W[(size_t)k * 3072 + (n - d) + 128 + rope_partner<32>(d - 128)]; }
    __device__ void epi(int, int m, int n, float v, float vp) const {
        const int d = n % 192, j = m % TPB; float o = v; if (d >= 128 && j >= CTX) o = rope_apply<32>(tab, j - CTX, d - 128, v, vp);
        QM[(size_t)m * 3072 + n] = f2bf(o);
    }
};
struct G_ukv {
    static constexpr bool DUAL = false; const bf16_t* A; const float* W; bf16_t* KVM; int N, K;
    __device__ int rows(int) const { return NTOK; }
    __device__ float a(int, int m, int k) const { return bf2f(A[(size_t)m * 512 + k]); }
    __device__ float w(int, int k, int n) const { return W[(size_t)k * 4096 + n]; }
    __device__ float w2(int, int, int) const { return 0.f; }
    __device__ void epi(int, int m, int n, float v, float) const { KVM[(size_t)m * 4096 + n] = f2bf(v); }
};
struct G_moe1 {
    static constexpr bool DUAL = true; const unsigned char* AS; const float *Wg, *Wu; bf16_t* ACT2; const int *CNT, *OFFS; int N, K;
    __device__ int rows(int z) const { return CNT[z]; }
    __device__ float a(int z, int m, int k) const { return __builtin_amdgcn_cvt_f32_fp8((int)AS[(size_t)(OFFS[z] + m) * D + k], 0); }
    __device__ float w(int z, int k, int n) const { return Wg[((size_t)z * D + k) * FFE + n]; }
    __device__ float w2(int z, int k, int n) const { return Wu[((size_t)z * D + k) * FFE + n]; }
    __device__ void epi(int z, int m, int n, float v, float v2) const { ACT2[(size_t)(OFFS[z] + m) * FFE + n] = f2bf(silu_f(v) * v2); }
};
struct G_moe2 {
    static constexpr bool DUAL = false; const unsigned char* ACT2; const float* Wd; float* Y; const int *CNT, *OFFS; int N, K;
    __device__ int rows(int z) const { return CNT[z]; }
    __device__ float a(int z, int m, int k) const { return __builtin_amdgcn_cvt_f32_fp8((int)ACT2[(size_t)(OFFS[z] + m) * FFE + k], 0) * (1.0f / A8_ACT); }
    __device__ float w(int z, int k, int n) const { return Wd[((size_t)z * FFE + k) * D + n]; }
    __device__ float w2(int, int, int) const { return 0.f; }
    __device__ void epi(int z, int m, int n, float v, float) const { Y[(size_t)(OFFS[z] + m) * D + n] = v; }
};

template <int DQK, int DV, class F> __global__ __launch_bounds__(256) void nattn(F f, int nkeys, float scale) {
    extern __shared__ float sm[];
    float* qs = sm;
    float* Pm = sm + 4 * DQK;
    __shared__ float rsum[4];
    const int z = blockIdx.y, q0 = blockIdx.x * 4, tid = threadIdx.x, lane = tid & 63, wave = tid >> 6;
    for (int i = tid; i < 4 * DQK; i += 256) { const int r = i / DQK, d = i % DQK; qs[i] = bf2f(f.qptr(z, q0 + r)[d]); }
    __syncthreads();
    for (int kk = tid; kk < nkeys; kk += 256) {
        float s0 = 0.f, s1 = 0.f, s2 = 0.f, s3 = 0.f;
        const bf16_t* kp = f.kptr(z, kk);
        for (int d = 0; d < 128; ++d) { const float kv = bf2f(kp[d]); s0 += qs[d] * kv; s1 += qs[DQK + d] * kv; s2 += qs[2 * DQK + d] * kv; s3 += qs[3 * DQK + d] * kv; }
        if (DQK > 128) { const bf16_t* k2 = f.k2ptr(z, kk);
            for (int d = 128; d < DQK; ++d) { const float kv = bf2f(k2[d - 128]); s0 += qs[d] * kv; s1 += qs[DQK + d] * kv; s2 += qs[2 * DQK + d] * kv; s3 += qs[3 * DQK + d] * kv; } }
        Pm[kk] = s0 * scale; Pm[nkeys + kk] = s1 * scale; Pm[2 * nkeys + kk] = s2 * scale; Pm[3 * nkeys + kk] = s3 * scale;
    }
    __syncthreads();
    {
        float* pr = Pm + wave * nkeys; float mx = -3.0e38f;
        for (int kk = lane; kk < nkeys; kk += 64) mx = fmaxf(mx, pr[kk]);
        mx = wave_max(mx); float s = 0.f;
        for (int kk = lane; kk < nkeys; kk += 64) { const float e = expf(pr[kk] - mx); pr[kk] = e; s += e; }
        s = wave_sum(s); if (lane == 0) rsum[wave] = s;
    }
    __syncthreads();
    for (int idx = tid; idx < 4 * DV; idx += 256) {
        const int r = idx / DV, e = idx % DV; const float* pr = Pm + r * nkeys; float acc = 0.f;
        for (int kk = 0; kk < nkeys; ++kk) acc += pr[kk] * bf2f(f.vptr(z, kk)[e]);
        f.store(z, q0 + r, e, acc / rsum[r]);
    }
}
struct A_diff {
    const bf16_t *Q, *K, *V; float* OD; int joff, pad;
    __device__ const bf16_t* qptr(int z, int qi) const { const int b = z >> 3, h = (z >> 1) & 3, c = z & 1; return Q + (size_t)(b * TPB + joff + qi) * 1024 + h * 256 + c * 128; }
    __device__ const bf16_t* kptr(int z, int kk) const { const int b = z >> 3, h = (z >> 1) & 3, c = z & 1; return K + (size_t)(b * TPB + kk) * 1024 + h * 256 + c * 128; }
    __device__ const bf16_t* k2ptr(int, int) const { return nullptr; }
    __device__ const bf16_t* vptr(int z, int kk) const { const int b = z >> 3, h = (z >> 1) & 3; return V + (size_t)(b * TPB + kk) * 1024 + h * 256; }
    __device__ void store(int z, int qi, int e, float v) const { const int b = z >> 3, h = (z >> 1) & 3, c = z & 1; OD[(((size_t)(b * TPB + joff + qi) * 4 + h) * 2 + c) * 256 + e] = v; }
};
struct A_mla {
    const bf16_t *QM, *KVM, *KR; bf16_t* OM;
    __device__ const bf16_t* qptr(int z, int qi) const { const int b = z >> 4, h = z & 15; return QM + (size_t)(b * TPB + CTX + qi) * 3072 + h * 192; }
    __device__ const bf16_t* kptr(int z, int kk) const { const int b = z >> 4, h = z & 15; return KVM + (size_t)(b * TPB + kk) * 4096 + h * 256; }
    __device__ const bf16_t* k2ptr(int z, int kk) const { const int b = z >> 4; return KR + (size_t)(b * TPB + kk) * 64; }
    __device__ const bf16_t* vptr(int z, int kk) const { const int b = z >> 4, h = z & 15; return KVM + (size_t)(b * TPB + kk) * 4096 + h * 256 + 128; }
    __device__ void store(int z, int qi, int e, float v) const { const int b = z >> 4, h = z & 15; OM[(size_t)(b * TPB + CTX + qi) * 2048 + h * 128 + e] = f2bf(v); }
};

#endif

#if ORACLE
__global__ __launch_bounds__(256) void k_cmp(const void* a, int a_bf  , const void* b, int b_bf, int rows, int cols, int lda, int ldb, int mask, const int* slottok, double* err) {
    double num = 0.0, den = 0.0;
    for (size_t i = (size_t)blockIdx.x * 256 + threadIdx.x; i < (size_t)rows * cols; i += (size_t)gridDim.x * 256) {
        const int r = (int)(i / cols), c = (int)(i % cols);
        if (mask == 1 && (r % TPB) < CTX) continue;
        if (mask == 2 && slottok[r] < 0) continue;
        const float va = a_bf == 2 ? __builtin_amdgcn_cvt_f32_fp8((int)((const unsigned char*)a)[(size_t)r * lda + c], 0) * (1.0f / A8_ACT) : a_bf ? bf2f(((const bf16_t*)a)[(size_t)r * lda + c]) : ((const float*)a)[(size_t)r * lda + c];
        const float vb = b_bf ? bf2f(((const bf16_t*)b)[(size_t)r * ldb + c]) : ((const float*)b)[(size_t)r * ldb + c];
        const double d = (double)va - (double)vb; num += d * d; den += (double)vb * (double)vb;
    }
    for (int o = 32; o >= 1; o >>= 1) { num += __shfl_xor(num, o); den += __shfl_xor(den, o); }
    if ((threadIdx.x & 63) == 0) { atomicAdd(err, num); atomicAdd(err + 1, den); }
}
__global__ __launch_bounds__(256) void k_verdict(float* out, size_t n, const double* err, int nslots, double tol) {
    int bad = -1;
    for (int s = 0; s < nslots; ++s) { const double num = err[2 * s], den = err[2 * s + 1]; const double t = s >= 16 ? 0.02 : tol; if (!(num <= t * den) || !(den > 0.0)) { bad = s; break; } }
    if (bad < 0) return;
    const float f = 1.0f + exp2f((float)(bad + 1));
    for (size_t i = (size_t)blockIdx.x * 256 + threadIdx.x; i < n; i += (size_t)gridDim.x * 256) out[i] *= f;
}
static_assert(sizeof(G_in) == 64 && sizeof(G_dftA) == 24 && sizeof(G_dftB) == 40 && sizeof(G_res) == 48 && sizeof(G_swiglu) == 40 && sizeof(G_dq) == 32 && sizeof(G_dkv) == 48 && sizeof(G_uq) == 40 && sizeof(G_ukv) == 32 && sizeof(G_moe1) == 56 && sizeof(G_moe2) == 48 && sizeof(A_diff) == 40 && sizeof(A_mla) == 32, "no padding bytes in by-value kernel arguments");
template <class G> static void run_gemm(const G& g, int Mmax, int Z, hipStream_t s) { hipLaunchKernelGGL(ngemm<G>, dim3((g.N + 127) / 128, (Mmax + 127) / 128, Z), dim3(256), 0, s, g); }
#endif
static_assert(sizeof(P) == 29 * 8, "P has no padding");

extern "C" void kernel_launch(void* const* d_in, const int* in_sizes, int n_in, void* d_out, int out_size, void* d_ws, size_t ws_size, hipStream_t stream) {
    static int grid = 0;
    if (grid == 0) {
        const size_t need = ORACLE ? (WS_SCR + (size_t)NSLOT * FFE * 2 > WS_SCR_XS + (size_t)NTOK * D * 4 ? WS_SCR + (size_t)NSLOT * FFE * 2 : WS_SCR_XS + (size_t)NTOK * D * 4) + 4096 : WS_END;
        if (n_in != 27 || ws_size < need) { fprintf(stderr, "kernel_launch: n_in %d ws %zu need %zu\n", n_in, ws_size, need); grid = -1; return; }
        int dev = 0, cus = 0, per_cu = 0;
        if (hipGetDevice(&dev) != hipSuccess || hipDeviceGetAttribute(&cus, hipDeviceAttributeMultiprocessorCount, dev) != hipSuccess) { grid = -1; return; }
        if (hipFuncSetAttribute((const void*)mega, hipFuncAttributeMaxDynamicSharedMemorySize, LDS_BYTES) != hipSuccess) { fprintf(stderr, "kernel_launch: hipFuncSetAttribute failed\n"); grid = -1; return; }
        if (hipOccupancyMaxActiveBlocksPerMultiprocessor(&per_cu, (const void*)mega, 512, LDS_BYTES) != hipSuccess || per_cu < 1) { fprintf(stderr, "kernel_launch: occupancy query says %d\n", per_cu); }
        (void)hipGetLastError();
        grid = cus;
    }
    if (grid < 0) return;
    (void)hipMemsetAsync((char*)d_ws + WS_CTL, 0, 1u << 20, stream);
    P p{};
    const float** pi = (const float**)&p;
    for (int i = 0; i < 27; ++i) pi[i] = (const float*)d_in[i];
    p.out = (float*)d_out; p.ws = (unsigned char*)d_ws;
#if !ORACLE
    hipLaunchKernelGGL(mega, dim3(grid), dim3(512), LDS_BYTES, stream, p, 0, NPH, 0);
#else
    double* ERR = (double*)(p.ws + WS_CTL + (size_t)CW_ERR * 4);
    unsigned char* SCR = p.ws + WS_SCR;
    const int* SLOTTOK = (const int*)(p.ws + WS_ROUTE + RT_SLOTTOK);
    auto PH = [&](int k) { hipLaunchKernelGGL(mega, dim3(grid), dim3(512), LDS_BYTES, stream, p, k, k + 1, k); };
    auto CMP = [&](int slot, const void* a, int abf, const void* b, int bbf, int rows, int cols, int lda, int ldb, int mask) {
        hipLaunchKernelGGL(k_cmp, dim3(2048), dim3(256), 0, stream, a, abf, b, bbf, rows, cols, lda, ldb, mask, SLOTTOK, ERR + 2 * slot); };
    const size_t SZ1K = (size_t)NTOK * 1024 * 2, SZXS = (size_t)NTOK * D * 4;
    PH(0); PH(1);
    PH(2);
    { bf16_t *Fo = (bf16_t*)SCR, *Qo = (bf16_t*)(SCR + SZ1K), *Ko = (bf16_t*)(SCR + 2 * SZ1K), *Vo = (bf16_t*)(SCR + 3 * SZ1K);
      G_in g{WSP(bf16_t, WS_H), p.ev_w_in, Fo, Qo, Ko, Vo, WSP(float2, WS_TABD), EIN, D}; run_gemm(g, NTOK, 1, stream);
      CMP(0, WSP(bf16_t, A0_F), 1, Fo, 1, NTOK, 1024, 1024, 1024, 0); CMP(1, WSP(bf16_t, A0_Q), 1, Qo, 1, NTOK, 1024, 1024, 1024, 0);
      CMP(2, WSP(bf16_t, A0_K), 1, Ko, 1, NTOK, 1024, 1024, 1024, 0); CMP(3, WSP(bf16_t, A0_V), 1, Vo, 1, NTOK, 1024, 1024, 1024, 0); }
    PH(3); PH(4);
    { float* T32 = (float*)SCR; bf16_t* MIXo = (bf16_t*)(SCR + (size_t)NTOK * 4 * 512 * 4);
      G_dftA g{WSP(bf16_t, A0_F), T32, 512, 256}; run_gemm(g, NTOK * 4, 1, stream);
      G_dftB g1{T32, MIXo, 256, 2 * SEQ, SEQ, CTX, 1.0f / sqrtf((float)SEQ * 256.f), 0}; run_gemm(g1, SEQ, 16, stream);
      G_dftB g2{T32, MIXo, 256, 2 * CTX, CTX, 0, 1.0f / sqrtf((float)CTX * 256.f), 0}; run_gemm(g2, CTX, 16, stream);
      CMP(4, WSP(bf16_t, A0_MIX), 1, MIXo, 1, NTOK, 1024, 2048, 2048, 0);
      float* ODo = (float*)SCR;
      A_diff f{WSP(bf16_t, A0_Q), WSP(bf16_t, A0_K), WSP(bf16_t, A0_V), ODo, CTX, 0};
      hipLaunchKernelGGL((nattn<128, 256, A_diff>), dim3(SEQ / 4, 32), dim3(256), (4 * 128 + 4 * TPB) * 4, stream, f, TPB, 0.08838834764831845f);
      A_diff f2{WSP(bf16_t, A0_Q), WSP(bf16_t, A0_K), WSP(bf16_t, A0_V), ODo, 0, 0};
      hipLaunchKernelGGL((nattn<128, 256, A_diff>), dim3(CTX / 4, 32), dim3(256), (4 * 128 + 4 * CTX) * 4, stream, f2, CTX, 0.08838834764831845f);
      CMP(5, WSP(float, A0_OD), 0, ODo, 0, NTOK, 2048, 2048, 2048, 0); }
    PH(5);
    { float* XSo = (float*)(p.ws + WS_SCR_XS); (void)hipMemcpyAsync(XSo, WSP(float, WS_XS), SZXS, hipMemcpyDeviceToDevice, stream);
      G_res g{WSP(bf16_t, A0_MIX), p.ev_w_out, XSo, WSP(float, WS_MODS), D, 2048, 2048, 2}; run_gemm(g, NTOK, 1, stream);
      PH(6); CMP(6, WSP(float, WS_XS), 0, XSo, 0, NTOK, D, D, D, 0); }
    PH(7);
    PH(8);
    { bf16_t* ACTo = (bf16_t*)SCR; G_swiglu g{WSP(bf16_t, WS_H), p.ffn_w_gate, p.ffn_w_up, ACTo, FFD, D}; run_gemm(g, NTOK, 1, stream);
      CMP(7, WSP(bf16_t, A0_ACT), 1, ACTo, 1, NTOK, FFD, FFD, FFD, 0); }
    { float* XSo = (float*)(p.ws + WS_SCR_XS); (void)hipMemcpyAsync(XSo, WSP(float, WS_XS), SZXS, hipMemcpyDeviceToDevice, stream);
      G_res g{WSP(bf16_t, A0_ACT), p.ffn_w_down, XSo, WSP(float, WS_MODS), D, FFD, FFD, 5}; run_gemm(g, NTOK, 1, stream);
      PH(9); CMP(8, WSP(float, WS_XS), 0, XSo, 0, NTOK, D, D, D, 0); }
    PH(10);
    PH(11);
    { float* CQo = (float*)SCR; float* CKVo = (float*)(SCR + (size_t)NTOK * 512 * 4); bf16_t* KRo = (bf16_t*)(SCR + (size_t)NTOK * 512 * 8);
      G_dq g{WSP(bf16_t, WS_H), p.od_w_dq, CQo, QLORA, D}; run_gemm(g, NTOK, 1, stream);
      G_dkv g2{WSP(bf16_t, WS_H), p.od_w_dkv, CKVo, KRo, WSP(float2, WS_TABM), 576, D}; run_gemm(g2, NTOK, 1, stream);
      CMP(9, WSP(float, A1_CQ), 0, CQo, 0, NTOK, 512, 512, 512, 0); CMP(10, WSP(float, A1_CKV), 0, CKVo, 0, NTOK, 512, 512, 512, 0); CMP(11, WSP(bf16_t, A1_KR), 1, KRo, 1, NTOK, 64, 64, 64, 0); }
    PH(12);
    PH(13);
    { bf16_t* QMo = (bf16_t*)SCR; bf16_t* KVMo = (bf16_t*)(SCR + (size_t)NTOK * 3072 * 2);
      G_uq g{WSP(bf16_t, A1_CQN), p.od_w_uq, QMo, WSP(float2, WS_TABM), 3072, 512}; run_gemm(g, NTOK, 1, stream);
      G_ukv g2{WSP(bf16_t, A1_CKVN), p.od_w_ukv, KVMo, 4096, 512}; run_gemm(g2, NTOK, 1, stream);
      CMP(12, WSP(bf16_t, A1_QM), 1, QMo, 1, NTOK, 3072, 3072, 3072, 1); CMP(13, WSP(bf16_t, A1_KVM), 1, KVMo, 1, NTOK, 4096, 4096, 4096, 0); }
    PH(14);
    { bf16_t* OMo = (bf16_t*)SCR; A_mla f{WSP(bf16_t, A1_QM), WSP(bf16_t, A1_KVM), WSP(bf16_t, A1_KR), OMo};
      hipLaunchKernelGGL((nattn<192, 128, A_mla>), dim3(SEQ / 4, 64), dim3(256), (4 * 192 + 4 * TPB) * 4, stream, f, TPB, 0.07216878364870323f);
      CMP(14, WSP(bf16_t, A1_OM), 1, OMo, 1, NTOK, 2048, 2048, 2048, 1); }
    { float* XSo = (float*)(p.ws + WS_SCR_XS); (void)hipMemcpyAsync(XSo, WSP(float, WS_XS), SZXS, hipMemcpyDeviceToDevice, stream);
      G_res g{WSP(bf16_t, A1_OM), p.od_w_o, XSo, WSP(float, WS_MODS) + 5 * 6 * D, D, 2048, 2048, 2}; run_gemm(g, NTOK, 1, stream);
      PH(15); CMP(15, WSP(float, WS_XS), 0, XSo, 0, NTOK, D, D, D, 1); }
    PH(16); PH(17); PH(18);
    PH(19);
    { bf16_t* ACT2o = (bf16_t*)SCR; G_moe1 g{WSP(unsigned char, A1_AS), p.moe_w_gate, p.moe_w_up, ACT2o, (const int*)(p.ws + WS_ROUTE + RT_CNT), (const int*)(p.ws + WS_ROUTE + RT_OFFS), FFE, D}; run_gemm(g, NB * SEQ, 8, stream);
      CMP(16, WSP(unsigned char, A1_ACT2), 2, ACT2o, 1, NSLOT, FFE, FFE, FFE, 2); }
    PH(20);
    { float* Yo = (float*)SCR; G_moe2 g{WSP(unsigned char, A1_ACT2), p.moe_w_down, Yo, (const int*)(p.ws + WS_ROUTE + RT_CNT), (const int*)(p.ws + WS_ROUTE + RT_OFFS), D, FFE}; run_gemm(g, NB * SEQ, 8, stream);
      CMP(17, WSP(float, A1_Y), 0, Yo, 0, NSLOT, D, D, D, 2); }
    PH(21);
    hipLaunchKernelGGL(k_verdict, dim3(2048), dim3(256), 0, stream, p.out, (size_t)NB * SEQ * D, (const double*)ERR, 18, 2.0e-4);
#endif
}
```

```cpp
#ifndef ORACLE
#define ORACLE 0
#endif
#include <hip/hip_runtime.h>
#include <cstdio>
#include <cstdint>

constexpr int D = 2048, NB = 4, SEQ = 2048, CTX = 256, TPB = SEQ + CTX  , NTOK = NB * TPB  ;
constexpr int FW = 1024, QKW = 1024, VW = 1024, EIN = 4096, FFD = 5632, NEXP = 8, FFE = 7168;
constexpr int QLORA = 512, KVLORA = 512, MROPE = 64, MH = 16;
constexpr int NSLOT = 2 * NB * SEQ + NEXP * 256;
constexpr float EPS = 1e-6f;

typedef unsigned short bf16_t;
typedef float f32x4 __attribute__((ext_vector_type(4)));
typedef short bf16x8 __attribute__((ext_vector_type(8)));

__device__ __forceinline__ float bf2f(bf16_t v) { return __uint_as_float(((unsigned)v) << 16); }
__device__ __forceinline__ bf16_t f2bf(float f) { unsigned u = __float_as_uint(f); u += 0x7fffu + ((u >> 16) & 1u); return (bf16_t)(u >> 16); }
__device__ __forceinline__ float wave_sum(float v) {
#pragma unroll
    for (int o = 1; o < 64; o <<= 1) v += __shfl_xor(v, o);
    return v;
}
__device__ __forceinline__ float wave_max(float v) {
#pragma unroll
    for (int o = 1; o < 64; o <<= 1) v = fmaxf(v, __shfl_xor(v, o));
    return v;
}
__device__ __forceinline__ int lane_id() { int l; asm volatile("v_mbcnt_lo_u32_b32 %0, -1, 0\n\tv_mbcnt_hi_u32_b32 %0, -1, %0" : "=v"(l)); return l; }
__device__ __forceinline__ int tid_from(int wv) { asm volatile("" : "+s"(wv)); return wv * 64 + lane_id(); }
#define TID_FROM(wv) tid_from(wv)
constexpr float W8_GU = 32.f, W8_DN = 64.f, A8_ACT = 4.f;
__device__ __forceinline__ unsigned pack4_fp8(float a, float b, float c, float d) {
    a = fminf(fmaxf(a, -448.f), 448.f); b = fminf(fmaxf(b, -448.f), 448.f); c = fminf(fmaxf(c, -448.f), 448.f); d = fminf(fmaxf(d, -448.f), 448.f);
    int w = 0; w = __builtin_amdgcn_cvt_pk_fp8_f32(a, b, w, false); w = __builtin_amdgcn_cvt_pk_fp8_f32(c, d, w, true); return (unsigned)w;
}
__device__ __forceinline__ float silu_f(float x) { return x / (1.f + expf(-x)); }

constexpr size_t al(size_t x) { return (x + 4095) / 4096 * 4096; }
constexpr size_t WS_CTL = 0;
constexpr size_t WS_XS = 1u << 20;
constexpr size_t WS_MODS = WS_XS + al((size_t)NTOK * D * 4);
constexpr size_t WS_TABD = WS_MODS + al((size_t)2 * 5 * 6 * D * 4);
constexpr size_t WS_TABM = WS_TABD + al(64 * 32 * 8);
constexpr size_t WS_SCAL = WS_TABM + al(64 * 16 * 8);
constexpr size_t WS_H = WS_SCAL + 4096;
constexpr size_t WS_ROUTE = WS_H + al((size_t)NTOK * D * 2);
constexpr size_t RT_TE = 0, RT_TG = (size_t)NTOK * 8, RT_TSLOT = (size_t)NTOK * 16, RT_SLOTTOK = (size_t)NTOK * 24, RT_CNT = RT_SLOTTOK + (size_t)NSLOT * 4, RT_OFFS = RT_CNT + 64;
constexpr size_t WT_IN = WS_ROUTE + al(RT_OFFS + 64);
constexpr size_t WT_OUT = WT_IN + al((size_t)4096 * 2048 * 2);
constexpr size_t WT_GU = WT_OUT + al((size_t)2048 * 2048 * 2);
constexpr size_t WT_DN = WT_GU + al((size_t)2 * FFD * 2048 * 2);
constexpr size_t WT_DQKV = WT_DN + al((size_t)2048 * FFD * 2);
constexpr size_t WT_UQ = WT_DQKV + al((size_t)1280 * 2048 * 2);
constexpr size_t WT_UKV = WT_UQ + al((size_t)3072 * 512 * 2);
constexpr size_t WT_O = WT_UKV + al((size_t)4096 * 512 * 2);
constexpr size_t WT_MGU = WT_O + al((size_t)2048 * 2048 * 2);
constexpr size_t WT_MD = WT_MGU + al((size_t)8 * 2 * FFE * 2048);
constexpr size_t WS_WCS = WT_MD + al((size_t)8 * 2048 * FFE);
constexpr size_t WS_DFTN = WS_WCS + al(512 * 256 * 2);
constexpr size_t WS_DFTC = WS_DFTN + al((size_t)2048 * 4096 * 2);
constexpr size_t WS_ACTS = WS_DFTC + al(256 * 512 * 2);
constexpr size_t A0_F = WS_ACTS;
constexpr size_t A0_Q = A0_F + al((size_t)NTOK * 1024 * 2);
constexpr size_t A0_K = A0_Q + al((size_t)NTOK * 1024 * 2);
constexpr size_t A0_V = A0_K + al((size_t)NTOK * 1024 * 2);
constexpr size_t A0_VT = A0_V + al((size_t)NTOK * 1024 * 2);
constexpr size_t A0_VTC = A0_VT + al((size_t)16 * 256 * 4096 * 2);
constexpr size_t A0_OD = A0_VTC + al((size_t)16 * 256 * 512 * 2);
constexpr size_t A0_MIX = A0_OD + al((size_t)NTOK * 2048 * 4);
constexpr size_t A0_ACT = A0_MIX + al((size_t)NTOK * 2048 * 2);
constexpr size_t A0_END = A0_ACT + al((size_t)NTOK * FFD * 2);
constexpr size_t A1_CQ = WS_ACTS;
constexpr size_t A1_CKV = A1_CQ + al((size_t)NTOK * 512 * 4);
constexpr size_t A1_KR = A1_CKV + al((size_t)NTOK * 512 * 4);
constexpr size_t A1_CQN = A1_KR + al((size_t)NTOK * 64 * 2);
constexpr size_t A1_CKVN = A1_CQN + al((size_t)NTOK * 512 * 2);
constexpr size_t A1_QM = A1_CKVN + al((size_t)NTOK * 512 * 2);
constexpr size_t A1_KVM = A1_QM + al((size_t)NTOK * 3072 * 2);
constexpr size_t A1_OM = A1_KVM + al((size_t)NTOK * 4096 * 2);
constexpr size_t A1_AS = A1_OM + al((size_t)NTOK * 2048 * 2);
constexpr size_t A1_ACT2 = A1_AS + al((size_t)NSLOT * 2048);
constexpr size_t A1_Y = WS_ACTS;
constexpr size_t A1_END = A1_ACT2 + al((size_t)NSLOT * FFE);
static_assert(A1_Y + (size_t)NSLOT * 2048 * 4 <= A1_AS, "Y overlays only the dead MLA buffers");
constexpr size_t WS_ARENA_END = A0_END > A1_END ? A0_END : A1_END;
constexpr size_t WS_SLAB = WS_ARENA_END;
constexpr size_t SLAB_BYTES = (size_t)384 << 18;
constexpr size_t WS_END = WS_SLAB + SLAB_BYTES;
constexpr size_t WS_SCR = WS_SLAB;
constexpr size_t WS_SCR_XS = WS_END;

struct P {
    const float *x, *c, *ctx, *c_ctx, *ada_w, *ada_b, *norm1_g, *norm2_g, *ev_w_in, *ev_w_out, *ev_lambda, *ev_subln_g;
    const float *od_w_dq, *od_q_norm_g, *od_w_uq, *od_w_dkv, *od_kv_norm_g, *od_w_ukv, *od_w_o;
    const float *ffn_w_gate, *ffn_w_up, *ffn_w_down, *moe_router, *moe_w_gate, *moe_w_up, *moe_w_down, *final_norm_g;
    float* out; unsigned char* ws;
};
#define WSP(T, off) ((T*)(p.ws + (off)))

__device__ __forceinline__ int mod_row(int R) { const int b = R / TPB, j = R - b * TPB; return j < CTX ? 4 : b; }

__device__ __forceinline__ void ph_prologue(const P& p, int bid, int nb, float* lds_f, int wv) {
    int tid_ = TID_FROM(wv); asm volatile("" : "+v"(tid_)); const int tid = tid_, lane = tid & 63, wave = tid >> 6;
    float* XS = WSP(float, WS_XS);
    if (ORACLE) for (size_t i = (size_t)bid * 512 + tid; i < (size_t)NTOK * (D / 4); i += (size_t)nb * 512) {
        const int R = (int)(i / (D / 4)), c4 = (int)(i % (D / 4)); const int b = R / TPB, j = R - b * TPB;
        const float* src = j < CTX ? p.ctx + ((size_t)(b * CTX + j)) * D : p.x + ((size_t)(b * SEQ + (j - CTX))) * D;
        ((f32x4*)XS)[i] = ((const f32x4*)src)[c4];
    }
    if (bid == 0) {
        float2* TD = WSP(float2, WS_TABD); float2* TM = WSP(float2, WS_TABM);
        for (int i = tid; i < 64 * 32; i += 512) { const int pos = i / 32, fi = i % 32; const double inv = pow(10000.0, -(double)(2 * fi) / 64.0), a = (double)pos * inv; TD[i] = make_float2((float)cos(a), (float)sin(a)); }
        for (int i = tid; i < 64 * 16; i += 512) { const int pos = i / 16, fi = i % 16; const double inv = pow(10000.0, -(double)(2 * fi) / 32.0), a = (double)pos * inv; TM[i] = make_float2((float)cos(a), (float)sin(a)); }
        if (wave == 0) {
            float s01 = 0.f, s23 = 0.f;
            for (int i = lane; i < 128; i += 64) { s01 += p.ev_lambda[i] * p.ev_lambda[128 + i]; s23 += p.ev_lambda[256 + i] * p.ev_lambda[384 + i]; }
            s01 = wave_sum(s01); s23 = wave_sum(s23);
            if (lane == 0) WSP(float, WS_SCAL)[0] = expf(s01) - expf(s23) + 0.2f;
        }
    }
    float* S = lds_f;
    float* RED = lds_f + 5 * 2048;
    for (int i = tid; i < 5 * D; i += 512) { const int bb = i / D, k = i % D; const float v = bb < 4 ? p.c[bb * D + k] : p.c_ctx[k]; S[i] = silu_f(v); }
    __syncthreads();
    float* MODS = WSP(float, WS_MODS);
    for (int it = bid; it < 2 * 128; it += nb) {
        const int layer = it >> 7, cg = it & 127, ln = lane < 48 ? lane : 47, col = cg * 96 + ln * 2;
        const float* W = p.ada_w + (size_t)layer * D * 6 * D + col;
        float a0[5], a1[5];
#pragma unroll
        for (int bb = 0; bb < 5; ++bb) { a0[bb] = 0.f; a1[bb] = 0.f; }
        const int kb = wave * 256;
#pragma unroll 1
        for (int k0 = 0; k0 < 256; k0 += 16) {
            float2 w[16];
#pragma unroll
            for (int u = 0; u < 16; ++u) w[u] = *(const float2*)(W + (size_t)(kb + k0 + u) * 6 * D);
#pragma unroll
            for (int u = 0; u < 16; ++u) {
#pragma unroll
                for (int bb = 0; bb < 5; ++bb) { const float s = S[bb * D + kb + k0 + u]; a0[bb] += s * w[u].x; a1[bb] += s * w[u].y; } }
        }
        if (lane < 48) {
#pragma unroll
            for (int bb = 0; bb < 5; ++bb) { RED[(wave * 5 + bb) * 96 + lane * 2] = a0[bb]; RED[(wave * 5 + bb) * 96 + lane * 2 + 1] = a1[bb]; } }
        __syncthreads();
        for (int i = tid; i < 5 * 96; i += 512) { const int bb = i / 96, cc = i % 96; float s = 0.f;
#pragma unroll
            for (int w = 0; w < 8; ++w) s += RED[(w * 5 + bb) * 96 + cc];
            MODS[((size_t)layer * 5 + bb) * 6 * D + cg * 96 + cc] = s + p.ada_b[(size_t)layer * 6 * D + cg * 96 + cc]; }
        __syncthreads();
    }
}

__device__ __forceinline__ const float* in_row(const P& p, int R) { const int b = R / TPB, j = R - b * TPB; return j < CTX ? p.ctx + ((size_t)(b * CTX + j)) * D : p.x + ((size_t)(b * SEQ + (j - CTX))) * D; }
template <bool FROM_IN = false> __device__ __forceinline__ void ph_norm_mod(const P& p, const float* g, int layer, int csh, int csc, int bid, int nb, int wv) {
    int tid_ = TID_FROM(wv); asm volatile("" : "+v"(tid_)); const int tid = tid_, lane = tid & 63, wave = tid >> 6;
    const float* XS = WSP(float, WS_XS); const float* MODS = WSP(float, WS_MODS) + (size_t)layer * 5 * 6 * D; bf16_t* H = WSP(bf16_t, WS_H);
    for (int R = bid * 8 + wave; R < NTOK; R += nb * 8) {
        const f32x4* xr = (const f32x4*)(FROM_IN ? in_row(p, R) : XS + (size_t)R * D); f32x4 v[8]; float ss = 0.f;
#pragma unroll
        for (int j = 0; j < 8; ++j) { v[j] = xr[lane + 64 * j]; ss += v[j].x * v[j].x + v[j].y * v[j].y + v[j].z * v[j].z + v[j].w * v[j].w; }
        const float rstd = 1.0f / sqrtf(wave_sum(ss) * (1.f / D) + EPS);
        const float* mr = MODS + (size_t)mod_row(R) * 6 * D;
#pragma unroll
        for (int j = 0; j < 8; ++j) { const int c0 = (lane + 64 * j) * 4; const f32x4 gg = *(const f32x4*)(g + c0), sh = *(const f32x4*)(mr + csh * D + c0), sc = *(const f32x4*)(mr + csc * D + c0);
            const f32x4 o = (v[j] * rstd * gg) * (sc + 1.f) + sh;
            ushort4 w; w.x = f2bf(o.x); w.y = f2bf(o.y); w.z = f2bf(o.z); w.w = f2bf(o.w);
            *(ushort4*)(H + (size_t)R * D + c0) = w; }
    }
}

__device__ __forceinline__ void ph_subln(const P& p, int bid, int nb, int wv) {
    int tid_ = TID_FROM(wv); asm volatile("" : "+v"(tid_)); const int tid = tid_, lane = tid & 63, wave = tid >> 6;
    const float* OD = WSP(float, A0_OD); bf16_t* MIX = WSP(bf16_t, A0_MIX); const float lam = WSP(float, WS_SCAL)[0];
    const f32x4 gg = *(const f32x4*)(p.ev_subln_g + lane * 4);
    for (int it0 = bid * 8 + wave; it0 < NTOK * 4; it0 += nb * 8 * 4) {
        f32x4 o0[4], o1[4];
#pragma unroll
        for (int u = 0; u < 4; ++u) { const int it = it0 + u * nb * 8; if (it < NTOK * 4) { o0[u] = *(const f32x4*)(OD + ((size_t)it * 2 + 0) * 256 + lane * 4); o1[u] = *(const f32x4*)(OD + ((size_t)it * 2 + 1) * 256 + lane * 4); } else { o0[u] = o1[u] = (f32x4){0.f, 0.f, 0.f, 0.f}; } }
#pragma unroll
        for (int u = 0; u < 4; ++u) { const int it = it0 + u * nb * 8; const int R = it >> 2, h = it & 3;
            const f32x4 o = o0[u] - o1[u] * lam;
            const float rstd = 1.0f / sqrtf(wave_sum(o.x * o.x + o.y * o.y + o.z * o.z + o.w * o.w) * (1.f / 256.f) + EPS);
            const f32x4 r = o * rstd * gg * 0.8f;
            ushort4 w; w.x = f2bf(r.x); w.y = f2bf(r.y); w.z = f2bf(r.z); w.w = f2bf(r.w);
            if (it < NTOK * 4) *(ushort4*)(MIX + (size_t)R * 2048 + 1024 + h * 256 + lane * 4) = w; }
    }
}

__device__ __forceinline__ void ph_lora_norm(const P& p, int bid, int nb, int wv) {
    int tid_ = TID_FROM(wv); asm volatile("" : "+v"(tid_)); const int tid = tid_, lane = tid & 63, wave = tid >> 6;
    for (int it = bid * 8 + wave; it < NTOK * 2; it += nb * 8) {
        const int R = it >> 1, which = it & 1;
        const float* src = (which ? WSP(float, A1_CKV) : WSP(float, A1_CQ)) + (size_t)R * 512; const float* g = which ? p.od_kv_norm_g : p.od_q_norm_g;
        bf16_t* dst = (which ? WSP(bf16_t, A1_CKVN) : WSP(bf16_t, A1_CQN)) + (size_t)R * 512;
        f32x4 v[2]; float ss = 0.f;
#pragma unroll
        for (int j = 0; j < 2; ++j) { v[j] = *(const f32x4*)(src + (lane + 64 * j) * 4); ss += v[j].x * v[j].x + v[j].y * v[j].y + v[j].z * v[j].z + v[j].w * v[j].w; }
        const float rstd = 1.0f / sqrtf(wave_sum(ss) * (1.f / 512.f) + EPS);
#pragma unroll
        for (int j = 0; j < 2; ++j) { const int c0 = (lane + 64 * j) * 4; const f32x4 gg = *(const f32x4*)(g + c0); const f32x4 o = v[j] * rstd * gg;
            ushort4 w; w.x = f2bf(o.x); w.y = f2bf(o.y); w.z = f2bf(o.z); w.w = f2bf(o.w); *(ushort4*)(dst + c0) = w; }
    }
}

__device__ __forceinline__ void ph_route(const P& p, int bid, int nb, float* rt  , int wv) {
    int tid_ = TID_FROM(wv); asm volatile("" : "+v"(tid_)); const int tid = tid_, lane = tid & 63, wave = tid >> 6;
    const float* XS = WSP(float, WS_XS); const float* MODS = WSP(float, WS_MODS) + (size_t)1 * 5 * 6 * D; bf16_t* H = WSP(bf16_t, WS_H);
    const float* g = p.norm2_g + D; int* TE = (int*)(p.ws + WS_ROUTE + RT_TE); float* TG = (float*)(p.ws + WS_ROUTE + RT_TG);
    for (int i = tid; i < D * 2; i += 512) { const f32x4 v = ((const f32x4*)p.moe_router)[i]; const int k = i >> 1, e0 = (i & 1) * 4; rt[(e0 + 0) * D + k] = v.x; rt[(e0 + 1) * D + k] = v.y; rt[(e0 + 2) * D + k] = v.z; rt[(e0 + 3) * D + k] = v.w; }
    __syncthreads();
    for (int t0 = (bid * 8 + wave) * 4; t0 < NB * SEQ; t0 += nb * 8 * 4) {
        const int b = t0 / SEQ, R0 = b * TPB + CTX + (t0 - b * SEQ);
        const float* mr = MODS + (size_t)b * 6 * D;
        f32x4 am[8], bm[8];
#pragma unroll
        for (int j = 0; j < 8; ++j) { const int c0 = (lane + 64 * j) * 4; const f32x4 gg = *(const f32x4*)(g + c0), sc = *(const f32x4*)(mr + 4 * D + c0); am[j] = gg * (sc + 1.f); bm[j] = *(const f32x4*)(mr + 3 * D + c0); }
        f32x4 v[8], vn[8];
#pragma unroll
        for (int j = 0; j < 8; ++j) v[j] = ((const f32x4*)(XS + (size_t)R0 * D))[lane + 64 * j];
#pragma unroll
        for (int k = 0; k < 4; ++k) {
            const int R = R0 + k;
            if (k < 3) {
#pragma unroll
                for (int j = 0; j < 8; ++j) vn[j] = ((const f32x4*)(XS + (size_t)(R + 1) * D))[lane + 64 * j]; }
            float ss = 0.f;
#pragma unroll
            for (int j = 0; j < 8; ++j) ss += v[j].x * v[j].x + v[j].y * v[j].y + v[j].z * v[j].z + v[j].w * v[j].w;
            const float rstd = 1.0f / sqrtf(wave_sum(ss) * (1.f / D) + EPS);
            float lg[8];
#pragma unroll
            for (int e = 0; e < 8; ++e) lg[e] = 0.f;
#pragma unroll
            for (int j = 0; j < 8; ++j) { const int c0 = (lane + 64 * j) * 4;
                const f32x4 o = (v[j] * rstd) * am[j] + bm[j];
                *(unsigned*)((unsigned char*)H + (size_t)R * D + c0) = pack4_fp8(o.x, o.y, o.z, o.w);
#pragma unroll
                for (int e = 0; e < 8; ++e) { const f32x4 r4 = *(const f32x4*)(rt + e * D + c0); lg[e] += (o.x * r4.x + o.y * r4.y) + (o.z * r4.z + o.w * r4.w); }
                asm volatile("" ::: "memory"); }
#pragma unroll
            for (int e = 0; e < 8; ++e) lg[e] = wave_sum(lg[e]);
            if (lane == 0) {
                int e1 = 0; float v1 = lg[0];
#pragma unroll
                for (int e = 1; e < 8; ++e) if (lg[e] > v1) { v1 = lg[e]; e1 = e; }
                int e2 = -1; float v2 = -3.0e38f;
#pragma unroll
                for (int e = 0; e < 8; ++e) if (e != e1 && lg[e] > v2) { v2 = lg[e]; e2 = e; }
                const float ex = expf(v2 - v1), w1 = 1.f / (1.f + ex), w2 = ex / (1.f + ex);
                TE[R * 2] = e1; TE[R * 2 + 1] = e2; TG[R * 2] = w1; TG[R * 2 + 1] = w2;
            }
#pragma unroll
            for (int j = 0; j < 8; ++j) v[j] = vn[j];
        }
    }
}

__device__ __forceinline__ void ph_sort(const P& p, int bid, int* lds_i, int wv) {
    if (bid != 0) return;
    int tid_ = TID_FROM(wv); asm volatile("" : "+v"(tid_)); const int tid = tid_;
    const int* TE = (const int*)(p.ws + WS_ROUTE + RT_TE); int* TSLOT = (int*)(p.ws + WS_ROUTE + RT_TSLOT); int* SLOTTOK = (int*)(p.ws + WS_ROUTE + RT_SLOTTOK);
    int* CNT = (int*)(p.ws + WS_ROUTE + RT_CNT); int* OFFS = (int*)(p.ws + WS_ROUTE + RT_OFFS);
    int* cn = lds_i;
    int* offs = lds_i + 8 * 512;
    int* tot = offs + 16;
    int c0 = 0, c1 = 0, c2 = 0, c3 = 0, c4 = 0, c5 = 0, c6 = 0, c7 = 0;
    for (int i = 0; i < 16; ++i) { const int t = tid * 16 + i, b = t / SEQ, R = b * TPB + CTX + (t - b * SEQ);
        for (int k = 0; k < 2; ++k) { const int e = TE[R * 2 + k]; c0 += e == 0; c1 += e == 1; c2 += e == 2; c3 += e == 3; c4 += e == 4; c5 += e == 5; c6 += e == 6; c7 += e == 7; } }
    cn[0 * 512 + tid] = c0; cn[1 * 512 + tid] = c1; cn[2 * 512 + tid] = c2; cn[3 * 512 + tid] = c3; cn[4 * 512 + tid] = c4; cn[5 * 512 + tid] = c5; cn[6 * 512 + tid] = c6; cn[7 * 512 + tid] = c7;
    __syncthreads();
    {
        const int e = tid >> 6, ln = tid & 63; int v[8]; int run = 0;
#pragma unroll
        for (int j = 0; j < 8; ++j) { const int t = cn[e * 512 + ln * 8 + j]; v[j] = run; run += t; }
        int incl = run;
#pragma unroll
        for (int o = 1; o < 64; o <<= 1) { const int n = __shfl_up(incl, o); if (ln >= o) incl += n; }
        const int excl = incl - run;
#pragma unroll
        for (int j = 0; j < 8; ++j) cn[e * 512 + ln * 8 + j] = v[j] + excl;
        if (ln == 63) tot[e] = incl;
    }
    __syncthreads();
    if (tid == 0) { int o = 0; for (int e = 0; e < 8; ++e) { offs[e] = o; OFFS[e] = o; CNT[e] = tot[e]; o += (tot[e] + 255) / 256 * 256; } offs[8] = o; OFFS[8] = o; }
    __syncthreads();
    for (int i = tid; i < NSLOT; i += 512) SLOTTOK[i] = -1;
    __syncthreads();
    int r0 = cn[0 * 512 + tid] + offs[0], r1 = cn[1 * 512 + tid] + offs[1], r2 = cn[2 * 512 + tid] + offs[2], r3 = cn[3 * 512 + tid] + offs[3];
    int r4 = cn[4 * 512 + tid] + offs[4], r5 = cn[5 * 512 + tid] + offs[5], r6 = cn[6 * 512 + tid] + offs[6], r7 = cn[7 * 512 + tid] + offs[7];
    for (int i = 0; i < 16; ++i) { const int t = tid * 16 + i, b = t / SEQ, R = b * TPB + CTX + (t - b * SEQ);
        for (int k = 0; k < 2; ++k) { const int e = TE[R * 2 + k]; int s;
            s = e == 0 ? r0 : e == 1 ? r1 : e == 2 ? r2 : e == 3 ? r3 : e == 4 ? r4 : e == 5 ? r5 : e == 6 ? r6 : r7;
            r0 += e == 0; r1 += e == 1; r2 += e == 2; r3 += e == 3; r4 += e == 4; r5 += e == 5; r6 += e == 6; r7 += e == 7;
            TSLOT[R * 2 + k] = s; SLOTTOK[s] = R; } }
}

__device__ __forceinline__ void ph_gather(const P& p, int bid, int nb, int wv) {
    int tid_ = TID_FROM(wv); asm volatile("" : "+v"(tid_)); const int tid = tid_, lane = tid & 63, wave = tid >> 6;
    const int* SLOTTOK = (const int*)(p.ws + WS_ROUTE + RT_SLOTTOK); const int* OFFS = (const int*)(p.ws + WS_ROUTE + RT_OFFS);
    const unsigned char* H8 = WSP(unsigned char, WS_H); unsigned char* AS = WSP(unsigned char, A1_AS); const int total = OFFS[8];
    for (int s0 = bid * 8 + wave; s0 < total; s0 += nb * 8 * 4) {
        int Rr[4];
#pragma unroll
        for (int u = 0; u < 4; ++u) { const int s = s0 + u * nb * 8; Rr[u] = SLOTTOK[s < total ? s : total - 1]; }
        uint4 v[4][2];
#pragma unroll
        for (int u = 0; u < 4; ++u) { const uint4* src = (const uint4*)(H8 + (size_t)(Rr[u] > 0 ? Rr[u] : 0) * D);
#pragma unroll
            for (int j = 0; j < 2; ++j) v[u][j] = src[lane + 64 * j]; }
#pragma unroll
        for (int u = 0; u < 4; ++u) { const int s = s0 + u * nb * 8; const bool pad = Rr[u] < 0; uint4* dst = (uint4*)(AS + (size_t)(s < total ? s : total - 1) * D);
#pragma unroll
            for (int j = 0; j < 2; ++j) { uint4 w = v[u][j]; if (pad) w = make_uint4(0, 0, 0, 0); if (s < total) dst[lane + 64 * j] = w; } }
    }
}

__device__ __forceinline__ void ph_final(const P& p, int bid, int nb, int wv) {
    int tid_ = TID_FROM(wv); asm volatile("" : "+v"(tid_)); const int tid = tid_, lane = tid & 63, wave = tid >> 6;
    const float* XS = WSP(float, WS_XS); const float* MODS = WSP(float, WS_MODS) + (size_t)1 * 5 * 6 * D; const bf16_t* Y = WSP(bf16_t, A1_Y);
    const float* TG = (const float*)(p.ws + WS_ROUTE + RT_TG); const int* TSLOT = (const int*)(p.ws + WS_ROUTE + RT_TSLOT);
    for (int t = bid * 8 + wave; t < NB * SEQ; t += nb * 8) {
        const int b = t / SEQ, R = b * TPB + CTX + (t - b * SEQ);
        const float g1 = TG[R * 2], g2 = TG[R * 2 + 1]; const int s1 = TSLOT[R * 2], s2 = TSLOT[R * 2 + 1];
        const float* mr = MODS + (size_t)b * 6 * D + 5 * D;
        f32x4 v[8]; float ss = 0.f;
#pragma unroll
        for (int j = 0; j < 8; ++j) { const int c0 = (lane + 64 * j) * 4;
            const f32x4 xv = *(const f32x4*)(XS + (size_t)R * D + c0), m5 = *(const f32x4*)(mr + c0);
            const uint2 q1 = *(const uint2*)(Y + (size_t)s1 * D + c0), q2 = *(const uint2*)(Y + (size_t)s2 * D + c0);
            const f32x4 y1 = {__uint_as_float(q1.x << 16), __uint_as_float(q1.x & 0xffff0000u), __uint_as_float(q1.y << 16), __uint_as_float(q1.y & 0xffff0000u)}, y2 = {__uint_as_float(q2.x << 16), __uint_as_float(q2.x & 0xffff0000u), __uint_as_float(q2.y << 16), __uint_as_float(q2.y & 0xffff0000u)};
            v[j] = xv + m5 * (y1 * g1 + y2 * g2); ss += v[j].x * v[j].x + v[j].y * v[j].y + v[j].z * v[j].z + v[j].w * v[j].w; }
        const float rstd = 1.0f / sqrtf(wave_sum(ss) * (1.f / D) + EPS);
#pragma unroll
        for (int j = 0; j < 8; ++j) { const int c0 = (lane + 64 * j) * 4; const f32x4 gg = *(const f32x4*)(p.final_norm_g + c0); *(f32x4*)(p.out + (size_t)t * D + c0) = v[j] * rstd * gg; }
    }
}


#define LAS __attribute__((address_space(3)))
typedef unsigned u32x4 __attribute__((ext_vector_type(4)));
typedef unsigned u32x2 __attribute__((ext_vector_type(2)));
typedef int i32x4 __attribute__((ext_vector_type(4)));
__device__ __forceinline__ unsigned cvt_pk_bf16(float lo, float hi) { unsigned r; asm volatile("v_cvt_pk_bf16_f32 %0, %1, %2" : "=v"(r) : "v"(lo), "v"(hi)); return r; }
__device__ __forceinline__ void store4bf(bf16_t* dst, const f32x4& v) { u32x2 w; w.x = cvt_pk_bf16(v[0], v[1]); w.y = cvt_pk_bf16(v[2], v[3]); *(u32x2*)dst = w; }
typedef float f32x2 __attribute__((ext_vector_type(2)));
__device__ __forceinline__ f32x2 swiglu2(f32x2 g, f32x2 u, float c1, float kinv) {
    const f32x2 t = g * c1; f32x2 e; e.x = __builtin_amdgcn_exp2f(t.x); e.y = __builtin_amdgcn_exp2f(t.y);
    const f32x2 d = e * kinv + kinv; f32x2 r; r.x = __builtin_amdgcn_rcpf(d.x); r.y = __builtin_amdgcn_rcpf(d.y);
    return (g * u) * r;
}
__device__ __forceinline__ float fast_silu(float x) { return x * __builtin_amdgcn_rcpf(1.f + __builtin_amdgcn_exp2f(-1.4426950408889634f * x)); }

constexpr int NWAVES = 8, RING_BYTES = 131072, MISC_OFF = RING_BYTES + 320, LDS_BYTES = 147456;
constexpr int CW_QUEUE = 2048;
constexpr int CW_DONE = 132096;
constexpr int CW_FILL = 140288;
#ifndef FILL
#define FILL 1
#endif
constexpr int CW_BAR = 4096;
constexpr int CW_ERR = 131072;

#define XB_TMO      128
#define XB_XCNT(j)  (256  + 64 * (j))
#define XB_XSUB(j)  (1280 + 64 * (j))
#define XB_XGEN(j)  (2304 + 64 * (j))
#define XB_TOP      3328
#define XB_TOPGEN   3392
#define XCD_BAR_WORDS 3456
#define XB_SPIN_CAP (1u << 18)

__device__ __forceinline__ unsigned xb_ld(unsigned* p)              { return __hip_atomic_load(p, __ATOMIC_RELAXED, __HIP_MEMORY_SCOPE_AGENT); }
__device__ __forceinline__ unsigned xb_add(unsigned* p, unsigned v) { return __hip_atomic_fetch_add(p, v, __ATOMIC_RELAXED, __HIP_MEMORY_SCOPE_AGENT); }
__device__ __forceinline__ unsigned xb_xcc_id() { return (unsigned)__builtin_amdgcn_s_getreg((3 << 11) | 20) & 0xFu; }
#define XB_SPIN(cond, bar) do { unsigned _sp = 0; while (cond) { __builtin_amdgcn_s_sleep(1); \
    if ((++_sp & 255u) == 0u) { if (xb_ld(&(bar)[XB_TMO])) break; if (_sp > XB_SPIN_CAP) { atomicAdd(&(bar)[XB_TMO], 1u); break; } } } } while (0)

struct XcdBarrier {
    unsigned* bar; unsigned x;
    volatile LAS unsigned* st;
};
__device__ __forceinline__ XcdBarrier xcd_barrier_post(unsigned* bar, volatile LAS unsigned* st, int wv) {
    XcdBarrier b; b.bar = bar; b.x = xb_xcc_id(); b.st = st;
    if (wv == 0 && lane_id() == 0) (void)xb_add(&bar[XB_XCNT(b.x)], 1u);
    return b;
}
__device__ __forceinline__ void xcd_barrier_complete(unsigned* bar, unsigned x, unsigned& nloc, unsigned& nx) {
    const unsigned G = gridDim.x * gridDim.y * gridDim.z;
    unsigned sum, cnt, mine, sp = 0u;
    for (;;) {
        sum = 0u; cnt = 0u; mine = 0u;
#pragma unroll
        for (unsigned j = 0; j < 16; ++j) { const unsigned c = xb_ld(&bar[XB_XCNT(j)]); sum += c; cnt += (c > 0u) ? 1u : 0u; mine = (j == x) ? c : mine; }
        if (sum == G) break;
        __builtin_amdgcn_s_sleep(1);
        if ((++sp & 255u) == 0u) { if (xb_ld(&bar[XB_TMO])) break; if (sp > XB_SPIN_CAP) { atomicAdd(&bar[XB_TMO], 1u); break; } }
    }
    nloc = mine > 0u ? mine : 1u; nx = cnt > 0u ? cnt : 1u;
}
__device__ __forceinline__ void xcd_barrier(const XcdBarrier& b, int wv) {
    asm volatile("s_waitcnt vmcnt(0)" ::: "memory");
    __syncthreads();
    if (wv == 0 && lane_id() == 0) {
        unsigned* bar = b.bar;
        __builtin_amdgcn_s_waitcnt(0);
        unsigned nloc = b.st[0], nx = b.st[1];
        if (nloc == 0u) { xcd_barrier_complete(bar, b.x, nloc, nx); b.st[0] = nloc; b.st[1] = nx; }
        const unsigned old = xb_add(&bar[XB_XSUB(b.x)], 1u);
        const unsigned gen = old / nloc;
        if (old + 1u == (gen + 1u) * nloc) {
            __builtin_amdgcn_fence(__ATOMIC_RELEASE, "agent");
            asm volatile("s_waitcnt vmcnt(0)" ::: "memory");
            const unsigned og = xb_add(&bar[XB_TOP], 1u);
            const unsigned tg = og / nx;
            if (og + 1u == (tg + 1u) * nx) xb_add(&bar[XB_TOPGEN], 1u);
            else XB_SPIN(xb_ld(&bar[XB_TOPGEN]) == tg, bar);
            __builtin_amdgcn_fence(__ATOMIC_ACQUIRE, "agent");
            xb_add(&bar[XB_XGEN(b.x)], 1u);
            asm volatile("s_waitcnt vmcnt(0)" ::: "memory");
        } else {
            XB_SPIN(xb_ld(&bar[XB_XGEN(b.x)]) == gen, bar);
            __builtin_amdgcn_fence(__ATOMIC_ACQUIRE, "agent");
            asm volatile("s_waitcnt vmcnt(0)" ::: "memory");
        }
    }
    __syncthreads();
}

namespace pg8 {
#define PG8_LAS __attribute__((address_space(3)))
constexpr int BM = 256, BK = 64, HALF = 128, HTB = HALF * BK * 2  , STAGE_BYTES = 8 * HTB, NXCD = 8, WGM = 8;
__host__ __device__ __forceinline__ int lds_byte(int r, int c) { const int st = (r >> 4) * 2 + (c >> 5), rr = r & 15, cc = c & 31, ob = rr * 64 + cc * 2; return st * 1024 + (ob ^ (((ob >> 9) & 1) << 5)); }
__host__ __device__ __forceinline__ void stage_rc(int b, int& R, int& C) { const int st = b / 1024, sb = b % 1024, swz = sb ^ (((sb >> 9) & 1) << 5); R = (st >> 1) * 16 + swz / 64; C = (st & 1) * 32 + (swz % 64) / 2; }

struct Unit { const char* A; const char* B; int pm, pn, z, nt; int ti, ks, nks, pad; };
struct Dims { int lda, ldb; float* slabs; };

template <class F> struct Epi {
    F f;
    __device__ __forceinline__ void operator()(const f32x4 (&acc)[2][2][4][2], const Unit& u, int wr, int wc, int fr, int fq) const {
        { const int l_ = lane_id(); fr = l_ & 15; fq = l_ >> 4; }
#pragma unroll
        for (int ai = 0; ai < 2; ++ai)
#pragma unroll
            for (int m = 0; m < 4; ++m) { const int rt = ai * HALF + wr * 64 + m * 16 + fr;
#pragma unroll
                for (int bj = 0; bj < 2; ++bj) f.put(u, rt, bj * HALF + wc * 32, fq, acc[ai][bj][m][0], acc[ai][bj][m][1]); }
    }
};

template <bool FP8 = false, bool TB = false  , bool TA = false  , bool TB16 = false  , class EpiT, class Sched>
__device__ __forceinline__ void gemm_phase(PG8_LAS unsigned char* lds, const Dims g, const Sched& S, const EpiT& E, int wv) {
    int tid_ = TID_FROM(wv); asm volatile("" : "+v"(tid_));
    const int tid = tid_, wid = __builtin_amdgcn_readfirstlane(tid >> 6), lane = tid & 63, wr = wid >> 2, wc = wid & 3, fr = lane & 15, fq = lane >> 4;
    unsigned voffA[2], voffB[2];
#pragma unroll
    for (int i = 0; i < 2; ++i) { int R, C; stage_rc(tid * 16 + i * 8192, R, C);
        voffA[i] = !TA ? (unsigned)(R * g.lda + C) * 2u
                 : FP8 ? (unsigned)(((R >> 4) * (g.lda * 2 / 16) + (C >> 3)) * 256 + (R & 15) * 16 + (C & 7) * 2) : (unsigned)(((R >> 4) * (g.lda * 2 / 32) + (C >> 4)) * 512 + (R & 15) * 32 + (C & 15) * 2);
        voffB[i] = FP8 ? (unsigned)((R >> 5) * 32 * (g.ldb * 2) + (C >> 5) * 2048 + (R & 31) * 64 + (C & 31) * 2) : TB ? (unsigned)((R >> 5) * 32 * (g.ldb * 2) + (R & 31) * 128 + C * 2) : TB16 ? (unsigned)(((R >> 4) * (g.ldb * 2 / 32) + (C >> 4)) * 512 + (R & 15) * 32 + (C & 15) * 2) : (unsigned)(R * g.ldb + C) * 2u; }
    const size_t kstep = (size_t)(BK * 2), kstepB = (FP8 || TB) ? (size_t)4096 : TB16 ? (size_t)2048 : kstep, kstepA = TA ? (size_t)2048 : kstep;
    const size_t hstepA = (size_t)HALF * g.lda * 2, hstepB = (size_t)HALF * g.ldb * 2;
    const unsigned ldsw = (unsigned)wid * 1024u;
    const int aoff = lds_byte(wr * 64 + fr, fq * 8), boff = lds_byte(wc * 32 + fr, fq * 8);
#define PG8_SA(b, h) (((b) * 2 + (h)) * HTB)
#define PG8_SB(b, h) ((4 + (b) * 2 + (h)) * HTB)
#define PG8_STAGE(bufoff, gbase, voff) do { const char* g_ = (const char*)(gbase); asm volatile("" : "+s"(g_));     \
        _Pragma("unroll") for (int _i = 0; _i < 2; ++_i) \
        __builtin_amdgcn_global_load_lds((const unsigned*)(g_ + (voff)[_i]), (PG8_LAS unsigned*)(lds + (bufoff) + ldsw + _i * 8192), 16, 0, 0); } while (0)
#define PG8_LDA(dst, b, h) do { _Pragma("unroll") for (int m = 0; m < 4; ++m) _Pragma("unroll") for (int k = 0; k < 2; ++k) dst[m][k] = *(const PG8_LAS bf16x8*)(lds + PG8_SA(b, h) + aoff + m * 2048 + k * 1024); } while (0)
#define PG8_LDB(dst, b, h) do { _Pragma("unroll") for (int n = 0; n < 2; ++n) _Pragma("unroll") for (int k = 0; k < 2; ++k) dst[n][k] = *(const PG8_LAS bf16x8*)(lds + PG8_SB(b, h) + boff + n * 2048 + k * 1024); } while (0)
#define PG8_CAT(lo, hi) __builtin_shufflevector(__builtin_bit_cast(i32x4, lo), __builtin_bit_cast(i32x4, hi), 0, 1, 2, 3, 4, 5, 6, 7)
#define PG8_MMA(ai, bj, At, Bt) do { __builtin_amdgcn_s_setprio(1); if constexpr (FP8) { _Pragma("unroll") for (int m = 0; m < 4; ++m) _Pragma("unroll") for (int n = 0; n < 2; ++n) \
        acc[ai][bj][m][n] = __builtin_amdgcn_mfma_scale_f32_16x16x128_f8f6f4(PG8_CAT(Bt[n][0], Bt[n][1]), PG8_CAT(At[m][0], At[m][1]), acc[ai][bj][m][n], 0, 0, 0, 0, 0, 0); }     \
        else { _Pragma("unroll") for (int m = 0; m < 4; ++m) _Pragma("unroll") for (int n = 0; n < 2; ++n) _Pragma("unroll") for (int k = 0; k < 2; ++k) \
        acc[ai][bj][m][n] = __builtin_amdgcn_mfma_f32_16x16x32_bf16(Bt[n][k], At[m][k], acc[ai][bj][m][n], 0, 0, 0); } __builtin_amdgcn_s_setprio(0); } while (0)
#define PG8_WAIT_V(n) asm volatile("s_waitcnt vmcnt(" #n ")" ::: "memory")
#define PG8_WAIT_L(n) asm volatile("s_waitcnt lgkmcnt(" #n ")" ::: "memory")
#define PG8_BAR __builtin_amdgcn_s_barrier()
#define PG8_SCHED __builtin_amdgcn_sched_barrier(0)
    Unit cur, nxt; int ui = 0;
    if (!S.next(0, cur)) return;
    f32x4 acc[2][2][4][2];
#pragma unroll
    for (int a = 0; a < 2; ++a)
#pragma unroll
        for (int b = 0; b < 2; ++b)
#pragma unroll
            for (int m = 0; m < 4; ++m)
#pragma unroll
                for (int n = 0; n < 2; ++n) acc[a][b][m][n] = (f32x4){0.f, 0.f, 0.f, 0.f};
    bf16x8 At[4][2], B0[2][2], B1[2][2];
    const char* cA = cur.A; const char* cB = cur.B;
    PG8_STAGE(PG8_SB(0, 0), cB, voffB); PG8_STAGE(PG8_SB(0, 1), cB + hstepB, voffB); PG8_STAGE(PG8_SA(0, 0), cA, voffA); PG8_STAGE(PG8_SA(0, 1), cA + hstepA, voffA);
    if (wr == 1) PG8_BAR;
    PG8_WAIT_V(2); PG8_BAR;
    PG8_STAGE(PG8_SB(1, 0), cB + kstepB, voffB); PG8_STAGE(PG8_SA(1, 0), cA + kstepA, voffA); PG8_STAGE(PG8_SB(1, 1), cB + hstepB + kstepB, voffB);
    PG8_WAIT_V(6); PG8_BAR;
    for (;;) {
        const bool has_next = S.next(ui + 1, nxt);
        const char* nA = has_next ? nxt.A : cA; const char* nB = has_next ? nxt.B : cB;
        const int nt = cur.nt;
        for (int t = 0; t < nt; t += 2) {
            const bool last = (t == nt - 2);
            const char* a1 = cA + (size_t)(t + 1) * kstepA;
            const char* a2 = last ? nA : cA + (size_t)(t + 2) * kstepA; const char* b2 = last ? nB : cB + (size_t)(t + 2) * kstepB;
            const char* a3 = a2 + kstepA; const char* b3 = b2 + kstepB;
            PG8_LDB(B0, 0, 0); PG8_LDB(B1, 0, 1); PG8_SCHED; PG8_LDA(At, 0, 0); PG8_STAGE(PG8_SA(1, 1), a1 + hstepA, voffA);
            PG8_WAIT_V(8); PG8_WAIT_L(0); PG8_BAR; PG8_MMA(0, 0, At, B0); PG8_MMA(0, 1, At, B1); PG8_BAR; PG8_SCHED;
            PG8_LDA(At, 0, 1); PG8_STAGE(PG8_SB(0, 0), b2, voffB); PG8_STAGE(PG8_SB(0, 1), b2 + hstepB, voffB); PG8_STAGE(PG8_SA(0, 0), a2, voffA);
            PG8_WAIT_V(8); PG8_WAIT_L(0); PG8_BAR; PG8_MMA(1, 0, At, B0); PG8_MMA(1, 1, At, B1); PG8_BAR; PG8_SCHED;
            PG8_LDB(B0, 1, 0); PG8_LDB(B1, 1, 1); PG8_SCHED; PG8_LDA(At, 1, 0); PG8_STAGE(PG8_SA(0, 1), a2 + hstepA, voffA);
            PG8_WAIT_V(8); PG8_WAIT_L(0); PG8_BAR; PG8_MMA(0, 0, At, B0); PG8_MMA(0, 1, At, B1); PG8_BAR; PG8_SCHED;
            PG8_LDA(At, 1, 1); PG8_STAGE(PG8_SB(1, 0), b3, voffB); PG8_STAGE(PG8_SB(1, 1), b3 + hstepB, voffB); PG8_STAGE(PG8_SA(1, 0), a3, voffA);
            PG8_WAIT_V(8); PG8_WAIT_L(0); PG8_BAR; PG8_MMA(1, 0, At, B0); PG8_MMA(1, 1, At, B1); PG8_BAR; PG8_SCHED;
        }
        if (wr == 0) PG8_BAR;
        if (cur.nks > 1) {
            int t2 = tid; asm volatile("" : "+v"(t2));
            float* sb = g.slabs + ((size_t)(cur.ti * cur.nks + cur.ks) << 16) + t2 * 4;
#pragma unroll
            for (int a = 0; a < 2; ++a)
#pragma unroll
                for (int m = 0; m < 4; ++m)
#pragma unroll
                    for (int b = 0; b < 2; ++b)
#pragma unroll
                        for (int n = 0; n < 2; ++n) *(f32x4*)(sb + ((((a * 4 + m) * 2 + b) * 2 + n) << 11)) = acc[a][b][m][n];
        } else E(acc, cur, wr, wc, fr, fq);
        if (!has_next) break;
#pragma unroll
        for (int a = 0; a < 2; ++a)
#pragma unroll
            for (int b = 0; b < 2; ++b)
#pragma unroll
                for (int m = 0; m < 4; ++m)
#pragma unroll
                    for (int n = 0; n < 2; ++n) acc[a][b][m][n] = (f32x4){0.f, 0.f, 0.f, 0.f};
        cur = nxt; cA = nA; cB = nB; ++ui;
        if (wr == 1) PG8_BAR;
    }
    PG8_WAIT_V(0);
    PG8_BAR;
#undef PG8_SA
#undef PG8_SB
#undef PG8_STAGE
#undef PG8_LDA
#undef PG8_LDB
#undef PG8_MMA
#undef PG8_CAT
#undef PG8_WAIT_V
#undef PG8_WAIT_L
#undef PG8_BAR
#undef PG8_SCHED
}

__device__ __forceinline__ int xcd_remap(int L, int total) { const int q = total / 8, r = total % 8, xcd = L % 8, off = L / 8; return (xcd < r ? xcd * (q + 1) : r * (q + 1) + (xcd - r) * q) + off; }
template <class Base, int BKSTEP = BK * 2, int AKSTEP = BK * 2> struct TailSched {
    Base b; int G, c, total, Fcut, r, s, nt_full, ksl;
    __device__ __forceinline__ void init(int total_, int K, int G_, int c_, int smax = 8) {
        total = total_; G = G_; c = c_; nt_full = K / BK; Fcut = (total / G) * G; r = total - Fcut; const int kp = nt_full / 2;
        s = 1;
        if (r > 0) { if (smax >= 8 && kp % 8 == 0 && kp / 8 >= 2 && r * 8 <= G) s = 8; else if (smax >= 4 && kp % 4 == 0 && kp / 4 >= 2 && r * 4 <= G) s = 4; else if (smax >= 2 && kp % 2 == 0 && kp / 2 >= 2 && r * 2 <= G) s = 2; }
        ksl = nt_full / s;
    }
    __device__ __forceinline__ bool next(int i, Unit& u) const {
        const int L = i * G + c;
#ifndef CHUNK_DEAL
#define CHUNK_DEAL 0
#endif
        if (L < Fcut) { b.decode(CHUNK_DEAL ? c * (Fcut / G) + i : xcd_remap(L, Fcut), u); u.nt = nt_full; u.ti = -1; u.ks = 0; u.nks = 1; u.pad = 0; return true; }
        const int q = L - Fcut; if (q >= r * s) return false;
        const int ti = q / s, ks = q - ti * s; b.decode(Fcut + ti, u);
        u.A += (size_t)ks * ksl * AKSTEP; u.B += (size_t)ks * ksl * BKSTEP; u.nt = ksl; u.ti = ti; u.ks = ks; u.nks = s; u.pad = 0; return true;
    }
};
template <class EpiT, class Base, int BKSTEP, int AKSTEP> __device__ __forceinline__ void tail_reduce(const TailSched<Base, BKSTEP, AKSTEP>& S, const EpiT& E, const float* slabs, int bid, int nb, int wv) {
    if (S.s <= 1) return;
    int tid_ = TID_FROM(wv); asm volatile("" : "+v"(tid_)); const int tid = tid_, wid = tid >> 6, lane = tid & 63, wr = wid >> 2, wc = wid & 3, fr = lane & 15, fq = lane >> 4;
    for (int it = bid; it < S.r * 16; it += nb) {
        const int ti = it >> 4, c16 = it & 15, ai = c16 >> 3, m = (c16 >> 1) & 3, bj = c16 & 1;
        Unit u; S.b.decode(S.Fcut + ti, u); u.nt = 0; u.ti = ti; u.ks = 0; u.nks = 1; u.pad = 0;
        f32x4 v0 = {0.f, 0.f, 0.f, 0.f}, v1 = {0.f, 0.f, 0.f, 0.f};
        for (int ks = 0; ks < S.s; ++ks) { const float* sb = slabs + ((size_t)(ti * S.s + ks) << 16) + tid * 4 + ((size_t)(c16 * 2) << 11); v0 += *(const f32x4*)sb; v1 += *(const f32x4*)(sb + 2048); }
        E.f.put(u, ai * HALF + wr * 64 + m * 16 + fr, bj * HALF + wc * 32, fq, v0, v1);
    }
}
template <bool LAT> struct GridBase {
    const char* A; const char* B; size_t atile, btile; int nM, nN;
    __device__ __forceinline__ void decode(int wgid, Unit& u) const {
        const int nig = WGM * nN, gid = wgid / nig, fm = gid * WGM, gsz = (nM - fm) < WGM ? (nM - fm) : WGM;
        int pm = fm + ((wgid % nig) % gsz); const int pn = (wgid % nig) / gsz;
        if (LAT) pm = pm + pm / 8 + 1;
        u.pm = pm; u.pn = pn; u.z = 0; u.A = A + (size_t)pm * atile; u.B = B + (size_t)pn * btile;
    }
};
template <bool LAT, int BKSTEP = BK * 2, int AKSTEP = BK * 2> struct GridSched : TailSched<GridBase<LAT>, BKSTEP, AKSTEP> {
    __device__ __forceinline__ void init(const void* A_, size_t atile_, const void* B_, size_t btile_, int nM_, int nN_, int K, int G_, int c_, int smax = 8) {
        this->b.A = (const char*)A_; this->b.B = (const char*)B_; this->b.atile = atile_; this->b.btile = btile_; this->b.nM = nM_; this->b.nN = nN_;
        TailSched<GridBase<LAT>, BKSTEP, AKSTEP>::init(nM_ * nN_, K, G_, c_, smax);
    }
};
}

__device__ __forceinline__ size_t act_tiled_off(int R, int c, int ld) { return ((size_t)(R >> 4) * (ld >> 4) + (c >> 4)) * 256 + (R & 15) * 16 + (c & 15); }
struct EF_in {
    bf16_t *F, *Q, *Kd, *V; const float2* tab;
    __device__ __forceinline__ void put(const pg8::Unit& u, int rt, int c32, int fq, const f32x4& v0, const f32x4& v1) const {
        const int R = u.pm * 256 + rt, cg = u.pn * 256 + c32;
        const int lo = (rt & 15) * 16 + 4 * fq, rg = __builtin_amdgcn_readfirstlane(R >> 4) * 64;
        if (cg < 1024) { bf16_t* d = F + (size_t)(rg + (cg >> 4)) * 256 + lo; store4bf(d, v0); store4bf(d + 256, v1); return; }
        if (cg >= 3072) { bf16_t* d = V + (size_t)(rg + ((cg - 3072) >> 4)) * 256 + lo; store4bf(d, v0); store4bf(d + 256, v1); return; }
        const int G = cg >> 6, w = (cg >> 5) & 1, a0 = 64 * G + 16 * w + 4 * fq;
        const int ac = (cg < 2048 ? a0 - 1024 : a0 - 2048) - 4 * fq;
        bf16_t* dst = (cg < 2048 ? Q : Kd) + (size_t)(rg + (ac >> 4)) * 256 + lo;
        const int j = R % TPB; f32x4 o0 = v0, o1 = v1;
        if (j >= CTX) { const int nl = j - CTX, pos = (G & 1) ? (nl & 63) : (nl >> 6); const f32x4* t4 = (const f32x4*)(tab + pos * 32 + 16 * w + 4 * fq); const f32x4 ta = t4[0], tb = t4[1];
            const f32x4 cs = {ta[0], ta[2], tb[0], tb[2]}, sn = {ta[1], ta[3], tb[1], tb[3]};
            o0 = v0 * cs - v1 * sn; o1 = v1 * cs + v0 * sn; }
        store4bf(dst, o0); store4bf(dst + 512, o1);
    }
};
struct EF_res {
    float* XS; const float* mods; int chunk, pad;
    __device__ __forceinline__ void put(const pg8::Unit& u, int rt, int c32, int fq, const f32x4& v0, const f32x4& v1) const {
        const int R = u.pm * 256 + rt, col = u.pn * 256 + c32 + 4 * fq; const int bb = (u.pm % 9 == 0) ? 4 : u.pm / 9;
        const float* m = mods + (size_t)bb * 6 * D + chunk * D + col; float* x = XS + (size_t)R * D + col;
        *(f32x4*)x = *(const f32x4*)x + *(const f32x4*)m * v0; *(f32x4*)(x + 16) = *(const f32x4*)(x + 16) + *(const f32x4*)(m + 16) * v1;
    }
};
struct EF_res0 {
    float* XS; const float* mods; const float* x; const float* ctx; int chunk, pad;
    __device__ __forceinline__ void put(const pg8::Unit& u, int rt, int c32, int fq, const f32x4& v0, const f32x4& v1) const {
        const int R = u.pm * 256 + rt, col = u.pn * 256 + c32 + 4 * fq; const int b = u.pm / 9, t9 = u.pm - 9 * b; const int bb = t9 == 0 ? 4 : b;
        const float* s = (t9 == 0 ? ctx + ((size_t)(b * CTX + rt)) * D : x + ((size_t)(b * SEQ + (t9 - 1) * 256 + rt)) * D) + col;
        const float* m = mods + (size_t)bb * 6 * D + chunk * D + col; float* o = XS + (size_t)R * D + col;
        *(f32x4*)o = *(const f32x4*)s + *(const f32x4*)m * v0; *(f32x4*)(o + 16) = *(const f32x4*)(s + 16) + *(const f32x4*)(m + 16) * v1;
    }
};
struct EF_swiglu {
    bf16_t* ACT; int ld, pad;
    __device__ __forceinline__ void put(const pg8::Unit& u, int rt, int c32, int fq, const f32x4& v0, const f32x4& v1) const {
        const size_t R = (size_t)u.pm * 256 + rt; const int oc = ((u.pn * 256 + c32) >> 1) + 4 * fq;
        const f32x2 a = swiglu2(f32x2{v0[0], v0[1]}, f32x2{v1[0], v1[1]}, -1.4426950408889634f, 1.f), b = swiglu2(f32x2{v0[2], v0[3]}, f32x2{v1[2], v1[3]}, -1.4426950408889634f, 1.f);
        const int sub = __builtin_amdgcn_readfirstlane(((int)(R >> 4)) * (ld >> 4) + (oc >> 4));
        store4bf(ACT + (size_t)sub * 256 + (rt & 15) * 16 + 4 * fq, f32x4{a.x, a.y, b.x, b.y});
    }
};
struct EF_dqkv {
    float *CQ, *CKV; bf16_t* KR; const float2* tab;
    __device__ __forceinline__ void put(const pg8::Unit& u, int rt, int c32, int fq, const f32x4& v0, const f32x4& v1) const {
        const int R = u.pm * 256 + rt, cg = u.pn * 256 + c32;
        if (cg < 512) { float* d = CQ + (size_t)R * 512 + cg + 4 * fq; *(f32x4*)d = v0; *(f32x4*)(d + 16) = v1; return; }
        if (cg < 1024) { float* d = CKV + (size_t)R * 512 + (cg - 512) + 4 * fq; *(f32x4*)d = v0; *(f32x4*)(d + 16) = v1; return; }
        if (cg >= 1088) return;
        const int half = (cg - 1024) >> 5, j = R % TPB; f32x4 o0 = v0, o1 = v1;
        if (j >= CTX) { const int nl = j - CTX, pos = half ? (nl & 63) : (nl >> 6); const f32x4* t4 = (const f32x4*)(tab + pos * 16 + 4 * fq); const f32x4 ta = t4[0], tb = t4[1];
            const f32x4 cs = {ta[0], ta[2], tb[0], tb[2]}, sn = {ta[1], ta[3], tb[1], tb[3]};
            o0 = v0 * cs - v1 * sn; o1 = v1 * cs + v0 * sn; }
        bf16_t* d = KR + (size_t)R * 64 + (cg - 1024) + 4 * fq; store4bf(d, o0); store4bf(d + 16, o1);
    }
};
struct EF_uq {
    bf16_t* QM; const float2* tab;
    __device__ __forceinline__ void put(const pg8::Unit& u, int rt, int c32, int fq, const f32x4& v0, const f32x4& v1) const {
        const int R = u.pm * 256 + rt, cg = u.pn * 256 + c32; const int q = (cg >> 5) % 6; f32x4 o0 = v0, o1 = v1;
        if (q >= 4) { const int nl = R % TPB - CTX, pos = (q == 5) ? (nl & 63) : (nl >> 6); const f32x4* t4 = (const f32x4*)(tab + pos * 16 + 4 * fq); const f32x4 ta = t4[0], tb = t4[1];
            const f32x4 cs = {ta[0], ta[2], tb[0], tb[2]}, sn = {ta[1], ta[3], tb[1], tb[3]};
            o0 = v0 * cs - v1 * sn; o1 = v1 * cs + v0 * sn; }
        const int sub = __builtin_amdgcn_readfirstlane((R >> 4) * (3072 / 16) + (cg >> 4));
        bf16_t* d = QM + (size_t)sub * 256 + (rt & 15) * 16 + 4 * fq; store4bf(d, o0); store4bf(d + 256, o1);
    }
};
struct EF_bf {
    bf16_t* O; int ld, pad;
    __device__ __forceinline__ void put(const pg8::Unit& u, int rt, int c32, int fq, const f32x4& v0, const f32x4& v1) const {
        const int sub = __builtin_amdgcn_readfirstlane(((u.pm * 256 + rt) >> 4) * (ld >> 4) + ((u.pn * 256 + c32) >> 4));
        bf16_t* d = O + (size_t)sub * 256 + (rt & 15) * 16 + 4 * fq; store4bf(d, v0); store4bf(d + 256, v1);
    }
};
struct EF_swiglu8 {
    unsigned char* ACT; int ld, pad;
    __device__ __forceinline__ void put(const pg8::Unit& u, int rt, int c32, int fq, const f32x4& v0, const f32x4& v1) const {
        const size_t R = (size_t)u.pm * 256 + rt; const int oc = ((u.pn * 256 + c32) >> 1) + 4 * fq; const float is = 1.0f / W8_GU;
        const f32x2 a = swiglu2(f32x2{v0[0], v0[1]}, f32x2{v1[0], v1[1]}, -1.4426950408889634f * is, 1.f / (is * is * A8_ACT)), b = swiglu2(f32x2{v0[2], v0[3]}, f32x2{v1[2], v1[3]}, -1.4426950408889634f * is, 1.f / (is * is * A8_ACT));
        const int sub = __builtin_amdgcn_readfirstlane(((int)(R >> 4)) * (ld >> 4) + (oc >> 4));
        *(unsigned*)(ACT + (size_t)sub * 256 + (rt & 15) * 16 + 4 * fq) = pack4_fp8(a.x, a.y, b.x, b.y);
    }
};
struct EF_y8 {
    bf16_t* O; int ld, pad;
    __device__ __forceinline__ void put(const pg8::Unit& u, int rt, int c32, int fq, const f32x4& v0, const f32x4& v1) const {
        bf16_t* d = O + ((size_t)u.pm * 256 + rt) * ld + u.pn * 256 + c32 + 4 * fq; const float is = 1.0f / (A8_ACT * W8_DN); store4bf(d, v0 * is); store4bf(d + 16, v1 * is);
    }
};
struct EF_probe {
    float* O; int ld, pad;
    __device__ __forceinline__ void put(const pg8::Unit& u, int rt, int c32, int fq, const f32x4& v0, const f32x4& v1) const {
        if (v0[0] + v0[1] + v0[2] + v0[3] + v1[0] + v1[1] + v1[2] + v1[3] == 1.2345678e30f) O[rt] = v0[0];
    }
};
struct EF_probe_math {
    unsigned char* ACT; int ld, pad;
    __device__ __forceinline__ void put(const pg8::Unit& u, int rt, int c32, int fq, const f32x4& v0, const f32x4& v1) const {
        const float is = 1.0f / W8_GU; float o[4];
#pragma unroll
        for (int e = 0; e < 4; ++e) o[e] = fast_silu(v0[e] * is) * (v1[e] * is) * A8_ACT;
        const unsigned w = pack4_fp8(o[0], o[1], o[2], o[3]);
        if (w == 0x12345678u) *(unsigned*)(ACT + rt) = w;
    }
};
struct EF_probe_store {
    unsigned char* ACT; int ld, pad;
    __device__ __forceinline__ void put(const pg8::Unit& u, int rt, int c32, int fq, const f32x4& v0, const f32x4& v1) const {
        const size_t R = ((size_t)u.pm * 256 + rt) & 8191; const int oc = ((u.pn * 256 + c32) >> 1) + 4 * fq;
        *(unsigned*)(ACT + R * ld + oc) = __builtin_bit_cast(unsigned, v0[0]) ^ __builtin_bit_cast(unsigned, v1[1]);
    }
};
struct EF_probe_lin {
    bf16_t* O; int ld, pad;
    __device__ __forceinline__ void put(const pg8::Unit& u, int rt, int c32, int fq, const f32x4& v0, const f32x4& v1) const {
        const int lane = (rt & 15) + 16 * fq; const size_t base = ((size_t)(u.pm * 16 + u.pn) * 65536) + (size_t)(rt >> 4) * 4096 + (size_t)(c32 >> 5) * 512;
        bf16_t* d = O + base + lane * 4; store4bf(d, v0); store4bf(d + 256, v1);
    }
};
struct EF_f32 {
    float* O; int ld, pad;
    __device__ __forceinline__ void put(const pg8::Unit& u, int rt, int c32, int fq, const f32x4& v0, const f32x4& v1) const {
        float* d = O + ((size_t)u.pm * 256 + rt) * ld + u.pn * 256 + c32 + 4 * fq; *(f32x4*)d = v0; *(f32x4*)(d + 16) = v1;
    }
};
struct EF_dftA {
    bf16_t *VT, *VTC;
    __device__ __forceinline__ void put(const pg8::Unit& u, int rt, int c32, int fq, const f32x4& v0, const f32x4& v1) const {
        const int bg = u.z & 15, lo = (rt & 15) * 16 + 4 * fq, rg = __builtin_amdgcn_readfirstlane(rt >> 4); bf16_t* d;
        if (u.z < 16) d = VT + (size_t)bg * 256 * 4096 + (size_t)(rg * 256 + ((u.pm * 2048 + u.pn * 256 + c32) >> 4)) * 256 + lo;
        else d = VTC + (size_t)bg * 256 * 512 + (size_t)(rg * 32 + ((u.pm * 256 + c32) >> 4)) * 256 + lo;
        store4bf(d, v0); store4bf(d + 256, v1);
    }
};
struct EF_dftB {
    bf16_t* MIX; float scale; int joff;
    __device__ __forceinline__ void put(const pg8::Unit& u, int rt, int c32, int fq, const f32x4& v0, const f32x4& v1) const {
        const int b = u.z >> 2, g = u.z & 3; const size_t R = (size_t)b * TPB + joff + u.pm * 256 + rt;
        bf16_t* d = MIX + R * 2048 + g * 256 + c32 + 4 * fq; store4bf(d, v0 * scale); store4bf(d + 16, v1 * scale);
    }
};

struct DftABase {
    const char* WCS; const char* F;
    __device__ __forceinline__ void decode(int L, pg8::Unit& u) const {
        int bg, part, pn, ctx;
        if (L < 256) { bg = L >> 4; part = (L >> 3) & 1; pn = L & 7; ctx = 0; } else { const int l = L - 256; bg = l >> 1; part = l & 1; pn = 0; ctx = 1; }
        const int b = bg >> 2, g = bg & 3;
        u.A = WCS + (size_t)part * 256 * 256 * 2; u.B = F + ((size_t)(b * TPB + (ctx ? 0 : CTX + pn * 256)) * 1024 + g * 256 * 16) * 2;
        u.pm = part; u.pn = pn; u.z = bg + 16 * ctx;
    }
};
struct DftBBase {
    const char* A; const char* B; size_t atile, bstride; int nk1, pad;
    __device__ __forceinline__ void decode(int L, pg8::Unit& u) const {
        const int bg = L / nk1, pm = L % nk1;
        u.A = A + (size_t)pm * atile; u.B = B + (size_t)bg * bstride; u.pm = pm; u.pn = 0; u.z = bg;
    }
};
struct MoeBase {
    const char* A; const char* B; size_t arow  , bexp  , btile; int nN, pad; int t0, t1, t2, t3, t4, t5, t6, t7; int o0, o1, o2, o3, o4, o5, o6, o7;
    __device__ __forceinline__ int init(const void* A_, size_t arow_, const void* B_, size_t bexp_, size_t btile_, int nN_, const int* CNT, const int* OFFS) {
        A = (const char*)A_; B = (const char*)B_; arow = arow_; bexp = bexp_; btile = btile_; nN = nN_; pad = 0;
        t0 = (CNT[0] + 255) >> 8; t1 = (CNT[1] + 255) >> 8; t2 = (CNT[2] + 255) >> 8; t3 = (CNT[3] + 255) >> 8; t4 = (CNT[4] + 255) >> 8; t5 = (CNT[5] + 255) >> 8; t6 = (CNT[6] + 255) >> 8; t7 = (CNT[7] + 255) >> 8;
        o0 = OFFS[0]; o1 = OFFS[1]; o2 = OFFS[2]; o3 = OFFS[3]; o4 = OFFS[4]; o5 = OFFS[5]; o6 = OFFS[6]; o7 = OFFS[7];
        return (t0 + t1 + t2 + t3 + t4 + t5 + t6 + t7) * nN;
    }
    __device__ __forceinline__ void decode(int l, pg8::Unit& u) const {
        int e = -1, te = 1, oe = 0;
#define MOE_STEP(k, tk, ok) if (e < 0) { const int n = tk * nN; if (l < n) { e = k; te = tk; oe = ok; } else l -= n; }
        MOE_STEP(0, t0, o0) MOE_STEP(1, t1, o1) MOE_STEP(2, t2, o2) MOE_STEP(3, t3, o3) MOE_STEP(4, t4, o4) MOE_STEP(5, t5, o5) MOE_STEP(6, t6, o6) MOE_STEP(7, t7, o7)
#undef MOE_STEP
        if (e < 0) { e = 0; l = 0; }
        const int mt = l % te, pn = l / te; const int row0 = oe + mt * 256;
        u.A = A + (size_t)row0 * arow; u.B = B + (size_t)e * bexp + (size_t)pn * btile; u.pm = row0 >> 8; u.pn = pn; u.z = e;
    }
};

template <int RM> __device__ __forceinline__ int rowmap(int c) {
    if (RM == 1) { if (c < 1024 || c >= 3072) return c; const int u = c & 63; return (c & ~63) + 32 * ((u & 31) >> 4) + 16 * (u >> 5) + (u & 15); }
    if (RM == 2) return 32 * (c >> 4) + (c & 15);
    if (RM == 3) return 32 * (c >> 4) + 16 + (c & 15);
    return c;
}
__device__ __forceinline__ size_t bf16_tiled_off(int row, int k, int K) { return ((size_t)(row >> 5) * (K >> 6) + (k >> 6)) * 2048 + (row & 31) * 64 + (k & 63); }
template <int RM> __device__ __forceinline__ void cvt_item(const float* W, int K, int N, bf16_t* WT, int row_off, LAS float* scr, int item, int lane) {
    const int nblk = N / 32, kb = item / nblk, nb = item % nblk, k0 = 64 * kb, n0 = 32 * nb;
    f32x4 v[8];
#pragma unroll
    for (int i = 0; i < 8; ++i) v[i] = *(const f32x4*)(W + (size_t)(k0 + (lane >> 3) + 8 * i) * N + n0 + 4 * (lane & 7));
#pragma unroll
    for (int i = 0; i < 8; ++i) { LAS float* d = scr + ((lane >> 3) + 8 * i) * 33 + 4 * (lane & 7); d[0] = v[i][0]; d[1] = v[i][1]; d[2] = v[i][2]; d[3] = v[i][3]; }
    asm volatile("s_waitcnt lgkmcnt(0)" ::: "memory");
    const int c = lane & 7;
#pragma unroll
    for (int j = 0; j < 4; ++j) { const int n = (lane >> 3) + 8 * j; const LAS float* s = scr + (8 * c) * 33 + n;
        u32x4 o; o.x = cvt_pk_bf16(s[0 * 33], s[1 * 33]); o.y = cvt_pk_bf16(s[2 * 33], s[3 * 33]); o.z = cvt_pk_bf16(s[4 * 33], s[5 * 33]); o.w = cvt_pk_bf16(s[6 * 33], s[7 * 33]);
        *(u32x4*)(WT + bf16_tiled_off(row_off + rowmap<RM>(n0 + n), k0 + 8 * c, K)) = o; }
    asm volatile("s_waitcnt lgkmcnt(0)" ::: "memory");
}
constexpr int MOE_I_MG = (2048 / 64) * (FFE / 32), MOE_I_MD = (FFE / 64) * (2048 / 32), MOE_ITEMS = 16 * MOE_I_MG + 8 * MOE_I_MD, MOE_BATCHES = MOE_ITEMS / 8;
__device__ __forceinline__ size_t fp8_tiled_off(int row, int k, int K) { return ((size_t)(row >> 5) * (K >> 6) + (k >> 6)) * 2048 + (row & 31) * 64 + (k & 63); }
struct Cvt8Job { const float* W; unsigned char* WT; int K, N, k0, n0, rm; float scale;
#ifdef PROBE_CVT_LINEAR
    unsigned char* lin;
#endif
};
__device__ __forceinline__ Cvt8Job moe_cvt_job(const P& p, int r) {
    Cvt8Job j; const int G = r >> 4, kbl = r & 15, t = G / 3584, g = G - t * 3584, e = g / 448, rem = g - e * 448;
    int kgrp, nbk;
    if (t < 2) { kgrp = rem / 224; nbk = rem - kgrp * 224; j.W = (t == 0 ? p.moe_w_gate : p.moe_w_up) + (size_t)e * 2048 * FFE; j.WT = WSP(unsigned char, WT_MGU) + (size_t)e * 2 * FFE * 2048; j.K = 2048; j.N = FFE; j.rm = 2 + t; j.scale = W8_GU; }
    else { kgrp = rem / 64; nbk = rem - kgrp * 64; j.W = p.moe_w_down + (size_t)e * FFE * 2048; j.WT = WSP(unsigned char, WT_MD) + (size_t)e * 2048 * FFE; j.K = FFE; j.N = 2048; j.rm = 0; j.scale = W8_DN; }
    j.k0 = 64 * (16 * kgrp + kbl); j.n0 = 32 * nbk;
#ifdef PROBE_CVT_LINEAR
    j.lin = (unsigned char*)p.ws + WS_END + (size_t)r * 2048;
#endif
    return j;
}
static_assert(MOE_ITEMS == 3 * 3584 * 16 && MOE_I_MG == 448 * 16 && MOE_I_MD == 448 * 16, "MoE conversion group layout");
__device__ __forceinline__ void cvt8_load(const Cvt8Job& j, int lane, f32x4 (&v)[8]) {
#pragma unroll
    for (int i = 0; i < 8; ++i) v[i] = *(const f32x4*)(j.W + (size_t)(j.k0 + (lane >> 3) + 8 * i) * j.N + j.n0 + 4 * (lane & 7));
}
__device__ __forceinline__ void cvt8_finish(const Cvt8Job& j, int lane, const f32x4 (&v)[8], LAS float* scr, bool st = true) {
#pragma unroll
    for (int i = 0; i < 8; ++i) { LAS float* d = scr + ((lane >> 3) + 8 * i) * 33 + 4 * (lane & 7); d[0] = v[i][0]; d[1] = v[i][1]; d[2] = v[i][2]; d[3] = v[i][3]; }
    asm volatile("s_waitcnt lgkmcnt(0)" ::: "memory");
    const int c = lane & 7; const float scale = j.scale;
#pragma unroll
    for (int q = 0; q < 4; ++q) { const int n = (lane >> 3) + 8 * q; const LAS float* s = scr + (8 * c) * 33 + n;
        u32x2 o; o.x = pack4_fp8(s[0 * 33] * scale, s[1 * 33] * scale, s[2 * 33] * scale, s[3 * 33] * scale); o.y = pack4_fp8(s[4 * 33] * scale, s[5 * 33] * scale, s[6 * 33] * scale, s[7 * 33] * scale);
        const int cn = j.n0 + n; const int row = j.rm == 0 ? cn : 32 * (cn >> 4) + (cn & 15) + (j.rm == 3 ? 16 : 0);
#ifdef PROBE_CVT_LINEAR
        if (!st) *(u32x2*)(j.lin + n * 64 + 8 * c) = o; else
#endif
        if (st || (o.x == 0x12345678u && o.y == 0x9abcdef0u)) *(u32x2*)(j.WT + fp8_tiled_off(row, j.k0 + 8 * c, j.K)) = o; }
    asm volatile("s_waitcnt lgkmcnt(0)" ::: "memory");
}
__device__ __forceinline__ void moe_cvt_item(const P& p, int r, LAS float* scr, int lane) { const Cvt8Job j = moe_cvt_job(p, r); f32x4 v[8]; cvt8_load(j, lane, v); cvt8_finish(j, lane, v, scr); }
__device__ __forceinline__ bool moe_fill_list(const P& p, unsigned* ctl, int phase, int nb, int owner, LAS float* scr, int lane, bool st = true) {
    unsigned* ctr = ctl + CW_FILL + 64 * owner; const int nown = 16 * ((MOE_ITEMS / 16 - owner + nb - 1) / nb);
#define MOE_ENTRY(e) (16 * (((e) >> 4) * nb + owner) + ((e) & 15))
    if (phase >= 0) {
        for (;;) {
            if ((int)__builtin_amdgcn_readfirstlane(xb_ld(ctl + CW_DONE + 64 * phase)) >= nb) return false;
            unsigned idx = 0; if (lane == 0) idx = xb_add(ctr, 1u);
            idx = __builtin_amdgcn_readfirstlane(idx);
            if ((int)idx >= nown) return true;
            moe_cvt_item(p, MOE_ENTRY((int)idx), scr, lane);
        }
    }
    unsigned raw = 0; if (lane == 0) raw = xb_add(ctr, 4u);
    for (;;) {
        const int idx = (int)__builtin_amdgcn_readfirstlane(raw);
        if (idx >= nown) return true;
        raw = 0; if (lane == 0) raw = xb_add(ctr, 4u);
        if (idx + 3 < nown) {
            f32x4 va[8], vb[8];
            const Cvt8Job j0 = moe_cvt_job(p, MOE_ENTRY(idx + 0)); cvt8_load(j0, lane, va);
            const Cvt8Job j1 = moe_cvt_job(p, MOE_ENTRY(idx + 1)); cvt8_load(j1, lane, vb);
            cvt8_finish(j0, lane, va, scr, st);
            const Cvt8Job j2 = moe_cvt_job(p, MOE_ENTRY(idx + 2)); cvt8_load(j2, lane, va);
            cvt8_finish(j1, lane, vb, scr, st);
            const Cvt8Job j3 = moe_cvt_job(p, MOE_ENTRY(idx + 3)); cvt8_load(j3, lane, vb);
            cvt8_finish(j2, lane, va, scr, st);
            cvt8_finish(j3, lane, vb, scr, st);
        } else
        for (int j = 0; j < 4 && idx + j < nown; ++j) moe_cvt_item(p, MOE_ENTRY(idx + j), scr, lane);
    }
}
__device__ __forceinline__ void moe_fill(const P& p, unsigned* ctl, int phase, int nb, int bid, LAS unsigned char* lds, volatile LAS unsigned* MISC, int wv) {
    const int lane = lane_id();
    LAS float* scr = (LAS float*)(lds + wv * 16384);
#ifdef PROBE_CVT_NOSTORE
    const bool st = MISC[25] == 0u;
#else
    const bool st = true;
#endif
    if (MISC[24] == 0u) { if (!moe_fill_list(p, ctl, phase, nb, bid, scr, lane, st)) return; MISC[24] = 1u; }
    if (phase >= 0) return;
#pragma unroll 1
    for (int k = 1; k <= 6; ++k) { if (!moe_fill_list(p, ctl, phase, nb, (bid + 41 * k) % nb, scr, lane, st)) return; }
}
__device__ __forceinline__ void ph_convert(const P& p, int bid, int nb, LAS unsigned char* lds, int wv) {
    int tid_ = TID_FROM(wv); asm volatile("" : "+v"(tid_)); const int tid = tid_, lane = tid & 63, wave = tid >> 6;
    LAS float* scr = (LAS float*)(lds + wave * 16384);
    const int gw = bid * NWAVES + wave, NGW = nb * NWAVES;
    constexpr int I_IN = (2048 / 64) * (4096 / 32), I_OUT = (2048 / 64) * (2048 / 32), I_G = (2048 / 64) * (FFD / 32), I_DN = (FFD / 64) * (2048 / 32);
    constexpr int I_DQ = (2048 / 64) * (512 / 32), I_DKV = (2048 / 64) * (576 / 32), I_UQ = (512 / 64) * (3072 / 32), I_UKV = (512 / 64) * (4096 / 32), I_O = I_OUT;
    constexpr int I_MG = (2048 / 64) * (FFE / 32), I_MD = (FFE / 64) * (2048 / 32);
    constexpr int NITEMS = I_IN + I_OUT + 2 * I_G + I_DN + I_DQ + I_DKV + I_UQ + I_UKV + I_O + (FILL ? 0 : 16 * I_MG + 8 * I_MD);
    for (int it = gw; it < NITEMS; it += NGW) {
        int r = it;
        if (r < I_IN) { cvt_item<1>(p.ev_w_in, 2048, 4096, WSP(bf16_t, WT_IN), 0, scr, r, lane); continue; } r -= I_IN;
        if (r < I_OUT) { cvt_item<0>(p.ev_w_out, 2048, 2048, WSP(bf16_t, WT_OUT), 0, scr, r, lane); continue; } r -= I_OUT;
        if (r < I_G) { cvt_item<2>(p.ffn_w_gate, 2048, FFD, WSP(bf16_t, WT_GU), 0, scr, r, lane); continue; } r -= I_G;
        if (r < I_G) { cvt_item<3>(p.ffn_w_up, 2048, FFD, WSP(bf16_t, WT_GU), 0, scr, r, lane); continue; } r -= I_G;
        if (r < I_DN) { cvt_item<0>(p.ffn_w_down, FFD, 2048, WSP(bf16_t, WT_DN), 0, scr, r, lane); continue; } r -= I_DN;
        if (r < I_DQ) { cvt_item<0>(p.od_w_dq, 2048, 512, WSP(bf16_t, WT_DQKV), 0, scr, r, lane); continue; } r -= I_DQ;
        if (r < I_DKV) { cvt_item<0>(p.od_w_dkv, 2048, 576, WSP(bf16_t, WT_DQKV), 512, scr, r, lane); continue; } r -= I_DKV;
        if (r < I_UQ) { cvt_item<0>(p.od_w_uq, 512, 3072, WSP(bf16_t, WT_UQ), 0, scr, r, lane); continue; } r -= I_UQ;
        if (r < I_UKV) { cvt_item<0>(p.od_w_ukv, 512, 4096, WSP(bf16_t, WT_UKV), 0, scr, r, lane); continue; } r -= I_UKV;
        if (r < I_O) { cvt_item<0>(p.od_w_o, 2048, 2048, WSP(bf16_t, WT_O), 0, scr, r, lane); continue; } r -= I_O;
        moe_cvt_item(p, r, scr, lane);
    }
    { bf16_t* z = WSP(bf16_t, WT_DQKV) + (size_t)1088 * 2048; for (size_t i = (size_t)bid * 512 + tid; i < (size_t)192 * 2048 / 8; i += (size_t)nb * 512) ((uint4*)z)[i] = make_uint4(0, 0, 0, 0); }
}
__device__ __forceinline__ void ph_dft_tables(const P& p, int bid, int nb, float* tab  , int wv) {
    int tid_ = TID_FROM(wv); asm volatile("" : "+v"(tid_)); const int tid = tid_;
    for (int i = tid; i < 2048; i += 512) tab[i] = cospif((float)i * (2.0f / 2048.0f));
    __syncthreads();
    bf16_t* DN = WSP(bf16_t, WS_DFTN); bf16_t* DC = WSP(bf16_t, WS_DFTC); bf16_t* WC = WSP(bf16_t, WS_WCS);
    for (size_t i = (size_t)bid * 512 + tid; i < (size_t)2048 * 4096 / 2; i += (size_t)nb * 512) {
        const int k1 = (int)(i / 2048), n2 = (int)(i % 2048) * 2; unsigned w = 0;
#pragma unroll
        for (int q = 0; q < 2; ++q) { const int nn = n2 + q, n = nn & 2047, part = nn >> 11; const int idx = (k1 * n) & 2047; const float v = part == 0 ? tab[idx] : -tab[(idx + 1536) & 2047]; w |= (unsigned)f2bf(v) << (16 * q); }
        ((unsigned*)DN)[i] = w;
    }
    for (int i = bid * 512 + tid; i < 256 * 512; i += nb * 512) { const int k1 = i / 512, nn = i % 512, n = nn & 255, part = nn >> 8; const int idx = ((k1 * n) & 255) * 8; DC[i] = f2bf(part == 0 ? tab[idx] : -tab[(idx + 1536) & 2047]); }
    for (int i = bid * 512 + tid; i < 512 * 256; i += nb * 512) { const int m = i / 256, cc = i % 256, k3 = m & 255; const int idx = ((k3 * cc) & 255) * 8; WC[i] = f2bf(m < 256 ? tab[idx] : tab[(idx + 1536) & 2047]); }
    __syncthreads();
}

#ifndef ATT_ROPE_SD1
#define ATT_ROPE_SD1 1
#endif
namespace att {
using s16x4  = __attribute__((ext_vector_type(4))) short;
using f32x16 = __attribute__((ext_vector_type(16))) float;
constexpr int QBLK = 32, KVBLK = 64, NW = 8;
constexpr size_t SHM_V = KVBLK * 128 * 2, SHM_K = KVBLK * 128 * 2, SHM_KR = KVBLK * 64 * 2;
constexpr size_t OFF_K = 2 * SHM_V, OFF_KR = OFF_K + 2 * SHM_K, OFF_WS = OFF_KR + 2 * SHM_KR, OFF_QR = OFF_WS + NW * 64 * 4, SHM_ATTN = OFF_QR + 256 * 128;
#define KSWZ(row, colB) ((row) * 256 + ((colB) ^ (((row) & 7) << 4)))
#define KRSWZ(row, colB) ((row) * 128 + ((colB) ^ (((row) & 7) << 4)))
#define SBAR() __builtin_amdgcn_sched_barrier(0)
__device__ __forceinline__ int crow(int r, int hi) { return (r & 3) + 8 * (r >> 2) + 4 * hi; }
__device__ __forceinline__ unsigned cvtpk(float lo, float hi) { unsigned r; asm volatile("v_cvt_pk_bf16_f32 %0, %1, %2" : "=v"(r) : "v"(lo), "v"(hi)); return r; }
__device__ __forceinline__ bf16x8 ld8(const bf16_t* p) { return *reinterpret_cast<const bf16x8*>(p); }

__device__ __forceinline__ void partialSM(f32x16& p0, f32x16& p1, float& m_reg, float& mn, float& alpha, const float C, const float thr) {
  float pmax = p0[0]; for (int r = 1; r < 16; ++r) pmax = fmaxf(pmax, p0[r]); for (int r = 0; r < 16; ++r) pmax = fmaxf(pmax, p1[r]);
  { auto rr = __builtin_amdgcn_permlane32_swap(__float_as_uint(pmax), __float_as_uint(pmax), false, false);
    pmax = fmaxf(__uint_as_float(rr[0]), __uint_as_float(rr[1])); }
  if (__builtin_expect(__all(pmax - m_reg <= thr), 1)) { mn = m_reg; alpha = 1.f; }
  else { mn = fmaxf(m_reg, pmax); alpha = __builtin_amdgcn_exp2f((m_reg - mn) * C); m_reg = mn; }
  float mnC = -mn * C;
  for (int r = 0; r < 16; ++r) p0[r] = fmaf(p0[r], C, mnC); for (int r = 0; r < 16; ++r) p1[r] = fmaf(p1[r], C, mnC);
  for (int r = 0; r < 16; ++r) p0[r] = __builtin_amdgcn_exp2f(p0[r]);
}
__device__ __forceinline__ void finishSM(f32x16& p0, f32x16& p1, float alpha, float& l_reg, bf16x8& pa0, bf16x8& pa1, bf16x8& pa2, bf16x8& pa3) {
  for (int r = 0; r < 16; ++r) p1[r] = __builtin_amdgcn_exp2f(p1[r]);
  float ps = 0; for (int r = 0; r < 16; ++r) ps += p0[r]; for (int r = 0; r < 16; ++r) ps += p1[r];
  { auto rr = __builtin_amdgcn_permlane32_swap(__float_as_uint(ps), __float_as_uint(ps), false, false);
    ps = __uint_as_float(rr[0]) + __uint_as_float(rr[1]); }
  l_reg = l_reg * alpha + ps;
#define PK4(P, BASE, OUT) do { unsigned a0 = cvtpk(P[BASE + 0], P[BASE + 1]), a1 = cvtpk(P[BASE + 2], P[BASE + 3]);   \
    unsigned b0 = cvtpk(P[BASE + 4], P[BASE + 5]), b1 = cvtpk(P[BASE + 6], P[BASE + 7]);                              \
    auto r0 = __builtin_amdgcn_permlane32_swap(a0, b0, false, false); auto r1 = __builtin_amdgcn_permlane32_swap(a1, b1, false, false); \
    u32x4 w = {r0[0], r1[0], r0[1], r1[1]}; OUT = *reinterpret_cast<bf16x8*>(&w); } while (0)
  PK4(p0, 0, pa0); PK4(p0, 8, pa1); PK4(p1, 0, pa2); PK4(p1, 8, pa3);
#undef PK4
}
template <bool ROPE> __device__ __forceinline__ void qkt(f32x16& p0, f32x16& p1, const char* Ks, const char* KRs, const char* QRs, const bf16x8* qr, int r32, int hi) {
  p0 = f32x16{}; p1 = f32x16{};
#pragma unroll
  for (int d0 = 0; d0 < 8; ++d0) { int cb = (d0 * 16 + hi * 8) * 2;
    bf16x8 b0 = *reinterpret_cast<const bf16x8*>(Ks + KSWZ(r32, cb));
    bf16x8 b1 = *reinterpret_cast<const bf16x8*>(Ks + KSWZ(32 + r32, cb));
    p0 = __builtin_amdgcn_mfma_f32_32x32x16_bf16(b0, qr[d0], p0, 0, 0, 0);
    p1 = __builtin_amdgcn_mfma_f32_32x32x16_bf16(b1, qr[d0], p1, 0, 0, 0); }
  if constexpr (ROPE) {
#pragma unroll
    for (int d1 = 0; d1 < 4; ++d1) { int cb = (d1 * 16 + hi * 8) * 2;
      bf16x8 b0 = *reinterpret_cast<const bf16x8*>(KRs + KRSWZ(r32, cb));
      bf16x8 b1 = *reinterpret_cast<const bf16x8*>(KRs + KRSWZ(32 + r32, cb));
      bf16x8 qf = *reinterpret_cast<const bf16x8*>(QRs + KRSWZ(r32, cb));
      p0 = __builtin_amdgcn_mfma_f32_32x32x16_bf16(b0, qf, p0, 0, 0, 0);
      p1 = __builtin_amdgcn_mfma_f32_32x32x16_bf16(b1, qf, p1, 0, 0, 0); }
  }
}
__device__ __forceinline__ int v_st(int k, int c) { const int kk = (k & ~0xC) | ((k & 4) << 1) | ((k & 8) >> 1); return ((kk >> 3) * 4 + (c >> 5)) * 512 + ((kk & 7) * 32 + (c & 31)) * 2; }
__device__ __forceinline__ int v_rd_base(int lane) { return ((lane & 3) << 3) | (((lane >> 2) & 3) << 6) | (((lane >> 4) & 1) << 5) | (((lane >> 5) & 1) << 8); }
constexpr int v_rd_off(int d0, int ks, int half) { return d0 * 512 + ks * 4096 + half * 2048; }
template <int OFF> __device__ __forceinline__ s16x4 tr_read(int vb) {
  s16x4 r; asm volatile("ds_read_b64_tr_b16 %0, %1 offset:%2" : "=&v"(r) : "v"(vb), "i"(OFF) : "memory"); return r;
}
template <int D0> __device__ __forceinline__ void pv_one(f32x16& od, int vb, bf16x8 pa0, bf16x8 pa1, bf16x8 pa2, bf16x8 pa3) {
  const s16x4 l0 = tr_read<v_rd_off(D0, 0, 0)>(vb), h0 = tr_read<v_rd_off(D0, 0, 1)>(vb), l1 = tr_read<v_rd_off(D0, 1, 0)>(vb), h1 = tr_read<v_rd_off(D0, 1, 1)>(vb);
  const s16x4 l2 = tr_read<v_rd_off(D0, 2, 0)>(vb), h2 = tr_read<v_rd_off(D0, 2, 1)>(vb), l3 = tr_read<v_rd_off(D0, 3, 0)>(vb), h3 = tr_read<v_rd_off(D0, 3, 1)>(vb);
  asm volatile("s_waitcnt lgkmcnt(0)" ::: "memory"); SBAR();
#define PK(L, H) (bf16x8){L[0], L[1], L[2], L[3], H[0], H[1], H[2], H[3]}
  od = __builtin_amdgcn_mfma_f32_32x32x16_bf16(pa0, PK(l0, h0), od, 0, 0, 0);
  od = __builtin_amdgcn_mfma_f32_32x32x16_bf16(pa1, PK(l1, h1), od, 0, 0, 0);
  od = __builtin_amdgcn_mfma_f32_32x32x16_bf16(pa2, PK(l2, h2), od, 0, 0, 0);
  od = __builtin_amdgcn_mfma_f32_32x32x16_bf16(pa3, PK(l3, h3), od, 0, 0, 0);
#undef PK
}
__device__ __forceinline__ void pv_d0(f32x16* o, int vb, bf16x8 pa0, bf16x8 pa1, bf16x8 pa2, bf16x8 pa3) {
  pv_one<0>(o[0], vb, pa0, pa1, pa2, pa3); pv_one<1>(o[1], vb, pa0, pa1, pa2, pa3); pv_one<2>(o[2], vb, pa0, pa1, pa2, pa3); pv_one<3>(o[3], vb, pa0, pa1, pa2, pa3);
}
template <int LDQ, int LDK, int LDV, int LDO, bool ROPE, bool OBF, bool TL = false>
__device__ __forceinline__ void attn_body(const bf16_t* __restrict__ Qb, const bf16_t* __restrict__ Kh, const bf16_t* __restrict__ Vh, const bf16_t* __restrict__ KRh,
                                          void* __restrict__ Ob, int seq, const float C, const float thr, char* lds, int wv) {
  int tid_ = TID_FROM(wv); asm volatile("" : "+v"(tid_));
  const int tid = tid_, wid = tid >> 6, lane = tid & 63, r32 = lane & 31, hi = lane >> 5;
  char* V_lds = lds; char* K_lds = lds + OFF_K; char* KR_lds = lds + OFF_KR;
  float* ws = (float*)(lds + OFF_WS) + wid * 64; float* li_l = ws; float* al_l = ws + 32;
  float m_reg = -1e30f, l_reg = 0; f32x16 o[4] = {}; bf16x8 qr[8];
  const int qrow = wid * QBLK + r32;
  const bf16_t* Qw = TL ? Qb + (long)(qrow >> 4) * (LDQ / 16) * 256 + (qrow & 15) * 16 + hi * 8 : Qb + (long)qrow * LDQ + hi * 8;
  constexpr int QS = TL ? 256 : 16;
#pragma unroll
  for (int d0 = 0; d0 < 8; ++d0) qr[d0] = ld8(Qw + d0 * QS);
  const char* QR_lds = lds + OFF_QR + wid * 4096;
  if constexpr (ROPE) {
#pragma unroll
    for (int d1 = 0; d1 < 4; ++d1) *(bf16x8*)(lds + OFF_QR + wid * 4096 + KRSWZ(r32, (d1 * 16 + hi * 8) * 2)) = ld8(Qw + (8 + d1) * QS);
  }
  const int sr = tid >> 4, sc = (tid & 15) * 8, vst0 = v_st(sr, sc), vst1 = v_st(32 + sr, sc);
  const int krr = tid >> 3, krc = (tid & 7) * 8;
  const int vb0 = (int)(uintptr_t)V_lds + v_rd_base(lane);
  constexpr int SD = (ROPE && ATT_ROPE_SD1) ? 1 : 2;
  struct { bf16x8 vs0, vs1, ks0, ks1, kr; } sr_[SD];
  const long kso = TL ? (long)(sr >> 4) * (LDK / 16) * 256 + (sr & 15) * 16 + (sc >> 4) * 256 + (sc & 15) : (long)sr * LDK + sc, vso = TL ? (long)(sr >> 4) * (LDV / 16) * 256 + (sr & 15) * 16 + (sc >> 4) * 256 + (sc & 15) : (long)sr * LDV + sc;
#define SLOAD(i, k0) do { sr_[i].vs0 = ld8(&Vh[(long)(k0) * LDV + vso]); sr_[i].vs1 = ld8(&Vh[(long)((k0) + 32) * LDV + vso]); \
    sr_[i].ks0 = ld8(&Kh[(long)(k0) * LDK + kso]); sr_[i].ks1 = ld8(&Kh[(long)((k0) + 32) * LDK + kso]); \
    if constexpr (ROPE) sr_[i].kr = ld8(&KRh[(long)((k0) + krr) * 64 + krc]); } while (0)
#define SWRITE(b, i) do { *(bf16x8*)(V_lds + (b) * SHM_V + vst0) = sr_[i].vs0;          \
    *(bf16x8*)(V_lds + (b) * SHM_V + vst1) = sr_[i].vs1; int kc = sc * 2;               \
    *(bf16x8*)(K_lds + (b) * SHM_K + KSWZ(sr, kc)) = sr_[i].ks0;                       \
    *(bf16x8*)(K_lds + (b) * SHM_K + KSWZ(32 + sr, kc)) = sr_[i].ks1;                  \
    if constexpr (ROPE) *(bf16x8*)(KR_lds + (b) * SHM_KR + KRSWZ(krr, krc * 2)) = sr_[i].kr; } while (0)
#define SWAIT() do { if constexpr (SD == 1) asm volatile("s_waitcnt vmcnt(0)" ::: "memory"); else if constexpr (ROPE) asm volatile("s_waitcnt vmcnt(5)" ::: "memory"); else asm volatile("s_waitcnt vmcnt(4)" ::: "memory"); } while (0)
#define RESC(a) do { if (__any((a) < 1.f)) { if (hi == 0) al_l[r32] = (a); asm volatile("s_waitcnt lgkmcnt(0)" ::: "memory"); \
    for (int d = 0; d < 4; ++d) for (int r = 0; r < 16; ++r) o[d][r] *= al_l[crow(r, hi)]; } } while (0)
  f32x16 pA0, pA1, pB0, pB1; float mnA, mnB, alA, alB; bf16x8 pa0, pa1, pa2, pa3; const int NT = seq / KVBLK;
  constexpr int SE = 0, SO = SD - 1;
  SLOAD(SE, 0); asm volatile("s_waitcnt vmcnt(0)" ::: "memory"); SWRITE(0, SE); __syncthreads();
  qkt<ROPE>(pA0, pA1, K_lds, KR_lds, QR_lds, qr, r32, hi); partialSM(pA0, pA1, m_reg, mnA, alA, C, thr);
  SLOAD(SO, KVBLK); if constexpr (SD == 2) { if (2 < NT) SLOAD(SE, 2 * KVBLK); }
  SWAIT(); SWRITE(1, SO); __syncthreads();
  for (int j = 1; j + 1 < NT; j += 2) {
    SBAR(); qkt<ROPE>(pB0, pB1, K_lds + SHM_K, KR_lds + SHM_KR, QR_lds, qr, r32, hi);
    finishSM(pA0, pA1, alA, l_reg, pa0, pa1, pa2, pa3); SBAR();
    SLOAD(SO, (j + SD) * KVBLK); SBAR();
    pv_d0(o, vb0, pa0, pa1, pa2, pa3); partialSM(pB0, pB1, m_reg, mnB, alB, C, thr);
    __syncthreads(); SWAIT(); SWRITE(0, SE);
    RESC(alB); __syncthreads();
    SBAR(); qkt<ROPE>(pA0, pA1, K_lds, KR_lds, QR_lds, qr, r32, hi);
    finishSM(pB0, pB1, alB, l_reg, pa0, pa1, pa2, pa3); SBAR();
    if (SD == 1 || j + 3 < NT) SLOAD(SE, (j + 1 + SD) * KVBLK); SBAR();
    pv_d0(o, vb0 + (int)SHM_V, pa0, pa1, pa2, pa3); partialSM(pA0, pA1, m_reg, mnA, alA, C, thr);
    __syncthreads(); SWAIT(); SWRITE(1, SO);
    RESC(alA); __syncthreads();
  }
  SBAR(); qkt<ROPE>(pB0, pB1, K_lds + SHM_K, KR_lds + SHM_KR, QR_lds, qr, r32, hi);
  finishSM(pA0, pA1, alA, l_reg, pa0, pa1, pa2, pa3); SBAR();
  pv_d0(o, vb0, pa0, pa1, pa2, pa3); partialSM(pB0, pB1, m_reg, mnB, alB, C, thr);
  __syncthreads(); RESC(alB);
  finishSM(pB0, pB1, alB, l_reg, pa0, pa1, pa2, pa3); SBAR();
  pv_d0(o, vb0 + (int)SHM_V, pa0, pa1, pa2, pa3);
  if (hi == 0) li_l[r32] = l_reg; asm volatile("s_waitcnt lgkmcnt(0)" ::: "memory");
  float rli[16];
#pragma unroll
  for (int r = 0; r < 16; ++r) rli[r] = __builtin_amdgcn_rcpf(li_l[crow(r, hi)]);
#pragma unroll
  for (int r = 0; r < 16; ++r) { const int orow = wid * QBLK + crow(r, hi);
#pragma unroll
    for (int d0 = 0; d0 < 4; ++d0) { const float val = o[d0][r] * rli[r];
      if constexpr (OBF) ((bf16_t*)Ob)[(long)orow * LDO + d0 * 32 + r32] = f2bf(val); else ((float*)Ob)[(long)orow * LDO + d0 * 32 + r32] = val; } }
  __syncthreads();
#undef SLOAD
#undef SWRITE
#undef SWAIT
#undef RESC
}
#undef KSWZ
#undef KRSWZ
#undef SBAR
}

constexpr int NPH = 22;
typedef const __attribute__((address_space(4))) P* KP4;
__global__ void __launch_bounds__(512, 2) mega(P p_arg, int ph_lo, int ph_hi, int bar_idx) {
    const KP4 kp0 = (KP4)__builtin_amdgcn_kernarg_segment_ptr();
#define LOCAL_P KP4 kp_ = kp0; asm volatile("" : "+s"(kp_)); const P& p = *(const P*)kp_;
    LOCAL_P
    extern __shared__ __attribute__((aligned(16))) unsigned char lds_raw[];
    LAS unsigned char* lds = (LAS unsigned char*)lds_raw;
    const int wv = __builtin_amdgcn_readfirstlane((int)threadIdx.x >> 6);
    const int tid = TID_FROM(wv), bid = blockIdx.x, nb = gridDim.x;
    volatile LAS unsigned* MISC = (volatile LAS unsigned*)(lds + MISC_OFF);
    for (int u = tid; u < (LDS_BYTES - RING_BYTES) / 4; u += 512) ((LAS unsigned*)(lds + RING_BYTES))[u] = 0u;
    __syncthreads();
    unsigned* ctl = (unsigned*)(p.ws + WS_CTL);
    XcdBarrier bar = xcd_barrier_post(ctl + CW_BAR + bar_idx * XCD_BAR_WORDS, MISC + 8, wv);
    float* SLABS = WSP(float, WS_SLAB);
#ifndef NHELP
#define NHELP 0
#endif
    const int nbw = nb - NHELP; const bool helper = NHELP > 0 && bid >= nbw;
#ifndef FILL_TAILS
#define FILL_TAILS 1
#endif
#ifndef FILL_MASK
#define FILL_MASK 0xFFFF7CBFu
#endif
#define FILL_TAIL(k) do { if (FILL && FILL_TAILS && ((FILL_MASK >> (k)) & 1u)) { __syncthreads(); if (wv == 0 && lane_id() == 0) (void)xb_add(ctl + CW_DONE + 64 * (k), 1u); moe_fill(p, ctl, (k), nb, bid, lds, MISC, wv); } } while (0)
#define GEMM_TAIL(S, E, off) do { if ((S).s > 1) { xcd_barrier(bar, wv); pg8::tail_reduce(S, E, SLABS + ((size_t)(off) << 16), bid, nb, wv); } } while (0)
#ifndef PH_MASK
#define PH_MASK 0xFFFFFFFFu
#endif
#define RUN(k) (((PH_MASK >> (k)) & 1u) && ph_lo <= (k) && (k) < ph_hi)
#define SEAM(k) do { if (RUN(k) && RUN((k) + 1)) xcd_barrier(bar, wv); } while (0)
#ifndef REPEAT_PH
#define REPEAT_PH (-1)
#endif
#ifndef REPEAT_N
#define REPEAT_N 2
#endif
#define NREP(k) ((k) == REPEAT_PH ? REPEAT_N : 1)
#define PH_BEGIN(k) if (RUN(k)) { _Pragma("unroll") for (int rep = 0; rep < NREP(k); ++rep) { LOCAL_P
#define PH_END(k) if (rep + 1 < NREP(k)) xcd_barrier(bar, wv); } } SEAM(k);
    const size_t T2048 = (size_t)256 * 2048 * 2, T512 = (size_t)256 * 512 * 2;
#ifndef SPLIT_G1
#define SPLIT_G1 1
#endif
#ifndef SPLIT_G2
#define SPLIT_G2 4
#endif
#ifndef SPLIT_G3
#define SPLIT_G3 4
#endif
#ifndef SPLIT_G4
#define SPLIT_G4 4
#endif
#ifndef SPLIT_P13
#define SPLIT_P13 1
#endif
#ifndef SPLIT_G9
#define SPLIT_G9 1
#endif
#ifndef SPLIT_G10
#define SPLIT_G10 8
#endif

    PH_BEGIN(0) { ph_prologue(p, bid, nb, (float*)lds_raw, wv); __syncthreads(); ph_dft_tables(p, bid, nb, (float*)lds_raw, wv); ph_convert(p, bid, nb, lds, wv);
#ifdef CONVERT_TWICE
        __syncthreads(); ph_convert(p, bid, nb, lds, wv);
#endif
    }
    PH_END(0)
    PH_BEGIN(1) ph_norm_mod<!ORACLE>(p, p.norm1_g, 0, 0, 1, bid, nb, wv);
    PH_END(1)
#ifdef EXTRA_BARS
    for (int e_ = 0; e_ < EXTRA_BARS; ++e_) xcd_barrier(bar, wv);
#endif
    PH_BEGIN(2) { pg8::GridSched<false, 4096> S; S.init(WSP(bf16_t, WS_H), T2048, WSP(bf16_t, WT_IN), T2048, 36, 16, 2048, nbw, bid, SPLIT_G1);
        pg8::Epi<EF_in> E{{WSP(bf16_t, A0_F), WSP(bf16_t, A0_Q), WSP(bf16_t, A0_K), WSP(bf16_t, A0_V), WSP(float2, WS_TABD)}};
        if (!helper) { pg8::gemm_phase<false, true>(lds, pg8::Dims{2048, 2048, SLABS}, S, E, wv); } FILL_TAIL(2);
        GEMM_TAIL(S, E, 0); }
    PH_END(2)
    PH_BEGIN(3) { pg8::TailSched<DftABase> S; S.b.WCS = (const char*)WSP(bf16_t, WS_WCS); S.b.F = (const char*)WSP(bf16_t, A0_F); S.init(288, 256, nb, bid);
        pg8::Epi<EF_dftA> E{{WSP(bf16_t, A0_VT), WSP(bf16_t, A0_VTC)}};
        pg8::gemm_phase<false, false, false, true>(lds, pg8::Dims{256, 1024, SLABS}, S, E, wv); GEMM_TAIL(S, E, 0); }
    PH_END(3)
    PH_BEGIN(4) {
        pg8::TailSched<DftBBase> S1; S1.b = DftBBase{(const char*)WSP(bf16_t, WS_DFTN), (const char*)WSP(bf16_t, A0_VT), (size_t)256 * 4096 * 2, (size_t)256 * 4096 * 2, 8, 0}; S1.init(128, 4096, nb, bid, 1);
        pg8::Epi<EF_dftB> E1{{WSP(bf16_t, A0_MIX), 1.0f / sqrtf(2048.f * 256.f), CTX}};
        pg8::gemm_phase<false, false, false, true>(lds, pg8::Dims{4096, 4096, SLABS}, S1, E1, wv);
        pg8::TailSched<DftBBase> S2; S2.b = DftBBase{(const char*)WSP(bf16_t, WS_DFTC), (const char*)WSP(bf16_t, A0_VTC), 0, (size_t)256 * 512 * 2, 1, 0}; S2.init(16, 512, nb, (bid + 128) % nb, 1);
        pg8::Epi<EF_dftB> E2{{WSP(bf16_t, A0_MIX), 1.0f / sqrtf(256.f * 256.f), 0}};
        pg8::gemm_phase<false, false, false, true>(lds, pg8::Dims{512, 512, SLABS + ((size_t)256 << 16)}, S2, E2, wv);
        __syncthreads();
        volatile LAS int* qslot = (volatile LAS int*)(MISC + 16);
        const bf16_t* Qd = WSP(bf16_t, A0_Q); const bf16_t* Kd = WSP(bf16_t, A0_K); const bf16_t* Vd = WSP(bf16_t, A0_V); float* OD = WSP(float, A0_OD);
        for (;;) {
            if (tid == 0) *qslot = (int)xb_add(ctl + CW_QUEUE + 64 * rep, 1u);
            __syncthreads();
            const int it = *qslot;
            __syncthreads();
            if (it >= 576) break;
            int inst, row0, seq;
            if (it < 512) { inst = it >> 3; row0 = CTX + (it & 7) * 256; seq = TPB; } else { inst = it - 512; row0 = 0; seq = CTX; }
            const int b = inst >> 4, h = (inst >> 2) & 3, c = (inst >> 1) & 1, vh = inst & 1;
            const size_t R0 = (size_t)b * TPB + row0, K0 = (size_t)b * TPB;
            att::attn_body<1024, 1024, 1024, 2048, false, false, true>(Qd + R0 * 1024 + (h * 256 + c * 128) * 16, Kd + K0 * 1024 + (h * 256 + c * 128) * 16, Vd + K0 * 1024 + (h * 256 + vh * 128) * 16, nullptr,
                OD + (R0 * 4 + h) * 512 + c * 256 + vh * 128, seq, 0.08838834764831845f * 1.4426950408889634f, 8.f / 0.08838834764831845f, (char*)lds_raw, wv);
        }
        FILL_TAIL(4);
        if (S1.s > 1 || S2.s > 1) { xcd_barrier(bar, wv); pg8::tail_reduce(S1, E1, SLABS, bid, nb, wv); pg8::tail_reduce(S2, E2, SLABS + ((size_t)256 << 16), bid, nb, wv); }
    }
    PH_END(4)
    PH_BEGIN(5) ph_subln(p, bid, nb, wv);
    PH_END(5)
    PH_BEGIN(6) { pg8::GridSched<false, 4096> S; S.init(WSP(bf16_t, A0_MIX), T2048, WSP(bf16_t, WT_OUT), T2048, 36, 8, 2048, nbw, bid, SPLIT_G2);
#if ORACLE
        pg8::Epi<EF_res> E{{WSP(float, WS_XS), WSP(float, WS_MODS), 2, 0}};
#else
        pg8::Epi<EF_res0> E{{WSP(float, WS_XS), WSP(float, WS_MODS), p.x, p.ctx, 2, 0}};
#endif
        if (!helper) { pg8::gemm_phase<false, true>(lds, pg8::Dims{2048, 2048, SLABS}, S, E, wv); } FILL_TAIL(6);
        GEMM_TAIL(S, E, 0); }
    PH_END(6)
    PH_BEGIN(7) ph_norm_mod(p, p.norm2_g, 0, 3, 4, bid, nb, wv);
    PH_END(7)
    PH_BEGIN(8) { pg8::GridSched<false, 4096> S; S.init(WSP(bf16_t, WS_H), T2048, WSP(bf16_t, WT_GU), T2048, 36, 44, 2048, nbw, bid, SPLIT_G3);
        pg8::Epi<EF_swiglu> E{{WSP(bf16_t, A0_ACT), FFD, 0}};
        if (!helper) { pg8::gemm_phase<false, true>(lds, pg8::Dims{2048, 2048, SLABS}, S, E, wv); } FILL_TAIL(8);
        GEMM_TAIL(S, E, 0); }
    PH_END(8)
    PH_BEGIN(9) { pg8::GridSched<false, 4096, 2048> S; S.init(WSP(bf16_t, A0_ACT), (size_t)256 * FFD * 2, WSP(bf16_t, WT_DN), (size_t)256 * FFD * 2, 36, 8, FFD, nbw, bid, SPLIT_G4);
        pg8::Epi<EF_res> E{{WSP(float, WS_XS), WSP(float, WS_MODS), 5, 0}};
        if (!helper) { pg8::gemm_phase<false, true, true>(lds, pg8::Dims{FFD, FFD, SLABS}, S, E, wv); } FILL_TAIL(9);
        GEMM_TAIL(S, E, 0); }
    PH_END(9)
    PH_BEGIN(10) ph_norm_mod(p, p.norm1_g + D, 1, 0, 1, bid, nb, wv);
    PH_END(10)
    PH_BEGIN(11) { pg8::GridSched<false, 4096> S; S.init(WSP(bf16_t, WS_H), T2048, WSP(bf16_t, WT_DQKV), T2048, 36, 5, 2048, nbw, bid);
        pg8::Epi<EF_dqkv> E{{WSP(float, A1_CQ), WSP(float, A1_CKV), WSP(bf16_t, A1_KR), WSP(float2, WS_TABM)}};
        if (!helper) { pg8::gemm_phase<false, true>(lds, pg8::Dims{2048, 2048, SLABS}, S, E, wv); } FILL_TAIL(11);
        GEMM_TAIL(S, E, 0); }
    PH_END(11)
    PH_BEGIN(12) ph_lora_norm(p, bid, nb, wv);
    PH_END(12)
    PH_BEGIN(13) {
        pg8::GridSched<true, 4096> S1; S1.init(WSP(bf16_t, A1_CQN), T512, WSP(bf16_t, WT_UQ), T512, 32, 12, 512, nbw, bid, SPLIT_P13);
        pg8::Epi<EF_uq> E1{{WSP(bf16_t, A1_QM), WSP(float2, WS_TABM)}};
        if (!helper) pg8::gemm_phase<false, true>(lds, pg8::Dims{512, 512, SLABS}, S1, E1, wv);
        pg8::GridSched<false, 4096> S2; S2.init(WSP(bf16_t, A1_CKVN), T512, WSP(bf16_t, WT_UKV), T512, 36, 16, 512, nbw, bid, SPLIT_P13);
        pg8::Epi<EF_bf> E2{{WSP(bf16_t, A1_KVM), 4096, 0}};
        if (!helper) pg8::gemm_phase<false, true>(lds, pg8::Dims{512, 512, SLABS + ((size_t)256 << 16)}, S2, E2, wv);
#ifdef PROBE_P13
#if PROBE_P13_MODE == 1
        for (int q_ = 0; q_ < PROBE_P13; ++q_) { __syncthreads(); pg8::Epi<EF_bf> E3{{(bf16_t*)(p.ws + WS_END), 4096, 0}}; if (!helper) pg8::gemm_phase<false, true>(lds, pg8::Dims{512, 512, SLABS}, S2, E3, wv); }
#elif PROBE_P13_MODE == 2
        for (int q_ = 0; q_ < PROBE_P13; ++q_) { __syncthreads(); pg8::Epi<EF_probe_lin> E3{{(bf16_t*)(p.ws + WS_END), 4096, 0}}; if (!helper) pg8::gemm_phase<false, true>(lds, pg8::Dims{512, 512, SLABS}, S2, E3, wv); }
#else
        for (int q_ = 0; q_ < PROBE_P13; ++q_) { __syncthreads(); pg8::Epi<EF_probe> E3{{SLABS, 0, 0}}; if (!helper) pg8::gemm_phase<false, true>(lds, pg8::Dims{512, 512, SLABS}, S2, E3, wv); }
#endif
#endif
        FILL_TAIL(13);
        if (S1.s > 1 || S2.s > 1) { xcd_barrier(bar, wv); pg8::tail_reduce(S1, E1, SLABS, bid, nb, wv); pg8::tail_reduce(S2, E2, SLABS + ((size_t)256 << 16), bid, nb, wv); }
    }
    PH_END(13)
    PH_BEGIN(14) {
        __syncthreads();
        const bf16_t* QM = WSP(bf16_t, A1_QM); const bf16_t* KVM = WSP(bf16_t, A1_KVM); const bf16_t* KR = WSP(bf16_t, A1_KR); bf16_t* OM = WSP(bf16_t, A1_OM);
        for (int r = 0; r * nb + bid < 512; ++r) {
            int it = r * nb + bid;
            if (nb == 256) { const int x = bid & 7, y = bid >> 3; it = (r * 32 + (y >> 3) * 8 + x) * 8 + (y & 7); }
            const int inst = it >> 3, qb = it & 7, b = inst >> 4, h = inst & 15;
            const size_t R0 = (size_t)b * TPB + CTX + qb * 256, K0 = (size_t)b * TPB;
            att::attn_body<3072, 4096, 4096, 2048, true, true, true>(QM + R0 * 3072 + h * 192 * 16, KVM + K0 * 4096 + h * 256 * 16, KVM + K0 * 4096 + (h * 256 + 128) * 16, KR + K0 * 64,
                OM + R0 * 2048 + h * 128, TPB, 0.07216878364870323f * 1.4426950408889634f, 8.f / 0.07216878364870323f, (char*)lds_raw, wv);
        }
    }
    PH_END(14)
    PH_BEGIN(15) { pg8::GridSched<true, 4096> S; S.init(WSP(bf16_t, A1_OM), T2048, WSP(bf16_t, WT_O), T2048, 32, 8, 2048, nbw, bid);
        pg8::Epi<EF_res> E{{WSP(float, WS_XS), WSP(float, WS_MODS) + 5 * 6 * D, 2, 0}};
        if (!helper) { pg8::gemm_phase<false, true>(lds, pg8::Dims{2048, 2048, SLABS}, S, E, wv); } FILL_TAIL(15);
        GEMM_TAIL(S, E, 0); }
    PH_END(15)
    PH_BEGIN(16) { __syncthreads(); ph_route(p, bid, nb, (float*)lds_raw, wv); }
    PH_END(16)
    PH_BEGIN(17) {
#ifdef PROBE_CVT
        if (rep > 0) { __syncthreads(); if (wv == 0 && lane_id() == 0) { __hip_atomic_store(ctl + CW_FILL + 64 * bid, 0u, __ATOMIC_RELAXED, __HIP_MEMORY_SCOPE_AGENT); MISC[24] = 0u; MISC[25] = 1u; } xcd_barrier(bar, wv); }
#endif
        __syncthreads(); ph_sort(p, bid, (int*)lds_raw, wv);
        if (FILL) { __syncthreads(); moe_fill(p, ctl, -1, nb, bid, lds, MISC, wv); } }
    PH_END(17)
    PH_BEGIN(18) ph_gather(p, bid, nb, wv);
    PH_END(18)
    PH_BEGIN(19) { pg8::TailSched<MoeBase, 4096> S; const int tot = S.b.init(WSP(unsigned char, A1_AS), (size_t)2048, WSP(unsigned char, WT_MGU), (size_t)2 * FFE * 2048, (size_t)256 * 2048, 56, (const int*)(p.ws + WS_ROUTE + RT_CNT), (const int*)(p.ws + WS_ROUTE + RT_OFFS)); S.init(tot, 1024, nb, bid, SPLIT_G9);
        pg8::Epi<EF_swiglu8> E{{WSP(unsigned char, A1_ACT2), FFE, 0}};
        pg8::gemm_phase<true>(lds, pg8::Dims{1024, 1024, SLABS}, S, E, wv); GEMM_TAIL(S, E, 0);
#ifdef PROBE_G9
#if PROBE_G9 == 1
        { xcd_barrier(bar, wv); pg8::Epi<EF_probe> E2{{SLABS, 0, 0}}; pg8::gemm_phase<true>(lds, pg8::Dims{1024, 1024, SLABS}, S, E2, wv); }
#elif PROBE_G9 == 2
        { xcd_barrier(bar, wv); pg8::Epi<EF_probe_math> E2{{(unsigned char*)SLABS, FFE, 0}}; pg8::gemm_phase<true>(lds, pg8::Dims{1024, 1024, SLABS}, S, E2, wv); }
#else
        { xcd_barrier(bar, wv); pg8::Epi<EF_probe_store> E2{{(unsigned char*)SLABS, FFE, 0}}; pg8::gemm_phase<true>(lds, pg8::Dims{1024, 1024, SLABS}, S, E2, wv); }
#endif
#endif
    }
    PH_END(19)
    PH_BEGIN(20) { pg8::TailSched<MoeBase, 4096, 2048> S; const int tot = S.b.init(WSP(unsigned char, A1_ACT2), (size_t)FFE, WSP(unsigned char, WT_MD), (size_t)2048 * FFE, (size_t)256 * FFE, 8, (const int*)(p.ws + WS_ROUTE + RT_CNT), (const int*)(p.ws + WS_ROUTE + RT_OFFS)); S.init(tot, FFE / 2, nb, bid, SPLIT_G10);
        pg8::Epi<EF_y8> E{{WSP(bf16_t, A1_Y), 2048, 0}};
        pg8::gemm_phase<true, false, true>(lds, pg8::Dims{FFE / 2, FFE / 2, SLABS}, S, E, wv); GEMM_TAIL(S, E, 0); }
    PH_END(20)
    PH_BEGIN(21) ph_final(p, bid, nb, wv);
    PH_END(21)
#undef GEMM_TAIL
#undef FILL_TAIL
#undef RUN
#undef SEAM
#undef PH_BEGIN
#undef PH_END
}
#if ORACLE
template <class G> __global__ __launch_bounds__(256) void ngemm(G g) {
    __shared__ float As[16][132]; __shared__ float Ws[16][132]; __shared__ float W2s[G::DUAL ? 16 : 1][132];
    const int z = blockIdx.z, M = g.rows(z), N = g.N, K = g.K, m0 = blockIdx.y * 128, n0 = blockIdx.x * 128;
    if (m0 >= M) return;
    const int tid = threadIdx.x, tx = tid & 15, ty = tid >> 4;
    float acc[8][8], acc2[G::DUAL ? 8 : 1][8];
#pragma unroll
    for (int i = 0; i < 8; ++i)
#pragma unroll
        for (int j = 0; j < 8; ++j) { acc[i][j] = 0.f; if constexpr (G::DUAL) acc2[i][j] = 0.f; }
    for (int k0 = 0; k0 < K; k0 += 16) {
#pragma unroll
        for (int i = 0; i < 8; ++i) { const int idx = tid + i * 256; const int k = idx & 15, m = idx >> 4; As[k][m] = (m0 + m < M) ? g.a(z, m0 + m, k0 + k) : 0.f; }
#pragma unroll
        for (int i = 0; i < 8; ++i) { const int idx = tid + i * 256; const int n = idx & 127, k = idx >> 7; const bool ok = n0 + n < N; Ws[k][n] = ok ? g.w(z, k0 + k, n0 + n) : 0.f; if constexpr (G::DUAL) W2s[k][n] = ok ? g.w2(z, k0 + k, n0 + n) : 0.f; }
        __syncthreads();
#pragma unroll
        for (int k = 0; k < 16; ++k) {
            float av[8], bv[8], b2[8];
#pragma unroll
            for (int i = 0; i < 8; ++i) { av[i] = As[k][ty * 8 + i]; bv[i] = Ws[k][tx * 8 + i]; if constexpr (G::DUAL) b2[i] = W2s[k][tx * 8 + i]; }
#pragma unroll
            for (int i = 0; i < 8; ++i)
#pragma unroll
                for (int j = 0; j < 8; ++j) { acc[i][j] += av[i] * bv[j]; if constexpr (G::DUAL) acc2[i][j] += av[i] * b2[j]; }
        }
        __syncthreads();
    }
#pragma unroll
    for (int i = 0; i < 8; ++i)
#pragma unroll
        for (int j = 0; j < 8; ++j) { const int m = m0 + ty * 8 + i, n = n0 + tx * 8 + j; if (m < M && n < N) g.epi(z, m, n, acc[i][j], G::DUAL ? acc2[i][j] : 0.f); }
}

template <int HALF> __device__ __forceinline__ int rope_partner(int d) { const int i = d % HALF; return i < HALF / 2 ? d + HALF / 2 : d - HALF / 2; }
template <int HALF> __device__ __forceinline__ float rope_apply(const float2* tab, int nl, int d, float v, float vp) {
    const int half = d / HALF, i = d % HALF, pos = half == 0 ? nl / 64 : nl % 64, fi = i % (HALF / 2); const float2 cs = tab[pos * (HALF / 2) + fi];
    return i < HALF / 2 ? v * cs.x - vp * cs.y : v * cs.x + vp * cs.y;
}

struct G_in {
    static constexpr bool DUAL = true; const bf16_t* H; const float* W; bf16_t *F, *Q, *Kd, *V; const float2* tab; int N, K;
    __device__ int rows(int) const { return NTOK; }
    __device__ float a(int, int m, int k) const { return bf2f(H[(size_t)m * D + k]); }
    __device__ float w(int, int k, int n) const { return W[(size_t)k * EIN + n]; }
    __device__ float w2(int, int k, int n) const { if (n < 1024 || n >= 3072) return 0.f; const int d = n & 127; return W[(size_t)k * EIN + (n - d) + rope_partner<64>(d)]; }
    __device__ void epi(int, int m, int n, float v, float vp) const {
        const int j = m % TPB;
        if (n < 1024) { F[(size_t)m * 1024 + n] = f2bf(v); return; }
        if (n >= 3072) { V[(size_t)m * 1024 + n - 3072] = f2bf(v); return; }
        float o = v; if (j >= CTX) o = rope_apply<64>(tab, j - CTX, n & 127, v, vp);
        if (n < 2048) Q[(size_t)m * 1024 + n - 1024] = f2bf(o); else Kd[(size_t)m * 1024 + n - 2048] = f2bf(o);
    }
};
struct G_dftA {
    static constexpr bool DUAL = false; const bf16_t* F; float* T; int N, K;
    __device__ int rows(int) const { return NTOK * 4; }
    __device__ float a(int, int m, int k) const { return bf2f(F[(size_t)m * 256 + k]); }
    __device__ float w(int, int k, int n) const { const int k3 = n & 255, idx = (k * k3) & 255; const float ang = (float)idx * (2.0f / 256.0f); return n < 256 ? cospif(ang) : sinpif(ang); }
    __device__ float w2(int, int, int) const { return 0.f; }
    __device__ void epi(int, int m, int n, float v, float) const { T[(size_t)m * 512 + n] = v; }
};
struct G_dftB {
    static constexpr bool DUAL = false; const float* T; bf16_t* MIX; int N, K, NS, joff; float scale; int pad;
    __device__ int rows(int) const { return NS; }
    __device__ float a(int, int m, int k) const { const int n = k % NS, part = k / NS; const int idx = (int)(((long)m * n) % NS); const float ang = (float)idx * (2.0f / (float)NS); return part == 0 ? cospif(ang) : -sinpif(ang); }
    __device__ float w(int z, int k, int n) const { const int b = z >> 2, g = z & 3, nn = k % NS, part = k / NS; const int R = b * TPB + joff + nn; return T[((size_t)R * 4 + g) * 512 + part * 256 + n]; }
    __device__ float w2(int, int, int) const { return 0.f; }
    __device__ void epi(int z, int m, int n, float v, float) const { const int b = z >> 2, g = z & 3; const int R = b * TPB + joff + m; MIX[(size_t)R * 2048 + g * 256 + n] = f2bf(v * scale); }
};
struct G_res {
    static constexpr bool DUAL = false; const bf16_t* A; const float* W; float* XS; const float* mods; int N, K, lda, chunk;
    __device__ int rows(int) const { return NTOK; }
    __device__ float a(int, int m, int k) const { return bf2f(A[(size_t)m * lda + k]); }
    __device__ float w(int, int k, int n) const { return W[(size_t)k * N + n]; }
    __device__ float w2(int, int, int) const { return 0.f; }
    __device__ void epi(int, int m, int n, float v, float) const { XS[(size_t)m * D + n] += mods[(size_t)mod_row(m) * 6 * D + chunk * D + n] * v; }
};
struct G_swiglu {
    static constexpr bool DUAL = true; const bf16_t* A; const float *Wg, *Wu; bf16_t* ACT; int N, K;
    __device__ int rows(int) const { return NTOK; }
    __device__ float a(int, int m, int k) const { return bf2f(A[(size_t)m * D + k]); }
    __device__ float w(int, int k, int n) const { return Wg[(size_t)k * N + n]; }
    __device__ float w2(int, int k, int n) const { return Wu[(size_t)k * N + n]; }
    __device__ void epi(int, int m, int n, float v, float v2) const { ACT[(size_t)m * N + n] = f2bf(silu_f(v) * v2); }
};
struct G_dq {
    static constexpr bool DUAL = false; const bf16_t* H; const float* W; float* CQ; int N, K;
    __device__ int rows(int) const { return NTOK; }
    __device__ float a(int, int m, int k) const { return bf2f(H[(size_t)m * D + k]); }
    __device__ float w(int, int k, int n) const { return W[(size_t)k * QLORA + n]; }
    __device__ float w2(int, int, int) const { return 0.f; }
    __device__ void epi(int, int m, int n, float v, float) const { CQ[(size_t)m * 512 + n] = v; }
};
struct G_dkv {
    static constexpr bool DUAL = true; const bf16_t* H; const float* W; float* CKV; bf16_t* KR; const float2* tab; int N, K;
    __device__ int rows(int) const { return NTOK; }
    __device__ float a(int, int m, int k) const { return bf2f(H[(size_t)m * D + k]); }
    __device__ float w(int, int k, int n) const { return W[(size_t)k * 576 + n]; }
    __device__ float w2(int, int k, int n) const { if (n < 512) return 0.f; return W[(size_t)k * 576 + 512 + rope_partner<32>(n - 512)]; }
    __device__ void epi(int, int m, int n, float v, float vp) const {
        if (n < 512) { CKV[(size_t)m * 512 + n] = v; return; }
        const int j = m % TPB; float o = v; if (j >= CTX) o = rope_apply<32>(tab, j - CTX, n - 512, v, vp);
        KR[(size_t)m * 64 + n - 512] = f2bf(o);
    }
};
struct G_uq {
    static constexpr bool DUAL = true; const bf16_t* A; const float* W; bf16_t* QM; const float2* tab; int N, K;
    __device__ int rows(int) const { return NTOK; }
    __device__ float a(int, int m, int k) const { return bf2f(A[(size_t)m * 512 + k]); }
    __device__ float w(int, int k, int n) const { return W[(size_t)k * 3072 + n]; }
    __device__ float w2(int, int k, int n) const { const int d = n % 192; if (d < 128) return 0.f; return W[(size_t)k * 3072 + (n - d) + 128 + rope_partner<32>(d - 128)]; }
    __device__ void epi(int, int m, int n, float v, float vp) const {
        const int d = n % 192, j = m % TPB; float o = v; if (d >= 128 && j >= CTX) o = rope_apply<32>(tab, j - CTX, d - 128, v, vp);
        QM[(size_t)m * 3072 + n] = f2bf(o);
    }
};
struct G_ukv {
    static constexpr bool DUAL = false; const bf16_t* A; const float* W; bf16_t* KVM; int N, K;
    __device__ int rows(int) const { return NTOK; }
    __device__ float a(int, int m, int k) const { return bf2f(A[(size_t)m * 512 + k]); }
    __device__ float w(int, int k, int n) const { return W[(size_t)k * 4096 + n]; }
    __device__ float w2(int, int, int) const { return 0.f; }
    __device__ void epi(int, int m, int n, float v, float) const { KVM[(size_t)m * 4096 + n] = f2bf(v); }
};
struct G_moe1 {
    static constexpr bool DUAL = true; const unsigned char* AS; const float *Wg, *Wu; bf16_t* ACT2; const int *CNT, *OFFS; int N, K;
    __device__ int rows(int z) const { return CNT[z]; }
    __device__ float a(int z, int m, int k) const { return __builtin_amdgcn_cvt_f32_fp8((int)AS[(size_t)(OFFS[z] + m) * D + k], 0); }
    __device__ float w(int z, int k, int n) const { return Wg[((size_t)z * D + k) * FFE + n]; }
    __device__ float w2(int z, int k, int n) const { return Wu[((size_t)z * D + k) * FFE + n]; }
    __device__ void epi(int z, int m, int n, float v, float v2) const { ACT2[(size_t)(OFFS[z] + m) * FFE + n] = f2bf(silu_f(v) * v2); }
};
struct G_moe2 {
    static constexpr bool DUAL = false; const unsigned char* ACT2; const float* Wd; float* Y; const int *CNT, *OFFS; int N, K;
    __device__ int rows(int z) const { return CNT[z]; }
    __device__ float a(int z, int m, int k) const { return __builtin_amdgcn_cvt_f32_fp8((int)ACT2[(size_t)(OFFS[z] + m) * FFE + k], 0) * (1.0f / A8_ACT); }
    __device__ float w(int z, int k, int n) const { return Wd[((size_t)z * FFE + k) * D + n]; }
    __device__ float w2(int, int, int) const { return 0.f; }
    __device__ void epi(int z, int m, int n, float v, float) const { Y[(size_t)(OFFS[z] + m) * D + n] = v; }
};

template <int DQK, int DV, class F> __global__ __launch_bounds__(256) void nattn(F f, int nkeys, float scale) {
    extern __shared__ float sm[];
    float* qs = sm;
    float* Pm = sm + 4 * DQK;
    __shared__ float rsum[4];
    const int z = blockIdx.y, q0 = blockIdx.x * 4, tid = threadIdx.x, lane = tid & 63, wave = tid >> 6;
    for (int i = tid; i < 4 * DQK; i += 256) { const int r = i / DQK, d = i % DQK; qs[i] = bf2f(f.qptr(z, q0 + r)[d]); }
    __syncthreads();
    for (int kk = tid; kk < nkeys; kk += 256) {
        float s0 = 0.f, s1 = 0.f, s2 = 0.f, s3 = 0.f;
        const bf16_t* kp = f.kptr(z, kk);
        for (int d = 0; d < 128; ++d) { const float kv = bf2f(kp[d]); s0 += qs[d] * kv; s1 += qs[DQK + d] * kv; s2 += qs[2 * DQK + d] * kv; s3 += qs[3 * DQK + d] * kv; }
        if (DQK > 128) { const bf16_t* k2 = f.k2ptr(z, kk);
            for (int d = 128; d < DQK; ++d) { const float kv = bf2f(k2[d - 128]); s0 += qs[d] * kv; s1 += qs[DQK + d] * kv; s2 += qs[2 * DQK + d] * kv; s3 += qs[3 * DQK + d] * kv; } }
        Pm[kk] = s0 * scale; Pm[nkeys + kk] = s1 * scale; Pm[2 * nkeys + kk] = s2 * scale; Pm[3 * nkeys + kk] = s3 * scale;
    }
    __syncthreads();
    {
        float* pr = Pm + wave * nkeys; float mx = -3.0e38f;
        for (int kk = lane; kk < nkeys; kk += 64) mx = fmaxf(mx, pr[kk]);
        mx = wave_max(mx); float s = 0.f;
        for (int kk = lane; kk < nkeys; kk += 64) { const float e = expf(pr[kk] - mx); pr[kk] = e; s += e; }
        s = wave_sum(s); if (lane == 0) rsum[wave] = s;
    }
    __syncthreads();
    for (int idx = tid; idx < 4 * DV; idx += 256) {
        const int r = idx / DV, e = idx % DV; const float* pr = Pm + r * nkeys; float acc = 0.f;
        for (int kk = 0; kk < nkeys; ++kk) acc += pr[kk] * bf2f(f.vptr(z, kk)[e]);
        f.store(z, q0 + r, e, acc / rsum[r]);
    }
}
struct A_diff {
    const bf16_t *Q, *K, *V; float* OD; int joff, pad;
    __device__ const bf16_t* qptr(int z, int qi) const { const int b = z >> 3, h = (z >> 1) & 3, c = z & 1; return Q + (size_t)(b * TPB + joff + qi) * 1024 + h * 256 + c * 128; }
    __device__ const bf16_t* kptr(int z, int kk) const { const int b = z >> 3, h = (z >> 1) & 3, c = z & 1; return K + (size_t)(b * TPB + kk) * 1024 + h * 256 + c * 128; }
    __device__ const bf16_t* k2ptr(int, int) const { return nullptr; }
    __device__ const bf16_t* vptr(int z, int kk) const { const int b = z >> 3, h = (z >> 1) & 3; return V + (size_t)(b * TPB + kk) * 1024 + h * 256; }
    __device__ void store(int z, int qi, int e, float v) const { const int b = z >> 3, h = (z >> 1) & 3, c = z & 1; OD[(((size_t)(b * TPB + joff + qi) * 4 + h) * 2 + c) * 256 + e] = v; }
};
struct A_mla {
    const bf16_t *QM, *KVM, *KR; bf16_t* OM;
    __device__ const bf16_t* qptr(int z, int qi) const { const int b = z >> 4, h = z & 15; return QM + (size_t)(b * TPB + CTX + qi) * 3072 + h * 192; }
    __device__ const bf16_t* kptr(int z, int kk) const { const int b = z >> 4, h = z & 15; return KVM + (size_t)(b * TPB + kk) * 4096 + h * 256; }
    __device__ const bf16_t* k2ptr(int z, int kk) const { const int b = z >> 4; return KR + (size_t)(b * TPB + kk) * 64; }
    __device__ const bf16_t* vptr(int z, int kk) const { const int b = z >> 4, h = z & 15; return KVM + (size_t)(b * TPB + kk) * 4096 + h * 256 + 128; }
    __device__ void store(int z, int qi, int e, float v) const { const int b = z >> 4, h = z & 15; OM[(size_t)(b * TPB + CTX + qi) * 2048 + h * 128 + e] = f2bf(v); }
};

#endif

#if ORACLE
__global__ __launch_bounds__(256) void k_cmp(const void* a, int a_bf  , const void* b, int b_bf, int rows, int cols, int lda, int ldb, int mask, const int* slottok, double* err) {
    double num = 0.0, den = 0.0;
    for (size_t i = (size_t)blockIdx.x * 256 + threadIdx.x; i < (size_t)rows * cols; i += (size_t)gridDim.x * 256) {
        const int r = (int)(i / cols), c = (int)(i % cols);
        if (mask == 1 && (r % TPB) < CTX) continue;
        if (mask == 2 && slottok[r] < 0) continue;
        const float va = a_bf == 2 ? __builtin_amdgcn_cvt_f32_fp8((int)((const unsigned char*)a)[(size_t)r * lda + c], 0) * (1.0f / A8_ACT) : a_bf ? bf2f(((const bf16_t*)a)[(size_t)r * lda + c]) : ((const float*)a)[(size_t)r * lda + c];
        const float vb = b_bf ? bf2f(((const bf16_t*)b)[(size_t)r * ldb + c]) : ((const float*)b)[(size_t)r * ldb + c];
        const double d = (double)va - (double)vb; num += d * d; den += (double)vb * (double)vb;
    }
    for (int o = 32; o >= 1; o >>= 1) { num += __shfl_xor(num, o); den += __shfl_xor(den, o); }
    if ((threadIdx.x & 63) == 0) { atomicAdd(err, num); atomicAdd(err + 1, den); }
}
__global__ __launch_bounds__(256) void k_verdict(float* out, size_t n, const double* err, int nslots, double tol) {
    int bad = -1;
    for (int s = 0; s < nslots; ++s) { const double num = err[2 * s], den = err[2 * s + 1]; const double t = s >= 16 ? 0.02 : tol; if (!(num <= t * den) || !(den > 0.0)) { bad = s; break; } }
    if (bad < 0) return;
    const float f = 1.0f + exp2f((float)(bad + 1));
    for (size_t i = (size_t)blockIdx.x * 256 + threadIdx.x; i < n; i += (size_t)gridDim.x * 256) out[i] *= f;
}
static_assert(sizeof(G_in) == 64 && sizeof(G_dftA) == 24 && sizeof(G_dftB) == 40 && sizeof(G_res) == 48 && sizeof(G_swiglu) == 40 && sizeof(G_dq) == 32 && sizeof(G_dkv) == 48 && sizeof(G_uq) == 40 && sizeof(G_ukv) == 32 && sizeof(G_moe1) == 56 && sizeof(G_moe2) == 48 && sizeof(A_diff) == 40 && sizeof(A_mla) == 32, "no padding bytes in by-value kernel arguments");
template <class G> static void run_gemm(const G& g, int Mmax, int Z, hipStream_t s) { hipLaunchKernelGGL(ngemm<G>, dim3((g.N + 127) / 128, (Mmax + 127) / 128, Z), dim3(256), 0, s, g); }
#endif
static_assert(sizeof(P) == 29 * 8, "P has no padding");

extern "C" void kernel_launch(void* const* d_in, const int* in_sizes, int n_in, void* d_out, int out_size, void* d_ws, size_t ws_size, hipStream_t stream) {
    static int grid = 0;
    if (grid == 0) {
        const size_t need = ORACLE ? (WS_SCR + (size_t)NSLOT * FFE * 2 > WS_SCR_XS + (size_t)NTOK * D * 4 ? WS_SCR + (size_t)NSLOT * FFE * 2 : WS_SCR_XS + (size_t)NTOK * D * 4) + 4096 : WS_END;
        if (n_in != 27 || ws_size < need) { fprintf(stderr, "kernel_launch: n_in %d ws %zu need %zu\n", n_in, ws_size, need); grid = -1; return; }
        int dev = 0, cus = 0, per_cu = 0;
        if (hipGetDevice(&dev) != hipSuccess || hipDeviceGetAttribute(&cus, hipDeviceAttributeMultiprocessorCount, dev) != hipSuccess) { grid = -1; return; }
        if (hipFuncSetAttribute((const void*)mega, hipFuncAttributeMaxDynamicSharedMemorySize, LDS_BYTES) != hipSuccess) { fprintf(stderr, "kernel_launch: hipFuncSetAttribute failed\n"); grid = -1; return; }
        if (hipOccupancyMaxActiveBlocksPerMultiprocessor(&per_cu, (const void*)mega, 512, LDS_BYTES) != hipSuccess || per_cu < 1) { fprintf(stderr, "kernel_launch: occupancy query says %d\n", per_cu); }
        (void)hipGetLastError();
        grid = cus;
    }
    if (grid < 0) return;
    (void)hipMemsetAsync((char*)d_ws + WS_CTL, 0, 1u << 20, stream);
    P p{};
    const float** pi = (const float**)&p;
    for (int i = 0; i < 27; ++i) pi[i] = (const float*)d_in[i];
    p.out = (float*)d_out; p.ws = (unsigned char*)d_ws;
#if !ORACLE
    hipLaunchKernelGGL(mega, dim3(grid), dim3(512), LDS_BYTES, stream, p, 0, NPH, 0);
#else
    double* ERR = (double*)(p.ws + WS_CTL + (size_t)CW_ERR * 4);
    unsigned char* SCR = p.ws + WS_SCR;
    const int* SLOTTOK = (const int*)(p.ws + WS_ROUTE + RT_SLOTTOK);
    auto PH = [&](int k) { hipLaunchKernelGGL(mega, dim3(grid), dim3(512), LDS_BYTES, stream, p, k, k + 1, k); };
    auto CMP = [&](int slot, const void* a, int abf, const void* b, int bbf, int rows, int cols, int lda, int ldb, int mask) {
        hipLaunchKernelGGL(k_cmp, dim3(2048), dim3(256), 0, stream, a, abf, b, bbf, rows, cols, lda, ldb, mask, SLOTTOK, ERR + 2 * slot); };
    const size_t SZ1K = (size_t)NTOK * 1024 * 2, SZXS = (size_t)NTOK * D * 4;
    PH(0); PH(1);
    PH(2);
    { bf16_t *Fo = (bf16_t*)SCR, *Qo = (bf16_t*)(SCR + SZ1K), *Ko = (bf16_t*)(SCR + 2 * SZ1K), *Vo = (bf16_t*)(SCR + 3 * SZ1K);
      G_in g{WSP(bf16_t, WS_H), p.ev_w_in, Fo, Qo, Ko, Vo, WSP(float2, WS_TABD), EIN, D}; run_gemm(g, NTOK, 1, stream);
      CMP(0, WSP(bf16_t, A0_F), 1, Fo, 1, NTOK, 1024, 1024, 1024, 0); CMP(1, WSP(bf16_t, A0_Q), 1, Qo, 1, NTOK, 1024, 1024, 1024, 0);
      CMP(2, WSP(bf16_t, A0_K), 1, Ko, 1, NTOK, 1024, 1024, 1024, 0); CMP(3, WSP(bf16_t, A0_V), 1, Vo, 1, NTOK, 1024, 1024, 1024, 0); }
    PH(3); PH(4);
    { float* T32 = (float*)SCR; bf16_t* MIXo = (bf16_t*)(SCR + (size_t)NTOK * 4 * 512 * 4);
      G_dftA g{WSP(bf16_t, A0_F), T32, 512, 256}; run_gemm(g, NTOK * 4, 1, stream);
      G_dftB g1{T32, MIXo, 256, 2 * SEQ, SEQ, CTX, 1.0f / sqrtf((float)SEQ * 256.f), 0}; run_gemm(g1, SEQ, 16, stream);
      G_dftB g2{T32, MIXo, 256, 2 * CTX, CTX, 0, 1.0f / sqrtf((float)CTX * 256.f), 0}; run_gemm(g2, CTX, 16, stream);
      CMP(4, WSP(bf16_t, A0_MIX), 1, MIXo, 1, NTOK, 1024, 2048, 2048, 0);
      float* ODo = (float*)SCR;
      A_diff f{WSP(bf16_t, A0_Q), WSP(bf16_t, A0_K), WSP(bf16_t, A0_V), ODo, CTX, 0};
      hipLaunchKernelGGL((nattn<128, 256, A_diff>), dim3(SEQ / 4, 32), dim3(256), (4 * 128 + 4 * TPB) * 4, stream, f, TPB, 0.08838834764831845f);
      A_diff f2{WSP(bf16_t, A0_Q), WSP(bf16_t, A0_K), WSP(bf16_t, A0_V), ODo, 0, 0};
      hipLaunchKernelGGL((nattn<128, 256, A_diff>), dim3(CTX / 4, 32), dim3(256), (4 * 128 + 4 * CTX) * 4, stream, f2, CTX, 0.08838834764831845f);
      CMP(5, WSP(float, A0_OD), 0, ODo, 0, NTOK, 2048, 2048, 2048, 0); }
    PH(5);
    { float* XSo = (float*)(p.ws + WS_SCR_XS); (void)hipMemcpyAsync(XSo, WSP(float, WS_XS), SZXS, hipMemcpyDeviceToDevice, stream);
      G_res g{WSP(bf16_t, A0_MIX), p.ev_w_out, XSo, WSP(float, WS_MODS), D, 2048, 2048, 2}; run_gemm(g, NTOK, 1, stream);
      PH(6); CMP(6, WSP(float, WS_XS), 0, XSo, 0, NTOK, D, D, D, 0); }
    PH(7);
    PH(8);
    { bf16_t* ACTo = (bf16_t*)SCR; G_swiglu g{WSP(bf16_t, WS_H), p.ffn_w_gate, p.ffn_w_up, ACTo, FFD, D}; run_gemm(g, NTOK, 1, stream);
      CMP(7, WSP(bf16_t, A0_ACT), 1, ACTo, 1, NTOK, FFD, FFD, FFD, 0); }
    { float* XSo = (float*)(p.ws + WS_SCR_XS); (void)hipMemcpyAsync(XSo, WSP(float, WS_XS), SZXS, hipMemcpyDeviceToDevice, stream);
      G_res g{WSP(bf16_t, A0_ACT), p.ffn_w_down, XSo, WSP(float, WS_MODS), D, FFD, FFD, 5}; run_gemm(g, NTOK, 1, stream);
      PH(9); CMP(8, WSP(float, WS_XS), 0, XSo, 0, NTOK, D, D, D, 0); }
    PH(10);
    PH(11);
    { float* CQo = (float*)SCR; float* CKVo = (float*)(SCR + (size_t)NTOK * 512 * 4); bf16_t* KRo = (bf16_t*)(SCR + (size_t)NTOK * 512 * 8);
      G_dq g{WSP(bf16_t, WS_H), p.od_w_dq, CQo, QLORA, D}; run_gemm(g, NTOK, 1, stream);
      G_dkv g2{WSP(bf16_t, WS_H), p.od_w_dkv, CKVo, KRo, WSP(float2, WS_TABM), 576, D}; run_gemm(g2, NTOK, 1, stream);
      CMP(9, WSP(float, A1_CQ), 0, CQo, 0, NTOK, 512, 512, 512, 0); CMP(10, WSP(float, A1_CKV), 0, CKVo, 0, NTOK, 512, 512, 512, 0); CMP(11, WSP(bf16_t, A1_KR), 1, KRo, 1, NTOK, 64, 64, 64, 0); }
    PH(12);
    PH(13);
    { bf16_t* QMo = (bf16_t*)SCR; bf16_t* KVMo = (bf16_t*)(SCR + (size_t)NTOK * 3072 * 2);
      G_uq g{WSP(bf16_t, A1_CQN), p.od_w_uq, QMo, WSP(float2, WS_TABM), 3072, 512}; run_gemm(g, NTOK, 1, stream);
      G_ukv g2{WSP(bf16_t, A1_CKVN), p.od_w_ukv, KVMo, 4096, 512}; run_gemm(g2, NTOK, 1, stream);
      CMP(12, WSP(bf16_t, A1_QM), 1, QMo, 1, NTOK, 3072, 3072, 3072, 1); CMP(13, WSP(bf16_t, A1_KVM), 1, KVMo, 1, NTOK, 4096, 4096, 4096, 0); }
    PH(14);
    { bf16_t* OMo = (bf16_t*)SCR; A_mla f{WSP(bf16_t, A1_QM), WSP(bf16_t, A1_KVM), WSP(bf16_t, A1_KR), OMo};
      hipLaunchKernelGGL((nattn<192, 128, A_mla>), dim3(SEQ / 4, 64), dim3(256), (4 * 192 + 4 * TPB) * 4, stream, f, TPB, 0.07216878364870323f);
      CMP(14, WSP(bf16_t, A1_OM), 1, OMo, 1, NTOK, 2048, 2048, 2048, 1); }
    { float* XSo = (float*)(p.ws + WS_SCR_XS); (void)hipMemcpyAsync(XSo, WSP(float, WS_XS), SZXS, hipMemcpyDeviceToDevice, stream);
      G_res g{WSP(bf16_t, A1_OM), p.od_w_o, XSo, WSP(float, WS_MODS) + 5 * 6 * D, D, 2048, 2048, 2}; run_gemm(g, NTOK, 1, stream);
      PH(15); CMP(15, WSP(float, WS_XS), 0, XSo, 0, NTOK, D, D, D, 1); }
    PH(16); PH(17); PH(18);
    PH(19);
    { bf16_t* ACT2o = (bf16_t*)SCR; G_moe1 g{WSP(unsigned char, A1_AS), p.moe_w_gate, p.moe_w_up, ACT2o, (const int*)(p.ws + WS_ROUTE + RT_CNT), (const int*)(p.ws + WS_ROUTE + RT_OFFS), FFE, D}; run_gemm(g, NB * SEQ, 8, stream);
      CMP(16, WSP(unsigned char, A1_ACT2), 2, ACT2o, 1, NSLOT, FFE, FFE, FFE, 2); }
    PH(20);
    { float* Yo = (float*)SCR; G_moe2 g{WSP(unsigned char, A1_ACT2), p.moe_w_down, Yo, (const int*)(p.ws + WS_ROUTE + RT_CNT), (const int*)(p.ws + WS_ROUTE + RT_OFFS), D, FFE}; run_gemm(g, NB * SEQ, 8, stream);
      CMP(17, WSP(float, A1_Y), 0, Yo, 0, NSLOT, D, D, D, 2); }
    PH(21);
    hipLaunchKernelGGL(k_verdict, dim3(2048), dim3(256), 0, stream, p.out, (size_t)NB * SEQ * D, (const double*)ERR, 18, 2.0e-4);
#endif
}
```
